# Optimizing an MI355X kernel written in HIP

```python
import jax, jax.numpy as jnp
from jax import lax
import numpy as np

D_MODEL = 1024
BATCH = 4
SEQ = 8192
DEPTH = 2

RWKV_HEADS = 8
RWKV_HEAD_DIM = 64
RWKV_WIDTH = RWKV_HEADS * RWKV_HEAD_DIM
DECAY_LORA = 64
ICLR_LORA = 64
GATE_LORA = 128
ATTN_HEADS = 8
ATTN_HEAD_DIM = 64
ATTN_WIDTH = ATTN_HEADS * ATTN_HEAD_DIM
MOBA_BLOCK = 256
MOBA_TOP_K = 3
Q_CHUNK = 128
POOL_WINDOWS = (2, 4, 8, 16)
POOL_GROUPS = 4
POOL_GROUP_DIM = 128
POOL_WIDTH = POOL_GROUPS * POOL_GROUP_DIM
N_BRANCH = 3
D_FF = 4 * D_MODEL
RMS_EPS = 1e-6
GN_EPS = 64e-5
NEG_INF = -1e30

RWKV_IN = 3 * RWKV_WIDTH + DECAY_LORA + ICLR_LORA + GATE_LORA
ATTN_IN = 3 * ATTN_WIDTH
GATE_IN = N_BRANCH * D_MODEL
N_IN = RWKV_IN + ATTN_IN + POOL_WIDTH + GATE_IN

kernel_name = 'hybrid_rwkv7_moba_pool_gated_block'


def rms_norm(x, g):
    x = x.astype(jnp.float32)
    return x * lax.rsqrt(jnp.mean(x * x, axis=-1, keepdims=True) + RMS_EPS) * g.astype(jnp.float32)


def token_shift(p):
    return jnp.pad(p, ((0, 0), (1, 0), (0, 0)))[:, :-1]


def rwkv7_time_mix(p, mu, w0, w_up, a0, a_up, g_up, k_k, k_a, r_k, lnx_g, lnx_b):
    B, T, _ = p.shape
    H, N, W = RWKV_HEADS, RWKV_HEAD_DIM, RWKV_WIDTH
    p = p + (token_shift(p) - p) * mu
    o3 = 3 * W
    o4 = o3 + DECAY_LORA
    o5 = o4 + ICLR_LORA
    r, k, v = p[..., :W], p[..., W:2 * W], p[..., 2 * W:o3]
    xw, xa, xg = p[..., o3:o4], p[..., o4:o5], p[..., o5:]
    w_log = -jax.nn.softplus(-(w0 + jnp.tanh(xw) @ w_up)) - 0.5
    decay = jnp.exp(-jnp.exp(w_log))
    a = jax.nn.sigmoid(a0 + xa @ a_up)
    g = jax.nn.sigmoid(xg) @ g_up
    heads = lambda t: t.reshape(B, T, H, N)
    kk = heads(k * k_k)
    kk = kk / jnp.maximum(jnp.linalg.norm(kk, axis=-1, keepdims=True), 1e-12)
    k = k * (1.0 + (a - 1.0) * k_a)
    r, decay, k, v, a = heads(r), heads(decay), heads(k), heads(v), heads(a)

    def step(S, inp):
        r_t, w_t, k_t, v_t, a_t, b_t = inp
        sa = jnp.einsum('bhvk,bhk->bhv', S, a_t)
        S = S * w_t[:, :, None, :] + sa[..., None] * b_t[:, :, None, :] + v_t[..., None] * k_t[:, :, None, :]
        return S, jnp.einsum('bhvk,bhk->bhv', S, r_t)

    xs = tuple(jnp.swapaxes(t, 0, 1) for t in (r, decay, k, v, -kk, kk * a))
    S0 = jnp.zeros((B, H, N, N), jnp.float32)
    _, o = lax.scan(step, S0, xs)
    o = jnp.swapaxes(o, 0, 1)
    mean = jnp.mean(o, axis=-1, keepdims=True)
    var = jnp.mean(jnp.square(o - mean), axis=-1, keepdims=True)
    o = ((o - mean) * lax.rsqrt(var + GN_EPS)).reshape(B, T, W) * lnx_g + lnx_b
    bonus = jnp.sum(r * k * r_k, axis=-1, keepdims=True) * v
    return (o + bonus.reshape(B, T, W)) * g


def moba_attention(q, k, v):
    B, T, H, Dh = q.shape
    NB = -(-T // MOBA_BLOCK)
    Tp = NB * MOBA_BLOCK
    NC = Tp // Q_CHUNK
    ks = min(MOBA_TOP_K, NB)
    pad = ((0, 0), (0, Tp - T), (0, 0), (0, 0))
    q, k, v = (jnp.pad(t, pad).transpose(0, 2, 1, 3) for t in (q, k, v))
    kb = k.reshape(B, H, NB, MOBA_BLOCK, Dh)
    vb = v.reshape(B, H, NB, MOBA_BLOCK, Dh)
    k_mean = jnp.mean(kb, axis=3)
    gate = jnp.einsum('bhtd,bhnd->bhtn', q, k_mean)
    q_blk = jnp.arange(Tp) // MOBA_BLOCK
    past = jnp.arange(NB)[None, :] < q_blk[:, None]
    gate = jnp.where(past, gate, NEG_INF)
    _, sel = lax.top_k(gate, ks)
    valid = sel < q_blk[:, None]
    slopes = jnp.asarray(2.0 ** (-8.0 * np.arange(1, H + 1) / H), jnp.float32)
    scale = Dh ** -0.5
    offs = jnp.arange(MOBA_BLOCK)
    head_idx = jnp.arange(H)[:, None, None]

    def per_batch(args):
        qb, kbb, vbb, selb, validb = args

        def to_chunks(t):
            return jnp.swapaxes(t.reshape(H, NC, Q_CHUNK, *t.shape[2:]), 0, 1)

        def chunk(cargs):
            c, qc, sc, vc = cargs
            t_pos = c * Q_CHUNK + jnp.arange(Q_CHUNK)
            own = (c * Q_CHUNK) // MOBA_BLOCK
            k_own = lax.dynamic_index_in_dim(kbb, own, axis=1, keepdims=False)
            v_own = lax.dynamic_index_in_dim(vbb, own, axis=1, keepdims=False)
            k_sel = kbb[head_idx, sc]
            v_sel = vbb[head_idx, sc]
            dist_own = (t_pos[:, None] - (own * MOBA_BLOCK + offs)[None, :]).astype(jnp.float32)
            dist_sel = (t_pos[None, :, None, None] - (sc[..., None] * MOBA_BLOCK + offs)).astype(jnp.float32)
            l_own = jnp.einsum('hcd,hsd->hcs', qc, k_own) * scale - slopes[:, None, None] * dist_own
            l_own = jnp.where(dist_own >= 0, l_own, NEG_INF)
            l_sel = jnp.einsum('hcd,hcjsd->hcjs', qc, k_sel) * scale - slopes[:, None, None, None] * dist_sel
            l_sel = jnp.where(vc[..., None], l_sel, NEG_INF)
            logits = jnp.concatenate([l_sel.reshape(H, Q_CHUNK, ks * MOBA_BLOCK), l_own], axis=-1)
            prob = jax.nn.softmax(logits, axis=-1)
            p_sel = prob[..., :ks * MOBA_BLOCK].reshape(H, Q_CHUNK, ks, MOBA_BLOCK)
            p_own = prob[..., ks * MOBA_BLOCK:]
            return jnp.einsum('hcs,hsd->hcd', p_own, v_own) + jnp.einsum('hcjs,hcjsd->hcd', p_sel, v_sel)

        out = lax.map(chunk, (jnp.arange(NC), to_chunks(qb), to_chunks(selb), to_chunks(validb)))
        return jnp.swapaxes(out, 0, 1).reshape(H, Tp, Dh)

    out = lax.map(per_batch, (q, kb, vb, sel, valid))
    return out.transpose(0, 2, 1, 3)[:, :T].reshape(B, T, H * Dh)


def pool_mix(u, pool_w, pool_scale):
    B, T, _ = u.shape
    ug = u.reshape(B, T, POOL_GROUPS, POOL_GROUP_DIM)
    cs = jnp.cumsum(ug, axis=1)
    outs = []
    for gi, w in enumerate(POOL_WINDOWS):
        c = cs[:, :, gi]
        lo = jnp.pad(c[:, :T - w], ((0, 0), (w, 0), (0, 0)))
        count = jnp.minimum(jnp.arange(T) + 1, w).astype(jnp.float32)[None, :, None]
        outs.append((c - lo) / count - ug[:, :, gi])
    d = jnp.stack(outs, axis=2)
    y = jnp.einsum('btgc,gcd->btgd', d, pool_w).reshape(B, T, POOL_WIDTH)
    return y * pool_scale


def setup_inputs(seed: int = 0) -> dict:
    key = jax.random.key(seed)
    ks = jax.random.split(key, 24)
    L, D, W = DEPTH, D_MODEL, RWKV_WIDTH
    nrm = lambda k, s: jax.random.normal(k, s, jnp.float32)
    return {
        'x': nrm(ks[0], (BATCH, SEQ, D)),
        'norm1_g': 1.0 + 0.05 * nrm(ks[1], (L, D)),
        'w_in': nrm(ks[2], (L, D, N_IN)) * D ** -0.5,
        'shift_mu': jax.random.uniform(ks[3], (L, RWKV_IN), jnp.float32),
        'w0': jax.random.uniform(ks[4], (L, W), jnp.float32, minval=-6.0, maxval=-1.0),
        'w_up': nrm(ks[5], (L, DECAY_LORA, W)) * 0.5 * DECAY_LORA ** -0.5,
        'a0': 0.5 * nrm(ks[6], (L, W)),
        'a_up': nrm(ks[7], (L, ICLR_LORA, W)) * 0.5 * ICLR_LORA ** -0.5,
        'g_up': nrm(ks[8], (L, GATE_LORA, W)) * GATE_LORA ** -0.5,
        'k_k': 0.85 + 0.05 * nrm(ks[9], (L, W)),
        'k_a': 1.0 + 0.05 * nrm(ks[10], (L, W)),
        'r_k': 0.1 * nrm(ks[11], (L, RWKV_HEADS, RWKV_HEAD_DIM)),
        'lnx_g': 1.0 + 0.05 * nrm(ks[12], (L, W)),
        'lnx_b': 0.01 * nrm(ks[13], (L, W)),
        'qn_g': 1.0 + 0.05 * nrm(ks[14], (L, ATTN_HEAD_DIM)),
        'kn_g': 1.0 + 0.05 * nrm(ks[15], (L, ATTN_HEAD_DIM)),
        'pool_w': nrm(ks[16], (L, POOL_GROUPS, POOL_GROUP_DIM, POOL_GROUP_DIM)) * POOL_GROUP_DIM ** -0.5,
        'pool_scale': 1.0 + 0.1 * nrm(ks[17], (L, POOL_WIDTH)),
        'w_branch': nrm(ks[18], (L, N_BRANCH, W, D)) * W ** -0.5,
        'w_out': nrm(ks[19], (L, D, D)) * D ** -0.5,
        'norm2_g': 1.0 + 0.05 * nrm(ks[20], (L, D)),
        'w_ff1': nrm(ks[21], (L, D, D_FF)) * D ** -0.5,
        'w_ff2': nrm(ks[22], (L, D_FF, D)) * D_FF ** -0.5,
    }


def reference(x, norm1_g, w_in, shift_mu, w0, w_up, a0, a_up, g_up, k_k, k_a, r_k, lnx_g, lnx_b,
              qn_g, kn_g, pool_w, pool_scale, w_branch, w_out, norm2_g, w_ff1, w_ff2):
    B, T, _ = x.shape
    out_dtype = x.dtype
    x = x.astype(jnp.float32)
    o1 = RWKV_IN
    o2 = o1 + ATTN_IN
    o3 = o2 + POOL_WIDTH
    for l in range(DEPTH):
        h = rms_norm(x, norm1_g[l])
        proj = h @ w_in[l]
        p_rwkv, p_attn, p_pool, p_gate = proj[..., :o1], proj[..., o1:o2], proj[..., o2:o3], proj[..., o3:]
        y_rwkv = rwkv7_time_mix(p_rwkv, shift_mu[l], w0[l], w_up[l], a0[l], a_up[l], g_up[l],
                                k_k[l], k_a[l], r_k[l], lnx_g[l], lnx_b[l])
        q = p_attn[..., :ATTN_WIDTH].reshape(B, T, ATTN_HEADS, ATTN_HEAD_DIM)
        k = p_attn[..., ATTN_WIDTH:2 * ATTN_WIDTH].reshape(B, T, ATTN_HEADS, ATTN_HEAD_DIM)
        v = p_attn[..., 2 * ATTN_WIDTH:].reshape(B, T, ATTN_HEADS, ATTN_HEAD_DIM)
        y_attn = moba_attention(rms_norm(q, qn_g[l]), rms_norm(k, kn_g[l]), v)
        y_pool = pool_mix(p_pool, pool_w[l], pool_scale[l])
        ys = jnp.stack([y_rwkv, y_attn, y_pool], axis=2)
        branch = jnp.einsum('btnc,ncd->btnd', ys, w_branch[l])
        gates = jax.nn.sigmoid(p_gate.reshape(B, T, N_BRANCH, D_MODEL))
        x = x + jnp.sum(gates * branch, axis=2) @ w_out[l]
        h2 = rms_norm(x, norm2_g[l])
        x = x + jnp.square(jax.nn.relu(h2 @ w_ff1[l])) @ w_ff2[l]
    return x.astype(out_dtype)
```

```cpp
#include <hip/hip_runtime.h>
#include <cstdio>
#include <cstdint>
namespace pg8 {
#define PG8_LAS __attribute__((address_space(3)))
typedef unsigned short bf16_t;
typedef short bf16x8 __attribute__((ext_vector_type(8)));
typedef float f32x4 __attribute__((ext_vector_type(4)));
typedef unsigned u32x4 __attribute__((ext_vector_type(4)));
constexpr int BM = 256, BK = 64, HALF = 128, HTB = HALF * BK * 2  , STAGE_BYTES = 8 * HTB, NXCD = 8, WGM = 8;

__host__ __device__ __forceinline__ int lds_byte(int r, int c) { const int st = (r >> 4) * 2 + (c >> 5), rr = r & 15, cc = c & 31, ob = rr * 64 + cc * 2; return st * 1024 + (ob ^ (((ob >> 9) & 1) << 5)); }
__host__ __device__ __forceinline__ void stage_rc(int b, int& R, int& C) { const int st = b / 1024, sb = b % 1024, swz = sb ^ (((sb >> 9) & 1) << 5); R = (st >> 1) * 16 + swz / 64; C = (st & 1) * 32 + (swz % 64) / 2; }
__host__ __device__ __forceinline__ int perm32(int rho) { const int n = rho >> 4, i = rho & 15; return 8 * (i >> 2) + 4 * n + (i & 3); }

struct Unit { int pm, pn; };
struct Gemm { const bf16_t* A; const bf16_t* Bt; int M, N, K, lda, ldb; };

struct StaticOrder {
    int nM, nN, nwg, G, c;
    __host__ __device__ void init(int M, int N, int G_, int c_) { nM = M / BM; nN = N / BM; nwg = nM * nN; G = G_; c = c_; }
    __host__ __device__ bool next(int i, Unit& u) const {
        const long L = (long)i * G + c; if (L >= nwg) return false;
        int wgid = (int)L; { const int q = nwg / NXCD, r = nwg % NXCD, xcd = wgid % NXCD, off = wgid / NXCD; wgid = (xcd < r ? xcd * (q + 1) : r * (q + 1) + (xcd - r) * q) + off; }
        const int nig = WGM * nN, gid = wgid / nig, fm = gid * WGM, gsz = (nM - fm) < WGM ? (nM - fm) : WGM;
        u.pm = fm + ((wgid % nig) % gsz); u.pn = (wgid % nig) / gsz; return true;
    }
    __device__ __forceinline__ void a_ready(const Unit&) const {}
    __device__ __forceinline__ void done(const Unit&) const {}
};

__device__ __forceinline__ unsigned cvt_pk_bf16(float lo, float hi) { unsigned r; asm volatile("v_cvt_pk_bf16_f32 %0, %1, %2" : "=v"(r) : "v"(lo), "v"(hi)); return r; }
__device__ __forceinline__ float sigm(float x) { return 1.0f / (1.0f + __expf(-x)); }
__device__ __forceinline__ float bf_lo(unsigned w) { return __builtin_bit_cast(float, w << 16); }
__device__ __forceinline__ float bf_hi(unsigned w) { return __builtin_bit_cast(float, w & 0xffff0000u); }
struct EpiA {
    static constexpr bool PERM = true, AFTER_DRAIN = false;
    bf16_t *RW, *AT, *PL;
    __device__ __forceinline__ void operator()(const f32x4 (&acc)[2][2][4][2], const Unit& u, int wr, int wc, int fr, int fq) const {
        bf16_t* base; int ldc, colt;
        if (u.pn < 7) { base = RW; ldc = 1792; colt = u.pn * 256; } else if (u.pn < 13) { base = AT; ldc = 1536; colt = (u.pn - 7) * 256; } else { base = PL; ldc = 512; colt = (u.pn - 13) * 256; }
        const int row0 = u.pm * BM + wr * 64 + fr, col0 = colt + wc * 32 + 8 * fq;
#pragma unroll
        for (int ai = 0; ai < 2; ++ai)
#pragma unroll
            for (int m = 0; m < 4; ++m) { bf16_t* rowp = base + (size_t)(row0 + ai * HALF + m * 16) * ldc + col0;
#pragma unroll
                for (int bj = 0; bj < 2; ++bj) { const f32x4 v0 = acc[ai][bj][m][0], v1 = acc[ai][bj][m][1];
                    u32x4 w; w.x = cvt_pk_bf16(v0[0], v0[1]); w.y = cvt_pk_bf16(v0[2], v0[3]); w.z = cvt_pk_bf16(v1[0], v1[1]); w.w = cvt_pk_bf16(v1[2], v1[3]);
                    *(u32x4*)(rowp + bj * HALF) = w; } }
    }
};
template <int MODE> struct EpiAct {
    static constexpr bool PERM = true, AFTER_DRAIN = false;
    bf16_t* O; int ldc;
    __device__ __forceinline__ void operator()(const f32x4 (&acc)[2][2][4][2], const Unit& u, int wr, int wc, int fr, int fq) const {
        const int row0 = u.pm * BM + wr * 64 + fr, col0 = u.pn * BM + wc * 32 + 8 * fq;
#pragma unroll
        for (int ai = 0; ai < 2; ++ai)
#pragma unroll
            for (int m = 0; m < 4; ++m) { bf16_t* rowp = O + (size_t)(row0 + ai * HALF + m * 16) * ldc + col0;
#pragma unroll
                for (int bj = 0; bj < 2; ++bj) { f32x4 v0 = acc[ai][bj][m][0], v1 = acc[ai][bj][m][1];
#pragma unroll
                    for (int e = 0; e < 4; ++e) {
                        if (MODE == 1) { v0[e] = sigm(v0[e]); v1[e] = sigm(v1[e]); }
                        if (MODE == 2) { const float a = fmaxf(v0[e], 0.f), b = fmaxf(v1[e], 0.f); v0[e] = a * a; v1[e] = b * b; } }
                    u32x4 w; w.x = cvt_pk_bf16(v0[0], v0[1]); w.y = cvt_pk_bf16(v0[2], v0[3]); w.z = cvt_pk_bf16(v1[0], v1[1]); w.w = cvt_pk_bf16(v1[2], v1[3]);
                    *(u32x4*)(rowp + bj * HALF) = w; } }
    }
};
template <bool FIRST> struct EpiBr {
    static constexpr bool PERM = true, AFTER_DRAIN = false;
    const bf16_t* GB; bf16_t* MBuf;
    __device__ __forceinline__ void operator()(const f32x4 (&acc)[2][2][4][2], const Unit& u, int wr, int wc, int fr, int fq) const {
        const int row0 = u.pm * BM + wr * 64 + fr, col0 = u.pn * BM + wc * 32 + 8 * fq;
#pragma unroll
        for (int ai = 0; ai < 2; ++ai)
#pragma unroll
            for (int m = 0; m < 4; ++m) { const size_t off = (size_t)(row0 + ai * HALF + m * 16) * 1024 + col0;
#pragma unroll
                for (int bj = 0; bj < 2; ++bj) { const f32x4 v0 = acc[ai][bj][m][0], v1 = acc[ai][bj][m][1];
                    const u32x4 gw = *(const u32x4*)(GB + off + bj * HALF);
                    float o[8] = {bf_lo(gw.x) * v0[0], bf_hi(gw.x) * v0[1], bf_lo(gw.y) * v0[2], bf_hi(gw.y) * v0[3], bf_lo(gw.z) * v1[0], bf_hi(gw.z) * v1[1], bf_lo(gw.w) * v1[2], bf_hi(gw.w) * v1[3]};
                    if (!FIRST) { const u32x4 mw = *(const u32x4*)(MBuf + off + bj * HALF);
                        o[0] += bf_lo(mw.x); o[1] += bf_hi(mw.x); o[2] += bf_lo(mw.y); o[3] += bf_hi(mw.y); o[4] += bf_lo(mw.z); o[5] += bf_hi(mw.z); o[6] += bf_lo(mw.w); o[7] += bf_hi(mw.w); }
                    u32x4 w; w.x = cvt_pk_bf16(o[0], o[1]); w.y = cvt_pk_bf16(o[2], o[3]); w.z = cvt_pk_bf16(o[4], o[5]); w.w = cvt_pk_bf16(o[6], o[7]);
                    *(u32x4*)(MBuf + off + bj * HALF) = w; } }
    }
};
struct EpiRes {
    static constexpr bool PERM = false, AFTER_DRAIN = false;
    const float* base; float* out;
    __device__ __forceinline__ void operator()(const f32x4 (&acc)[2][2][4][2], const Unit& u, int wr, int wc, int fr, int fq) const {
        const int row0 = u.pm * BM + wr * 64 + fr, col0 = u.pn * BM + wc * 32 + 4 * fq;
#pragma unroll
        for (int ai = 0; ai < 2; ++ai)
#pragma unroll
            for (int m = 0; m < 4; ++m) { const size_t off = (size_t)(row0 + ai * HALF + m * 16) * 1024 + col0;
#pragma unroll
                for (int bj = 0; bj < 2; ++bj)
#pragma unroll
                    for (int n = 0; n < 2; ++n) { const f32x4 bs = *(const f32x4*)(base + off + bj * HALF + n * 16); *(f32x4*)(out + off + bj * HALF + n * 16) = bs + acc[ai][bj][m][n]; } }
    }
};
template <class Epi, class Sched, bool ALIGN_EPI = false, bool SP2 = false>
__device__ __forceinline__ void gemm_phase(PG8_LAS unsigned char* lds, const Gemm g, const Sched& S, const Epi& E) {
    const int tid = threadIdx.x, wid = __builtin_amdgcn_readfirstlane(tid >> 6), lane = tid & 63, wr = wid >> 2, wc = wid & 3, fr = lane & 15, fq = lane >> 4;
    const int K = g.K, nt = K / BK;
    unsigned voffA[2], voffB[2];
#pragma unroll
    for (int i = 0; i < 2; ++i) { int R, C; stage_rc(tid * 16 + i * 8192, R, C); const int Rb = Epi::PERM ? ((R & ~31) + perm32(R & 31)) : R;
        voffA[i] = (unsigned)(R * g.lda + C) * 2u; voffB[i] = (unsigned)(Rb * g.ldb + C) * 2u; }
    const size_t kstep = (size_t)(BK * 2);
    const size_t hstepA = (size_t)HALF * g.lda * 2, hstepB = (size_t)HALF * g.ldb * 2;
    const size_t tstepA = 2 * hstepA, tstepB = 2 * hstepB;
    const unsigned ldsw = (unsigned)wid * 1024u;
    const int aoff = lds_byte(wr * 64 + fr, fq * 8), boff = lds_byte(wc * 32 + fr, fq * 8);
#define PG8_SA(b, h) (((b) * 2 + (h)) * HTB)
#define PG8_SB(b, h) ((4 + (b) * 2 + (h)) * HTB)
#define PG8_STAGE(bufoff, gbase, voff) do { _Pragma("unroll") for (int _i = 0; _i < 2; ++_i) \
        __builtin_amdgcn_global_load_lds((const unsigned*)((const char*)(gbase) + (voff)[_i]), (PG8_LAS unsigned*)(lds + (bufoff) + ldsw + _i * 8192), 16, 0, 0); } while (0)
#define PG8_LDA(dst, b, h) do { _Pragma("unroll") for (int m = 0; m < 4; ++m) _Pragma("unroll") for (int k = 0; k < 2; ++k) dst[m][k] = *(const PG8_LAS bf16x8*)(lds + PG8_SA(b, h) + aoff + m * 2048 + k * 1024); } while (0)
#define PG8_LDB(dst, b, h) do { _Pragma("unroll") for (int n = 0; n < 2; ++n) _Pragma("unroll") for (int k = 0; k < 2; ++k) dst[n][k] = *(const PG8_LAS bf16x8*)(lds + PG8_SB(b, h) + boff + n * 2048 + k * 1024); } while (0)
#define PG8_MMA(ai, bj, At, Bt) do { __builtin_amdgcn_s_setprio(1); _Pragma("unroll") for (int m = 0; m < 4; ++m) _Pragma("unroll") for (int n = 0; n < 2; ++n) _Pragma("unroll") for (int k = 0; k < 2; ++k) \
        acc[ai][bj][m][n] = __builtin_amdgcn_mfma_f32_16x16x32_bf16(Bt[n][k], At[m][k], acc[ai][bj][m][n], 0, 0, 0); __builtin_amdgcn_s_setprio(0); } while (0)
#define PG8_WAIT_V(n) asm volatile("s_waitcnt vmcnt(" #n ")" ::: "memory")
#define PG8_WAIT_L(n) asm volatile("s_waitcnt lgkmcnt(" #n ")" ::: "memory")
#define PG8_BAR __builtin_amdgcn_s_barrier()
#define PG8_SCHED __builtin_amdgcn_sched_barrier(0)
    Unit cur, nxt; int ui = 0;
    if (!S.next(0, cur)) return;
    f32x4 acc[2][2][4][2];
#pragma unroll
    for (int a = 0; a < 2; ++a)
#pragma unroll
        for (int b = 0; b < 2; ++b)
#pragma unroll
            for (int m = 0; m < 4; ++m)
#pragma unroll
                for (int n = 0; n < 2; ++n) acc[a][b][m][n] = (f32x4){0.f, 0.f, 0.f, 0.f};
    bf16x8 At[4][2], B0[2][2], B1[2][2];
    const char* cA = (const char*)g.A + (size_t)cur.pm * tstepA; const char* cB = (const char*)g.Bt + (size_t)cur.pn * tstepB;
    S.a_ready(cur);
    if constexpr (SP2) {
        PG8_STAGE(PG8_SB(0, 0), cB, voffB); PG8_STAGE(PG8_SB(0, 1), cB + hstepB, voffB); PG8_STAGE(PG8_SA(0, 0), cA, voffA); PG8_STAGE(PG8_SA(0, 1), cA + hstepA, voffA);
        if (wr == 1) PG8_BAR;
        PG8_WAIT_V(2); PG8_BAR;
        PG8_STAGE(PG8_SB(1, 0), cB + kstep, voffB); PG8_STAGE(PG8_SA(1, 0), cA + kstep, voffA); PG8_STAGE(PG8_SB(1, 1), cB + hstepB + kstep, voffB);
        PG8_WAIT_V(6); PG8_BAR;
    } else {
        PG8_STAGE(PG8_SB(0, 0), cB, voffB); PG8_STAGE(PG8_SA(0, 0), cA, voffA); PG8_STAGE(PG8_SB(0, 1), cB + hstepB, voffB); PG8_STAGE(PG8_SA(0, 1), cA + hstepA, voffA);
        if (wr == 1) PG8_BAR;
        PG8_WAIT_V(4); PG8_BAR;
        PG8_STAGE(PG8_SB(1, 0), cB + kstep, voffB); PG8_STAGE(PG8_SA(1, 0), cA + kstep, voffA); PG8_STAGE(PG8_SB(1, 1), cB + hstepB + kstep, voffB);
        PG8_WAIT_V(6); PG8_BAR;
    }
    for (;;) {
        const bool has_next = S.next(ui + 1, nxt);
        const char* nA = has_next ? (const char*)g.A + (size_t)nxt.pm * tstepA : cA; const char* nB = has_next ? (const char*)g.Bt + (size_t)nxt.pn * tstepB : cB;
        for (int t = 0; t < nt; t += 2) {
            const bool last = (t == nt - 2);
            const char* a1 = cA + (size_t)(t + 1) * kstep;
            const char* a2 = last ? nA : cA + (size_t)(t + 2) * kstep; const char* b2 = last ? nB : cB + (size_t)(t + 2) * kstep;
            const char* a3 = a2 + kstep; const char* b3 = b2 + kstep;
            if (last && has_next) S.a_ready(nxt);
            if constexpr (SP2) {
            PG8_LDB(B0, 0, 0); PG8_LDB(B1, 0, 1); PG8_SCHED; PG8_LDA(At, 0, 0); PG8_STAGE(PG8_SA(1, 1), a1 + hstepA, voffA);
            PG8_WAIT_V(8); PG8_WAIT_L(0); PG8_BAR; PG8_MMA(0, 0, At, B0); PG8_MMA(0, 1, At, B1); PG8_BAR; PG8_SCHED;
            PG8_LDA(At, 0, 1); PG8_STAGE(PG8_SB(0, 0), b2, voffB); PG8_STAGE(PG8_SB(0, 1), b2 + hstepB, voffB); PG8_STAGE(PG8_SA(0, 0), a2, voffA);
            PG8_WAIT_V(8); PG8_WAIT_L(0); PG8_BAR; PG8_MMA(1, 0, At, B0); PG8_MMA(1, 1, At, B1); PG8_BAR; PG8_SCHED;
            PG8_LDB(B0, 1, 0); PG8_LDB(B1, 1, 1); PG8_SCHED; PG8_LDA(At, 1, 0); PG8_STAGE(PG8_SA(0, 1), a2 + hstepA, voffA);
            PG8_WAIT_V(8); PG8_WAIT_L(0); PG8_BAR; PG8_MMA(0, 0, At, B0); PG8_MMA(0, 1, At, B1); PG8_BAR; PG8_SCHED;
            PG8_LDA(At, 1, 1); PG8_STAGE(PG8_SB(1, 0), b3, voffB); PG8_STAGE(PG8_SB(1, 1), b3 + hstepB, voffB); PG8_STAGE(PG8_SA(1, 0), a3, voffA);
            PG8_WAIT_V(8); PG8_WAIT_L(0); PG8_BAR; PG8_MMA(1, 0, At, B0); PG8_MMA(1, 1, At, B1); PG8_BAR; PG8_SCHED;
            } else {
            PG8_LDB(B0, 0, 0); PG8_SCHED; PG8_LDA(At, 0, 0); PG8_STAGE(PG8_SA(1, 1), a1 + hstepA, voffA);
            PG8_WAIT_L(8); PG8_BAR; PG8_WAIT_L(0); PG8_MMA(0, 0, At, B0); PG8_BAR; PG8_SCHED;
            PG8_LDB(B1, 0, 1); PG8_STAGE(PG8_SB(0, 0), b2, voffB);
            PG8_BAR; PG8_WAIT_L(0); PG8_MMA(0, 1, At, B1); PG8_BAR;
            PG8_LDA(At, 0, 1); PG8_STAGE(PG8_SA(0, 0), a2, voffA);
            PG8_BAR; PG8_WAIT_L(0); PG8_MMA(1, 0, At, B0); PG8_BAR; PG8_SCHED;
            PG8_STAGE(PG8_SB(0, 1), b2 + hstepB, voffB);
            PG8_WAIT_V(6); PG8_BAR; PG8_MMA(1, 1, At, B1); PG8_BAR;
            PG8_LDB(B0, 1, 0); PG8_SCHED; PG8_LDA(At, 1, 0); PG8_STAGE(PG8_SA(0, 1), a2 + hstepA, voffA);
            PG8_WAIT_L(8); PG8_BAR; PG8_WAIT_L(0); PG8_MMA(0, 0, At, B0); PG8_BAR; PG8_SCHED;
            PG8_LDB(B1, 1, 1); PG8_STAGE(PG8_SB(1, 0), b3, voffB);
            PG8_BAR; PG8_WAIT_L(0); PG8_MMA(0, 1, At, B1); PG8_BAR;
            PG8_LDA(At, 1, 1); PG8_STAGE(PG8_SA(1, 0), a3, voffA);
            PG8_BAR; PG8_WAIT_L(0); PG8_MMA(1, 0, At, B0); PG8_BAR; PG8_SCHED;
            PG8_STAGE(PG8_SB(1, 1), b3 + hstepB, voffB);
            PG8_WAIT_V(6); PG8_BAR; PG8_MMA(1, 1, At, B1); PG8_BAR;
            }
        }
        if constexpr (ALIGN_EPI) { if (wr == 0) PG8_BAR; }
        if constexpr (!Epi::AFTER_DRAIN) { E(acc, cur, wr, wc, fr, fq); S.done(cur); }
        if (!has_next) break;
#pragma unroll
        for (int a = 0; a < 2; ++a)
#pragma unroll
            for (int b = 0; b < 2; ++b)
#pragma unroll
                for (int m = 0; m < 4; ++m)
#pragma unroll
                    for (int n = 0; n < 2; ++n) acc[a][b][m][n] = (f32x4){0.f, 0.f, 0.f, 0.f};
        cur = nxt; cA = nA; cB = nB; ++ui;
        if constexpr (ALIGN_EPI) { if (wr == 1) PG8_BAR; }
    }
    PG8_WAIT_V(0);
    if constexpr (!ALIGN_EPI) { if (wr == 0) PG8_BAR; }
    PG8_BAR;
    if constexpr (Epi::AFTER_DRAIN) { E.fused(acc, cur, wr, wc, fr, fq, lds, wid, lane); S.done(cur); }
#undef PG8_SA
#undef PG8_SB
#undef PG8_STAGE
#undef PG8_LDA
#undef PG8_LDB
#undef PG8_MMA
#undef PG8_WAIT_V
#undef PG8_WAIT_L
#undef PG8_BAR
#undef PG8_SCHED
}
}
constexpr int NB = 4, T = 8192, D = 1024, M = NB * T, FF = 4096;
constexpr int NRW = 1792, NAT = 1536, NPL = 512, NA = NRW + NAT + NPL  , NG = 3072, NIN = NA + NG  , W = 512;
constexpr int NH = 8, HD = 64, MB_BLK = 256, NBLK = T / MB_BLK  ;
constexpr int NWAVES = 8;
typedef unsigned short bf16;
typedef unsigned v4u __attribute__((ext_vector_type(4)));
typedef unsigned v2u __attribute__((ext_vector_type(2)));
typedef float f32x4 __attribute__((ext_vector_type(4)));
#define GAS __attribute__((address_space(1)))
#define LAS __attribute__((address_space(3)))
typedef GAS unsigned gu32;
#define RLX_AGENT __ATOMIC_RELAXED, __HIP_MEMORY_SCOPE_AGENT
#define LDS_WAIT() asm volatile("s_waitcnt lgkmcnt(0)" ::: "memory")
#define VM_WAIT() asm volatile("s_waitcnt vmcnt(0)" ::: "memory")
__device__ __forceinline__ unsigned f2bf(float f) { unsigned u = __builtin_bit_cast(unsigned, f); return (u + 0x7fffu + ((u >> 16) & 1u)) >> 16; }
__device__ __forceinline__ unsigned pk2(float lo, float hi) { return f2bf(lo) | (f2bf(hi) << 16); }
__device__ __forceinline__ float bf2f(unsigned b) { return __builtin_bit_cast(float, b << 16); }
__device__ __forceinline__ float bflo(unsigned w) { return __builtin_bit_cast(float, w << 16); }
__device__ __forceinline__ float bfhi(unsigned w) { return __builtin_bit_cast(float, w & 0xffff0000u); }
__device__ __forceinline__ float sigmoidf_(float x) { return 1.0f / (1.0f + __expf(-x)); }
__device__ __forceinline__ float wave_sum(float v) {
#pragma unroll
    for (int o = 1; o < 64; o <<= 1) v += __shfl_xor(v, o);
    return v;
}

constexpr size_t MiB = 1u << 20;
constexpr size_t WS_CTL = 0, CTL_ZERO_BYTES = 1 * MiB;
constexpr size_t WS_WIN = 1 * MiB, WS_WB = 15 * MiB, WS_WO = 18 * MiB, WS_W1 = 20 * MiB, WS_W2 = 28 * MiB, WS_KM = 36 * MiB;
constexpr size_t WS_H = 40 * MiB, WS_RW = 104 * MiB, WS_AT = 216 * MiB, WS_PL = 312 * MiB, WS_D = 344 * MiB, WS_YA = 376 * MiB, WS_YR = 408 * MiB;
constexpr size_t WS_R = 216 * MiB, WS_LW = 248 * MiB, WS_K = 280 * MiB, WS_V = 312 * MiB, WS_KK = 440 * MiB, WS_A = 472 * MiB, WS_G = 40 * MiB;
constexpr size_t WS_GB = 216 * MiB, WS_MB = 280 * MiB, WS_HID = 104 * MiB, WS_END = 504 * MiB;
constexpr int CW_BAR = 4096;
constexpr int RING_OFF = 0, RING_BYTES = 131072;
constexpr int LDSCTL_OFF = RING_BYTES, MISC_OFF = LDSCTL_OFF + 320;
constexpr int LDS_BYTES = 147456;
#define XB_TMO      128
#define XB_XCNT(j)  (256  + 64 * (j))
#define XB_XSUB(j)  (1280 + 64 * (j))
#define XB_XGEN(j)  (2304 + 64 * (j))
#define XB_TOP      3328
#define XB_TOPGEN   3392
#define XCD_BAR_WORDS 3456
#define XB_SPIN_CAP (1u << 18)
__device__ __forceinline__ unsigned xb_ld(unsigned* p)              { return __hip_atomic_load(p, __ATOMIC_RELAXED, __HIP_MEMORY_SCOPE_AGENT); }
__device__ __forceinline__ unsigned xb_add(unsigned* p, unsigned v) { return __hip_atomic_fetch_add(p, v, __ATOMIC_RELAXED, __HIP_MEMORY_SCOPE_AGENT); }
__device__ __forceinline__ unsigned xb_xcc_id() { return (unsigned)__builtin_amdgcn_s_getreg((3 << 11) | 20) & 0xFu; }
#define XB_SPIN(cond, bar) do { unsigned _sp = 0; while (cond) { __builtin_amdgcn_s_sleep(1); \
    if ((++_sp & 255u) == 0u) { if (xb_ld(&(bar)[XB_TMO])) break; if (_sp > XB_SPIN_CAP) { atomicAdd(&(bar)[XB_TMO], 1u); break; } } } } while (0)
struct XcdBarrier { unsigned* bar; unsigned x; volatile LAS unsigned* st; };
__device__ __forceinline__ XcdBarrier xcd_barrier_post(unsigned* bar, volatile LAS unsigned* st) {
    XcdBarrier b; b.bar = bar; b.x = xb_xcc_id(); b.st = st;
    if (threadIdx.x == 0) (void)xb_add(&bar[XB_XCNT(b.x)], 1u);
    return b;
}
__device__ __forceinline__ void xcd_barrier_complete(unsigned* bar, unsigned x, unsigned& nloc, unsigned& nx) {
    const unsigned G = gridDim.x * gridDim.y * gridDim.z;
    unsigned sum, cnt, mine, sp = 0u;
    for (;;) {
        sum = 0u; cnt = 0u; mine = 0u;
#pragma unroll
        for (unsigned j = 0; j < 16; ++j) { const unsigned c = xb_ld(&bar[XB_XCNT(j)]); sum += c; cnt += (c > 0u) ? 1u : 0u; mine = (j == x) ? c : mine; }
        if (sum == G) break;
        __builtin_amdgcn_s_sleep(1);
        if ((++sp & 255u) == 0u) { if (xb_ld(&bar[XB_TMO])) break; if (sp > XB_SPIN_CAP) { atomicAdd(&bar[XB_TMO], 1u); break; } }
    }
    nloc = mine > 0u ? mine : 1u; nx = cnt > 0u ? cnt : 1u;
}
__device__ __forceinline__ void xcd_barrier(const XcdBarrier& b) {
    asm volatile("s_waitcnt vmcnt(0)" ::: "memory");
    __syncthreads();
    if (threadIdx.x == 0) {
        unsigned* bar = b.bar;
        __builtin_amdgcn_s_waitcnt(0);
        unsigned nloc = b.st[0], nx = b.st[1];
        if (nloc == 0u) { xcd_barrier_complete(bar, b.x, nloc, nx); b.st[0] = nloc; b.st[1] = nx; }
        const unsigned old = xb_add(&bar[XB_XSUB(b.x)], 1u);
        const unsigned gen = old / nloc;
        if (old + 1u == (gen + 1u) * nloc) {
            __builtin_amdgcn_fence(__ATOMIC_RELEASE, "agent");
            asm volatile("s_waitcnt vmcnt(0)" ::: "memory");
            const unsigned og = xb_add(&bar[XB_TOP], 1u);
            const unsigned tg = og / nx;
            if (og + 1u == (tg + 1u) * nx) xb_add(&bar[XB_TOPGEN], 1u);
            else XB_SPIN(xb_ld(&bar[XB_TOPGEN]) == tg, bar);
            __builtin_amdgcn_fence(__ATOMIC_ACQUIRE, "agent");
            xb_add(&bar[XB_XGEN(b.x)], 1u);
            asm volatile("s_waitcnt vmcnt(0)" ::: "memory");
        } else {
            XB_SPIN(xb_ld(&bar[XB_XGEN(b.x)]) == gen, bar);
            __builtin_amdgcn_fence(__ATOMIC_ACQUIRE, "agent");
            asm volatile("s_waitcnt vmcnt(0)" ::: "memory");
        }
    }
    __syncthreads();
}

struct Args { const float* in[23]; float* out; unsigned char* ws; int ph_lo, ph_hi, layer, pad; };
enum Phase { PH_CONV = 0, PH_NORM1 = 1, PH_GEMMA = 2, PH_GB = 3, PH_GO = 4, PH_NORM2 = 5, PH_FF1 = 6, PH_FF2 = 7, PH_N = 8 };
enum In { I_X = 0, I_N1G, I_WIN, I_MU, I_W0, I_WUP, I_A0, I_AUP, I_GUP, I_KK, I_KA, I_RK, I_LNG, I_LNB, I_QNG, I_KNG, I_POOLW, I_POOLS, I_WBR, I_WOUT, I_N2G, I_FF1, I_FF2 };

__device__ __forceinline__ void p0_transpose_item(const float* Wm, int K, int N, bf16* WT, LAS float* scr, int item, int lane) {
    const int nblk = N / 32, kb = item / nblk, nb = item % nblk, k0 = 64 * kb, n0 = 32 * nb;
#pragma unroll 8
    for (int i = 0; i < 32; ++i) { const int kk = 2 * i + (lane >> 5); scr[kk * 33 + (lane & 31)] = Wm[(size_t)(k0 + kk) * N + n0 + (lane & 31)]; }
    LDS_WAIT(); asm volatile("" ::: "memory");
    const int c = lane & 7;
#pragma unroll
    for (int j = 0; j < 4; ++j) { const int n = (lane >> 3) + 8 * j; const LAS float* s = scr + (8 * c) * 33 + n;
        v4u o; o.x = pk2(s[0 * 33], s[1 * 33]); o.y = pk2(s[2 * 33], s[3 * 33]); o.z = pk2(s[4 * 33], s[5 * 33]); o.w = pk2(s[6 * 33], s[7 * 33]);
        *(GAS v4u*)(WT + (size_t)(n0 + n) * K + k0 + 8 * c) = o; }
    LDS_WAIT(); asm volatile("" ::: "memory");
}
__device__ __forceinline__ void rms_rows(const float* x, const float* g, bf16* out, int gw, int NGW, int lane) {
    f32x4 gv[4];
#pragma unroll
    for (int j = 0; j < 4; ++j) gv[j] = ((const f32x4*)g)[lane + 64 * j];
    for (int m = gw; m < M; m += NGW) {
        const GAS f32x4* xr = (const GAS f32x4*)(x + (size_t)m * D) + lane;
        f32x4 v[4]; float s = 0.f;
#pragma unroll
        for (int j = 0; j < 4; ++j) { v[j] = xr[64 * j]; s += (v[j].x * v[j].x + v[j].y * v[j].y) + (v[j].z * v[j].z + v[j].w * v[j].w); }
        const float rstd = 1.0f / sqrtf(wave_sum(s) * (1.0f / D) + 1e-6f);
        GAS unsigned long long* o8 = (GAS unsigned long long*)(out + (size_t)m * D) + lane;
#pragma unroll
        for (int j = 0; j < 4; ++j) { const f32x4 y = v[j] * rstd * gv[j]; o8[64 * j] = (unsigned long long)pk2(y.x, y.y) | ((unsigned long long)pk2(y.z, y.w) << 32); }
    }
}

__global__ void __launch_bounds__(NWAVES * 64, 2) mk_fwd(Args args) {
    extern __shared__ __attribute__((aligned(16))) unsigned char lds_raw[];
    LAS unsigned char* lds = (LAS unsigned char*)lds_raw;
    const int tid = threadIdx.x, lane = tid & 63, wave = __builtin_amdgcn_readfirstlane(tid >> 6);
    const int G = gridDim.x;
    const int L = args.layer;
    unsigned char* ws = args.ws;
    bf16* WinT = (bf16*)(ws + WS_WIN); bf16* WbT = (bf16*)(ws + WS_WB); bf16* WoT = (bf16*)(ws + WS_WO); bf16* W1T = (bf16*)(ws + WS_W1); bf16* W2T = (bf16*)(ws + WS_W2);
    bf16* Hb = (bf16*)(ws + WS_H);
    const float* xsrc = (L == 0) ? args.in[I_X] : args.out;
    const int lo = args.ph_lo, hi = args.ph_hi;
    const int gw = blockIdx.x * NWAVES + wave, NGW = G * NWAVES;
#define IN(k) (lo <= (k) && (k) < hi)

    if (IN(PH_CONV)) {
        LAS float* scr = (LAS float*)(lds + RING_OFF + wave * 16384);
        const float* w_in = args.in[I_WIN] + (size_t)L * D * NIN;
        const float* w_br = args.in[I_WBR] + (size_t)L * 3 * W * D;
        const float* w_out = args.in[I_WOUT] + (size_t)L * D * D;
        const float* w_f1 = args.in[I_FF1] + (size_t)L * D * FF;
        const float* w_f2 = args.in[I_FF2] + (size_t)L * FF * D;
        constexpr int I_IN = (D / 64) * (NIN / 32), I_B = (W / 64) * (D / 32), I_O = (D / 64) * (D / 32), I_1 = (D / 64) * (FF / 32), I_2 = (FF / 64) * (D / 32);
        constexpr int NITEMS = I_IN + 2 * I_B + I_O + I_1 + I_2;
        for (int it = gw; it < NITEMS; it += NGW) {
            int r = it;
            if (r < I_IN) { p0_transpose_item(w_in, D, NIN, WinT, scr, r, lane); continue; } r -= I_IN;
            if (r < I_B) { p0_transpose_item(w_br, W, D, WbT, scr, r, lane); continue; } r -= I_B;
            if (r < I_B) { p0_transpose_item(w_br + (size_t)W * D, W, D, WbT + (size_t)D * W, scr, r, lane); continue; } r -= I_B;
            if (r < I_O) { p0_transpose_item(w_out, D, D, WoT, scr, r, lane); continue; } r -= I_O;
            if (r < I_1) { p0_transpose_item(w_f1, D, FF, W1T, scr, r, lane); continue; } r -= I_1;
            p0_transpose_item(w_f2, FF, D, W2T, scr, r, lane);
        }
        const float* pw = args.in[I_POOLW] + (size_t)L * 4 * 128 * 128; const float* ps = args.in[I_POOLS] + (size_t)L * W; const float* wb2 = w_br + (size_t)2 * W * D;
        bf16* WeT = WbT + (size_t)2 * D * W;
        for (int idx = blockIdx.x * (NWAVES * 64) + tid; idx < W * D; idx += G * NWAVES * 64) {
            const int gc = idx / D, dout = idx % D, g = gc >> 7;
            const float* pwr = pw + (size_t)gc * 128; float acc = 0.f;
            for (int dp = 0; dp < 128; ++dp) acc += pwr[dp] * ps[g * 128 + dp] * wb2[(size_t)(g * 128 + dp) * D + dout];
            WeT[(size_t)dout * W + gc] = (bf16)f2bf(acc);
        }
    }
    if (IN(PH_NORM1)) rms_rows(xsrc, args.in[I_N1G] + (size_t)L * D, Hb, gw, NGW, lane);
    if (IN(PH_GEMMA)) {
        pg8::Gemm g{Hb, WinT, M, NA, D, D, D}; pg8::StaticOrder S; S.init(M, NA, G, (int)blockIdx.x);
        pg8::EpiA E{(bf16*)(ws + WS_RW), (bf16*)(ws + WS_AT), (bf16*)(ws + WS_PL)};
        pg8::gemm_phase<pg8::EpiA, pg8::StaticOrder, true, true>(lds + RING_OFF, g, S, E);
    }
    if (IN(PH_GB)) {
        bf16* GBp = (bf16*)(ws + WS_GB); bf16* MBp = (bf16*)(ws + WS_MB);
        pg8::StaticOrder S; S.init(M, D, G, (int)blockIdx.x);
        const bf16* Ysrc[3] = {(const bf16*)(ws + WS_YR), (const bf16*)(ws + WS_YA), (const bf16*)(ws + WS_D)};
#pragma unroll
        for (int b = 0; b < 3; ++b) {
            { pg8::Gemm g{Hb, WinT + (size_t)(NA + b * D) * D, M, D, D, D, D}; pg8::EpiAct<1> E{GBp, D};
              pg8::gemm_phase<pg8::EpiAct<1>, pg8::StaticOrder, true, true>(lds + RING_OFF, g, S, E); }
            __syncthreads();
            { pg8::Gemm g{Ysrc[b], WbT + (size_t)b * D * W, M, D, W, W, W};
              if (b == 0) { pg8::EpiBr<true> E{GBp, MBp}; pg8::gemm_phase<pg8::EpiBr<true>, pg8::StaticOrder, true, true>(lds + RING_OFF, g, S, E); }
              else { pg8::EpiBr<false> E{GBp, MBp}; pg8::gemm_phase<pg8::EpiBr<false>, pg8::StaticOrder, true, true>(lds + RING_OFF, g, S, E); } }
            __syncthreads();
        }
    }
    if (IN(PH_GO)) {
        pg8::Gemm g{(const bf16*)(ws + WS_MB), WoT, M, D, D, D, D}; pg8::StaticOrder S; S.init(M, D, G, (int)blockIdx.x);
        pg8::EpiRes E{xsrc, args.out};
        pg8::gemm_phase<pg8::EpiRes, pg8::StaticOrder, true, true>(lds + RING_OFF, g, S, E);
    }
    if (IN(PH_NORM2)) rms_rows(args.out, args.in[I_N2G] + (size_t)L * D, Hb, gw, NGW, lane);
    if (IN(PH_FF1)) {
        pg8::Gemm g{Hb, W1T, M, FF, D, D, D}; pg8::StaticOrder S; S.init(M, FF, G, (int)blockIdx.x);
        pg8::EpiAct<2> E{(bf16*)(ws + WS_HID), FF};
        pg8::gemm_phase<pg8::EpiAct<2>, pg8::StaticOrder, true, true>(lds + RING_OFF, g, S, E);
    }
    if (IN(PH_FF2)) {
        pg8::Gemm g{(const bf16*)(ws + WS_HID), W2T, M, D, FF, FF, FF}; pg8::StaticOrder S; S.init(M, D, G, (int)blockIdx.x);
        pg8::EpiRes E{args.out, args.out};
        pg8::gemm_phase<pg8::EpiRes, pg8::StaticOrder, true, true>(lds + RING_OFF, g, S, E);
    }
#undef IN
}
__global__ void __launch_bounds__(512) k_attn_prep(bf16* AT, const float* qg, const float* kg, float* KM) {
    __shared__ float red[8][64];
    const int bid = blockIdx.x, h = bid & 7, n = (bid >> 3) & 31, b = bid >> 8;
    const int tid = threadIdx.x, lane = tid & 63, wave = tid >> 6;
    const float gq = qg[lane], gk = kg[lane];
    float ksum = 0.f;
    for (int i = 0; i < 32; ++i) {
        const size_t row = (size_t)b * T + n * 256 + wave * 32 + i;
        bf16* qp = AT + row * NAT + h * 64 + lane; bf16* kp = qp + 512;
        const float q = bf2f(*qp), k = bf2f(*kp);
        const float qs = wave_sum(q * q), ks = wave_sum(k * k);
        const float qn = q * (1.0f / sqrtf(qs * (1.0f / 64.0f) + 1e-6f)) * gq;
        const float kn = k * (1.0f / sqrtf(ks * (1.0f / 64.0f) + 1e-6f)) * gk;
        *qp = (bf16)f2bf(qn); *kp = (bf16)f2bf(kn); ksum += kn;
    }
    red[wave][lane] = ksum; __syncthreads();
    if (wave == 0) { float s = 0.f; for (int w = 0; w < 8; ++w) s += red[w][lane]; KM[(((size_t)b * NH + h) * NBLK + n) * 64 + lane] = s * (1.0f / 256.0f); }
}
__global__ void __launch_bounds__(256) k_moba(const bf16* AT, const float* KM, bf16* YA) {
    __shared__ v4u Ko[256 * 8], Vo[256 * 8];
    const int bid = blockIdx.x, qb = bid & 31, h = (bid >> 5) & 7, b = bid >> 8;
    const int i = threadIdx.x, t = qb * 256 + i; const size_t row = (size_t)b * T + t;
    { const v4u* kp = (const v4u*)(AT + row * NAT + 512 + h * 64); const v4u* vp = (const v4u*)(AT + row * NAT + 1024 + h * 64);
#pragma unroll
      for (int c = 0; c < 8; ++c) { Ko[i * 8 + c] = kp[c]; Vo[i * 8 + c] = vp[c]; } }
    float q[64];
    { const v4u* qp = (const v4u*)(AT + row * NAT + h * 64);
#pragma unroll
      for (int c = 0; c < 8; ++c) { const v4u w = qp[c]; q[8*c+0] = bflo(w.x); q[8*c+1] = bfhi(w.x); q[8*c+2] = bflo(w.y); q[8*c+3] = bfhi(w.y); q[8*c+4] = bflo(w.z); q[8*c+5] = bfhi(w.z); q[8*c+6] = bflo(w.w); q[8*c+7] = bfhi(w.w); } }
    __syncthreads();
    const float slope = exp2f(-(float)(h + 1));
    float g0 = -3e38f, g1 = -3e38f, g2 = -3e38f; int s0 = -1, s1 = -1, s2 = -1;
    for (int n = 0; n < qb; ++n) {
        const float* km = KM + (((size_t)b * NH + h) * NBLK + n) * 64; float g = 0.f;
#pragma unroll
        for (int d = 0; d < 64; ++d) g += q[d] * km[d];
        if (g > g0) { g2 = g1; s2 = s1; g1 = g0; s1 = s0; g0 = g; s0 = n; }
        else if (g > g1) { g2 = g1; s2 = s1; g1 = g; s1 = n; }
        else if (g > g2) { g2 = g; s2 = n; }
    }
    float mx = -3e38f, l = 0.f; float o[64];
#pragma unroll
    for (int d = 0; d < 64; ++d) o[d] = 0.f;
#define MOBA_KEY(KP, VP, DIST) do { float s_ = 0.f; \
        _Pragma("unroll") for (int c = 0; c < 8; ++c) { const v4u w = (KP)[c]; s_ += q[8*c+0] * bflo(w.x) + q[8*c+1] * bfhi(w.x) + q[8*c+2] * bflo(w.y) + q[8*c+3] * bfhi(w.y) + q[8*c+4] * bflo(w.z) + q[8*c+5] * bfhi(w.z) + q[8*c+6] * bflo(w.w) + q[8*c+7] * bfhi(w.w); } \
        s_ = s_ * 0.125f - slope * (float)(DIST); \
        const float mn_ = fmaxf(mx, s_), corr_ = __expf(mx - mn_), p_ = __expf(s_ - mn_); mx = mn_; l = l * corr_ + p_; \
        _Pragma("unroll") for (int c = 0; c < 8; ++c) { const v4u w = (VP)[c]; \
            o[8*c+0] = o[8*c+0] * corr_ + p_ * bflo(w.x); o[8*c+1] = o[8*c+1] * corr_ + p_ * bfhi(w.x); o[8*c+2] = o[8*c+2] * corr_ + p_ * bflo(w.y); o[8*c+3] = o[8*c+3] * corr_ + p_ * bfhi(w.y); \
            o[8*c+4] = o[8*c+4] * corr_ + p_ * bflo(w.z); o[8*c+5] = o[8*c+5] * corr_ + p_ * bfhi(w.z); o[8*c+6] = o[8*c+6] * corr_ + p_ * bflo(w.w); o[8*c+7] = o[8*c+7] * corr_ + p_ * bfhi(w.w); } } while (0)
    for (int j = 0; j < 3; ++j) {
        const int n = (j == 0) ? s0 : (j == 1 ? s1 : s2);
        if (n < 0) continue;
        for (int s = 0; s < 256; ++s) {
            const size_t kr = (size_t)b * T + n * 256 + s;
            const v4u* kp = (const v4u*)(AT + kr * NAT + 512 + h * 64); const v4u* vp = (const v4u*)(AT + kr * NAT + 1024 + h * 64);
            MOBA_KEY(kp, vp, t - (n * 256 + s));
        }
    }
    for (int s = 0; s <= i; ++s) { const v4u* kp = Ko + s * 8; const v4u* vp = Vo + s * 8; MOBA_KEY(kp, vp, i - s); }
#undef MOBA_KEY
    const float inv = 1.0f / l;
    v4u* yp = (v4u*)(YA + row * W + h * 64);
#pragma unroll
    for (int c = 0; c < 8; ++c) { v4u w; w.x = pk2(o[8*c+0] * inv, o[8*c+1] * inv); w.y = pk2(o[8*c+2] * inv, o[8*c+3] * inv); w.z = pk2(o[8*c+4] * inv, o[8*c+5] * inv); w.w = pk2(o[8*c+6] * inv, o[8*c+7] * inv); yp[c] = w; }
}
__global__ void __launch_bounds__(256) k_pool(const bf16* PL, bf16* Dd) {
    const size_t idx = (size_t)blockIdx.x * 256 + threadIdx.x; const int ch = (int)(idx & 511); const size_t row = idx >> 9; const int t = (int)(row & (T - 1));
    const int wdw = 2 << (ch >> 7); const int cnt = (t + 1 < wdw) ? (t + 1) : wdw;
    float s = 0.f; for (int i = 0; i < cnt; ++i) s += bf2f(PL[(row - i) * NPL + ch]);
    Dd[row * NPL + ch] = (bf16)f2bf(s / (float)cnt - bf2f(PL[row * NPL + ch]));
}
struct RwkvPrepArgs { const bf16* RW; const float *mu, *w0, *w_up, *a0, *a_up, *g_up, *k_k, *k_a; bf16 *R, *LW, *K, *V, *KK, *A, *G; };
__global__ void __launch_bounds__(512) k_rwkv_prep(RwkvPrepArgs a) {
    __shared__ float pm[4][NRW]; __shared__ float tw[4][64], xa[4][64], sg[4][128];
    const int tid = threadIdx.x; const size_t r0 = (size_t)blockIdx.x * 4;
    for (int idx = tid; idx < 4 * NRW; idx += 512) { const int tt = idx / NRW, c = idx % NRW; const size_t row = r0 + tt; const int t = (int)(row & (T - 1));
        const float cur = bf2f(a.RW[row * NRW + c]); const float prev = (t == 0) ? 0.f : bf2f(a.RW[(row - 1) * NRW + c]); pm[tt][c] = cur + (prev - cur) * a.mu[c]; }
    __syncthreads();
    for (int idx = tid; idx < 4 * 256; idx += 512) { const int tt = idx >> 8, c = idx & 255; const float v = pm[tt][1536 + c];
        if (c < 64) tw[tt][c] = tanhf(v); else if (c < 128) xa[tt][c - 64] = v; else sg[tt][c - 128] = sigmoidf_(v); }
    __syncthreads();
    const int j = tid; float accw[4] = {0.f, 0.f, 0.f, 0.f}, acca[4] = {0.f, 0.f, 0.f, 0.f}, accg[4] = {0.f, 0.f, 0.f, 0.f};
    for (int i = 0; i < 64; ++i) { const float wu = a.w_up[i * W + j], au = a.a_up[i * W + j];
#pragma unroll
        for (int tt = 0; tt < 4; ++tt) { accw[tt] += tw[tt][i] * wu; acca[tt] += xa[tt][i] * au; } }
    for (int i = 0; i < 128; ++i) { const float gu = a.g_up[i * W + j];
#pragma unroll
        for (int tt = 0; tt < 4; ++tt) accg[tt] += sg[tt][i] * gu; }
    const float w0j = a.w0[j], a0j = a.a0[j], kkj = a.k_k[j], kaj = a.k_a[j];
#pragma unroll
    for (int tt = 0; tt < 4; ++tt) { const size_t o = (r0 + tt) * W + j;
        const float lw = -0.60653065971263342f * sigmoidf_(w0j + accw[tt]);
        const float av = sigmoidf_(a0j + acca[tt]);
        const float r = pm[tt][j], k = pm[tt][512 + j], v = pm[tt][1024 + j];
        float kk = k * kkj; const float nrm = sqrtf(wave_sum(kk * kk)); kk = kk / fmaxf(nrm, 1e-12f);
        const float k2 = k * (1.0f + (av - 1.0f) * kaj);
        a.R[o] = (bf16)f2bf(r); a.LW[o] = (bf16)f2bf(lw); a.K[o] = (bf16)f2bf(k2); a.V[o] = (bf16)f2bf(v); a.KK[o] = (bf16)f2bf(kk); a.A[o] = (bf16)f2bf(av); a.G[o] = (bf16)f2bf(accg[tt]); }
}
struct RwkvScanArgs { const bf16 *R, *LW, *K, *V, *KK, *A, *G; const float *r_k, *lnx_g, *lnx_b; bf16* YR; };
__global__ void __launch_bounds__(64) k_rwkv_scan(RwkvScanArgs a) {
    __shared__ __attribute__((aligned(16))) float sr[16][64], sw[16][64], sk[16][64], sa[16][64], sb[16][64], sv[16][64], sgt[16][64];
    const int b = blockIdx.x >> 3, h = blockIdx.x & 7, v = threadIdx.x;
    float S[64];
#pragma unroll
    for (int k = 0; k < 64; ++k) S[k] = 0.f;
    const float rk = a.r_k[h * 64 + v], lg = a.lnx_g[h * 64 + v], lb = a.lnx_b[h * 64 + v];
    for (int t0 = 0; t0 < T; t0 += 16) {
        __syncthreads();
        for (int s = 0; s < 16; ++s) { const size_t o = ((size_t)b * T + t0 + s) * W + h * 64 + v;
            const float kk = bf2f(a.KK[o]), av = bf2f(a.A[o]);
            sr[s][v] = bf2f(a.R[o]); sw[s][v] = __expf(bf2f(a.LW[o])); sk[s][v] = bf2f(a.K[o]); sa[s][v] = -kk; sb[s][v] = kk * av; sv[s][v] = bf2f(a.V[o]); sgt[s][v] = bf2f(a.G[o]); }
        __syncthreads();
        for (int s = 0; s < 16; ++s) {
            const float vv = sv[s][v];
            float sacc = 0.f;
#pragma unroll
            for (int k = 0; k < 64; k += 4) { const f32x4 av4 = *(const f32x4*)&sa[s][k]; sacc += S[k] * av4.x + S[k + 1] * av4.y + S[k + 2] * av4.z + S[k + 3] * av4.w; }
            float o = 0.f;
#pragma unroll
            for (int k = 0; k < 64; k += 4) { const f32x4 w4 = *(const f32x4*)&sw[s][k], b4 = *(const f32x4*)&sb[s][k], k4 = *(const f32x4*)&sk[s][k], r4 = *(const f32x4*)&sr[s][k];
                S[k] = S[k] * w4.x + sacc * b4.x + vv * k4.x; S[k + 1] = S[k + 1] * w4.y + sacc * b4.y + vv * k4.y; S[k + 2] = S[k + 2] * w4.z + sacc * b4.z + vv * k4.z; S[k + 3] = S[k + 3] * w4.w + sacc * b4.w + vv * k4.w;
                o += S[k] * r4.x + S[k + 1] * r4.y + S[k + 2] * r4.z + S[k + 3] * r4.w; }
            const float mean = wave_sum(o) * (1.0f / 64.0f); const float dv = o - mean; const float var = wave_sum(dv * dv) * (1.0f / 64.0f);
            const float on = dv * (1.0f / sqrtf(var + 64e-5f)) * lg + lb;
            const float bon = wave_sum(sr[s][v] * sk[s][v] * rk) * vv;
            a.YR[((size_t)b * T + t0 + s) * W + h * 64 + v] = (bf16)f2bf((on + bon) * sgt[s][v]);
        }
    }
}
extern "C" void kernel_launch(void* const* d_in, const int* in_sizes, int n_in, void* d_out, int out_size, void* d_ws, size_t ws_size, hipStream_t stream) {
    static int grid = 0;
    if (grid == 0) {
        if (n_in != 23 || in_sizes[0] != M * D || out_size != M * D || ws_size < WS_END) { fprintf(stderr, "kernel_launch: unexpected shapes (n_in %d, in0 %d, out %d, ws %zu)\n", n_in, n_in > 0 ? in_sizes[0] : -1, out_size, ws_size); grid = -1; return; }
        int dev = 0, cus = 0;
        if (hipGetDevice(&dev) != hipSuccess || hipDeviceGetAttribute(&cus, hipDeviceAttributeMultiprocessorCount, dev) != hipSuccess) { grid = -1; return; }
        if (hipFuncSetAttribute((const void*)mk_fwd, hipFuncAttributeMaxDynamicSharedMemorySize, LDS_BYTES) != hipSuccess) { fprintf(stderr, "kernel_launch: hipFuncSetAttribute failed\n"); grid = -1; return; }
        (void)hipGetLastError();
        grid = cus;
    }
    if (grid < 0) return;
    unsigned char* ws = (unsigned char*)d_ws;
    (void)hipMemsetAsync(ws + WS_CTL, 0, CTL_ZERO_BYTES, stream);
    Args a{};
    for (int i = 0; i < 23; ++i) a.in[i] = (const float*)d_in[i];
    a.out = (float*)d_out; a.ws = ws;
    auto run = [&](int lo, int hi, int layer) { a.ph_lo = lo; a.ph_hi = hi; a.layer = layer; hipLaunchKernelGGL(mk_fwd, dim3(grid), dim3(NWAVES * 64), LDS_BYTES, stream, a); };
    for (int L = 0; L < 2; ++L) {
        const float* const* in = (const float* const*)d_in;
        run(PH_CONV, PH_NORM1 + 1, L);
        run(PH_GEMMA, PH_GEMMA + 1, L);
        hipLaunchKernelGGL(k_attn_prep, dim3(NB * NBLK * NH), dim3(512), 0, stream, (bf16*)(ws + WS_AT), in[I_QNG] + L * 64, in[I_KNG] + L * 64, (float*)(ws + WS_KM));
        hipLaunchKernelGGL(k_moba, dim3(NB * NH * NBLK), dim3(256), 0, stream, (const bf16*)(ws + WS_AT), (const float*)(ws + WS_KM), (bf16*)(ws + WS_YA));
        hipLaunchKernelGGL(k_pool, dim3(M * NPL / 256), dim3(256), 0, stream, (const bf16*)(ws + WS_PL), (bf16*)(ws + WS_D));
        RwkvPrepArgs pa{}; pa.RW = (const bf16*)(ws + WS_RW); pa.mu = in[I_MU] + L * NRW; pa.w0 = in[I_W0] + L * W; pa.w_up = in[I_WUP] + (size_t)L * 64 * W; pa.a0 = in[I_A0] + L * W; pa.a_up = in[I_AUP] + (size_t)L * 64 * W;
        pa.g_up = in[I_GUP] + (size_t)L * 128 * W; pa.k_k = in[I_KK] + L * W; pa.k_a = in[I_KA] + L * W;
        pa.R = (bf16*)(ws + WS_R); pa.LW = (bf16*)(ws + WS_LW); pa.K = (bf16*)(ws + WS_K); pa.V = (bf16*)(ws + WS_V); pa.KK = (bf16*)(ws + WS_KK); pa.A = (bf16*)(ws + WS_A); pa.G = (bf16*)(ws + WS_G);
        hipLaunchKernelGGL(k_rwkv_prep, dim3(M / 4), dim3(512), 0, stream, pa);
        RwkvScanArgs sa{}; sa.R = pa.R; sa.LW = pa.LW; sa.K = pa.K; sa.V = pa.V; sa.KK = pa.KK; sa.A = pa.A; sa.G = pa.G;
        sa.r_k = in[I_RK] + L * W; sa.lnx_g = in[I_LNG] + L * W; sa.lnx_b = in[I_LNB] + L * W; sa.YR = (bf16*)(ws + WS_YR);
        hipLaunchKernelGGL(k_rwkv_scan, dim3(NB * NH), dim3(64), 0, stream, sa);
        run(PH_NORM1, PH_NORM1 + 1, L);
        run(PH_GB, PH_GB + 1, L);
        run(PH_GO, PH_GO + 1, L);
        run(PH_NORM2, PH_NORM2 + 1, L);
        run(PH_FF1, PH_FF1 + 1, L);
        run(PH_FF2, PH_FF2 + 1, L);
    }
}
```

```cpp
#include <hip/hip_runtime.h>
#include <cstdio>
#include <cstdint>
#define GAS __attribute__((address_space(1)))
namespace pg8 {
#define PG8_LAS __attribute__((address_space(3)))
typedef unsigned short bf16_t;
typedef short bf16x8 __attribute__((ext_vector_type(8)));
typedef float f32x4 __attribute__((ext_vector_type(4)));
typedef unsigned u32x4 __attribute__((ext_vector_type(4)));
constexpr int BM = 256, BK = 64, HALF = 128, HTB = HALF * BK * 2  , STAGE_BYTES = 8 * HTB, NXCD = 8, WGM = 8;

__host__ __device__ __forceinline__ int lds_byte(int r, int c) { const int st = (r >> 4) * 2 + (c >> 5), rr = r & 15, cc = c & 31, ob = rr * 64 + cc * 2; return st * 1024 + (ob ^ (((ob >> 9) & 1) << 5)); }
__host__ __device__ __forceinline__ void stage_rc(int b, int& R, int& C) { const int st = b / 1024, sb = b % 1024, swz = sb ^ (((sb >> 9) & 1) << 5); R = (st >> 1) * 16 + swz / 64; C = (st & 1) * 32 + (swz % 64) / 2; }
__host__ __device__ __forceinline__ int perm32(int rho) { const int n = rho >> 4, i = rho & 15; return 8 * (i >> 2) + 4 * n + (i & 3); }

struct Unit { int pm, pn; };
struct Gemm { const bf16_t* A; const bf16_t* Bt; int M, N, K, lda, ldb; };

struct StaticOrder {
    int nM, nN, nwg, G, c;
    __host__ __device__ void init(int M, int N, int G_, int c_) { nM = M / BM; nN = N / BM; nwg = nM * nN; G = G_; c = c_; }
    __host__ __device__ bool next(int i, Unit& u) const {
        const long L = (long)i * G + c; if (L >= nwg) return false;
        int wgid = (int)L; { const int q = nwg / NXCD, r = nwg % NXCD, xcd = wgid % NXCD, off = wgid / NXCD; wgid = (xcd < r ? xcd * (q + 1) : r * (q + 1) + (xcd - r) * q) + off; }
        const int nig = WGM * nN, gid = wgid / nig, fm = gid * WGM, gsz = (nM - fm) < WGM ? (nM - fm) : WGM;
        u.pm = fm + ((wgid % nig) % gsz); u.pn = (wgid % nig) / gsz; return true;
    }
    __device__ __forceinline__ void a_ready(const Unit&) const {}
    __device__ __forceinline__ void done(const Unit&) const {}
};

__device__ __forceinline__ unsigned cvt_pk_bf16(float lo, float hi) { unsigned r; asm volatile("v_cvt_pk_bf16_f32 %0, %1, %2" : "=v"(r) : "v"(lo), "v"(hi)); return r; }
__device__ __forceinline__ float sigm(float x) { return 1.0f / (1.0f + __expf(-x)); }
__device__ __forceinline__ float bf_lo(unsigned w) { return __builtin_bit_cast(float, w << 16); }
__device__ __forceinline__ float bf_hi(unsigned w) { return __builtin_bit_cast(float, w & 0xffff0000u); }
struct EpiA {
    static constexpr bool PERM = true, AFTER_DRAIN = false;
    bf16_t *RW, *AT, *PL, *SB, *HB;
    __device__ __forceinline__ void operator()(const f32x4 (&acc)[2][2][4][2], const Unit& u, int wr, int wc, int fr, int fq) const {
        bf16_t* base; int ldc, colt;
        if (u.pn < 7) { base = RW; ldc = 1792; colt = u.pn * 256; } else if (u.pn < 13) { base = AT; ldc = 1536; colt = (u.pn - 7) * 256; } else { base = PL; ldc = 512; colt = (u.pn - 13) * 256; }
        const int row0 = u.pm * BM + wr * 64 + fr, col0 = colt + wc * 32 + 8 * fq;
#pragma unroll
        for (int ai = 0; ai < 2; ++ai)
#pragma unroll
            for (int m = 0; m < 4; ++m) { bf16_t* rowp = base + (size_t)(row0 + ai * HALF + m * 16) * ldc + col0;
#pragma unroll
                for (int bj = 0; bj < 2; ++bj) { const f32x4 v0 = acc[ai][bj][m][0], v1 = acc[ai][bj][m][1];
                    u32x4 w; w.x = cvt_pk_bf16(v0[0], v0[1]); w.y = cvt_pk_bf16(v0[2], v0[3]); w.z = cvt_pk_bf16(v1[0], v1[1]); w.w = cvt_pk_bf16(v1[2], v1[3]);
                    *(GAS u32x4*)(rowp + bj * HALF) = w;
                    if (u.pn < 7 && m == 3 && fr == 15) *(GAS u32x4*)(SB + (size_t)((row0 + ai * HALF + 48) >> 6) * 1792 + col0 + bj * HALF) = w;
                    if (u.pn >= 13 && m == 3 && wr == 1 && fr >= 1) *(GAS u32x4*)(HB + ((size_t)((row0 + ai * HALF + 48) >> 7) * 15 + (fr - 1)) * 512 + col0 + bj * HALF) = w; } }
    }
};
template <int MODE> struct EpiAct {
    static constexpr bool PERM = true, AFTER_DRAIN = false;
    bf16_t* O; int ldc;
    __device__ __forceinline__ void operator()(const f32x4 (&acc)[2][2][4][2], const Unit& u, int wr, int wc, int fr, int fq) const {
        const int row0 = u.pm * BM + wr * 64 + fr, col0 = u.pn * BM + wc * 32 + 8 * fq;
#pragma unroll
        for (int ai = 0; ai < 2; ++ai)
#pragma unroll
            for (int m = 0; m < 4; ++m) { bf16_t* rowp = O + (size_t)(row0 + ai * HALF + m * 16) * ldc + col0;
#pragma unroll
                for (int bj = 0; bj < 2; ++bj) { f32x4 v0 = acc[ai][bj][m][0], v1 = acc[ai][bj][m][1];
#pragma unroll
                    for (int e = 0; e < 4; ++e) {
                        if (MODE == 1) { v0[e] = sigm(v0[e]); v1[e] = sigm(v1[e]); }
                        if (MODE == 2) { const float a = fmaxf(v0[e], 0.f), b = fmaxf(v1[e], 0.f); v0[e] = a * a; v1[e] = b * b; } }
                    u32x4 w; w.x = cvt_pk_bf16(v0[0], v0[1]); w.y = cvt_pk_bf16(v0[2], v0[3]); w.z = cvt_pk_bf16(v1[0], v1[1]); w.w = cvt_pk_bf16(v1[2], v1[3]);
                    *(GAS u32x4*)(rowp + bj * HALF) = w; } }
    }
};
template <bool FIRST> struct EpiBr {
    static constexpr bool PERM = true, AFTER_DRAIN = false;
    const bf16_t* GB; bf16_t* MBuf;
    __device__ __forceinline__ void operator()(const f32x4 (&acc)[2][2][4][2], const Unit& u, int wr, int wc, int fr, int fq) const {
        const int row0 = u.pm * BM + wr * 64 + fr, col0 = u.pn * BM + wc * 32 + 8 * fq;
#pragma unroll
        for (int ai = 0; ai < 2; ++ai)
#pragma unroll
            for (int m = 0; m < 4; ++m) { const size_t off = (size_t)(row0 + ai * HALF + m * 16) * 1024 + col0;
#pragma unroll
                for (int bj = 0; bj < 2; ++bj) { const f32x4 v0 = acc[ai][bj][m][0], v1 = acc[ai][bj][m][1];
                    const u32x4 gw = *(const GAS u32x4*)(GB + off + bj * HALF);
                    float o[8] = {bf_lo(gw.x) * v0[0], bf_hi(gw.x) * v0[1], bf_lo(gw.y) * v0[2], bf_hi(gw.y) * v0[3], bf_lo(gw.z) * v1[0], bf_hi(gw.z) * v1[1], bf_lo(gw.w) * v1[2], bf_hi(gw.w) * v1[3]};
                    if (!FIRST) { const u32x4 mw = *(const GAS u32x4*)(MBuf + off + bj * HALF);
                        o[0] += bf_lo(mw.x); o[1] += bf_hi(mw.x); o[2] += bf_lo(mw.y); o[3] += bf_hi(mw.y); o[4] += bf_lo(mw.z); o[5] += bf_hi(mw.z); o[6] += bf_lo(mw.w); o[7] += bf_hi(mw.w); }
                    u32x4 w; w.x = cvt_pk_bf16(o[0], o[1]); w.y = cvt_pk_bf16(o[2], o[3]); w.z = cvt_pk_bf16(o[4], o[5]); w.w = cvt_pk_bf16(o[6], o[7]);
                    *(GAS u32x4*)(MBuf + off + bj * HALF) = w; } }
    }
};
struct EpiRes {
    static constexpr bool PERM = false, AFTER_DRAIN = false;
    const float* base; float* out;
    __device__ __forceinline__ void operator()(const f32x4 (&acc)[2][2][4][2], const Unit& u, int wr, int wc, int fr, int fq) const {
        const int row0 = u.pm * BM + wr * 64 + fr, col0 = u.pn * BM + wc * 32 + 4 * fq;
#pragma unroll
        for (int ai = 0; ai < 2; ++ai)
#pragma unroll
            for (int m = 0; m < 4; ++m) { const size_t off = (size_t)(row0 + ai * HALF + m * 16) * 1024 + col0;
#pragma unroll
                for (int bj = 0; bj < 2; ++bj)
#pragma unroll
                    for (int n = 0; n < 2; ++n) { const f32x4 bs = *(const GAS f32x4*)(base + off + bj * HALF + n * 16); *(GAS f32x4*)(out + off + bj * HALF + n * 16) = bs + acc[ai][bj][m][n]; } }
    }
};
template <class Epi, class Sched, bool ALIGN_EPI = false, bool SP2 = false>
__device__ __forceinline__ void gemm_phase(PG8_LAS unsigned char* lds, const Gemm g, const Sched& S, const Epi& E, const int tid) {
    const int wid = __builtin_amdgcn_readfirstlane(tid >> 6), lane = tid & 63, wr = wid >> 2, wc = wid & 3, fr = lane & 15, fq = lane >> 4;
    const int K = g.K, nt = K / BK;
    unsigned voffA[2], voffB[2];
#pragma unroll
    for (int i = 0; i < 2; ++i) { int R, C; stage_rc(tid * 16 + i * 8192, R, C); const int Rb = Epi::PERM ? ((R & ~31) + perm32(R & 31)) : R;
        voffA[i] = (unsigned)(R * g.lda + C) * 2u; voffB[i] = (unsigned)(Rb * g.ldb + C) * 2u; }
    const size_t kstep = (size_t)(BK * 2);
    const size_t hstepA = (size_t)HALF * g.lda * 2, hstepB = (size_t)HALF * g.ldb * 2;
    const size_t tstepA = 2 * hstepA, tstepB = 2 * hstepB;
    const unsigned ldsw = (unsigned)wid * 1024u;
    const int aoff = lds_byte(wr * 64 + fr, fq * 8), boff = lds_byte(wc * 32 + fr, fq * 8);
#define PG8_SA(b, h) (((b) * 2 + (h)) * HTB)
#define PG8_SB(b, h) ((4 + (b) * 2 + (h)) * HTB)
#define PG8_STAGE(bufoff, gbase, voff) do { _Pragma("unroll") for (int _i = 0; _i < 2; ++_i) \
        __builtin_amdgcn_global_load_lds((const unsigned*)((const char*)(gbase) + (voff)[_i]), (PG8_LAS unsigned*)(lds + (bufoff) + ldsw + _i * 8192), 16, 0, 0); } while (0)
#define PG8_LDA(dst, b, h) do { _Pragma("unroll") for (int m = 0; m < 4; ++m) _Pragma("unroll") for (int k = 0; k < 2; ++k) dst[m][k] = *(const PG8_LAS bf16x8*)(lds + PG8_SA(b, h) + aoff + m * 2048 + k * 1024); } while (0)
#define PG8_LDB(dst, b, h) do { _Pragma("unroll") for (int n = 0; n < 2; ++n) _Pragma("unroll") for (int k = 0; k < 2; ++k) dst[n][k] = *(const PG8_LAS bf16x8*)(lds + PG8_SB(b, h) + boff + n * 2048 + k * 1024); } while (0)
#define PG8_MMA(ai, bj, At, Bt) do { __builtin_amdgcn_s_setprio(1); _Pragma("unroll") for (int m = 0; m < 4; ++m) _Pragma("unroll") for (int n = 0; n < 2; ++n) _Pragma("unroll") for (int k = 0; k < 2; ++k) \
        acc[ai][bj][m][n] = __builtin_amdgcn_mfma_f32_16x16x32_bf16(Bt[n][k], At[m][k], acc[ai][bj][m][n], 0, 0, 0); __builtin_amdgcn_s_setprio(0); } while (0)
#define PG8_WAIT_V(n) asm volatile("s_waitcnt vmcnt(" #n ")" ::: "memory")
#define PG8_WAIT_L(n) asm volatile("s_waitcnt lgkmcnt(" #n ")" ::: "memory")
#define PG8_BAR __builtin_amdgcn_s_barrier()
#define PG8_SCHED __builtin_amdgcn_sched_barrier(0)
    Unit cur, nxt; int ui = 0;
    if (!S.next(0, cur)) return;
    f32x4 acc[2][2][4][2];
#pragma unroll
    for (int a = 0; a < 2; ++a)
#pragma unroll
        for (int b = 0; b < 2; ++b)
#pragma unroll
            for (int m = 0; m < 4; ++m)
#pragma unroll
                for (int n = 0; n < 2; ++n) acc[a][b][m][n] = (f32x4){0.f, 0.f, 0.f, 0.f};
    bf16x8 At[4][2], B0[2][2], B1[2][2];
    const char* cA = (const char*)g.A + (size_t)cur.pm * tstepA; const char* cB = (const char*)g.Bt + (size_t)cur.pn * tstepB;
    S.a_ready(cur);
    if constexpr (SP2) {
        PG8_STAGE(PG8_SB(0, 0), cB, voffB); PG8_STAGE(PG8_SB(0, 1), cB + hstepB, voffB); PG8_STAGE(PG8_SA(0, 0), cA, voffA); PG8_STAGE(PG8_SA(0, 1), cA + hstepA, voffA);
        if (wr == 1) PG8_BAR;
        PG8_WAIT_V(2); PG8_BAR;
        PG8_STAGE(PG8_SB(1, 0), cB + kstep, voffB); PG8_STAGE(PG8_SA(1, 0), cA + kstep, voffA); PG8_STAGE(PG8_SB(1, 1), cB + hstepB + kstep, voffB);
        PG8_WAIT_V(6); PG8_BAR;
    } else {
        PG8_STAGE(PG8_SB(0, 0), cB, voffB); PG8_STAGE(PG8_SA(0, 0), cA, voffA); PG8_STAGE(PG8_SB(0, 1), cB + hstepB, voffB); PG8_STAGE(PG8_SA(0, 1), cA + hstepA, voffA);
        if (wr == 1) PG8_BAR;
        PG8_WAIT_V(4); PG8_BAR;
        PG8_STAGE(PG8_SB(1, 0), cB + kstep, voffB); PG8_STAGE(PG8_SA(1, 0), cA + kstep, voffA); PG8_STAGE(PG8_SB(1, 1), cB + hstepB + kstep, voffB);
        PG8_WAIT_V(6); PG8_BAR;
    }
    for (;;) {
        const bool has_next = S.next(ui + 1, nxt);
        const char* nA = has_next ? (const char*)g.A + (size_t)nxt.pm * tstepA : cA; const char* nB = has_next ? (const char*)g.Bt + (size_t)nxt.pn * tstepB : cB;
        for (int t = 0; t < nt; t += 2) {
            const bool last = (t == nt - 2);
            const char* a1 = cA + (size_t)(t + 1) * kstep;
            const char* a2 = last ? nA : cA + (size_t)(t + 2) * kstep; const char* b2 = last ? nB : cB + (size_t)(t + 2) * kstep;
            const char* a3 = a2 + kstep; const char* b3 = b2 + kstep;
            if (last && has_next) S.a_ready(nxt);
            if constexpr (SP2) {
            PG8_LDB(B0, 0, 0); PG8_LDB(B1, 0, 1); PG8_SCHED; PG8_LDA(At, 0, 0); PG8_STAGE(PG8_SA(1, 1), a1 + hstepA, voffA);
            PG8_WAIT_V(8); PG8_WAIT_L(0); PG8_BAR; PG8_MMA(0, 0, At, B0); PG8_MMA(0, 1, At, B1); PG8_BAR; PG8_SCHED;
            PG8_LDA(At, 0, 1); PG8_STAGE(PG8_SB(0, 0), b2, voffB); PG8_STAGE(PG8_SB(0, 1), b2 + hstepB, voffB); PG8_STAGE(PG8_SA(0, 0), a2, voffA);
            PG8_WAIT_V(8); PG8_WAIT_L(0); PG8_BAR; PG8_MMA(1, 0, At, B0); PG8_MMA(1, 1, At, B1); PG8_BAR; PG8_SCHED;
            PG8_LDB(B0, 1, 0); PG8_LDB(B1, 1, 1); PG8_SCHED; PG8_LDA(At, 1, 0); PG8_STAGE(PG8_SA(0, 1), a2 + hstepA, voffA);
            PG8_WAIT_V(8); PG8_WAIT_L(0); PG8_BAR; PG8_MMA(0, 0, At, B0); PG8_MMA(0, 1, At, B1); PG8_BAR; PG8_SCHED;
            PG8_LDA(At, 1, 1); PG8_STAGE(PG8_SB(1, 0), b3, voffB); PG8_STAGE(PG8_SB(1, 1), b3 + hstepB, voffB); PG8_STAGE(PG8_SA(1, 0), a3, voffA);
            PG8_WAIT_V(8); PG8_WAIT_L(0); PG8_BAR; PG8_MMA(1, 0, At, B0); PG8_MMA(1, 1, At, B1); PG8_BAR; PG8_SCHED;
            } else {
            PG8_LDB(B0, 0, 0); PG8_SCHED; PG8_LDA(At, 0, 0); PG8_STAGE(PG8_SA(1, 1), a1 + hstepA, voffA);
            PG8_WAIT_L(8); PG8_BAR; PG8_WAIT_L(0); PG8_MMA(0, 0, At, B0); PG8_BAR; PG8_SCHED;
            PG8_LDB(B1, 0, 1); PG8_STAGE(PG8_SB(0, 0), b2, voffB);
            PG8_BAR; PG8_WAIT_L(0); PG8_MMA(0, 1, At, B1); PG8_BAR;
            PG8_LDA(At, 0, 1); PG8_STAGE(PG8_SA(0, 0), a2, voffA);
            PG8_BAR; PG8_WAIT_L(0); PG8_MMA(1, 0, At, B0); PG8_BAR; PG8_SCHED;
            PG8_STAGE(PG8_SB(0, 1), b2 + hstepB, voffB);
            PG8_WAIT_V(6); PG8_BAR; PG8_MMA(1, 1, At, B1); PG8_BAR;
            PG8_LDB(B0, 1, 0); PG8_SCHED; PG8_LDA(At, 1, 0); PG8_STAGE(PG8_SA(0, 1), a2 + hstepA, voffA);
            PG8_WAIT_L(8); PG8_BAR; PG8_WAIT_L(0); PG8_MMA(0, 0, At, B0); PG8_BAR; PG8_SCHED;
            PG8_LDB(B1, 1, 1); PG8_STAGE(PG8_SB(1, 0), b3, voffB);
            PG8_BAR; PG8_WAIT_L(0); PG8_MMA(0, 1, At, B1); PG8_BAR;
            PG8_LDA(At, 1, 1); PG8_STAGE(PG8_SA(1, 0), a3, voffA);
            PG8_BAR; PG8_WAIT_L(0); PG8_MMA(1, 0, At, B0); PG8_BAR; PG8_SCHED;
            PG8_STAGE(PG8_SB(1, 1), b3 + hstepB, voffB);
            PG8_WAIT_V(6); PG8_BAR; PG8_MMA(1, 1, At, B1); PG8_BAR;
            }
        }
        if constexpr (ALIGN_EPI) { if (wr == 0) PG8_BAR; }
        if constexpr (!Epi::AFTER_DRAIN) { E(acc, cur, wr, wc, fr, fq); S.done(cur); }
        if (!has_next) break;
#pragma unroll
        for (int a = 0; a < 2; ++a)
#pragma unroll
            for (int b = 0; b < 2; ++b)
#pragma unroll
                for (int m = 0; m < 4; ++m)
#pragma unroll
                    for (int n = 0; n < 2; ++n) acc[a][b][m][n] = (f32x4){0.f, 0.f, 0.f, 0.f};
        cur = nxt; cA = nA; cB = nB; ++ui;
        if constexpr (ALIGN_EPI) { if (wr == 1) PG8_BAR; }
    }
    PG8_WAIT_V(0);
    if constexpr (!ALIGN_EPI) { if (wr == 0) PG8_BAR; }
    PG8_BAR;
    if constexpr (Epi::AFTER_DRAIN) { E.fused(acc, cur, wr, wc, fr, fq, lds, wid, lane); S.done(cur); }
#undef PG8_SA
#undef PG8_SB
#undef PG8_STAGE
#undef PG8_LDA
#undef PG8_LDB
#undef PG8_MMA
#undef PG8_WAIT_V
#undef PG8_WAIT_L
#undef PG8_BAR
#undef PG8_SCHED
}
}
constexpr int NB = 4, T = 8192, D = 1024, M = NB * T, FF = 4096;
constexpr int NRW = 1792, NAT = 1536, NPL = 512, NA = NRW + NAT + NPL  , NG = 3072, NIN = NA + NG  , W = 512;
constexpr int NH = 8, HD = 64, MB_BLK = 256, NBLK = T / MB_BLK  ;
constexpr int NWAVES = 8;
typedef unsigned short bf16;
typedef unsigned v4u __attribute__((ext_vector_type(4)));
typedef unsigned v2u __attribute__((ext_vector_type(2)));
typedef float f32x4 __attribute__((ext_vector_type(4)));
#define LAS __attribute__((address_space(3)))
typedef GAS unsigned gu32;
#define RLX_AGENT __ATOMIC_RELAXED, __HIP_MEMORY_SCOPE_AGENT
#define LDS_WAIT() asm volatile("s_waitcnt lgkmcnt(0)" ::: "memory")
#define VM_WAIT() asm volatile("s_waitcnt vmcnt(0)" ::: "memory")
__device__ __forceinline__ unsigned f2bf(float f) { unsigned u = __builtin_bit_cast(unsigned, f); return (u + 0x7fffu + ((u >> 16) & 1u)) >> 16; }
typedef float f32x2_t __attribute__((ext_vector_type(2)));
typedef __bf16 bf16x2_t __attribute__((ext_vector_type(2)));
__device__ __forceinline__ unsigned pk2(float lo, float hi) { f32x2_t v = {lo, hi}; bf16x2_t b = __builtin_convertvector(v, bf16x2_t); return __builtin_bit_cast(unsigned, b); }
__device__ __forceinline__ float bf2f(unsigned b) { return __builtin_bit_cast(float, b << 16); }
__device__ __forceinline__ float bflo(unsigned w) { return __builtin_bit_cast(float, w << 16); }
__device__ __forceinline__ float bfhi(unsigned w) { return __builtin_bit_cast(float, w & 0xffff0000u); }
__device__ __forceinline__ float sigmoidf_(float x) { return 1.0f / (1.0f + __expf(-x)); }
__device__ __forceinline__ float fsig(float x) { return __builtin_amdgcn_rcpf(1.0f + __builtin_amdgcn_exp2f(-1.4426950408889634f * x)); }
__device__ __forceinline__ float ftanh(float x) { return 2.0f * fsig(2.0f * x) - 1.0f; }
__device__ __forceinline__ float wave_sum(float v) {
#pragma unroll
    for (int o = 1; o < 64; o <<= 1) v += __shfl_xor(v, o);
    return v;
}

constexpr size_t MiB = 1u << 20;
constexpr size_t WS_CTL = 0, CTL_ZERO_BYTES = 1 * MiB;
constexpr size_t WS_WIN = 1 * MiB, WS_WB = 15 * MiB, WS_WO = 18 * MiB, WS_W1 = 20 * MiB, WS_W2 = 28 * MiB, WS_KM = 36 * MiB, WS_LORA = 37 * MiB;
constexpr size_t WS_H = 40 * MiB, WS_RW = 104 * MiB, WS_AT = 216 * MiB, WS_PL = 312 * MiB  , WS_VT = 344 * MiB  ;
constexpr size_t WS_GF = 376 * MiB, WS_PST = 408 * MiB, WS_QST = 440 * MiB, WS_SST = 472 * MiB, WS_BON = 504 * MiB, WS_SB = 505 * MiB, WS_HB = 507 * MiB, WS_END = 511 * MiB;
constexpr size_t WS_GB = 376 * MiB, WS_MB = 440 * MiB, WS_HID = 104 * MiB;
constexpr int CW_BAR = 4096, CW_Q = 8192;
constexpr int RING_OFF = 0, RING_BYTES = 131072;
constexpr int LDS_BYTES = 153600, LDSCTL_OFF = LDS_BYTES - 1024, MISC_OFF = LDSCTL_OFF + 320;
#define XB_TMO      128
#define XB_XCNT(j)  (256  + 64 * (j))
#define XB_XSUB(j)  (1280 + 64 * (j))
#define XB_XGEN(j)  (2304 + 64 * (j))
#define XB_TOP      3328
#define XB_TOPGEN   3392
#define XCD_BAR_WORDS 3456
#define XB_SPIN_CAP (1u << 18)
__device__ __forceinline__ unsigned xb_ld(unsigned* p)              { return __hip_atomic_load(p, __ATOMIC_RELAXED, __HIP_MEMORY_SCOPE_AGENT); }
__device__ __forceinline__ unsigned xb_add(unsigned* p, unsigned v) { return __hip_atomic_fetch_add(p, v, __ATOMIC_RELAXED, __HIP_MEMORY_SCOPE_AGENT); }
__device__ __forceinline__ unsigned xb_xcc_id() { return (unsigned)__builtin_amdgcn_s_getreg((3 << 11) | 20) & 0xFu; }
#define XB_SPIN(cond, bar) do { unsigned _sp = 0; while (cond) { __builtin_amdgcn_s_sleep(1); \
    if ((++_sp & 255u) == 0u) { if (xb_ld(&(bar)[XB_TMO])) break; if (_sp > XB_SPIN_CAP) { atomicAdd(&(bar)[XB_TMO], 1u); break; } } } } while (0)
struct XcdBarrier { unsigned* bar; unsigned x; volatile LAS unsigned* st; };
__device__ __forceinline__ XcdBarrier xcd_barrier_post(unsigned* bar, volatile LAS unsigned* st) {
    XcdBarrier b; b.bar = bar; b.x = xb_xcc_id(); b.st = st;
    if (threadIdx.x == 0) (void)xb_add(&bar[XB_XCNT(b.x)], 1u);
    return b;
}
__device__ __forceinline__ void xcd_barrier_complete(unsigned* bar, unsigned x, unsigned& nloc, unsigned& nx) {
    const unsigned G = gridDim.x * gridDim.y * gridDim.z;
    unsigned sum, cnt, mine, sp = 0u;
    for (;;) {
        sum = 0u; cnt = 0u; mine = 0u;
#pragma unroll
        for (unsigned j = 0; j < 16; ++j) { const unsigned c = xb_ld(&bar[XB_XCNT(j)]); sum += c; cnt += (c > 0u) ? 1u : 0u; mine = (j == x) ? c : mine; }
        if (sum == G) break;
        __builtin_amdgcn_s_sleep(1);
        if ((++sp & 255u) == 0u) { if (xb_ld(&bar[XB_TMO])) break; if (sp > XB_SPIN_CAP) { atomicAdd(&bar[XB_TMO], 1u); break; } }
    }
    nloc = mine > 0u ? mine : 1u; nx = cnt > 0u ? cnt : 1u;
}
__device__ __forceinline__ void xcd_barrier(const XcdBarrier& b) {
    asm volatile("s_waitcnt vmcnt(0)" ::: "memory");
    __syncthreads();
    if (threadIdx.x == 0) {
        unsigned* bar = b.bar;
        __builtin_amdgcn_s_waitcnt(0);
        unsigned nloc = b.st[0], nx = b.st[1];
        if (nloc == 0u) { xcd_barrier_complete(bar, b.x, nloc, nx); b.st[0] = nloc; b.st[1] = nx; }
        const unsigned old = xb_add(&bar[XB_XSUB(b.x)], 1u);
        const unsigned gen = old / nloc;
        if (old + 1u == (gen + 1u) * nloc) {
            __builtin_amdgcn_fence(__ATOMIC_RELEASE, "agent");
            asm volatile("s_waitcnt vmcnt(0)" ::: "memory");
            const unsigned og = xb_add(&bar[XB_TOP], 1u);
            const unsigned tg = og / nx;
            if (og + 1u == (tg + 1u) * nx) xb_add(&bar[XB_TOPGEN], 1u);
            else XB_SPIN(xb_ld(&bar[XB_TOPGEN]) == tg, bar);
            __builtin_amdgcn_fence(__ATOMIC_ACQUIRE, "agent");
            xb_add(&bar[XB_XGEN(b.x)], 1u);
            asm volatile("s_waitcnt vmcnt(0)" ::: "memory");
        } else {
            XB_SPIN(xb_ld(&bar[XB_XGEN(b.x)]) == gen, bar);
            __builtin_amdgcn_fence(__ATOMIC_ACQUIRE, "agent");
            asm volatile("s_waitcnt vmcnt(0)" ::: "memory");
        }
    }
    __syncthreads();
}

struct Args { const float* in[23]; float* out; unsigned char* ws; int ph_lo, ph_hi, l_lo, l_hi, fused, probe_upto, probe_dup, pad; };
enum Phase { PH_CONV = 0, PH_GEMMA, PH_MIX1, PH_MIX2, PH_S3, PH_GB, PH_GO, PH_NORM2, PH_FF1, PH_FF2, PH_N };
enum In { I_X = 0, I_N1G, I_WIN, I_MU, I_W0, I_WUP, I_A0, I_AUP, I_GUP, I_KK, I_KA, I_RK, I_LNG, I_LNB, I_QNG, I_KNG, I_POOLW, I_POOLS, I_WBR, I_WOUT, I_N2G, I_FF1, I_FF2 };

__device__ __forceinline__ void p0_transpose_item(const float* Wm, int K, int N, bf16* WT, LAS float* scr, int item, int lane) {
    const int nblk = N / 32, kb = item / nblk, nb = item % nblk, k0 = 64 * kb, n0 = 32 * nb;
#pragma unroll 8
    for (int i = 0; i < 32; ++i) { const int kk = 2 * i + (lane >> 5); scr[kk * 33 + (lane & 31)] = ((const GAS float*)Wm)[(size_t)(k0 + kk) * N + n0 + (lane & 31)]; }
    LDS_WAIT(); asm volatile("" ::: "memory");
    const int c = lane & 7;
#pragma unroll
    for (int j = 0; j < 4; ++j) { const int n = (lane >> 3) + 8 * j; const LAS float* s = scr + (8 * c) * 33 + n;
        v4u o; o.x = pk2(s[0 * 33], s[1 * 33]); o.y = pk2(s[2 * 33], s[3 * 33]); o.z = pk2(s[4 * 33], s[5 * 33]); o.w = pk2(s[6 * 33], s[7 * 33]);
        *(GAS v4u*)(WT + (size_t)(n0 + n) * K + k0 + 8 * c) = o; }
    LDS_WAIT(); asm volatile("" ::: "memory");
}
__device__ __forceinline__ void rms_rows(const float* x, const float* g, bf16* out, int gw, int NGW, int lane) {
    f32x4 gv[4];
#pragma unroll
    for (int j = 0; j < 4; ++j) gv[j] = ((const GAS f32x4*)g)[lane + 64 * j];
    for (int m0 = gw; m0 < M; m0 += 4 * NGW) {
        f32x4 v[4][4];
#pragma unroll
        for (int rr = 0; rr < 4; ++rr) { const int m = m0 + rr * NGW; if (m < M) { const GAS f32x4* xr = (const GAS f32x4*)(x + (size_t)m * D) + lane;
#pragma unroll
            for (int j = 0; j < 4; ++j) v[rr][j] = xr[64 * j]; } }
#pragma unroll
        for (int rr = 0; rr < 4; ++rr) { const int m = m0 + rr * NGW; if (m < M) {
            float s_ = 0.f;
#pragma unroll
            for (int j = 0; j < 4; ++j) s_ += (v[rr][j].x * v[rr][j].x + v[rr][j].y * v[rr][j].y) + (v[rr][j].z * v[rr][j].z + v[rr][j].w * v[rr][j].w);
            const float rstd = 1.0f / sqrtf(wave_sum(s_) * (1.0f / D) + 1e-6f);
            GAS unsigned long long* o8 = (GAS unsigned long long*)(out + (size_t)m * D) + lane;
#pragma unroll
            for (int j = 0; j < 4; ++j) { const f32x4 y = v[rr][j] * rstd * gv[j]; o8[64 * j] = (unsigned long long)pk2(y.x, y.y) | ((unsigned long long)pk2(y.z, y.w) << 32); } } }
    }
}

__device__ __forceinline__ void ph_attn_prep(LAS unsigned char* lds, bf16* AT, bf16* VT, const float* qg, const float* kg, float* KM, int G, const int tid) {
    LAS float* red = (LAS float*)lds;
    LAS unsigned char* vt = lds + 2048;
    const int lane = tid & 63, wave = tid >> 6, tsub = lane >> 3, dq = lane & 7;
    float gq[8], gk[8];
#pragma unroll
    for (int e = 0; e < 8; ++e) { gq[e] = ((const GAS float*)qg)[dq * 8 + e] * (0.125f * 1.4426950408889634f); gk[e] = ((const GAS float*)kg)[dq * 8 + e]; }
    for (int bid = blockIdx.x; bid < NB * NBLK * NH; bid += G) {
        const int h = bid & 7, n = (bid >> 3) & 31, b = bid >> 8;
        v4u qv[4], kv[4], vv[4];
#pragma unroll
        for (int j = 0; j < 4; ++j) { const size_t row = (size_t)b * T + n * 256 + wave * 32 + 8 * j + tsub; const bf16* qp = AT + row * NAT + h * 64 + dq * 8;
            qv[j] = *(const GAS v4u*)qp; kv[j] = *(const GAS v4u*)(qp + 512); vv[j] = *(const GAS v4u*)(qp + 1024); }
        float ksum[8];
#pragma unroll
        for (int e = 0; e < 8; ++e) ksum[e] = 0.f;
#pragma unroll
        for (int j = 0; j < 4; ++j) {
            const int tok = wave * 32 + 8 * j + tsub; const size_t row = (size_t)b * T + n * 256 + tok; bf16* qp = AT + row * NAT + h * 64 + dq * 8;
            float q[8], k[8];
            q[0] = bflo(qv[j].x); q[1] = bfhi(qv[j].x); q[2] = bflo(qv[j].y); q[3] = bfhi(qv[j].y); q[4] = bflo(qv[j].z); q[5] = bfhi(qv[j].z); q[6] = bflo(qv[j].w); q[7] = bfhi(qv[j].w);
            k[0] = bflo(kv[j].x); k[1] = bfhi(kv[j].x); k[2] = bflo(kv[j].y); k[3] = bfhi(kv[j].y); k[4] = bflo(kv[j].z); k[5] = bfhi(kv[j].z); k[6] = bflo(kv[j].w); k[7] = bfhi(kv[j].w);
            float qs = 0.f, ks = 0.f;
#pragma unroll
            for (int e = 0; e < 8; ++e) { qs += q[e] * q[e]; ks += k[e] * k[e]; }
            qs += __shfl_xor(qs, 1); qs += __shfl_xor(qs, 2); qs += __shfl_xor(qs, 4);
            ks += __shfl_xor(ks, 1); ks += __shfl_xor(ks, 2); ks += __shfl_xor(ks, 4);
            const float rq = 1.0f / sqrtf(qs * (1.0f / 64.0f) + 1e-6f), rk = 1.0f / sqrtf(ks * (1.0f / 64.0f) + 1e-6f);
#pragma unroll
            for (int e = 0; e < 8; ++e) { q[e] = q[e] * rq * gq[e]; k[e] = k[e] * rk * gk[e]; ksum[e] += k[e]; }
            v4u w; w.x = pk2(q[0], q[1]); w.y = pk2(q[2], q[3]); w.z = pk2(q[4], q[5]); w.w = pk2(q[6], q[7]); *(GAS v4u*)qp = w;
            w.x = pk2(k[0], k[1]); w.y = pk2(k[2], k[3]); w.z = pk2(k[4], k[5]); w.w = pk2(k[6], k[7]); *(GAS v4u*)(qp + 512) = w;
            const unsigned vw[4] = {vv[j].x, vv[j].y, vv[j].z, vv[j].w};
#pragma unroll
            for (int e = 0; e < 8; ++e) *(LAS bf16*)(vt + (dq * 8 + e) * 520 + tok * 2) = (bf16)((e & 1) ? (vw[e >> 1] >> 16) : (vw[e >> 1] & 0xffffu));
        }
#pragma unroll
        for (int e = 0; e < 8; ++e) { float s_ = ksum[e]; s_ += __shfl_xor(s_, 8); s_ += __shfl_xor(s_, 16); s_ += __shfl_xor(s_, 32); if (tsub == 0) red[wave * 64 + dq * 8 + e] = s_; }
        __syncthreads();
        if (wave == 0) { float s_ = 0.f; for (int w = 0; w < 8; ++w) s_ += red[w * 64 + lane]; ((GAS float*)KM)[(((size_t)b * NH + h) * NBLK + n) * 64 + lane] = s_ * (1.0f / 256.0f); }
#pragma unroll
        for (int j = 0; j < 4; ++j) { const int c = tid + 512 * j, dim = c >> 5, part = c & 31;
            const v2u lo = *(const LAS v2u*)(vt + dim * 520 + part * 16), hi = *(const LAS v2u*)(vt + dim * 520 + part * 16 + 8);
            v4u w; w.x = lo.x; w.y = lo.y; w.z = hi.x; w.w = hi.y;
            *(GAS v4u*)(VT + (((size_t)(b * NH + h) * (T / 32) + n * 8 + (part >> 2)) * 64 + dim) * 32 + (part & 3) * 8) = w; }
        __syncthreads();
    }
}
__device__ __forceinline__ void ph_pool(bf16* PL_, const bf16* HB_, int G, const int tid) {
    GAS bf16* PL = (GAS bf16*)PL_; const GAS bf16* HB = (const GAS bf16*)HB_;
    const int ch = tid, wdw = 2 << (ch >> 7);
    for (int u = blockIdx.x; u < M / 128; u += G) {
        float ring[16];
        const int tb0 = (u * 128) & (T - 1);
#pragma unroll
        for (int k = 0; k < 16; ++k) ring[k] = 0.f;
        unsigned short hv[15], cu[16], nx[16];
        if (tb0 > 0) {
#pragma unroll
            for (int j = 0; j < 15; ++j) hv[j] = HB[((size_t)(u - 1) * 15 + j) * 512 + ch];
        }
#pragma unroll
        for (int tt = 0; tt < 16; ++tt) cu[tt] = PL[((size_t)u * 128 + tt) * NPL + ch];
        if (tb0 > 0) {
#pragma unroll
            for (int j = 0; j < 15; ++j) ring[1 + j] = bf2f(hv[j]);
        }
#pragma unroll
        for (int t0 = 0; t0 < 128; t0 += 16) {
            if (t0 + 16 < 128) {
#pragma unroll
                for (int tt = 0; tt < 16; ++tt) nx[tt] = PL[((size_t)u * 128 + t0 + 16 + tt) * NPL + ch];
            }
#pragma unroll
            for (int tt = 0; tt < 16; ++tt) {
                const float cur = bf2f(cu[tt]);
                ring[tt] = cur;
                float sm = 0.f;
#pragma unroll
                for (int i = 0; i < 16; ++i) sm += (i < wdw) ? ring[(tt - i) & 15] : 0.f;
                const int tpos = tb0 + t0 + tt; const int cnt = (tpos + 1 < wdw) ? (tpos + 1) : wdw;
                PL[((size_t)u * 128 + t0 + tt) * NPL + ch] = (bf16)f2bf(sm / (float)cnt - cur);
            }
#pragma unroll
            for (int tt = 0; tt < 16; ++tt) cu[tt] = nx[tt];
        }
    }
}
namespace rw {
typedef short bf16x8 __attribute__((ext_vector_type(8)));
constexpr int MATB = 64 * 144;
constexpr int FPB = 64 * 272;
constexpr int X0 = 0, ACTW = X0, ACTA = X0 + MATB, ACTG = X0 + 2 * MATB  , AAB = X0, AAK = X0 + MATB, ARB = X0 + 2 * MATB, ARK = X0 + 3 * MATB;
constexpr int Y0 = 4 * MATB, LWP = Y0, AIP = Y0 + FPB, LGO = AIP, TOT = Y0 + 2 * FPB  , GCV = TOT + 2048  , DG = Y0  , TI = Y0 + 4096  , U0T = Y0 + 8192;
constexpr int PTAB = GCV + 256  ;
constexpr int Z0 = Y0 + 2 * FPB + 2048 + 256 + 3072, AT_ = Z0, BT_ = Z0 + MATB, KT_ = Z0 + 2 * MATB, RT_ = Z0 + 3 * MATB, ATT = Z0 + 4 * MATB, BHT = Z0 + 5 * MATB, KHT = Z0 + 6 * MATB, VTT = Z0 + 7 * MATB;
constexpr int S1_LDS = Z0 + 8 * MATB;
static_assert(S1_LDS <= 153600 - 1024, "S1 LDS map below the control words");
static_assert(U0T + MATB <= TOT, "U0T inside the dead f32 region");
__device__ __forceinline__ f32x4 mma(bf16x8 a, bf16x8 b, f32x4 c) { return __builtin_amdgcn_mfma_f32_16x16x32_bf16(a, b, c, 0, 0, 0); }
__device__ __forceinline__ bf16x8 ldf(const LAS unsigned char* mat, int row, int s, int g) { return *(const LAS bf16x8*)(mat + row * 144 + s * 64 + g * 16); }
__device__ __forceinline__ v2u pack4(f32x4 v) { v2u w; w.x = pk2(v[0], v[1]); w.y = pk2(v[2], v[3]); return w; }
__device__ __forceinline__ f32x4 unpack4(v2u w) { return (f32x4){bflo(w.x), bfhi(w.x), bflo(w.y), bfhi(w.y)}; }
__device__ __forceinline__ void unpack8(v4u w, float* o) { o[0] = bflo(w.x); o[1] = bfhi(w.x); o[2] = bflo(w.y); o[3] = bfhi(w.y); o[4] = bflo(w.z); o[5] = bfhi(w.z); o[6] = bflo(w.w); o[7] = bfhi(w.w); }
__device__ __forceinline__ v4u pack8(const float* o) { v4u w; w.x = pk2(o[0], o[1]); w.y = pk2(o[2], o[3]); w.z = pk2(o[4], o[5]); w.w = pk2(o[6], o[7]); return w; }
#define LDS_BAR() do { asm volatile("s_waitcnt lgkmcnt(0)" ::: "memory"); __builtin_amdgcn_s_barrier(); asm volatile("" ::: "memory"); } while (0)
#define RW_BAR() do { asm volatile("s_waitcnt vmcnt(0) lgkmcnt(0)" ::: "memory"); __builtin_amdgcn_s_barrier(); asm volatile("" ::: "memory"); } while (0)

struct S1Args {
    bf16* RW; const bf16* SB;
    const float *mu, *w0, *a0, *k_k, *k_a, *r_k;
    const bf16 *WupT, *AupT, *GupT;
    bf16 *Gf, *Pst, *Qst; float* bonus;
    bf16 *Rh, *O0; int ldo;
    bf16* Vm; int ldv;
};
__device__ __forceinline__ void s1_unit(LAS unsigned char* lds, const S1Args& A, const int unit, const int tid, int& hprev, const bool dummy = false) {
    const int lane = tid & 63, wave = __builtin_amdgcn_readfirstlane(tid >> 6), r = lane & 15, g = lane >> 4;
    const int h = unit & 7, cidx = unit >> 3  , c_in_b = cidx & 127;
    const size_t row0 = (size_t)cidx * 64;
    const int t = tid >> 3, q = tid & 7;
    float rp[8], kp[8], lwv[8], av[8], kk[8], vp[8];
    if (h != hprev) {
        LAS float* pt = (LAS float*)(lds + PTAB);
        for (int i = tid; i < 768; i += 512) {
            float v_;
            if (i < 192) v_ = ((const GAS float*)A.mu)[(i >> 6) * 512 + h * 64 + (i & 63)];
            else if (i < 448) v_ = ((const GAS float*)A.mu)[1536 + (i - 192)];
            else { const int j = i - 448, c_ = h * 64 + (j & 63); const int w_ = j >> 6; const float* pp_ = (w_ == 0) ? A.w0 : (w_ == 1) ? A.a0 : (w_ == 2) ? A.k_k : (w_ == 3) ? A.k_a : A.r_k; v_ = ((const GAS float*)pp_)[c_]; }
            pt[i] = v_;
        }
        hprev = h;
        LDS_BAR();
    }
    const LAS float* PT = (const LAS float*)(lds + PTAB);
    bf16x8 fw[2], fa[2], fg[4];
    {
        const int cb = wave >> 1;
        const bf16* wu = A.WupT + (size_t)(h * 64 + 16 * cb + r) * 64 + 8 * g;
        const bf16* au = A.AupT + (size_t)(h * 64 + 16 * cb + r) * 64 + 8 * g;
        const bf16* gu = A.GupT + (size_t)(h * 64 + 16 * cb + r) * 128 + 8 * g;
#pragma unroll
        for (int s = 0; s < 2; ++s) { fw[s] = *(const GAS bf16x8*)(wu + 32 * s); fa[s] = *(const GAS bf16x8*)(au + 32 * s); }
#pragma unroll
        for (int s = 0; s < 4; ++s) fg[s] = *(const GAS bf16x8*)(gu + 32 * s);
    }
    {
        const bf16* cur = A.RW + (row0 + t) * NRW;
        const bf16* prv = (t > 0) ? (cur - NRW) : (A.SB + (size_t)(cidx - 1) * NRW);
        const bool hasprev = (t > 0) || (c_in_b > 0);
        float c8[8], p8[8];
#define MIXLOAD(COL, MUO, DST) do { unpack8(*(const GAS v4u*)(cur + (COL)), c8); if (hasprev) unpack8(*(const GAS v4u*)(prv + (COL)), p8); \
            _Pragma("unroll") for (int e = 0; e < 8; ++e) { const float pv_ = hasprev ? p8[e] : 0.f; DST[e] = c8[e] + (pv_ - c8[e]) * PT[(MUO) + e]; } } while (0)
        MIXLOAD(h * 64 + 8 * q, 8 * q, rp); MIXLOAD(512 + h * 64 + 8 * q, 64 + 8 * q, kp); MIXLOAD(1024 + h * 64 + 8 * q, 128 + 8 * q, vp);
#pragma unroll
        for (int e = 0; e < 8; ++e) *(LAS bf16*)(lds + VTT + (8 * q + e) * 144 + t * 2) = (bf16)f2bf(vp[e]);
        float x8[8];
        MIXLOAD(1536 + 8 * q, 192 + 8 * q, x8);
#pragma unroll
        for (int e = 0; e < 8; ++e) x8[e] = ftanh(x8[e]);
        *(LAS v4u*)(lds + ACTW + t * 144 + q * 16) = pack8(x8);
        MIXLOAD(1600 + 8 * q, 256 + 8 * q, x8);
        *(LAS v4u*)(lds + ACTA + t * 144 + q * 16) = pack8(x8);
        MIXLOAD(1664 + 16 * q, 320 + 16 * q, x8);
#pragma unroll
        for (int e = 0; e < 8; ++e) x8[e] = fsig(x8[e]);
        *(LAS v4u*)(lds + ACTG + t * 272 + q * 32) = pack8(x8);
        MIXLOAD(1664 + 16 * q + 8, 320 + 16 * q + 8, x8);
#pragma unroll
        for (int e = 0; e < 8; ++e) x8[e] = fsig(x8[e]);
        *(LAS v4u*)(lds + ACTG + t * 272 + q * 32 + 16) = pack8(x8);
#undef MIXLOAD
    }
    LDS_BAR();
    if (!dummy) *(GAS v4u*)(A.Vm + (row0 + t) * A.ldv + h * 64 + 8 * q) = pack8(vp);
    {
        const int cb = wave >> 1;
#pragma unroll
        for (int i = 0; i < 2; ++i) {
            const int tb = 2 * (wave & 1) + i;
            f32x4 cw = {0.f, 0.f, 0.f, 0.f}, ca = {0.f, 0.f, 0.f, 0.f}, cg = {0.f, 0.f, 0.f, 0.f};
#pragma unroll
            for (int s = 0; s < 2; ++s) { cw = mma(fw[s], ldf(lds + ACTW, 16 * tb + r, s, g), cw); ca = mma(fa[s], ldf(lds + ACTA, 16 * tb + r, s, g), ca); }
#pragma unroll
            for (int s = 0; s < 4; ++s) cg = mma(fg[s], *(const LAS bf16x8*)(lds + ACTG + (16 * tb + r) * 272 + s * 64 + g * 16), cg);
            *(LAS f32x4*)(lds + LWP + (16 * tb + r) * 272 + (16 * cb + 4 * g) * 4) = cw;
            *(LAS f32x4*)(lds + AIP + (16 * tb + r) * 272 + (16 * cb + 4 * g) * 4) = ca;
            if (!dummy) *(GAS v2u*)(A.Gf + (row0 + 16 * tb + r) * W + h * 64 + 16 * cb + 4 * g) = pack4(cg);
        }
    }
    LDS_BAR();
    {
        const f32x4 l0 = *(const LAS f32x4*)(lds + LWP + t * 272 + q * 32), l1 = *(const LAS f32x4*)(lds + LWP + t * 272 + q * 32 + 16);
        const f32x4 a0v = *(const LAS f32x4*)(lds + AIP + t * 272 + q * 32), a1v = *(const LAS f32x4*)(lds + AIP + t * 272 + q * 32 + 16);
        float ss = 0.f, bon = 0.f;
#pragma unroll
        for (int e = 0; e < 8; ++e) { const int hc = 8 * q + e;
            const float lp = (e < 4) ? l0[e & 3] : l1[e & 3], ap = (e < 4) ? a0v[e & 3] : a1v[e & 3];
            lwv[e] = -0.60653065971263342f * fsig(PT[448 + hc] + lp);
            av[e] = fsig(PT[512 + hc] + ap);
            kk[e] = kp[e] * PT[576 + hc]; ss += kk[e] * kk[e];
            kp[e] = kp[e] * (1.0f + (av[e] - 1.0f) * PT[640 + hc]);
            bon += rp[e] * kp[e] * PT[704 + hc]; }
        ss += __shfl_xor(ss, 1); ss += __shfl_xor(ss, 2); ss += __shfl_xor(ss, 4);
        bon += __shfl_xor(bon, 1); bon += __shfl_xor(bon, 2); bon += __shfl_xor(bon, 4);
        const float inv = 1.0f / fmaxf(sqrtf(ss), 1e-12f);
#pragma unroll
        for (int e = 0; e < 8; ++e) kk[e] *= inv;
        if (q == 0 && !dummy) ((GAS float*)A.bonus)[(row0 + t) * 8 + h] = bon;
        *(LAS f32x4*)(lds + LWP + t * 272 + q * 32) = (f32x4){lwv[0], lwv[1], lwv[2], lwv[3]};
        *(LAS f32x4*)(lds + LWP + t * 272 + q * 32 + 16) = (f32x4){lwv[4], lwv[5], lwv[6], lwv[7]};
    }
    LDS_BAR();
    {
        const int c = tid & 63, seg = tid >> 6; float x[8]; float run = 0.f;
#pragma unroll
        for (int i = 0; i < 8; ++i) { run += *(const LAS float*)(lds + LWP + (8 * seg + i) * 272 + c * 4); x[i] = run; }
        *(LAS float*)(lds + TOT + (seg * 64 + c) * 4) = run;
        LDS_BAR();
        float off = 0.f;
        for (int s2 = 0; s2 < seg; ++s2) off += *(const LAS float*)(lds + TOT + (s2 * 64 + c) * 4);
#pragma unroll
        for (int i = 0; i < 8; ++i) *(LAS float*)(lds + LGO + (8 * seg + i) * 272 + c * 4) = x[i] + off;
    }
    LDS_BAR();
    {
        const f32x4 g0 = *(const LAS f32x4*)(lds + LGO + t * 272 + q * 32), g1 = *(const LAS f32x4*)(lds + LGO + t * 272 + q * 32 + 16);
        const f32x4 e0 = *(const LAS f32x4*)(lds + LGO + 63 * 272 + q * 32), e1 = *(const LAS f32x4*)(lds + LGO + 63 * 272 + q * 32 + 16);
        float at[8], bt[8], kt[8], rt[8], bh[8], kh[8];
#pragma unroll
        for (int e = 0; e < 8; ++e) { const float lg = (e < 4) ? g0[e & 3] : g1[e & 3], lc = (e < 4) ? e0[e & 3] : e1[e & 3];
            const float gm1 = __expf(lg - lwv[e]), gi = __expf(-lg), gt = __expf(lg), gr = __expf(lc - lg);
            const float bb = kk[e] * av[e];
            at[e] = -kk[e] * gm1; bt[e] = bb * gi; kt[e] = kp[e] * gi; rt[e] = rp[e] * gt; bh[e] = bb * gr; kh[e] = kp[e] * gr;
            if (t == 63) *(LAS float*)(lds + GCV + (8 * q + e) * 4) = __expf(lc); }
        *(LAS v4u*)(lds + AT_ + t * 144 + q * 16) = pack8(at); *(LAS v4u*)(lds + BT_ + t * 144 + q * 16) = pack8(bt);
        *(LAS v4u*)(lds + KT_ + t * 144 + q * 16) = pack8(kt); *(LAS v4u*)(lds + RT_ + t * 144 + q * 16) = pack8(rt);
#pragma unroll
        for (int e = 0; e < 8; ++e) { const int o = (8 * q + e) * 144 + t * 2;
            *(LAS bf16*)(lds + ATT + o) = (bf16)f2bf(at[e]); *(LAS bf16*)(lds + BHT + o) = (bf16)f2bf(bh[e]); *(LAS bf16*)(lds + KHT + o) = (bf16)f2bf(kh[e]); }
    }
    LDS_BAR();
    {
        const int hv_tb[10] = {0, 1, 1, 2, 2, 2, 3, 3, 3, 3}, hv_jb[10] = {0, 0, 1, 0, 1, 2, 0, 1, 2, 3};
        const int z_tb[6] = {0, 0, 0, 1, 1, 2}, z_jb[6] = {1, 2, 3, 2, 3, 3};
#pragma unroll
        for (int pass = 0; pass < 2; ++pass) {
            const int hi = (pass == 0) ? wave : (wave < 2 ? 8 + wave : -1);
            if (hi >= 0) {
                int tb = 0, jb = 0;
#pragma unroll
                for (int k = 0; k < 10; ++k) if (k == hi) { tb = hv_tb[k]; jb = hv_jb[k]; }
                f32x4 cab = {0.f, 0.f, 0.f, 0.f}, cak = cab, crb = cab, crk = cab;
#pragma unroll
                for (int s = 0; s < 2; ++s) { const bf16x8 fb = ldf(lds + BT_, 16 * jb + r, s, g), fk = ldf(lds + KT_, 16 * jb + r, s, g), fa = ldf(lds + AT_, 16 * tb + r, s, g), fr = ldf(lds + RT_, 16 * tb + r, s, g);
                    cab = mma(fb, fa, cab); cak = mma(fk, fa, cak); crb = mma(fb, fr, crb); crk = mma(fk, fr, crk); }
                const int tt = 16 * tb + r;
#pragma unroll
                for (int e = 0; e < 4; ++e) { const int j = 16 * jb + 4 * g + e; if (!(j < tt)) { cab[e] = 0.f; cak[e] = 0.f; } if (!(j <= tt)) { crb[e] = 0.f; crk[e] = 0.f; } }
                const int o = tt * 144 + (16 * jb + 4 * g) * 2;
                *(LAS v2u*)(lds + AAB + o) = pack4(cab); *(LAS v2u*)(lds + AAK + o) = pack4(cak); *(LAS v2u*)(lds + ARB + o) = pack4(crb); *(LAS v2u*)(lds + ARK + o) = pack4(crk);
                if (tb == jb) *(LAS f32x4*)(lds + DG + ((tb * 16 + r) * 16 + 4 * g) * 4) = cab;
            }
        }
        if (wave >= 2) {
            int tb = 0, jb = 0;
#pragma unroll
            for (int k = 0; k < 6; ++k) if (k == wave - 2) { tb = z_tb[k]; jb = z_jb[k]; }
            const int o = (16 * tb + r) * 144 + (16 * jb + 4 * g) * 2; const v2u z = {0u, 0u};
            *(LAS v2u*)(lds + AAB + o) = z; *(LAS v2u*)(lds + AAK + o) = z; *(LAS v2u*)(lds + ARB + o) = z; *(LAS v2u*)(lds + ARK + o) = z;
        }
    }
    LDS_BAR();
    f32x4 Y[4];
    if (wave == 7) {
        const int blk = lane >> 4, col = lane & 15; float x[16];
#pragma unroll
        for (int tt = 0; tt < 16; ++tt) {
            float acc = (tt == col) ? 1.0f : 0.0f;
            const LAS float* nrow = (const LAS float*)(lds + DG + ((blk * 16 + tt) * 16) * 4);
#pragma unroll
            for (int j = 0; j < 16; ++j) if (j < tt) acc += nrow[j] * x[j];
            x[tt] = acc;
            *(LAS bf16*)(lds + TI + ((blk * 16 + tt) * 16 + col) * 2) = (bf16)f2bf(acc);
        }
    }
    if (wave < 4) {
#pragma unroll
        for (int i = 0; i < 4; ++i) { Y[i] = (f32x4){0.f, 0.f, 0.f, 0.f};
#pragma unroll
            for (int s = 0; s < 2; ++s) Y[i] = mma(ldf(lds + AAK, 16 * i + r, s, g), ldf(lds + VTT, 16 * wave + r, s, g), Y[i]); }
    } else {
#pragma unroll
        for (int i = 0; i < 4; ++i) Y[i] = unpack4(*(const LAS v2u*)(lds + ATT + (16 * (wave - 4) + r) * 144 + (16 * i + 4 * g) * 2));
    }
    LDS_BAR();
    {
        v2u Xb[4];
        const bf16x8 zf = {0, 0, 0, 0, 0, 0, 0, 0};
#pragma unroll
        for (int i = 0; i < 4; ++i) {
            if (i >= 1) {
                v4u bw; bw.x = Xb[0].x; bw.y = Xb[0].y; bw.z = (i >= 2) ? Xb[1].x : 0u; bw.w = (i >= 2) ? Xb[1].y : 0u;
                v4u aw; const v2u a0 = *(const LAS v2u*)(lds + AAB + (16 * i + r) * 144 + (4 * g) * 2), a1 = *(const LAS v2u*)(lds + AAB + (16 * i + r) * 144 + (16 + 4 * g) * 2);
                aw.x = a0.x; aw.y = a0.y; aw.z = a1.x; aw.w = a1.y;
                Y[i] = mma(__builtin_bit_cast(bf16x8, aw), __builtin_bit_cast(bf16x8, bw), Y[i]);
            }
            if (i >= 3) {
                v4u bw; bw.x = Xb[2].x; bw.y = Xb[2].y; bw.z = 0u; bw.w = 0u;
                v4u aw; const v2u a0 = *(const LAS v2u*)(lds + AAB + (16 * i + r) * 144 + (32 + 4 * g) * 2);
                aw.x = a0.x; aw.y = a0.y; aw.z = 0u; aw.w = 0u;
                Y[i] = mma(__builtin_bit_cast(bf16x8, aw), __builtin_bit_cast(bf16x8, bw), Y[i]);
            }
            v4u tw; const v2u t0 = *(const LAS v2u*)(lds + TI + ((i * 16 + r) * 16 + 4 * g) * 2); tw.x = t0.x; tw.y = t0.y; tw.z = 0u; tw.w = 0u;
            v4u yw; const v2u yp = pack4(Y[i]); yw.x = yp.x; yw.y = yp.y; yw.z = 0u; yw.w = 0u;
            const f32x4 X = mma(__builtin_bit_cast(bf16x8, tw), __builtin_bit_cast(bf16x8, yw), (f32x4){0.f, 0.f, 0.f, 0.f});
            Xb[i] = pack4(X);
            const int dst = (wave < 4) ? (U0T + (16 * wave + r) * 144) : (ATT + (16 * (wave - 4) + r) * 144);
            *(LAS v2u*)(lds + dst + (16 * i + 4 * g) * 2) = Xb[i];
        }
        (void)zf;
    }
    LDS_BAR();
    {
#pragma unroll
        for (int i = 0; i < 2; ++i) {
            const int qq = 2 * wave + i, rb = qq >> 2, cb = qq & 3;
            f32x4 crh = {0.f, 0.f, 0.f, 0.f}, co0 = crh, cp = crh, cq = crh;
#pragma unroll
            for (int s = 0; s < 2; ++s) {
                const bf16x8 fah = ldf(lds + ATT, 16 * rb + r, s, g), fu0 = ldf(lds + U0T, 16 * rb + r, s, g), fvt = ldf(lds + VTT, 16 * rb + r, s, g), fbh = ldf(lds + BHT, 16 * rb + r, s, g), fkh = ldf(lds + KHT, 16 * rb + r, s, g);
                const bf16x8 frb = ldf(lds + ARB, 16 * cb + r, s, g), frk = ldf(lds + ARK, 16 * cb + r, s, g), fbhc = ldf(lds + BHT, 16 * cb + r, s, g), fu0c = ldf(lds + U0T, 16 * cb + r, s, g), fvtc = ldf(lds + VTT, 16 * cb + r, s, g);
                crh = mma(fah, frb, crh);
                co0 = mma(fu0, frb, co0); co0 = mma(fvt, frk, co0);
                cp = mma(fah, fbhc, cp);
                cq = mma(fbh, fu0c, cq); cq = mma(fkh, fvtc, cq);
            }
            crh = crh + unpack4(*(const LAS v2u*)(lds + RT_ + (16 * cb + r) * 144 + (16 * rb + 4 * g) * 2));
            if (rb == cb) {
#pragma unroll
                for (int e = 0; e < 4; ++e) if (4 * g + e == r) cp[e] += *(const LAS float*)(lds + GCV + (16 * rb + 4 * g + e) * 4);
            }
            const size_t tok = row0 + 16 * cb + r;
            if (!dummy) {
            *(GAS v2u*)(A.Rh + tok * A.ldo + h * 64 + 16 * rb + 4 * g) = pack4(crh);
            *(GAS v2u*)(A.O0 + tok * A.ldo + h * 64 + 16 * rb + 4 * g) = pack4(co0);
            const size_t su = (size_t)(((cidx >> 7) * 8 + h) * 128 + c_in_b);
            *(GAS v2u*)(A.Pst + su * 4096 + (16 * cb + r) * 64 + 32 * (rb >> 1) + 8 * g + 4 * (rb & 1)) = pack4(cp);
            *(GAS v2u*)(A.Qst + su * 4096 + (16 * cb + r) * 64 + 16 * g + 4 * rb) = pack4(cq);
            }
        }
    }
    LDS_BAR();
}

struct PQ { v4u p[4][2]; v4u q[2]; };
constexpr int S2_NS = 8, S2_SLOTB = 2048, S2_FLAGS = 4 * S2_NS * S2_SLOTB;
__device__ __forceinline__ void s2_chain(LAS unsigned char* lds, const bf16* Pst, const bf16* Qst, const int bh, const int vb, const int lane) {
    const int r = lane & 15, g = lane >> 4;
    f32x4 S[4];
#pragma unroll
    for (int i = 0; i < 4; ++i) S[i] = (f32x4){0.f, 0.f, 0.f, 0.f};
    const size_t ustep = (size_t)4096;
    const bf16* Pp = Pst + ((size_t)bh * 128) * 4096 + r * 64 + 8 * g;
    const bf16* Qp = Qst + ((size_t)bh * 128) * 4096 + (16 * vb + r) * 64 + 16 * g;
    LAS unsigned char* ring = lds + vb * (S2_NS * S2_SLOTB) + r * 128 + g * 8;
    volatile LAS int* prod = (volatile LAS int*)(lds + S2_FLAGS + vb * 64);
    volatile LAS int* cons = (volatile LAS int*)(lds + S2_FLAGS + 256 + vb * 64);
#define S2_GLD(DST, PTR) asm volatile("global_load_dwordx4 %0, %1, off" : "=v"(DST) : "v"(PTR) : "memory")
#define S2_LOAD(B, C) do { const int c_ = (C) < 128 ? (C) : 127; const bf16* P_ = Pp + (size_t)c_ * ustep; const bf16* Q_ = Qp + (size_t)c_ * ustep; \
        _Pragma("unroll") for (int i = 0; i < 4; ++i) { S2_GLD(B.p[i][0], P_ + (16 * i) * 64); S2_GLD(B.p[i][1], P_ + (16 * i) * 64 + 32); } \
        S2_GLD(B.q[0], Q_); S2_GLD(B.q[1], Q_ + 8); } while (0)
#define S2_READY(B, N) asm volatile("s_waitcnt vmcnt(" #N ")" : "+v"(B.p[0][0]), "+v"(B.p[0][1]), "+v"(B.p[1][0]), "+v"(B.p[1][1]), "+v"(B.p[2][0]), "+v"(B.p[2][1]), "+v"(B.p[3][0]), "+v"(B.p[3][1]), "+v"(B.q[0]), "+v"(B.q[1]) :: "memory")
#define S2_STEP(B, C) do { v2u sb_[4]; \
        { unsigned sp_ = 0; while ((C) - *cons >= S2_NS && ++sp_ < (1u << 22)) __builtin_amdgcn_s_sleep(1); } asm volatile("" ::: "memory");   \
        _Pragma("unroll") for (int i = 0; i < 4; ++i) { sb_[i] = pack4(S[i]); *(LAS v2u*)(ring + ((C) & (S2_NS - 1)) * S2_SLOTB + 32 * i) = sb_[i]; } \
        asm volatile("s_waitcnt lgkmcnt(0)" ::: "memory"); if (lane == 0) *prod = (C) + 1; \
        _Pragma("unroll") for (int i = 0; i < 4; ++i) { v2u qi_; qi_.x = (i & 1) ? B.q[i >> 1].z : B.q[i >> 1].x; qi_.y = (i & 1) ? B.q[i >> 1].w : B.q[i >> 1].y; f32x4 n_ = unpack4(qi_); \
            _Pragma("unroll") for (int s_ = 0; s_ < 2; ++s_) { \
                v4u bw_; bw_.x = sb_[2 * s_].x; bw_.y = sb_[2 * s_].y; bw_.z = sb_[2 * s_ + 1].x; bw_.w = sb_[2 * s_ + 1].y; \
                n_ = mma(__builtin_bit_cast(bf16x8, B.p[i][s_]), __builtin_bit_cast(bf16x8, bw_), n_); } \
            S[i] = n_; } } while (0)
#define PIN() asm volatile("" ::: "memory")
    PQ B0, B1, B2, B3;
    asm volatile("s_waitcnt vmcnt(0)" ::: "memory");
    S2_LOAD(B0, 0); S2_LOAD(B1, 1); S2_LOAD(B2, 2);
    for (int c = 0; c < 128; c += 4) {
        S2_LOAD(B3, c + 3); S2_READY(B0, 30); S2_STEP(B0, c);
        S2_LOAD(B0, c + 4); S2_READY(B1, 30); S2_STEP(B1, c + 1);
        S2_LOAD(B1, c + 5); S2_READY(B2, 30); S2_STEP(B2, c + 2);
        S2_LOAD(B2, c + 6); S2_READY(B3, 30); S2_STEP(B3, c + 3);
    }
    asm volatile("s_waitcnt vmcnt(0)" : "+v"(B0.p[0][0]), "+v"(B0.p[0][1]), "+v"(B0.p[1][0]), "+v"(B0.p[1][1]), "+v"(B0.p[2][0]), "+v"(B0.p[2][1]), "+v"(B0.p[3][0]), "+v"(B0.p[3][1]), "+v"(B0.q[0]), "+v"(B0.q[1]),
                 "+v"(B1.p[0][0]), "+v"(B1.p[0][1]), "+v"(B1.p[1][0]), "+v"(B1.p[1][1]), "+v"(B1.p[2][0]), "+v"(B1.p[2][1]), "+v"(B1.p[3][0]), "+v"(B1.p[3][1]), "+v"(B1.q[0]), "+v"(B1.q[1]) :: "memory");
    asm volatile("" : "+v"(B2.p[0][0]), "+v"(B2.p[0][1]), "+v"(B2.p[1][0]), "+v"(B2.p[1][1]), "+v"(B2.p[2][0]), "+v"(B2.p[2][1]), "+v"(B2.p[3][0]), "+v"(B2.p[3][1]), "+v"(B2.q[0]), "+v"(B2.q[1]) :: "memory");
#undef S2_LOAD
#undef S2_STEP
}
__device__ __forceinline__ void s2_storer(LAS unsigned char* lds, bf16* Sst, const int bh, const int vb, const int lane) {
    volatile LAS int* prod = (volatile LAS int*)(lds + S2_FLAGS + vb * 64);
    volatile LAS int* cons = (volatile LAS int*)(lds + S2_FLAGS + 256 + vb * 64);
    const LAS unsigned char* ring = lds + vb * (S2_NS * S2_SLOTB) + lane * 32;
    bf16* Sp = Sst + ((size_t)bh * 128) * 4096 + (16 * vb) * 64 + lane * 16;
    for (int c = 0; c < 128; ++c) {
        { unsigned sp_ = 0; while (*prod <= c && ++sp_ < (1u << 22)) __builtin_amdgcn_s_sleep(1); }
        asm volatile("" ::: "memory");
        const v4u a_ = *(const LAS v4u*)(ring + (c & (S2_NS - 1)) * S2_SLOTB), b_ = *(const LAS v4u*)(ring + (c & (S2_NS - 1)) * S2_SLOTB + 16);
        asm volatile("s_waitcnt lgkmcnt(0)" ::: "memory");
        if (lane == 0) *cons = c + 1;
        *(GAS v4u*)(Sp + (size_t)c * 4096) = a_; *(GAS v4u*)(Sp + (size_t)c * 4096 + 8) = b_;
    }
}

struct S3Args { const bf16 *Rh, *O0; int ldo; const bf16* Vp; int ldv; const bf16 *Gf, *Sst; const float *bonus, *lnx_g, *lnx_b; bf16* Y; int ldy; };
__device__ __forceinline__ void s3_task(const S3Args& A, const int task, const int lane) {
    const int r = lane & 15, g = lane >> 4;
    const int tb = task & 3, unit = task >> 2, h = unit & 7, cidx = unit >> 3;
    const size_t tok = (size_t)cidx * 64 + 16 * tb + r;
    f32x4 o[4];
    bf16x8 fr[2];
#pragma unroll
    for (int s = 0; s < 2; ++s) fr[s] = *(const GAS bf16x8*)(A.Rh + tok * A.ldo + h * 64 + 32 * s + 8 * g);
#pragma unroll
    for (int i = 0; i < 4; ++i) {
        o[i] = unpack4(*(const GAS v2u*)(A.O0 + tok * A.ldo + h * 64 + 16 * i + 4 * g));
#pragma unroll
        for (int s = 0; s < 2; ++s) o[i] = mma(*(const GAS bf16x8*)(A.Sst + (size_t)(((cidx >> 7) * 8 + h) * 128 + (cidx & 127)) * 4096 + (16 * i + r) * 64 + 32 * s + 8 * g), fr[s], o[i]);
    }
    float sm = 0.f;
#pragma unroll
    for (int i = 0; i < 4; ++i) sm += (o[i][0] + o[i][1]) + (o[i][2] + o[i][3]);
    sm += __shfl_xor(sm, 16); sm += __shfl_xor(sm, 32);
    const float mean = sm * (1.0f / 64.0f); float sq = 0.f;
#pragma unroll
    for (int i = 0; i < 4; ++i) { o[i] = o[i] - mean; sq += (o[i][0] * o[i][0] + o[i][1] * o[i][1]) + (o[i][2] * o[i][2] + o[i][3] * o[i][3]); }
    sq += __shfl_xor(sq, 16); sq += __shfl_xor(sq, 32);
    const float rstd = 1.0f / sqrtf(sq * (1.0f / 64.0f) + 64e-5f);
    const float bon = ((const GAS float*)A.bonus)[tok * 8 + h];
#pragma unroll
    for (int i = 0; i < 4; ++i) {
        const int hv = h * 64 + 16 * i + 4 * g;
        const f32x4 lg = *(const GAS f32x4*)(A.lnx_g + hv), lb = *(const GAS f32x4*)(A.lnx_b + hv);
        const f32x4 vv = unpack4(*(const GAS v2u*)(A.Vp + tok * A.ldv + hv)), gg = unpack4(*(const GAS v2u*)(A.Gf + tok * W + hv));
        const f32x4 y = (o[i] * rstd * lg + lb + vv * bon) * gg;
        *(GAS v2u*)(A.Y + tok * A.ldy + hv) = pack4(y);
    }
}
}
namespace moba {
typedef short bf16x8 __attribute__((ext_vector_type(8)));
constexpr int OSP = 132;
constexpr int OSLOT = 0, LSUM = OSLOT + 4 * 256 * OSP, KMF = LSUM + 4 * 256 * 4, CNT = KMF + 8192, OFFS = CNT + 128, FILL = OFFS + 128, QLIST = FILL + 128, QSLOT = QLIST + 1024, ITEMS = QSLOT + 1024, ICTR = ITEMS + 1024, MOBA_LDS = ICTR + 64;
static_assert(MOBA_LDS <= 153600 - 1024, "MoBA LDS map below the control words");
__device__ __forceinline__ f32x4 mma(bf16x8 a, bf16x8 b, f32x4 c) { return __builtin_amdgcn_mfma_f32_16x16x32_bf16(a, b, c, 0, 0, 0); }
struct Args { bf16* AT; const bf16* VT; const float* KM; };
struct KV { bf16x8 k[2][2]; bf16x8 v[4]; };
__device__ __forceinline__ void item(LAS unsigned char* lds, const Args& A, const int b, const int h, const int qb, const int kblk, const int off, const int cnt, const int nkc, const bool own, const int lane) {
    const int r = lane & 15, g = lane >> 4;
    const float slope2 = exp2f(-(float)(h + 1)) * 1.4426950408889634f;
    int ql[2]; float aq[2];
    bf16x8 qf[2][2];
#pragma unroll
    for (int qt = 0; qt < 2; ++qt) {
        const int li = qt * 16 + r;
        int qv = -1;
        if (own) qv = off + li; else if (li < cnt) qv = (int)*(const LAS unsigned char*)(lds + QLIST + off + li);
        ql[qt] = qv;
        const int qrow = (qv >= 0) ? qv : 0;
        aq[qt] = (qv >= 0) ? -slope2 * (float)(256 * (qb - kblk) + qrow) : -1e30f;
    }
    const bf16* kbase = A.AT + ((size_t)b * T + kblk * 256 + 8 * (r >> 2) + (r & 3)) * NAT + 512 + h * 64 + 8 * g;
    const bf16* vbase = A.VT + (((size_t)(b * NH + h) * (T / 32) + kblk * 8) * 64 + r) * 32 + 8 * g;
    f32x4 o[4][2]; float l[2] = {0.f, 0.f};
#pragma unroll
    for (int db = 0; db < 4; ++db) { o[db][0] = (f32x4){0.f, 0.f, 0.f, 0.f}; o[db][1] = (f32x4){0.f, 0.f, 0.f, 0.f}; }
#define GLD16(DST, PTR) asm volatile("global_load_dwordx4 %0, %1, off" : "=v"(DST) : "v"(PTR) : "memory")
#define MOBA_LOAD(B, KC) do { const int kc_ = (KC) < nkc ? (KC) : nkc - 1; \
        _Pragma("unroll") for (int kt = 0; kt < 2; ++kt) { const bf16* kp_ = kbase + (size_t)(kc_ * 32 + kt * 4) * NAT; GLD16(B.k[kt][0], kp_); GLD16(B.k[kt][1], kp_ + 32); } \
        _Pragma("unroll") for (int db = 0; db < 4; ++db) { const bf16* vp_ = vbase + (size_t)kc_ * (64 * 32) + (16 * db) * 32; GLD16(B.v[db], vp_); } } while (0)
#define MOBA_READY(B, N) asm volatile("s_waitcnt vmcnt(" #N ")" : "+v"(B.k[0][0]), "+v"(B.k[0][1]), "+v"(B.k[1][0]), "+v"(B.k[1][1]), "+v"(B.v[0]), "+v"(B.v[1]), "+v"(B.v[2]), "+v"(B.v[3]) :: "memory")
#define MOBA_COMPUTE(B, KC) do { v4u pb_[2]; const int kb_ = (KC) * 32 + 8 * g; const bool dg_ = own && ((KC) == nkc - 1); \
        _Pragma("unroll") for (int qt = 0; qt < 2; ++qt) { unsigned pw_[4]; const float bs_ = aq[qt] + slope2 * (float)kb_; const int dl_ = ql[qt] - kb_; \
            _Pragma("unroll") for (int kt = 0; kt < 2; ++kt) { f32x4 st_ = {0.f, 0.f, 0.f, 0.f}; \
                st_ = mma(B.k[kt][0], qf[qt][0], st_); st_ = mma(B.k[kt][1], qf[qt][1], st_); f32x4 p_; \
                if (dg_) { _Pragma("unroll") for (int e = 0; e < 4; ++e) { float x_ = (st_[e] + bs_) + cst[kt * 4 + e]; if (4 * kt + e > dl_) x_ = -1e30f; p_[e] = __builtin_amdgcn_exp2f(x_); } } \
                else { _Pragma("unroll") for (int e = 0; e < 4; ++e) p_[e] = __builtin_amdgcn_exp2f((st_[e] + bs_) + cst[kt * 4 + e]); } \
                l[qt] += (p_[0] + p_[1]) + (p_[2] + p_[3]); pw_[2 * kt] = pk2(p_[0], p_[1]); pw_[2 * kt + 1] = pk2(p_[2], p_[3]); } \
            pb_[qt].x = pw_[0]; pb_[qt].y = pw_[1]; pb_[qt].z = pw_[2]; pb_[qt].w = pw_[3]; } \
        _Pragma("unroll") for (int db = 0; db < 4; ++db) { _Pragma("unroll") for (int qt = 0; qt < 2; ++qt) o[db][qt] = mma(B.v[db], __builtin_bit_cast(bf16x8, pb_[qt]), o[db][qt]); } } while (0)
    float cst[8];
#pragma unroll
    for (int j = 0; j < 8; ++j) cst[j] = slope2 * (float)j;
    KV B0, B1, B2;
    MOBA_LOAD(B0, 0); MOBA_LOAD(B1, 1);
#pragma unroll
    for (int qt = 0; qt < 2; ++qt) { const int qrow = (ql[qt] >= 0) ? ql[qt] : 0; const bf16* qp = A.AT + ((size_t)b * T + qb * 256 + qrow) * NAT + h * 64 + 8 * g;
        qf[qt][0] = *(const GAS bf16x8*)qp; qf[qt][1] = *(const GAS bf16x8*)(qp + 32); }
    asm volatile("" :: "v"(qf[0][0]), "v"(qf[0][1]), "v"(qf[1][0]), "v"(qf[1][1]) : "memory");
    for (int kc = 0; kc < nkc; kc += 3) {
        MOBA_LOAD(B2, kc + 2); MOBA_READY(B0, 16); MOBA_COMPUTE(B0, kc);
        if (kc + 1 < nkc) { MOBA_LOAD(B0, kc + 3); MOBA_READY(B1, 16); MOBA_COMPUTE(B1, kc + 1); }
        if (kc + 2 < nkc) { MOBA_LOAD(B1, kc + 4); MOBA_READY(B2, 16); MOBA_COMPUTE(B2, kc + 2); }
    }
    asm volatile("s_waitcnt vmcnt(0)" : "+v"(B0.k[0][0]), "+v"(B0.k[0][1]), "+v"(B0.k[1][0]), "+v"(B0.k[1][1]), "+v"(B0.v[0]), "+v"(B0.v[1]), "+v"(B0.v[2]), "+v"(B0.v[3]),
                 "+v"(B1.k[0][0]), "+v"(B1.k[0][1]), "+v"(B1.k[1][0]), "+v"(B1.k[1][1]), "+v"(B1.v[0]), "+v"(B1.v[1]), "+v"(B1.v[2]), "+v"(B1.v[3]),
                 "+v"(B2.k[0][0]), "+v"(B2.k[0][1]), "+v"(B2.k[1][0]), "+v"(B2.k[1][1]), "+v"(B2.v[0]), "+v"(B2.v[1]), "+v"(B2.v[2]), "+v"(B2.v[3]) :: "memory");
#undef MOBA_LOAD
#undef MOBA_COMPUTE
#pragma unroll
    for (int qt = 0; qt < 2; ++qt) {
        float ls = l[qt]; ls += __shfl_xor(ls, 16); ls += __shfl_xor(ls, 32);
        if (ql[qt] >= 0) {
            const int slot = own ? 0 : (int)*(const LAS unsigned char*)(lds + QSLOT + off + qt * 16 + r);
            LAS unsigned char* op = lds + OSLOT + (slot * 256 + ql[qt]) * OSP + g * 8;
#pragma unroll
            for (int db = 0; db < 4; ++db) { *(LAS unsigned*)(op + db * 32) = pk2(o[db][qt][0], o[db][qt][1]); *(LAS unsigned*)(op + db * 32 + 4) = pk2(o[db][qt][2], o[db][qt][3]); }
            if (g == 0) *((LAS float*)(lds + LSUM) + slot * 256 + ql[qt]) = ls;
        }
    }
}
__device__ __forceinline__ void unit(LAS unsigned char* lds, const Args& A, const int b, const int h, const int qb, const int tid, const bool dummy = false) {
    const int lane = tid & 63;
    for (int i = tid; i < qb * 64; i += 512) ((LAS float*)(lds + KMF))[i] = ((const GAS float*)A.KM)[((size_t)(b * NH + h) * NBLK) * 64 + i];
    if (tid < 96) ((LAS int*)(lds + CNT))[tid] = 0;
    if (tid == 0) *(LAS int*)(lds + ICTR) = 0;
    RW_BAR();
    int s0 = -1, s1 = -1, s2 = -1;
    if (tid < 256 && qb > 0) {
        float q[64];
        const GAS v4u* qp = (const GAS v4u*)(A.AT + ((size_t)b * T + qb * 256 + tid) * NAT + h * 64);
#pragma unroll
        for (int c = 0; c < 8; ++c) { const v4u w = qp[c]; q[8*c+0] = bflo(w.x); q[8*c+1] = bfhi(w.x); q[8*c+2] = bflo(w.y); q[8*c+3] = bfhi(w.y); q[8*c+4] = bflo(w.z); q[8*c+5] = bfhi(w.z); q[8*c+6] = bflo(w.w); q[8*c+7] = bfhi(w.w); }
        float g0 = -3e38f, g1 = -3e38f, g2 = -3e38f;
        for (int n = 0; n < qb; ++n) {
            const LAS f32x4* km = (const LAS f32x4*)(lds + KMF + n * 256); float gt = 0.f;
#pragma unroll
            for (int d = 0; d < 16; ++d) { const f32x4 k4 = km[d]; gt += q[4*d] * k4.x + q[4*d+1] * k4.y + q[4*d+2] * k4.z + q[4*d+3] * k4.w; }
            if (gt > g0) { g2 = g1; s2 = s1; g1 = g0; s1 = s0; g0 = gt; s0 = n; }
            else if (gt > g1) { g2 = g1; s2 = s1; g1 = gt; s1 = n; }
            else if (gt > g2) { g2 = gt; s2 = n; }
        }
        if (s0 >= 0) __hip_atomic_fetch_add((LAS int*)(lds + CNT) + s0, 1, __ATOMIC_RELAXED, __HIP_MEMORY_SCOPE_WORKGROUP);
        if (s1 >= 0) __hip_atomic_fetch_add((LAS int*)(lds + CNT) + s1, 1, __ATOMIC_RELAXED, __HIP_MEMORY_SCOPE_WORKGROUP);
        if (s2 >= 0) __hip_atomic_fetch_add((LAS int*)(lds + CNT) + s2, 1, __ATOMIC_RELAXED, __HIP_MEMORY_SCOPE_WORKGROUP);
    }
    RW_BAR();
    if (tid == 0) {
        int run = 0, ni = 0;
        for (int n = 0; n < qb; ++n) { const int c = ((LAS int*)(lds + CNT))[n]; ((LAS int*)(lds + OFFS))[n] = run;
            for (int k = 0; k < c; k += 32) { ((LAS int*)(lds + ITEMS))[2 * ni] = n | ((c - k < 32 ? c - k : 32) << 8); ((LAS int*)(lds + ITEMS))[2 * ni + 1] = run + k; ++ni; }
            run += c; }
        for (int i = 7; i >= 0; --i) { ((LAS int*)(lds + ITEMS))[2 * ni] = qb | (32 << 8) | (1 << 16) | ((i + 1) << 20); ((LAS int*)(lds + ITEMS))[2 * ni + 1] = 32 * i; ++ni; }
        *(LAS int*)(lds + ICTR + 4) = ni;
    }
    RW_BAR();
    if (tid < 256) {
        if (s0 >= 0) { const int p = __hip_atomic_fetch_add((LAS int*)(lds + FILL) + s0, 1, __ATOMIC_RELAXED, __HIP_MEMORY_SCOPE_WORKGROUP); *(LAS unsigned char*)(lds + QLIST + ((LAS int*)(lds + OFFS))[s0] + p) = (unsigned char)tid; *(LAS unsigned char*)(lds + QSLOT + ((LAS int*)(lds + OFFS))[s0] + p) = (unsigned char)1; }
        if (s1 >= 0) { const int p = __hip_atomic_fetch_add((LAS int*)(lds + FILL) + s1, 1, __ATOMIC_RELAXED, __HIP_MEMORY_SCOPE_WORKGROUP); *(LAS unsigned char*)(lds + QLIST + ((LAS int*)(lds + OFFS))[s1] + p) = (unsigned char)tid; *(LAS unsigned char*)(lds + QSLOT + ((LAS int*)(lds + OFFS))[s1] + p) = (unsigned char)2; }
        if (s2 >= 0) { const int p = __hip_atomic_fetch_add((LAS int*)(lds + FILL) + s2, 1, __ATOMIC_RELAXED, __HIP_MEMORY_SCOPE_WORKGROUP); *(LAS unsigned char*)(lds + QLIST + ((LAS int*)(lds + OFFS))[s2] + p) = (unsigned char)tid; *(LAS unsigned char*)(lds + QSLOT + ((LAS int*)(lds + OFFS))[s2] + p) = (unsigned char)3; }
    }
    RW_BAR();
    {
        const int ni = *(const LAS int*)(lds + ICTR + 4);
        for (;;) {
            int idx = 0; if (lane == 0) idx = __hip_atomic_fetch_add((LAS int*)(lds + ICTR), 1, __ATOMIC_RELAXED, __HIP_MEMORY_SCOPE_WORKGROUP);
            idx = __builtin_amdgcn_readfirstlane(idx);
            if (idx >= ni) break;
            const int w0 = __builtin_amdgcn_readfirstlane(((const LAS int*)(lds + ITEMS))[2 * idx]), w1 = __builtin_amdgcn_readfirstlane(((const LAS int*)(lds + ITEMS))[2 * idx + 1]);
            const bool own = (w0 >> 16) & 1;
            item(lds, A, b, h, qb, w0 & 255, w1, (w0 >> 8) & 255, own ? (w0 >> 20) : 8, own, lane);
        }
    }
    RW_BAR();
    if (!dummy) {
        const int qloc = tid >> 1, half = tid & 1;
        const int nslot = 1 + (qb < 3 ? qb : 3);
        float acc[32]; float lt = 0.f;
#pragma unroll
        for (int d = 0; d < 32; ++d) acc[d] = 0.f;
        for (int sl = 0; sl < nslot; ++sl) {
            const LAS unsigned* op = (const LAS unsigned*)(lds + OSLOT + (sl * 256 + qloc) * OSP + half * 64);
#pragma unroll
            for (int d = 0; d < 16; ++d) { const unsigned w = op[d]; acc[2 * d] += bflo(w); acc[2 * d + 1] += bfhi(w); }
            lt += *((const LAS float*)(lds + LSUM) + sl * 256 + qloc);
        }
        const float inv = 1.0f / lt;
        bf16* yp = A.AT + ((size_t)b * T + qb * 256 + qloc) * NAT + h * 64 + half * 32;
#pragma unroll
        for (int c = 0; c < 4; ++c) { v4u w; w.x = pk2(acc[8*c] * inv, acc[8*c+1] * inv); w.y = pk2(acc[8*c+2] * inv, acc[8*c+3] * inv); w.z = pk2(acc[8*c+4] * inv, acc[8*c+5] * inv); w.w = pk2(acc[8*c+6] * inv, acc[8*c+7] * inv); *(GAS v4u*)(yp + 8 * c) = w; }
    }
    RW_BAR();
}
}

__global__ void __launch_bounds__(NWAVES * 64, 2) mk_fwd(Args args) {
    extern __shared__ __attribute__((aligned(16))) unsigned char lds_raw[];
    LAS unsigned char* lds = (LAS unsigned char*)lds_raw;
    const int tid0 = threadIdx.x;
    const int G = gridDim.x;
    unsigned char* ws0 = args.ws;
    const int lo = args.ph_lo, hi = args.ph_hi;
    const int NGW = G * NWAVES;
    const bool fused = args.fused != 0;
    volatile LAS unsigned* MISC = (volatile LAS unsigned*)(lds + MISC_OFF);
    for (int u = tid0; u < (LDS_BYTES - LDSCTL_OFF) / 4; u += NWAVES * 64) ((LAS unsigned*)(lds + LDSCTL_OFF))[u] = 0u;
    __syncthreads();
    XcdBarrier bar; bar.bar = (unsigned*)(ws0 + WS_CTL) + CW_BAR; bar.x = 0; bar.st = nullptr;
    if (fused) bar = xcd_barrier_post((unsigned*)(ws0 + WS_CTL) + CW_BAR, MISC + 8);
#define IN(k) (lo <= (k) && (k) < hi && (rep == 1 || (k) <= args.probe_upto || (k) == args.probe_dup))
#define SEAM(k) do { if (fused && !((k) == PH_FF2 && L == args.l_hi - 1)) xcd_barrier(bar); } while (0)

    for (int L = args.l_lo; L < args.l_hi; ++L)
    for (int rep = (args.probe_upto >= 0 || args.probe_dup >= 0) ? 0 : 1; rep < 2; ++rep) {
    const float* xsrc = (L == 0) ? args.in[I_X] : args.out;
    int tidL = threadIdx.x; asm volatile("" : "+v"(tidL));
    const int tid = tidL, lane = tid & 63, wave = __builtin_amdgcn_readfirstlane(tid >> 6), gw = blockIdx.x * NWAVES + wave;
    if (IN(PH_CONV)) {
        unsigned char* ws = args.ws; asm volatile("" : "+s"(ws));
        LAS float* scr = (LAS float*)(lds + RING_OFF + wave * 16384);
        const float* w_in = args.in[I_WIN] + (size_t)L * D * NIN;
        const float* w_br = args.in[I_WBR] + (size_t)L * 3 * W * D;
        const float* w_out = args.in[I_WOUT] + (size_t)L * D * D;
        const float* w_f1 = args.in[I_FF1] + (size_t)L * D * FF;
        const float* w_f2 = args.in[I_FF2] + (size_t)L * FF * D;
        constexpr int I_IN = (D / 64) * (NIN / 32), I_B = (W / 64) * (D / 32), I_O = (D / 64) * (D / 32), I_1 = (D / 64) * (FF / 32), I_2 = (FF / 64) * (D / 32);
        constexpr int I_LU = 16, I_LG = 32;
        constexpr int NITEMS = I_IN + 2 * I_B + I_O + I_1 + I_2 + 2 * I_LU + I_LG;
        bf16* WupT = (bf16*)(ws + WS_LORA); bf16* AupT = WupT + 512 * 64; bf16* GupT = AupT + 512 * 64;
        for (int it = gw; it < NITEMS; it += NGW) {
            int r = it;
            if (r < I_IN) { p0_transpose_item(w_in, D, NIN, ((bf16*)(ws + WS_WIN)), scr, r, lane); continue; } r -= I_IN;
            if (r < I_B) { p0_transpose_item(w_br, W, D, ((bf16*)(ws + WS_WB)), scr, r, lane); continue; } r -= I_B;
            if (r < I_B) { p0_transpose_item(w_br + (size_t)W * D, W, D, ((bf16*)(ws + WS_WB)) + (size_t)D * W, scr, r, lane); continue; } r -= I_B;
            if (r < I_O) { p0_transpose_item(w_out, D, D, ((bf16*)(ws + WS_WO)), scr, r, lane); continue; } r -= I_O;
            if (r < I_1) { p0_transpose_item(w_f1, D, FF, ((bf16*)(ws + WS_W1)), scr, r, lane); continue; } r -= I_1;
            if (r < I_2) { p0_transpose_item(w_f2, FF, D, ((bf16*)(ws + WS_W2)), scr, r, lane); continue; } r -= I_2;
            if (r < I_LU) { p0_transpose_item(args.in[I_WUP] + (size_t)L * 64 * W, 64, W, WupT, scr, r, lane); continue; } r -= I_LU;
            if (r < I_LU) { p0_transpose_item(args.in[I_AUP] + (size_t)L * 64 * W, 64, W, AupT, scr, r, lane); continue; } r -= I_LU;
            p0_transpose_item(args.in[I_GUP] + (size_t)L * 128 * W, 128, W, GupT, scr, r, lane);
        }
        const float* pw = args.in[I_POOLW] + (size_t)L * 4 * 128 * 128; const float* ps = args.in[I_POOLS] + (size_t)L * W; const float* wb2 = w_br + (size_t)2 * W * D;
        bf16* WeT = ((bf16*)(ws + WS_WB)) + (size_t)2 * D * W;
        for (int idx = blockIdx.x * (NWAVES * 64) + tid; idx < W * D; idx += G * NWAVES * 64) {
            const int gc = idx / D, dout = idx % D, g = gc >> 7;
            const GAS float* pwr = (const GAS float*)pw + (size_t)gc * 128; float acc = 0.f;
            for (int dp = 0; dp < 128; ++dp) acc += pwr[dp] * ((const GAS float*)ps)[g * 128 + dp] * ((const GAS float*)wb2)[(size_t)(g * 128 + dp) * D + dout];
            ((GAS bf16*)WeT)[(size_t)dout * W + gc] = (bf16)f2bf(acc);
        }
        rms_rows(xsrc, args.in[I_N1G] + (size_t)L * D, ((bf16*)(ws + WS_H)), gw, NGW, lane);
        SEAM(PH_CONV);
    }
    if (IN(PH_GEMMA)) {
        unsigned char* ws = args.ws; asm volatile("" : "+s"(ws));
        pg8::Gemm g{((bf16*)(ws + WS_H)), ((bf16*)(ws + WS_WIN)), M, NA, D, D, D}; pg8::StaticOrder S; S.init(M, NA, G, (int)blockIdx.x);
        pg8::EpiA E{(bf16*)(ws + WS_RW), (bf16*)(ws + WS_AT), (bf16*)(ws + WS_PL), (bf16*)(ws + WS_SB), (bf16*)(ws + WS_HB)};
        pg8::gemm_phase<pg8::EpiA, pg8::StaticOrder, true, true>(lds + RING_OFF, g, S, E, tidL);
        SEAM(PH_GEMMA);
    }
    if (IN(PH_MIX1)) {
        unsigned char* ws = args.ws; asm volatile("" : "+s"(ws));
        ph_attn_prep(lds, (bf16*)(ws + WS_AT), (bf16*)(ws + WS_VT), args.in[I_QNG] + L * 64, args.in[I_KNG] + L * 64, (float*)(ws + WS_KM), G, tidL);
        ph_pool((bf16*)(ws + WS_PL), (const bf16*)(ws + WS_HB), G, tidL);
        __syncthreads();
        rw::S1Args A1; A1.RW = (bf16*)(ws + WS_RW); A1.SB = (const bf16*)(ws + WS_SB);
        A1.mu = args.in[I_MU] + L * NRW; A1.w0 = args.in[I_W0] + L * W; A1.a0 = args.in[I_A0] + L * W; A1.k_k = args.in[I_KK] + L * W; A1.k_a = args.in[I_KA] + L * W; A1.r_k = args.in[I_RK] + L * W;
        A1.WupT = (const bf16*)(ws + WS_LORA); A1.AupT = A1.WupT + 512 * 64; A1.GupT = A1.AupT + 512 * 64;
        A1.Gf = (bf16*)(ws + WS_GF); A1.Pst = (bf16*)(ws + WS_PST); A1.Qst = (bf16*)(ws + WS_QST); A1.bonus = (float*)(ws + WS_BON);
        A1.Rh = (bf16*)(ws + WS_RW); A1.O0 = (bf16*)(ws + WS_RW) + 512; A1.ldo = NRW; A1.Vm = (bf16*)(ws + WS_RW) + 1024; A1.ldv = NRW;
        int hprev = -1;
        for (int unit = blockIdx.x; unit < NB * 128 * NH; unit += G) rw::s1_unit(lds, A1, unit, tidL, hprev);
        SEAM(PH_MIX1);
    }
    if (IN(PH_MIX2)) {
        unsigned char* ws = args.ws; asm volatile("" : "+s"(ws));
        { moba::Args MA; MA.AT = (bf16*)(ws + WS_AT); MA.VT = (const bf16*)(ws + WS_VT); MA.KM = (const float*)(ws + WS_KM);
          if (G == 256) {
              const int xcd = blockIdx.x & 7, slot = blockIdx.x >> 3;
              if (slot < 4) {
                  if (tid < 8) *(volatile LAS int*)(lds + rw::S2_FLAGS + tid * 64) = 0;
                  __syncthreads();
                  if (wave < 4) rw::s2_chain(lds, (const bf16*)(ws + WS_PST), (const bf16*)(ws + WS_QST), slot * 8 + xcd, wave, lane);
                  else rw::s2_storer(lds, (bf16*)(ws + WS_SST), slot * 8 + xcd, wave - 4, lane);
              }
              volatile LAS int* qslot = (volatile LAS int*)(lds + LDSCTL_OFF + 64);
              for (int qx = 0; qx < 8; ++qx) {
                  const int x = (xcd + qx) & 7;
                  gu32* qw = (gu32*)(ws + WS_CTL) + CW_Q + (L * 8 + x) * 64;
                  for (;;) {
                      __syncthreads();
                      if (tid == 0) *qslot = (int)__hip_atomic_fetch_add(qw, 1u, RLX_AGENT);
                      __syncthreads();
                      const int u = *qslot;
                      if (u >= 128) break;
                      const int pair = (u >> 5) * 8 + x;
                      int tq = tidL; asm volatile("" : "+v"(tq));
#ifdef PROBE_MOBA2
                      moba::unit(lds, MA, pair >> 3, pair & 7, 31 - (u & 31), tq, true);
#endif
                      moba::unit(lds, MA, pair >> 3, pair & 7, 31 - (u & 31), tq);
                  }
              }
          } else {
              for (int bh = blockIdx.x; bh < NB * NH; bh += G) {
                  __syncthreads();
                  if (tid < 8) *(volatile LAS int*)(lds + rw::S2_FLAGS + tid * 64) = 0;
                  __syncthreads();
                  if (wave < 4) rw::s2_chain(lds, (const bf16*)(ws + WS_PST), (const bf16*)(ws + WS_QST), bh, wave, lane);
                  else rw::s2_storer(lds, (bf16*)(ws + WS_SST), bh, wave - 4, lane);
              }
              __syncthreads();
              for (int u = blockIdx.x; u < NB * NH * NBLK; u += G) moba::unit(lds, MA, u >> 8, (u >> 5) & 7, u & 31, tidL); } }
        SEAM(PH_MIX2);
    }
    if (IN(PH_S3)) {
        unsigned char* ws = args.ws; asm volatile("" : "+s"(ws));
        rw::S3Args A3; A3.Rh = (const bf16*)(ws + WS_RW); A3.O0 = A3.Rh + 512; A3.ldo = NRW; A3.Vp = A3.Rh + 1024; A3.ldv = NRW; A3.Gf = (const bf16*)(ws + WS_GF); A3.Sst = (const bf16*)(ws + WS_SST);
        A3.bonus = (const float*)(ws + WS_BON); A3.lnx_g = args.in[I_LNG] + L * W; A3.lnx_b = args.in[I_LNB] + L * W; A3.Y = (bf16*)(ws + WS_RW); A3.ldy = NRW;
        for (int task = gw; task < NB * 128 * NH * 4; task += NGW) rw::s3_task(A3, task, lane);
        SEAM(PH_S3);
    }
    if (IN(PH_GB)) {
        unsigned char* ws = args.ws; asm volatile("" : "+s"(ws));
        bf16* GBp = (bf16*)(ws + WS_GB); bf16* MBp = (bf16*)(ws + WS_MB);
        pg8::StaticOrder S; S.init(M, D, G, (int)blockIdx.x);
#pragma unroll
        for (int b = 0; b < 3; ++b) {
            { int tv = tidL; asm volatile("" : "+v"(tv)); pg8::Gemm g{((bf16*)(ws + WS_H)), ((bf16*)(ws + WS_WIN)) + (size_t)(NA + b * D) * D, M, D, D, D, D}; pg8::EpiAct<1> E{GBp, D};
              pg8::gemm_phase<pg8::EpiAct<1>, pg8::StaticOrder, true, true>(lds + RING_OFF, g, S, E, tv); }
            __syncthreads();
            { int tv = tidL; asm volatile("" : "+v"(tv)); const bf16* Ysrc = (b == 0) ? (const bf16*)(ws + WS_RW) : (b == 1 ? (const bf16*)(ws + WS_AT) : (const bf16*)(ws + WS_PL));
              pg8::Gemm g{Ysrc, ((bf16*)(ws + WS_WB)) + (size_t)b * D * W, M, D, W, (b == 0) ? NRW : (b == 1 ? NAT : NPL), W};
              if (b == 0) { pg8::EpiBr<true> E{GBp, MBp}; pg8::gemm_phase<pg8::EpiBr<true>, pg8::StaticOrder, true, true>(lds + RING_OFF, g, S, E, tv); }
              else { pg8::EpiBr<false> E{GBp, MBp}; pg8::gemm_phase<pg8::EpiBr<false>, pg8::StaticOrder, true, true>(lds + RING_OFF, g, S, E, tv); } }
            __syncthreads();
        }
        SEAM(PH_GB);
    }
    if (IN(PH_GO)) {
        unsigned char* ws = args.ws; asm volatile("" : "+s"(ws));
        pg8::Gemm g{(const bf16*)(ws + WS_MB), ((bf16*)(ws + WS_WO)), M, D, D, D, D}; pg8::StaticOrder S; S.init(M, D, G, (int)blockIdx.x);
        pg8::EpiRes E{xsrc, args.out};
        pg8::gemm_phase<pg8::EpiRes, pg8::StaticOrder, true, true>(lds + RING_OFF, g, S, E, tidL);
        SEAM(PH_GO);
    }
    if (IN(PH_NORM2)) { unsigned char* ws = args.ws; asm volatile("" : "+s"(ws)); rms_rows(args.out, args.in[I_N2G] + (size_t)L * D, ((bf16*)(ws + WS_H)), gw, NGW, lane); SEAM(PH_NORM2); }
        unsigned char* ws = args.ws; asm volatile("" : "+s"(ws));
    if (IN(PH_FF1)) {
        unsigned char* ws = args.ws; asm volatile("" : "+s"(ws));
        pg8::Gemm g{((bf16*)(ws + WS_H)), ((bf16*)(ws + WS_W1)), M, FF, D, D, D}; pg8::StaticOrder S; S.init(M, FF, G, (int)blockIdx.x);
        pg8::EpiAct<2> E{(bf16*)(ws + WS_HID), FF};
        pg8::gemm_phase<pg8::EpiAct<2>, pg8::StaticOrder, true, true>(lds + RING_OFF, g, S, E, tidL);
        SEAM(PH_FF1);
    }
    if (IN(PH_FF2)) {
        unsigned char* ws = args.ws; asm volatile("" : "+s"(ws));
        pg8::Gemm g{(const bf16*)(ws + WS_HID), ((bf16*)(ws + WS_W2)), M, D, FF, FF, FF}; pg8::StaticOrder S; S.init(M, D, G, (int)blockIdx.x);
        pg8::EpiRes E{args.out, args.out};
        pg8::gemm_phase<pg8::EpiRes, pg8::StaticOrder, true, true>(lds + RING_OFF, g, S, E, tidL);
        SEAM(PH_FF2);
    }
    }
#undef IN
#undef SEAM
}

#ifndef MK_MULTI
#define MK_MULTI 0
#endif
#ifndef PROBE_UPTO
#define PROBE_UPTO (-1)
#endif
#ifndef PROBE_DUP
#define PROBE_DUP (-1)
#endif
extern "C" void kernel_launch(void* const* d_in, const int* in_sizes, int n_in, void* d_out, int out_size, void* d_ws, size_t ws_size, hipStream_t stream) {
    static int grid = 0;
    if (grid == 0) {
        if (n_in != 23 || in_sizes[0] != M * D || out_size != M * D || ws_size < WS_END) { fprintf(stderr, "kernel_launch: unexpected shapes (n_in %d, in0 %d, out %d, ws %zu)\n", n_in, n_in > 0 ? in_sizes[0] : -1, out_size, ws_size); grid = -1; return; }
        int dev = 0, cus = 0;
        if (hipGetDevice(&dev) != hipSuccess || hipDeviceGetAttribute(&cus, hipDeviceAttributeMultiprocessorCount, dev) != hipSuccess) { grid = -1; return; }
        if (hipFuncSetAttribute((const void*)mk_fwd, hipFuncAttributeMaxDynamicSharedMemorySize, LDS_BYTES) != hipSuccess) { fprintf(stderr, "kernel_launch: hipFuncSetAttribute failed\n"); grid = -1; return; }
        int per_cu = 0;
        if (hipOccupancyMaxActiveBlocksPerMultiprocessor(&per_cu, (const void*)mk_fwd, NWAVES * 64, LDS_BYTES) != hipSuccess || per_cu < 1) fprintf(stderr, "kernel_launch: occupancy query reports %d\n", per_cu);
        (void)hipGetLastError();
        grid = cus;
    }
    if (grid < 0) return;
    unsigned char* ws = (unsigned char*)d_ws;
    (void)hipMemsetAsync(ws + WS_CTL, 0, CTL_ZERO_BYTES, stream);
    Args a{};
    for (int i = 0; i < 23; ++i) a.in[i] = (const float*)d_in[i];
    a.out = (float*)d_out; a.ws = ws;
#if MK_MULTI
    for (int L = 0; L < 2; ++L) for (int p = 0; p < PH_N; ++p) { a.ph_lo = p; a.ph_hi = p + 1; a.l_lo = L; a.l_hi = L + 1; a.fused = 0; a.probe_upto = -1; a.probe_dup = -1; hipLaunchKernelGGL(mk_fwd, dim3(grid), dim3(NWAVES * 64), LDS_BYTES, stream, a); }
#else
    a.ph_lo = 0; a.ph_hi = PH_N; a.l_lo = 0; a.l_hi = 2; a.fused = 1; a.probe_upto = PROBE_UPTO; a.probe_dup = PROBE_DUP;
    hipLaunchKernelGGL(mk_fwd, dim3(grid), dim3(NWAVES * 64), LDS_BYTES, stream, a);
#endif
}
```

```cpp
#include <hip/hip_runtime.h>
#include <cstdio>
#include <cstdint>
#define GAS __attribute__((address_space(1)))
namespace pg8 {
#define PG8_LAS __attribute__((address_space(3)))
typedef unsigned short bf16_t;
typedef short bf16x8 __attribute__((ext_vector_type(8)));
typedef float f32x4 __attribute__((ext_vector_type(4)));
typedef unsigned u32x4 __attribute__((ext_vector_type(4)));
constexpr int BM = 256, BK = 64, HALF = 128, HTB = HALF * BK * 2  , STAGE_BYTES = 8 * HTB, NXCD = 8, WGM = 8;

__host__ __device__ __forceinline__ int lds_byte(int r, int c) { const int st = (r >> 4) * 2 + (c >> 5), rr = r & 15, cc = c & 31, ob = rr * 64 + cc * 2; return st * 1024 + (ob ^ (((ob >> 9) & 1) << 5)); }
__host__ __device__ __forceinline__ void stage_rc(int b, int& R, int& C) { const int st = b / 1024, sb = b % 1024, swz = sb ^ (((sb >> 9) & 1) << 5); R = (st >> 1) * 16 + swz / 64; C = (st & 1) * 32 + (swz % 64) / 2; }
__host__ __device__ __forceinline__ int perm32(int rho) { const int n = rho >> 4, i = rho & 15; return 8 * (i >> 2) + 4 * n + (i & 3); }

struct Unit { int pm, pn; };
struct Gemm { const bf16_t* A; const bf16_t* Bt; int M, N, K, lda, ldb; };

struct StaticOrder {
    int nM, nN, nwg, G, c;
    __host__ __device__ void init(int M, int N, int G_, int c_) { nM = M / BM; nN = N / BM; nwg = nM * nN; G = G_; c = c_; }
    __host__ __device__ bool next(int i, Unit& u) const {
        const long L = (long)i * G + c; if (L >= nwg) return false;
        int wgid = (int)L; { const int q = nwg / NXCD, r = nwg % NXCD, xcd = wgid % NXCD, off = wgid / NXCD; wgid = (xcd < r ? xcd * (q + 1) : r * (q + 1) + (xcd - r) * q) + off; }
        const int nig = WGM * nN, gid = wgid / nig, fm = gid * WGM, gsz = (nM - fm) < WGM ? (nM - fm) : WGM;
        u.pm = fm + ((wgid % nig) % gsz); u.pn = (wgid % nig) / gsz; return true;
    }
    __device__ __forceinline__ void a_ready(const Unit&) const {}
    __device__ __forceinline__ void done(const Unit&) const {}
};

__device__ __forceinline__ unsigned cvt_pk_bf16(float lo, float hi) { unsigned r; asm volatile("v_cvt_pk_bf16_f32 %0, %1, %2" : "=v"(r) : "v"(lo), "v"(hi)); return r; }
__device__ __forceinline__ float sigm(float x) { return 1.0f / (1.0f + __expf(-x)); }
__device__ __forceinline__ float bf_lo(unsigned w) { return __builtin_bit_cast(float, w << 16); }
__device__ __forceinline__ float bf_hi(unsigned w) { return __builtin_bit_cast(float, w & 0xffff0000u); }
struct EpiA {
    static constexpr bool PERM = true, AFTER_DRAIN = false;
    bf16_t *RW, *AT, *PL, *SB, *HB;
    __device__ __forceinline__ void operator()(const f32x4 (&acc)[2][2][4][2], const Unit& u, int wr, int wc, int fr, int fq) const {
        bf16_t* base; int ldc, colt;
        if (u.pn < 7) { base = RW; ldc = 1792; colt = u.pn * 256; } else if (u.pn < 13) { base = AT; ldc = 1536; colt = (u.pn - 7) * 256; } else { base = PL; ldc = 512; colt = (u.pn - 13) * 256; }
        const int row0 = u.pm * BM + wr * 64 + fr, col0 = colt + wc * 32 + 8 * fq;
#pragma unroll
        for (int ai = 0; ai < 2; ++ai)
#pragma unroll
            for (int m = 0; m < 4; ++m) { bf16_t* rowp = base + (size_t)(row0 + ai * HALF + m * 16) * ldc + col0;
#pragma unroll
                for (int bj = 0; bj < 2; ++bj) { const f32x4 v0 = acc[ai][bj][m][0], v1 = acc[ai][bj][m][1];
                    u32x4 w; w.x = cvt_pk_bf16(v0[0], v0[1]); w.y = cvt_pk_bf16(v0[2], v0[3]); w.z = cvt_pk_bf16(v1[0], v1[1]); w.w = cvt_pk_bf16(v1[2], v1[3]);
                    *(GAS u32x4*)(rowp + bj * HALF) = w;
                    if (u.pn < 7 && m == 3 && fr == 15) *(GAS u32x4*)(SB + (size_t)((row0 + ai * HALF + 48) >> 6) * 1792 + col0 + bj * HALF) = w;
                    if (u.pn >= 13 && m == 3 && wr == 1 && fr >= 1) *(GAS u32x4*)(HB + ((size_t)((row0 + ai * HALF + 48) >> 7) * 15 + (fr - 1)) * 512 + col0 + bj * HALF) = w; } }
    }
};
template <int MODE> struct EpiAct {
    static constexpr bool PERM = true, AFTER_DRAIN = false;
    bf16_t* O; int ldc;
    __device__ __forceinline__ void operator()(const f32x4 (&acc)[2][2][4][2], const Unit& u, int wr, int wc, int fr, int fq) const {
        const int row0 = u.pm * BM + wr * 64 + fr, col0 = u.pn * BM + wc * 32 + 8 * fq;
#pragma unroll
        for (int ai = 0; ai < 2; ++ai)
#pragma unroll
            for (int m = 0; m < 4; ++m) { bf16_t* rowp = O + (size_t)(row0 + ai * HALF + m * 16) * ldc + col0;
#pragma unroll
                for (int bj = 0; bj < 2; ++bj) { f32x4 v0 = acc[ai][bj][m][0], v1 = acc[ai][bj][m][1];
#pragma unroll
                    for (int e = 0; e < 4; ++e) {
                        if (MODE == 1) { v0[e] = sigm(v0[e]); v1[e] = sigm(v1[e]); }
                        if (MODE == 2) { const float a = fmaxf(v0[e], 0.f), b = fmaxf(v1[e], 0.f); v0[e] = a * a; v1[e] = b * b; } }
                    u32x4 w; w.x = cvt_pk_bf16(v0[0], v0[1]); w.y = cvt_pk_bf16(v0[2], v0[3]); w.z = cvt_pk_bf16(v1[0], v1[1]); w.w = cvt_pk_bf16(v1[2], v1[3]);
                    *(GAS u32x4*)(rowp + bj * HALF) = w; } }
    }
};
template <bool FIRST> struct EpiBr {
    static constexpr bool PERM = true, AFTER_DRAIN = false;
    const bf16_t* GB; bf16_t* MBuf;
    __device__ __forceinline__ void operator()(const f32x4 (&acc)[2][2][4][2], const Unit& u, int wr, int wc, int fr, int fq) const {
        const int row0 = u.pm * BM + wr * 64 + fr, col0 = u.pn * BM + wc * 32 + 8 * fq;
#pragma unroll
        for (int ai = 0; ai < 2; ++ai)
#pragma unroll
            for (int m = 0; m < 4; ++m) { const size_t off = (size_t)(row0 + ai * HALF + m * 16) * 1024 + col0;
#pragma unroll
                for (int bj = 0; bj < 2; ++bj) { const f32x4 v0 = acc[ai][bj][m][0], v1 = acc[ai][bj][m][1];
                    const u32x4 gw = *(const GAS u32x4*)(GB + off + bj * HALF);
                    float o[8] = {bf_lo(gw.x) * v0[0], bf_hi(gw.x) * v0[1], bf_lo(gw.y) * v0[2], bf_hi(gw.y) * v0[3], bf_lo(gw.z) * v1[0], bf_hi(gw.z) * v1[1], bf_lo(gw.w) * v1[2], bf_hi(gw.w) * v1[3]};
                    if (!FIRST) { const u32x4 mw = *(const GAS u32x4*)(MBuf + off + bj * HALF);
                        o[0] += bf_lo(mw.x); o[1] += bf_hi(mw.x); o[2] += bf_lo(mw.y); o[3] += bf_hi(mw.y); o[4] += bf_lo(mw.z); o[5] += bf_hi(mw.z); o[6] += bf_lo(mw.w); o[7] += bf_hi(mw.w); }
                    u32x4 w; w.x = cvt_pk_bf16(o[0], o[1]); w.y = cvt_pk_bf16(o[2], o[3]); w.z = cvt_pk_bf16(o[4], o[5]); w.w = cvt_pk_bf16(o[6], o[7]);
                    *(GAS u32x4*)(MBuf + off + bj * HALF) = w; } }
    }
};
struct EpiRes {
    static constexpr bool PERM = false, AFTER_DRAIN = false;
    const float* base; float* out;
    __device__ __forceinline__ void operator()(const f32x4 (&acc)[2][2][4][2], const Unit& u, int wr, int wc, int fr, int fq) const {
        const int row0 = u.pm * BM + wr * 64 + fr, col0 = u.pn * BM + wc * 32 + 4 * fq;
#pragma unroll
        for (int ai = 0; ai < 2; ++ai)
#pragma unroll
            for (int m = 0; m < 4; ++m) { const size_t off = (size_t)(row0 + ai * HALF + m * 16) * 1024 + col0;
#pragma unroll
                for (int bj = 0; bj < 2; ++bj)
#pragma unroll
                    for (int n = 0; n < 2; ++n) { const f32x4 bs = *(const GAS f32x4*)(base + off + bj * HALF + n * 16); *(GAS f32x4*)(out + off + bj * HALF + n * 16) = bs + acc[ai][bj][m][n]; } }
    }
};
template <class Epi, class Sched, bool ALIGN_EPI = false, bool SP2 = false>
__device__ __forceinline__ void gemm_phase(PG8_LAS unsigned char* lds, const Gemm g, const Sched& S, const Epi& E, const int tid) {
    const int wid = __builtin_amdgcn_readfirstlane(tid >> 6), lane = tid & 63, wr = wid >> 2, wc = wid & 3, fr = lane & 15, fq = lane >> 4;
    const int K = g.K, nt = K / BK;
    unsigned voffA[2], voffB[2];
#pragma unroll
    for (int i = 0; i < 2; ++i) { int R, C; stage_rc(tid * 16 + i * 8192, R, C); const int Rb = Epi::PERM ? ((R & ~31) + perm32(R & 31)) : R;
        voffA[i] = (unsigned)(R * g.lda + C) * 2u; voffB[i] = (unsigned)(Rb * g.ldb + C) * 2u; }
    const size_t kstep = (size_t)(BK * 2);
    const size_t hstepA = (size_t)HALF * g.lda * 2, hstepB = (size_t)HALF * g.ldb * 2;
    const size_t tstepA = 2 * hstepA, tstepB = 2 * hstepB;
    const unsigned ldsw = (unsigned)wid * 1024u;
    const int aoff = lds_byte(wr * 64 + fr, fq * 8), boff = lds_byte(wc * 32 + fr, fq * 8);
#define PG8_SA(b, h) (((b) * 2 + (h)) * HTB)
#define PG8_SB(b, h) ((4 + (b) * 2 + (h)) * HTB)
#define PG8_STAGE(bufoff, gbase, voff) do { _Pragma("unroll") for (int _i = 0; _i < 2; ++_i) \
        __builtin_amdgcn_global_load_lds((const unsigned*)((const char*)(gbase) + (voff)[_i]), (PG8_LAS unsigned*)(lds + (bufoff) + ldsw + _i * 8192), 16, 0, 0); } while (0)
#define PG8_LDA(dst, b, h) do { _Pragma("unroll") for (int m = 0; m < 4; ++m) _Pragma("unroll") for (int k = 0; k < 2; ++k) dst[m][k] = *(const PG8_LAS bf16x8*)(lds + PG8_SA(b, h) + aoff + m * 2048 + k * 1024); } while (0)
#define PG8_LDB(dst, b, h) do { _Pragma("unroll") for (int n = 0; n < 2; ++n) _Pragma("unroll") for (int k = 0; k < 2; ++k) dst[n][k] = *(const PG8_LAS bf16x8*)(lds + PG8_SB(b, h) + boff + n * 2048 + k * 1024); } while (0)
#define PG8_MMA(ai, bj, At, Bt) do { __builtin_amdgcn_s_setprio(1); _Pragma("unroll") for (int m = 0; m < 4; ++m) _Pragma("unroll") for (int n = 0; n < 2; ++n) _Pragma("unroll") for (int k = 0; k < 2; ++k) \
        acc[ai][bj][m][n] = __builtin_amdgcn_mfma_f32_16x16x32_bf16(Bt[n][k], At[m][k], acc[ai][bj][m][n], 0, 0, 0); __builtin_amdgcn_s_setprio(0); } while (0)
#define PG8_WAIT_V(n) asm volatile("s_waitcnt vmcnt(" #n ")" ::: "memory")
#define PG8_WAIT_L(n) asm volatile("s_waitcnt lgkmcnt(" #n ")" ::: "memory")
#define PG8_BAR __builtin_amdgcn_s_barrier()
#define PG8_SCHED __builtin_amdgcn_sched_barrier(0)
    Unit cur, nxt; int ui = 0;
    if (!S.next(0, cur)) return;
    f32x4 acc[2][2][4][2];
#pragma unroll
    for (int a = 0; a < 2; ++a)
#pragma unroll
        for (int b = 0; b < 2; ++b)
#pragma unroll
            for (int m = 0; m < 4; ++m)
#pragma unroll
                for (int n = 0; n < 2; ++n) acc[a][b][m][n] = (f32x4){0.f, 0.f, 0.f, 0.f};
    bf16x8 At[4][2], B0[2][2], B1[2][2];
    const char* cA = (const char*)g.A + (size_t)cur.pm * tstepA; const char* cB = (const char*)g.Bt + (size_t)cur.pn * tstepB;
    S.a_ready(cur);
    if constexpr (SP2) {
        PG8_STAGE(PG8_SB(0, 0), cB, voffB); PG8_STAGE(PG8_SB(0, 1), cB + hstepB, voffB); PG8_STAGE(PG8_SA(0, 0), cA, voffA); PG8_STAGE(PG8_SA(0, 1), cA + hstepA, voffA);
        if (wr == 1) PG8_BAR;
        PG8_WAIT_V(2); PG8_BAR;
        PG8_STAGE(PG8_SB(1, 0), cB + kstep, voffB); PG8_STAGE(PG8_SA(1, 0), cA + kstep, voffA); PG8_STAGE(PG8_SB(1, 1), cB + hstepB + kstep, voffB);
        PG8_WAIT_V(6); PG8_BAR;
    } else {
        PG8_STAGE(PG8_SB(0, 0), cB, voffB); PG8_STAGE(PG8_SA(0, 0), cA, voffA); PG8_STAGE(PG8_SB(0, 1), cB + hstepB, voffB); PG8_STAGE(PG8_SA(0, 1), cA + hstepA, voffA);
        if (wr == 1) PG8_BAR;
        PG8_WAIT_V(4); PG8_BAR;
        PG8_STAGE(PG8_SB(1, 0), cB + kstep, voffB); PG8_STAGE(PG8_SA(1, 0), cA + kstep, voffA); PG8_STAGE(PG8_SB(1, 1), cB + hstepB + kstep, voffB);
        PG8_WAIT_V(6); PG8_BAR;
    }
    for (;;) {
        const bool has_next = S.next(ui + 1, nxt);
        const char* nA = has_next ? (const char*)g.A + (size_t)nxt.pm * tstepA : cA; const char* nB = has_next ? (const char*)g.Bt + (size_t)nxt.pn * tstepB : cB;
        for (int t = 0; t < nt; t += 2) {
            const bool last = (t == nt - 2);
            const char* a1 = cA + (size_t)(t + 1) * kstep;
            const char* a2 = last ? nA : cA + (size_t)(t + 2) * kstep; const char* b2 = last ? nB : cB + (size_t)(t + 2) * kstep;
            const char* a3 = a2 + kstep; const char* b3 = b2 + kstep;
            if (last && has_next) S.a_ready(nxt);
            if constexpr (SP2) {
            PG8_LDB(B0, 0, 0); PG8_LDB(B1, 0, 1); PG8_SCHED; PG8_LDA(At, 0, 0); PG8_STAGE(PG8_SA(1, 1), a1 + hstepA, voffA);
            PG8_WAIT_V(8); PG8_WAIT_L(0); PG8_BAR; PG8_MMA(0, 0, At, B0); PG8_MMA(0, 1, At, B1); PG8_BAR; PG8_SCHED;
            PG8_LDA(At, 0, 1); PG8_STAGE(PG8_SB(0, 0), b2, voffB); PG8_STAGE(PG8_SB(0, 1), b2 + hstepB, voffB); PG8_STAGE(PG8_SA(0, 0), a2, voffA);
            PG8_WAIT_V(8); PG8_WAIT_L(0); PG8_BAR; PG8_MMA(1, 0, At, B0); PG8_MMA(1, 1, At, B1); PG8_BAR; PG8_SCHED;
            PG8_LDB(B0, 1, 0); PG8_LDB(B1, 1, 1); PG8_SCHED; PG8_LDA(At, 1, 0); PG8_STAGE(PG8_SA(0, 1), a2 + hstepA, voffA);
            PG8_WAIT_V(8); PG8_WAIT_L(0); PG8_BAR; PG8_MMA(0, 0, At, B0); PG8_MMA(0, 1, At, B1); PG8_BAR; PG8_SCHED;
            PG8_LDA(At, 1, 1); PG8_STAGE(PG8_SB(1, 0), b3, voffB); PG8_STAGE(PG8_SB(1, 1), b3 + hstepB, voffB); PG8_STAGE(PG8_SA(1, 0), a3, voffA);
            PG8_WAIT_V(8); PG8_WAIT_L(0); PG8_BAR; PG8_MMA(1, 0, At, B0); PG8_MMA(1, 1, At, B1); PG8_BAR; PG8_SCHED;
            } else {
            PG8_LDB(B0, 0, 0); PG8_SCHED; PG8_LDA(At, 0, 0); PG8_STAGE(PG8_SA(1, 1), a1 + hstepA, voffA);
            PG8_WAIT_L(8); PG8_BAR; PG8_WAIT_L(0); PG8_MMA(0, 0, At, B0); PG8_BAR; PG8_SCHED;
            PG8_LDB(B1, 0, 1); PG8_STAGE(PG8_SB(0, 0), b2, voffB);
            PG8_BAR; PG8_WAIT_L(0); PG8_MMA(0, 1, At, B1); PG8_BAR;
            PG8_LDA(At, 0, 1); PG8_STAGE(PG8_SA(0, 0), a2, voffA);
            PG8_BAR; PG8_WAIT_L(0); PG8_MMA(1, 0, At, B0); PG8_BAR; PG8_SCHED;
            PG8_STAGE(PG8_SB(0, 1), b2 + hstepB, voffB);
            PG8_WAIT_V(6); PG8_BAR; PG8_MMA(1, 1, At, B1); PG8_BAR;
            PG8_LDB(B0, 1, 0); PG8_SCHED; PG8_LDA(At, 1, 0); PG8_STAGE(PG8_SA(0, 1), a2 + hstepA, voffA);
            PG8_WAIT_L(8); PG8_BAR; PG8_WAIT_L(0); PG8_MMA(0, 0, At, B0); PG8_BAR; PG8_SCHED;
            PG8_LDB(B1, 1, 1); PG8_STAGE(PG8_SB(1, 0), b3, voffB);
            PG8_BAR; PG8_WAIT_L(0); PG8_MMA(0, 1, At, B1); PG8_BAR;
            PG8_LDA(At, 1, 1); PG8_STAGE(PG8_SA(1, 0), a3, voffA);
            PG8_BAR; PG8_WAIT_L(0); PG8_MMA(1, 0, At, B0); PG8_BAR; PG8_SCHED;
            PG8_STAGE(PG8_SB(1, 1), b3 + hstepB, voffB);
            PG8_WAIT_V(6); PG8_BAR; PG8_MMA(1, 1, At, B1); PG8_BAR;
            }
        }
        if constexpr (ALIGN_EPI) { if (wr == 0) PG8_BAR; }
        if constexpr (!Epi::AFTER_DRAIN) { E(acc, cur, wr, wc, fr, fq); S.done(cur); }
        if (!has_next) break;
#pragma unroll
        for (int a = 0; a < 2; ++a)
#pragma unroll
            for (int b = 0; b < 2; ++b)
#pragma unroll
                for (int m = 0; m < 4; ++m)
#pragma unroll
                    for (int n = 0; n < 2; ++n) acc[a][b][m][n] = (f32x4){0.f, 0.f, 0.f, 0.f};
        cur = nxt; cA = nA; cB = nB; ++ui;
        if constexpr (ALIGN_EPI) { if (wr == 1) PG8_BAR; }
    }
    PG8_WAIT_V(0);
    if constexpr (!ALIGN_EPI) { if (wr == 0) PG8_BAR; }
    PG8_BAR;
    if constexpr (Epi::AFTER_DRAIN) { E.fused(acc, cur, wr, wc, fr, fq, lds, wid, lane); S.done(cur); }
#undef PG8_SA
#undef PG8_SB
#undef PG8_STAGE
#undef PG8_LDA
#undef PG8_LDB
#undef PG8_MMA
#undef PG8_WAIT_V
#undef PG8_WAIT_L
#undef PG8_BAR
#undef PG8_SCHED
}
}
constexpr int NB = 4, T = 8192, D = 1024, M = NB * T, FF = 4096;
constexpr int NRW = 1792, NAT = 1536, NPL = 512, NA = NRW + NAT + NPL  , NG = 3072, NIN = NA + NG  , W = 512;
constexpr int NH = 8, HD = 64, MB_BLK = 256, NBLK = T / MB_BLK  ;
constexpr int NWAVES = 8;
typedef unsigned short bf16;
typedef unsigned v4u __attribute__((ext_vector_type(4)));
typedef unsigned v2u __attribute__((ext_vector_type(2)));
typedef float f32x4 __attribute__((ext_vector_type(4)));
#define LAS __attribute__((address_space(3)))
typedef GAS unsigned gu32;
#define RLX_AGENT __ATOMIC_RELAXED, __HIP_MEMORY_SCOPE_AGENT
#define LDS_WAIT() asm volatile("s_waitcnt lgkmcnt(0)" ::: "memory")
#define VM_WAIT() asm volatile("s_waitcnt vmcnt(0)" ::: "memory")
__device__ __forceinline__ unsigned f2bf(float f) { unsigned u = __builtin_bit_cast(unsigned, f); return (u + 0x7fffu + ((u >> 16) & 1u)) >> 16; }
typedef float f32x2_t __attribute__((ext_vector_type(2)));
typedef __bf16 bf16x2_t __attribute__((ext_vector_type(2)));
__device__ __forceinline__ unsigned pk2(float lo, float hi) { f32x2_t v = {lo, hi}; bf16x2_t b = __builtin_convertvector(v, bf16x2_t); return __builtin_bit_cast(unsigned, b); }
__device__ __forceinline__ float bf2f(unsigned b) { return __builtin_bit_cast(float, b << 16); }
__device__ __forceinline__ float bflo(unsigned w) { return __builtin_bit_cast(float, w << 16); }
__device__ __forceinline__ float bfhi(unsigned w) { return __builtin_bit_cast(float, w & 0xffff0000u); }
__device__ __forceinline__ float sigmoidf_(float x) { return 1.0f / (1.0f + __expf(-x)); }
__device__ __forceinline__ float fsig(float x) { return __builtin_amdgcn_rcpf(1.0f + __builtin_amdgcn_exp2f(-1.4426950408889634f * x)); }
__device__ __forceinline__ float ftanh(float x) { return 2.0f * fsig(2.0f * x) - 1.0f; }
__device__ __forceinline__ float wave_sum(float v) {
#pragma unroll
    for (int o = 1; o < 64; o <<= 1) v += __shfl_xor(v, o);
    return v;
}

constexpr size_t MiB = 1u << 20;
constexpr size_t WS_CTL = 0, CTL_ZERO_BYTES = 1 * MiB;
constexpr size_t WS_WIN = 1 * MiB, WS_WB = 15 * MiB, WS_WO = 18 * MiB, WS_W1 = 20 * MiB, WS_W2 = 28 * MiB, WS_KM = 36 * MiB, WS_LORA = 37 * MiB;
constexpr size_t WS_H = 40 * MiB, WS_RW = 104 * MiB, WS_AT = 216 * MiB, WS_PL = 312 * MiB  , WS_VT = 344 * MiB  ;
constexpr size_t WS_GF = 376 * MiB, WS_PST = 408 * MiB, WS_QST = 440 * MiB, WS_SST = 472 * MiB, WS_BON = 504 * MiB, WS_SB = 505 * MiB, WS_HB = 507 * MiB, WS_END = 511 * MiB;
constexpr size_t WS_GB = 376 * MiB, WS_MB = 440 * MiB, WS_HID = 104 * MiB;
constexpr int CW_BAR = 4096, CW_Q = 8192;
constexpr int RING_OFF = 0, RING_BYTES = 131072;
constexpr int LDS_BYTES = 153600, LDSCTL_OFF = LDS_BYTES - 1024, MISC_OFF = LDSCTL_OFF + 320;
#define XB_TMO      128
#define XB_XCNT(j)  (256  + 64 * (j))
#define XB_XSUB(j)  (1280 + 64 * (j))
#define XB_XGEN(j)  (2304 + 64 * (j))
#define XB_TOP      3328
#define XB_TOPGEN   3392
#define XCD_BAR_WORDS 3456
#define XB_SPIN_CAP (1u << 18)
__device__ __forceinline__ unsigned xb_ld(unsigned* p)              { return __hip_atomic_load(p, __ATOMIC_RELAXED, __HIP_MEMORY_SCOPE_AGENT); }
__device__ __forceinline__ unsigned xb_add(unsigned* p, unsigned v) { return __hip_atomic_fetch_add(p, v, __ATOMIC_RELAXED, __HIP_MEMORY_SCOPE_AGENT); }
__device__ __forceinline__ unsigned xb_xcc_id() { return (unsigned)__builtin_amdgcn_s_getreg((3 << 11) | 20) & 0xFu; }
#define XB_SPIN(cond, bar) do { unsigned _sp = 0; while (cond) { __builtin_amdgcn_s_sleep(1); \
    if ((++_sp & 255u) == 0u) { if (xb_ld(&(bar)[XB_TMO])) break; if (_sp > XB_SPIN_CAP) { atomicAdd(&(bar)[XB_TMO], 1u); break; } } } } while (0)
struct XcdBarrier { unsigned* bar; unsigned x; volatile LAS unsigned* st; };
__device__ __forceinline__ XcdBarrier xcd_barrier_post(unsigned* bar, volatile LAS unsigned* st) {
    XcdBarrier b; b.bar = bar; b.x = xb_xcc_id(); b.st = st;
    if (threadIdx.x == 0) (void)xb_add(&bar[XB_XCNT(b.x)], 1u);
    return b;
}
__device__ __forceinline__ void xcd_barrier_complete(unsigned* bar, unsigned x, unsigned& nloc, unsigned& nx) {
    const unsigned G = gridDim.x * gridDim.y * gridDim.z;
    unsigned sum, cnt, mine, sp = 0u;
    for (;;) {
        sum = 0u; cnt = 0u; mine = 0u;
#pragma unroll
        for (unsigned j = 0; j < 16; ++j) { const unsigned c = xb_ld(&bar[XB_XCNT(j)]); sum += c; cnt += (c > 0u) ? 1u : 0u; mine = (j == x) ? c : mine; }
        if (sum == G) break;
        __builtin_amdgcn_s_sleep(1);
        if ((++sp & 255u) == 0u) { if (xb_ld(&bar[XB_TMO])) break; if (sp > XB_SPIN_CAP) { atomicAdd(&bar[XB_TMO], 1u); break; } }
    }
    nloc = mine > 0u ? mine : 1u; nx = cnt > 0u ? cnt : 1u;
}
__device__ __forceinline__ void xcd_barrier(const XcdBarrier& b) {
    asm volatile("s_waitcnt vmcnt(0)" ::: "memory");
    __syncthreads();
    if (threadIdx.x == 0) {
        unsigned* bar = b.bar;
        __builtin_amdgcn_s_waitcnt(0);
        unsigned nloc = b.st[0], nx = b.st[1];
        if (nloc == 0u) { xcd_barrier_complete(bar, b.x, nloc, nx); b.st[0] = nloc; b.st[1] = nx; }
        const unsigned old = xb_add(&bar[XB_XSUB(b.x)], 1u);
        const unsigned gen = old / nloc;
        if (old + 1u == (gen + 1u) * nloc) {
            __builtin_amdgcn_fence(__ATOMIC_RELEASE, "agent");
            asm volatile("s_waitcnt vmcnt(0)" ::: "memory");
            const unsigned og = xb_add(&bar[XB_TOP], 1u);
            const unsigned tg = og / nx;
            if (og + 1u == (tg + 1u) * nx) xb_add(&bar[XB_TOPGEN], 1u);
            else XB_SPIN(xb_ld(&bar[XB_TOPGEN]) == tg, bar);
            __builtin_amdgcn_fence(__ATOMIC_ACQUIRE, "agent");
            xb_add(&bar[XB_XGEN(b.x)], 1u);
            asm volatile("s_waitcnt vmcnt(0)" ::: "memory");
        } else {
            XB_SPIN(xb_ld(&bar[XB_XGEN(b.x)]) == gen, bar);
            __builtin_amdgcn_fence(__ATOMIC_ACQUIRE, "agent");
            asm volatile("s_waitcnt vmcnt(0)" ::: "memory");
        }
    }
    __syncthreads();
}

struct Args { const float* in[23]; float* out; unsigned char* ws; int ph_lo, ph_hi, l_lo, l_hi, fused, probe_upto, probe_dup, pad; };
enum Phase { PH_CONV = 0, PH_GEMMA, PH_MIX1, PH_MIX2, PH_S3, PH_GB, PH_GO, PH_NORM2, PH_FF1, PH_FF2, PH_N };
enum In { I_X = 0, I_N1G, I_WIN, I_MU, I_W0, I_WUP, I_A0, I_AUP, I_GUP, I_KK, I_KA, I_RK, I_LNG, I_LNB, I_QNG, I_KNG, I_POOLW, I_POOLS, I_WBR, I_WOUT, I_N2G, I_FF1, I_FF2 };

__device__ __forceinline__ void p0_transpose_item(const float* Wm, int K, int N, bf16* WT, LAS float* scr, int item, int lane) {
    const int nblk = N / 32, kb = item / nblk, nb = item % nblk, k0 = 64 * kb, n0 = 32 * nb;
#pragma unroll 8
    for (int i = 0; i < 32; ++i) { const int kk = 2 * i + (lane >> 5); scr[kk * 33 + (lane & 31)] = ((const GAS float*)Wm)[(size_t)(k0 + kk) * N + n0 + (lane & 31)]; }
    LDS_WAIT(); asm volatile("" ::: "memory");
    const int c = lane & 7;
#pragma unroll
    for (int j = 0; j < 4; ++j) { const int n = (lane >> 3) + 8 * j; const LAS float* s = scr + (8 * c) * 33 + n;
        v4u o; o.x = pk2(s[0 * 33], s[1 * 33]); o.y = pk2(s[2 * 33], s[3 * 33]); o.z = pk2(s[4 * 33], s[5 * 33]); o.w = pk2(s[6 * 33], s[7 * 33]);
        *(GAS v4u*)(WT + (size_t)(n0 + n) * K + k0 + 8 * c) = o; }
    LDS_WAIT(); asm volatile("" ::: "memory");
}
__device__ __forceinline__ void rms_rows(const float* x, const float* g, bf16* out, int gw, int NGW, int lane) {
    f32x4 gv[4];
#pragma unroll
    for (int j = 0; j < 4; ++j) gv[j] = ((const GAS f32x4*)g)[lane + 64 * j];
    for (int m0 = gw; m0 < M; m0 += 4 * NGW) {
        f32x4 v[4][4];
#pragma unroll
        for (int rr = 0; rr < 4; ++rr) { const int m = m0 + rr * NGW; if (m < M) { const GAS f32x4* xr = (const GAS f32x4*)(x + (size_t)m * D) + lane;
#pragma unroll
            for (int j = 0; j < 4; ++j) v[rr][j] = xr[64 * j]; } }
#pragma unroll
        for (int rr = 0; rr < 4; ++rr) { const int m = m0 + rr * NGW; if (m < M) {
            float s_ = 0.f;
#pragma unroll
            for (int j = 0; j < 4; ++j) s_ += (v[rr][j].x * v[rr][j].x + v[rr][j].y * v[rr][j].y) + (v[rr][j].z * v[rr][j].z + v[rr][j].w * v[rr][j].w);
            const float rstd = 1.0f / sqrtf(wave_sum(s_) * (1.0f / D) + 1e-6f);
            GAS unsigned long long* o8 = (GAS unsigned long long*)(out + (size_t)m * D) + lane;
#pragma unroll
            for (int j = 0; j < 4; ++j) { const f32x4 y = v[rr][j] * rstd * gv[j]; o8[64 * j] = (unsigned long long)pk2(y.x, y.y) | ((unsigned long long)pk2(y.z, y.w) << 32); } } }
    }
}

__device__ __forceinline__ void ph_attn_prep(LAS unsigned char* lds, bf16* AT, bf16* VT, const float* qg, const float* kg, float* KM, int G, const int tid) {
    LAS float* red = (LAS float*)lds;
    LAS unsigned char* vt = lds + 2048;
    const int lane = tid & 63, wave = tid >> 6, tsub = lane >> 3, dq = lane & 7;
    float gq[8], gk[8];
#pragma unroll
    for (int e = 0; e < 8; ++e) { gq[e] = ((const GAS float*)qg)[dq * 8 + e] * (0.125f * 1.4426950408889634f); gk[e] = ((const GAS float*)kg)[dq * 8 + e]; }
    for (int bid = blockIdx.x; bid < NB * NBLK * NH; bid += G) {
        const int h = bid & 7, n = (bid >> 3) & 31, b = bid >> 8;
        v4u qv[4], kv[4], vv[4];
#pragma unroll
        for (int j = 0; j < 4; ++j) { const size_t row = (size_t)b * T + n * 256 + wave * 32 + 8 * j + tsub; const bf16* qp = AT + row * NAT + h * 64 + dq * 8;
            qv[j] = *(const GAS v4u*)qp; kv[j] = *(const GAS v4u*)(qp + 512); vv[j] = *(const GAS v4u*)(qp + 1024); }
        float ksum[8];
#pragma unroll
        for (int e = 0; e < 8; ++e) ksum[e] = 0.f;
#pragma unroll
        for (int j = 0; j < 4; ++j) {
            const int tok = wave * 32 + 8 * j + tsub; const size_t row = (size_t)b * T + n * 256 + tok; bf16* qp = AT + row * NAT + h * 64 + dq * 8;
            float q[8], k[8];
            q[0] = bflo(qv[j].x); q[1] = bfhi(qv[j].x); q[2] = bflo(qv[j].y); q[3] = bfhi(qv[j].y); q[4] = bflo(qv[j].z); q[5] = bfhi(qv[j].z); q[6] = bflo(qv[j].w); q[7] = bfhi(qv[j].w);
            k[0] = bflo(kv[j].x); k[1] = bfhi(kv[j].x); k[2] = bflo(kv[j].y); k[3] = bfhi(kv[j].y); k[4] = bflo(kv[j].z); k[5] = bfhi(kv[j].z); k[6] = bflo(kv[j].w); k[7] = bfhi(kv[j].w);
            float qs = 0.f, ks = 0.f;
#pragma unroll
            for (int e = 0; e < 8; ++e) { qs += q[e] * q[e]; ks += k[e] * k[e]; }
            qs += __shfl_xor(qs, 1); qs += __shfl_xor(qs, 2); qs += __shfl_xor(qs, 4);
            ks += __shfl_xor(ks, 1); ks += __shfl_xor(ks, 2); ks += __shfl_xor(ks, 4);
            const float rq = 1.0f / sqrtf(qs * (1.0f / 64.0f) + 1e-6f), rk = 1.0f / sqrtf(ks * (1.0f / 64.0f) + 1e-6f);
#pragma unroll
            for (int e = 0; e < 8; ++e) { q[e] = q[e] * rq * gq[e]; k[e] = k[e] * rk * gk[e]; ksum[e] += k[e]; }
            v4u w; w.x = pk2(q[0], q[1]); w.y = pk2(q[2], q[3]); w.z = pk2(q[4], q[5]); w.w = pk2(q[6], q[7]); *(GAS v4u*)qp = w;
            w.x = pk2(k[0], k[1]); w.y = pk2(k[2], k[3]); w.z = pk2(k[4], k[5]); w.w = pk2(k[6], k[7]); *(GAS v4u*)(qp + 512) = w;
            const unsigned vw[4] = {vv[j].x, vv[j].y, vv[j].z, vv[j].w};
#pragma unroll
            for (int e = 0; e < 8; ++e) *(LAS bf16*)(vt + (dq * 8 + e) * 520 + tok * 2) = (bf16)((e & 1) ? (vw[e >> 1] >> 16) : (vw[e >> 1] & 0xffffu));
        }
#pragma unroll
        for (int e = 0; e < 8; ++e) { float s_ = ksum[e]; s_ += __shfl_xor(s_, 8); s_ += __shfl_xor(s_, 16); s_ += __shfl_xor(s_, 32); if (tsub == 0) red[wave * 64 + dq * 8 + e] = s_; }
        __syncthreads();
        if (wave == 0) { float s_ = 0.f; for (int w = 0; w < 8; ++w) s_ += red[w * 64 + lane]; ((GAS float*)KM)[(((size_t)b * NH + h) * NBLK + n) * 64 + lane] = s_ * (1.0f / 256.0f); }
#pragma unroll
        for (int j = 0; j < 4; ++j) { const int c = tid + 512 * j, dim = c >> 5, part = c & 31;
            const v2u lo = *(const LAS v2u*)(vt + dim * 520 + part * 16), hi = *(const LAS v2u*)(vt + dim * 520 + part * 16 + 8);
            v4u w; w.x = lo.x; w.y = lo.y; w.z = hi.x; w.w = hi.y;
            *(GAS v4u*)(VT + (((size_t)(b * NH + h) * (T / 32) + n * 8 + (part >> 2)) * 64 + dim) * 32 + (part & 3) * 8) = w; }
        __syncthreads();
    }
}
__device__ __forceinline__ void ph_pool(bf16* PL_, const bf16* HB_, int G, const int tid) {
    GAS bf16* PL = (GAS bf16*)PL_; const GAS bf16* HB = (const GAS bf16*)HB_;
    const int ch = tid, wdw = 2 << (ch >> 7);
    for (int u = blockIdx.x; u < M / 128; u += G) {
        float ring[16];
        const int tb0 = (u * 128) & (T - 1);
#pragma unroll
        for (int k = 0; k < 16; ++k) ring[k] = 0.f;
        unsigned short hv[15], cu[16], nx[16];
        if (tb0 > 0) {
#pragma unroll
            for (int j = 0; j < 15; ++j) hv[j] = HB[((size_t)(u - 1) * 15 + j) * 512 + ch];
        }
#pragma unroll
        for (int tt = 0; tt < 16; ++tt) cu[tt] = PL[((size_t)u * 128 + tt) * NPL + ch];
        if (tb0 > 0) {
#pragma unroll
            for (int j = 0; j < 15; ++j) ring[1 + j] = bf2f(hv[j]);
        }
#pragma unroll
        for (int t0 = 0; t0 < 128; t0 += 16) {
            if (t0 + 16 < 128) {
#pragma unroll
                for (int tt = 0; tt < 16; ++tt) nx[tt] = PL[((size_t)u * 128 + t0 + 16 + tt) * NPL + ch];
            }
#pragma unroll
            for (int tt = 0; tt < 16; ++tt) {
                const float cur = bf2f(cu[tt]);
                ring[tt] = cur;
                float sm = 0.f;
#pragma unroll
                for (int i = 0; i < 16; ++i) sm += (i < wdw) ? ring[(tt - i) & 15] : 0.f;
                const int tpos = tb0 + t0 + tt; const int cnt = (tpos + 1 < wdw) ? (tpos + 1) : wdw;
                PL[((size_t)u * 128 + t0 + tt) * NPL + ch] = (bf16)f2bf(sm / (float)cnt - cur);
            }
#pragma unroll
            for (int tt = 0; tt < 16; ++tt) cu[tt] = nx[tt];
        }
    }
}
namespace rw {
typedef short bf16x8 __attribute__((ext_vector_type(8)));
constexpr int MATB = 64 * 144;
constexpr int FPB = 64 * 272;
constexpr int X0 = 0, ACTW = X0, ACTA = X0 + MATB, ACTG = X0 + 2 * MATB  , AAB = X0, AAK = X0 + MATB, ARB = X0 + 2 * MATB, ARK = X0 + 3 * MATB;
constexpr int Y0 = 4 * MATB, LWP = Y0, AIP = Y0 + FPB, LGO = AIP, TOT = Y0 + 2 * FPB  , GCV = TOT + 2048  , DG = Y0  , TI = Y0 + 4096  , U0T = Y0 + 8192;
constexpr int PTAB = GCV + 256  ;
constexpr int Z0 = Y0 + 2 * FPB + 2048 + 256 + 3072, AT_ = Z0, BT_ = Z0 + MATB, KT_ = Z0 + 2 * MATB, RT_ = Z0 + 3 * MATB, ATT = Z0 + 4 * MATB, BHT = Z0 + 5 * MATB, KHT = Z0 + 6 * MATB, VTT = Z0 + 7 * MATB;
constexpr int S1_LDS = Z0 + 8 * MATB;
static_assert(S1_LDS <= 153600 - 1024, "S1 LDS map below the control words");
static_assert(U0T + MATB <= TOT, "U0T inside the dead f32 region");
__device__ __forceinline__ f32x4 mma(bf16x8 a, bf16x8 b, f32x4 c) { return __builtin_amdgcn_mfma_f32_16x16x32_bf16(a, b, c, 0, 0, 0); }
__device__ __forceinline__ bf16x8 ldf(const LAS unsigned char* mat, int row, int s, int g) { return *(const LAS bf16x8*)(mat + row * 144 + s * 64 + g * 16); }
__device__ __forceinline__ v2u pack4(f32x4 v) { v2u w; w.x = pk2(v[0], v[1]); w.y = pk2(v[2], v[3]); return w; }
__device__ __forceinline__ f32x4 unpack4(v2u w) { return (f32x4){bflo(w.x), bfhi(w.x), bflo(w.y), bfhi(w.y)}; }
__device__ __forceinline__ void unpack8(v4u w, float* o) { o[0] = bflo(w.x); o[1] = bfhi(w.x); o[2] = bflo(w.y); o[3] = bfhi(w.y); o[4] = bflo(w.z); o[5] = bfhi(w.z); o[6] = bflo(w.w); o[7] = bfhi(w.w); }
__device__ __forceinline__ v4u pack8(const float* o) { v4u w; w.x = pk2(o[0], o[1]); w.y = pk2(o[2], o[3]); w.z = pk2(o[4], o[5]); w.w = pk2(o[6], o[7]); return w; }
#define LDS_BAR() do { asm volatile("s_waitcnt lgkmcnt(0)" ::: "memory"); __builtin_amdgcn_s_barrier(); asm volatile("" ::: "memory"); } while (0)
#define RW_BAR() do { asm volatile("s_waitcnt vmcnt(0) lgkmcnt(0)" ::: "memory"); __builtin_amdgcn_s_barrier(); asm volatile("" ::: "memory"); } while (0)

struct S1Args {
    bf16* RW; const bf16* SB;
    const float *mu, *w0, *a0, *k_k, *k_a, *r_k;
    const bf16 *WupT, *AupT, *GupT;
    bf16 *Gf, *Pst, *Qst; float* bonus;
    bf16 *Rh, *O0; int ldo;
    bf16* Vm; int ldv;
};
__device__ __forceinline__ void s1_unit(LAS unsigned char* lds, const S1Args& A, const int unit, const int tid, int& hprev, const bool dummy = false) {
    const int lane = tid & 63, wave = __builtin_amdgcn_readfirstlane(tid >> 6), r = lane & 15, g = lane >> 4;
    const int h = unit & 7, cidx = unit >> 3  , c_in_b = cidx & 127;
    const size_t row0 = (size_t)cidx * 64;
    const int t = tid >> 3, q = tid & 7;
    float rp[8], kp[8], lwv[8], av[8], kk[8], vp[8];
    if (h != hprev) {
        LAS float* pt = (LAS float*)(lds + PTAB);
        for (int i = tid; i < 768; i += 512) {
            float v_;
            if (i < 192) v_ = ((const GAS float*)A.mu)[(i >> 6) * 512 + h * 64 + (i & 63)];
            else if (i < 448) v_ = ((const GAS float*)A.mu)[1536 + (i - 192)];
            else { const int j = i - 448, c_ = h * 64 + (j & 63); const int w_ = j >> 6; const float* pp_ = (w_ == 0) ? A.w0 : (w_ == 1) ? A.a0 : (w_ == 2) ? A.k_k : (w_ == 3) ? A.k_a : A.r_k; v_ = ((const GAS float*)pp_)[c_]; }
            pt[i] = v_;
        }
        hprev = h;
        LDS_BAR();
    }
    const LAS float* PT = (const LAS float*)(lds + PTAB);
    bf16x8 fw[2], fa[2], fg[4];
    {
        const int cb = wave >> 1;
        const bf16* wu = A.WupT + (size_t)(h * 64 + 16 * cb + r) * 64 + 8 * g;
        const bf16* au = A.AupT + (size_t)(h * 64 + 16 * cb + r) * 64 + 8 * g;
        const bf16* gu = A.GupT + (size_t)(h * 64 + 16 * cb + r) * 128 + 8 * g;
#pragma unroll
        for (int s = 0; s < 2; ++s) { fw[s] = *(const GAS bf16x8*)(wu + 32 * s); fa[s] = *(const GAS bf16x8*)(au + 32 * s); }
#pragma unroll
        for (int s = 0; s < 4; ++s) fg[s] = *(const GAS bf16x8*)(gu + 32 * s);
    }
    {
        const bf16* cur = A.RW + (row0 + t) * NRW;
        const bf16* prv = (t > 0) ? (cur - NRW) : (A.SB + (size_t)(cidx - 1) * NRW);
        const bool hasprev = (t > 0) || (c_in_b > 0);
        float c8[8], p8[8];
#define MIXLOAD(COL, MUO, DST) do { unpack8(*(const GAS v4u*)(cur + (COL)), c8); if (hasprev) unpack8(*(const GAS v4u*)(prv + (COL)), p8); \
            _Pragma("unroll") for (int e = 0; e < 8; ++e) { const float pv_ = hasprev ? p8[e] : 0.f; DST[e] = c8[e] + (pv_ - c8[e]) * PT[(MUO) + e]; } } while (0)
        MIXLOAD(h * 64 + 8 * q, 8 * q, rp); MIXLOAD(512 + h * 64 + 8 * q, 64 + 8 * q, kp); MIXLOAD(1024 + h * 64 + 8 * q, 128 + 8 * q, vp);
#pragma unroll
        for (int e = 0; e < 8; ++e) *(LAS bf16*)(lds + VTT + (8 * q + e) * 144 + t * 2) = (bf16)f2bf(vp[e]);
        float x8[8];
        MIXLOAD(1536 + 8 * q, 192 + 8 * q, x8);
#pragma unroll
        for (int e = 0; e < 8; ++e) x8[e] = ftanh(x8[e]);
        *(LAS v4u*)(lds + ACTW + t * 144 + q * 16) = pack8(x8);
        MIXLOAD(1600 + 8 * q, 256 + 8 * q, x8);
        *(LAS v4u*)(lds + ACTA + t * 144 + q * 16) = pack8(x8);
        MIXLOAD(1664 + 16 * q, 320 + 16 * q, x8);
#pragma unroll
        for (int e = 0; e < 8; ++e) x8[e] = fsig(x8[e]);
        *(LAS v4u*)(lds + ACTG + t * 272 + q * 32) = pack8(x8);
        MIXLOAD(1664 + 16 * q + 8, 320 + 16 * q + 8, x8);
#pragma unroll
        for (int e = 0; e < 8; ++e) x8[e] = fsig(x8[e]);
        *(LAS v4u*)(lds + ACTG + t * 272 + q * 32 + 16) = pack8(x8);
#undef MIXLOAD
    }
    LDS_BAR();
    if (!dummy) *(GAS v4u*)(A.Vm + (row0 + t) * A.ldv + h * 64 + 8 * q) = pack8(vp);
    {
        const int cb = wave >> 1;
#pragma unroll
        for (int i = 0; i < 2; ++i) {
            const int tb = 2 * (wave & 1) + i;
            f32x4 cw = {0.f, 0.f, 0.f, 0.f}, ca = {0.f, 0.f, 0.f, 0.f}, cg = {0.f, 0.f, 0.f, 0.f};
#pragma unroll
            for (int s = 0; s < 2; ++s) { cw = mma(fw[s], ldf(lds + ACTW, 16 * tb + r, s, g), cw); ca = mma(fa[s], ldf(lds + ACTA, 16 * tb + r, s, g), ca); }
#pragma unroll
            for (int s = 0; s < 4; ++s) cg = mma(fg[s], *(const LAS bf16x8*)(lds + ACTG + (16 * tb + r) * 272 + s * 64 + g * 16), cg);
            *(LAS f32x4*)(lds + LWP + (16 * tb + r) * 272 + (16 * cb + 4 * g) * 4) = cw;
            *(LAS f32x4*)(lds + AIP + (16 * tb + r) * 272 + (16 * cb + 4 * g) * 4) = ca;
            if (!dummy) *(GAS v2u*)(A.Gf + (row0 + 16 * tb + r) * W + h * 64 + 16 * cb + 4 * g) = pack4(cg);
        }
    }
    LDS_BAR();
    {
        const f32x4 l0 = *(const LAS f32x4*)(lds + LWP + t * 272 + q * 32), l1 = *(const LAS f32x4*)(lds + LWP + t * 272 + q * 32 + 16);
        const f32x4 a0v = *(const LAS f32x4*)(lds + AIP + t * 272 + q * 32), a1v = *(const LAS f32x4*)(lds + AIP + t * 272 + q * 32 + 16);
        float ss = 0.f, bon = 0.f;
#pragma unroll
        for (int e = 0; e < 8; ++e) { const int hc = 8 * q + e;
            const float lp = (e < 4) ? l0[e & 3] : l1[e & 3], ap = (e < 4) ? a0v[e & 3] : a1v[e & 3];
            lwv[e] = -0.60653065971263342f * fsig(PT[448 + hc] + lp);
            av[e] = fsig(PT[512 + hc] + ap);
            kk[e] = kp[e] * PT[576 + hc]; ss += kk[e] * kk[e];
            kp[e] = kp[e] * (1.0f + (av[e] - 1.0f) * PT[640 + hc]);
            bon += rp[e] * kp[e] * PT[704 + hc]; }
        ss += __shfl_xor(ss, 1); ss += __shfl_xor(ss, 2); ss += __shfl_xor(ss, 4);
        bon += __shfl_xor(bon, 1); bon += __shfl_xor(bon, 2); bon += __shfl_xor(bon, 4);
        const float inv = 1.0f / fmaxf(sqrtf(ss), 1e-12f);
#pragma unroll
        for (int e = 0; e < 8; ++e) kk[e] *= inv;
        if (q == 0 && !dummy) ((GAS float*)A.bonus)[(row0 + t) * 8 + h] = bon;
        *(LAS f32x4*)(lds + LWP + t * 272 + q * 32) = (f32x4){lwv[0], lwv[1], lwv[2], lwv[3]};
        *(LAS f32x4*)(lds + LWP + t * 272 + q * 32 + 16) = (f32x4){lwv[4], lwv[5], lwv[6], lwv[7]};
    }
    LDS_BAR();
    {
        const int c = tid & 63, seg = tid >> 6; float x[8]; float run = 0.f;
#pragma unroll
        for (int i = 0; i < 8; ++i) { run += *(const LAS float*)(lds + LWP + (8 * seg + i) * 272 + c * 4); x[i] = run; }
        *(LAS float*)(lds + TOT + (seg * 64 + c) * 4) = run;
        LDS_BAR();
        float off = 0.f;
        for (int s2 = 0; s2 < seg; ++s2) off += *(const LAS float*)(lds + TOT + (s2 * 64 + c) * 4);
#pragma unroll
        for (int i = 0; i < 8; ++i) *(LAS float*)(lds + LGO + (8 * seg + i) * 272 + c * 4) = x[i] + off;
    }
    LDS_BAR();
    {
        const f32x4 g0 = *(const LAS f32x4*)(lds + LGO + t * 272 + q * 32), g1 = *(const LAS f32x4*)(lds + LGO + t * 272 + q * 32 + 16);
        const f32x4 e0 = *(const LAS f32x4*)(lds + LGO + 63 * 272 + q * 32), e1 = *(const LAS f32x4*)(lds + LGO + 63 * 272 + q * 32 + 16);
        float at[8], bt[8], kt[8], rt[8], bh[8], kh[8];
#pragma unroll
        for (int e = 0; e < 8; ++e) { const float lg = (e < 4) ? g0[e & 3] : g1[e & 3], lc = (e < 4) ? e0[e & 3] : e1[e & 3];
            const float gm1 = __expf(lg - lwv[e]), gi = __expf(-lg), gt = __expf(lg), gr = __expf(lc - lg);
            const float bb = kk[e] * av[e];
            at[e] = -kk[e] * gm1; bt[e] = bb * gi; kt[e] = kp[e] * gi; rt[e] = rp[e] * gt; bh[e] = bb * gr; kh[e] = kp[e] * gr;
            if (t == 63) *(LAS float*)(lds + GCV + (8 * q + e) * 4) = __expf(lc); }
        *(LAS v4u*)(lds + AT_ + t * 144 + q * 16) = pack8(at); *(LAS v4u*)(lds + BT_ + t * 144 + q * 16) = pack8(bt);
        *(LAS v4u*)(lds + KT_ + t * 144 + q * 16) = pack8(kt); *(LAS v4u*)(lds + RT_ + t * 144 + q * 16) = pack8(rt);
#pragma unroll
        for (int e = 0; e < 8; ++e) { const int o = (8 * q + e) * 144 + t * 2;
            *(LAS bf16*)(lds + ATT + o) = (bf16)f2bf(at[e]); *(LAS bf16*)(lds + BHT + o) = (bf16)f2bf(bh[e]); *(LAS bf16*)(lds + KHT + o) = (bf16)f2bf(kh[e]); }
    }
    LDS_BAR();
    {
        const int hv_tb[10] = {0, 1, 1, 2, 2, 2, 3, 3, 3, 3}, hv_jb[10] = {0, 0, 1, 0, 1, 2, 0, 1, 2, 3};
        const int z_tb[6] = {0, 0, 0, 1, 1, 2}, z_jb[6] = {1, 2, 3, 2, 3, 3};
#pragma unroll
        for (int pass = 0; pass < 2; ++pass) {
            const int hi = (pass == 0) ? wave : (wave < 2 ? 8 + wave : -1);
            if (hi >= 0) {
                int tb = 0, jb = 0;
#pragma unroll
                for (int k = 0; k < 10; ++k) if (k == hi) { tb = hv_tb[k]; jb = hv_jb[k]; }
                f32x4 cab = {0.f, 0.f, 0.f, 0.f}, cak = cab, crb = cab, crk = cab;
#pragma unroll
                for (int s = 0; s < 2; ++s) { const bf16x8 fb = ldf(lds + BT_, 16 * jb + r, s, g), fk = ldf(lds + KT_, 16 * jb + r, s, g), fa = ldf(lds + AT_, 16 * tb + r, s, g), fr = ldf(lds + RT_, 16 * tb + r, s, g);
                    cab = mma(fb, fa, cab); cak = mma(fk, fa, cak); crb = mma(fb, fr, crb); crk = mma(fk, fr, crk); }
                const int tt = 16 * tb + r;
#pragma unroll
                for (int e = 0; e < 4; ++e) { const int j = 16 * jb + 4 * g + e; if (!(j < tt)) { cab[e] = 0.f; cak[e] = 0.f; } if (!(j <= tt)) { crb[e] = 0.f; crk[e] = 0.f; } }
                const int o = tt * 144 + (16 * jb + 4 * g) * 2;
                *(LAS v2u*)(lds + AAB + o) = pack4(cab); *(LAS v2u*)(lds + AAK + o) = pack4(cak); *(LAS v2u*)(lds + ARB + o) = pack4(crb); *(LAS v2u*)(lds + ARK + o) = pack4(crk);
                if (tb == jb) *(LAS f32x4*)(lds + DG + ((tb * 16 + r) * 16 + 4 * g) * 4) = cab;
            }
        }
        if (wave >= 2) {
            int tb = 0, jb = 0;
#pragma unroll
            for (int k = 0; k < 6; ++k) if (k == wave - 2) { tb = z_tb[k]; jb = z_jb[k]; }
            const int o = (16 * tb + r) * 144 + (16 * jb + 4 * g) * 2; const v2u z = {0u, 0u};
            *(LAS v2u*)(lds + AAB + o) = z; *(LAS v2u*)(lds + AAK + o) = z; *(LAS v2u*)(lds + ARB + o) = z; *(LAS v2u*)(lds + ARK + o) = z;
        }
    }
    LDS_BAR();
    f32x4 Y[4];
    if (wave == 7) {
        const int blk = lane >> 4, col = lane & 15; float x[16];
#pragma unroll
        for (int tt = 0; tt < 16; ++tt) {
            float acc = (tt == col) ? 1.0f : 0.0f;
            const LAS float* nrow = (const LAS float*)(lds + DG + ((blk * 16 + tt) * 16) * 4);
#pragma unroll
            for (int j = 0; j < 16; ++j) if (j < tt) acc += nrow[j] * x[j];
            x[tt] = acc;
            *(LAS bf16*)(lds + TI + ((blk * 16 + tt) * 16 + col) * 2) = (bf16)f2bf(acc);
        }
    }
    if (wave < 4) {
#pragma unroll
        for (int i = 0; i < 4; ++i) { Y[i] = (f32x4){0.f, 0.f, 0.f, 0.f};
#pragma unroll
            for (int s = 0; s < 2; ++s) Y[i] = mma(ldf(lds + AAK, 16 * i + r, s, g), ldf(lds + VTT, 16 * wave + r, s, g), Y[i]); }
    } else {
#pragma unroll
        for (int i = 0; i < 4; ++i) Y[i] = unpack4(*(const LAS v2u*)(lds + ATT + (16 * (wave - 4) + r) * 144 + (16 * i + 4 * g) * 2));
    }
    LDS_BAR();
    {
        v2u Xb[4];
        const bf16x8 zf = {0, 0, 0, 0, 0, 0, 0, 0};
#pragma unroll
        for (int i = 0; i < 4; ++i) {
            if (i >= 1) {
                v4u bw; bw.x = Xb[0].x; bw.y = Xb[0].y; bw.z = (i >= 2) ? Xb[1].x : 0u; bw.w = (i >= 2) ? Xb[1].y : 0u;
                v4u aw; const v2u a0 = *(const LAS v2u*)(lds + AAB + (16 * i + r) * 144 + (4 * g) * 2), a1 = *(const LAS v2u*)(lds + AAB + (16 * i + r) * 144 + (16 + 4 * g) * 2);
                aw.x = a0.x; aw.y = a0.y; aw.z = a1.x; aw.w = a1.y;
                Y[i] = mma(__builtin_bit_cast(bf16x8, aw), __builtin_bit_cast(bf16x8, bw), Y[i]);
            }
            if (i >= 3) {
                v4u bw; bw.x = Xb[2].x; bw.y = Xb[2].y; bw.z = 0u; bw.w = 0u;
                v4u aw; const v2u a0 = *(const LAS v2u*)(lds + AAB + (16 * i + r) * 144 + (32 + 4 * g) * 2);
                aw.x = a0.x; aw.y = a0.y; aw.z = 0u; aw.w = 0u;
                Y[i] = mma(__builtin_bit_cast(bf16x8, aw), __builtin_bit_cast(bf16x8, bw), Y[i]);
            }
            v4u tw; const v2u t0 = *(const LAS v2u*)(lds + TI + ((i * 16 + r) * 16 + 4 * g) * 2); tw.x = t0.x; tw.y = t0.y; tw.z = 0u; tw.w = 0u;
            v4u yw; const v2u yp = pack4(Y[i]); yw.x = yp.x; yw.y = yp.y; yw.z = 0u; yw.w = 0u;
            const f32x4 X = mma(__builtin_bit_cast(bf16x8, tw), __builtin_bit_cast(bf16x8, yw), (f32x4){0.f, 0.f, 0.f, 0.f});
            Xb[i] = pack4(X);
            const int dst = (wave < 4) ? (U0T + (16 * wave + r) * 144) : (ATT + (16 * (wave - 4) + r) * 144);
            *(LAS v2u*)(lds + dst + (16 * i + 4 * g) * 2) = Xb[i];
        }
        (void)zf;
    }
    LDS_BAR();
    {
#pragma unroll
        for (int i = 0; i < 2; ++i) {
            const int qq = 2 * wave + i, rb = qq >> 2, cb = qq & 3;
            f32x4 crh = {0.f, 0.f, 0.f, 0.f}, co0 = crh, cp = crh, cq = crh;
#pragma unroll
            for (int s = 0; s < 2; ++s) {
                const bf16x8 fah = ldf(lds + ATT, 16 * rb + r, s, g), fu0 = ldf(lds + U0T, 16 * rb + r, s, g), fvt = ldf(lds + VTT, 16 * rb + r, s, g), fbh = ldf(lds + BHT, 16 * rb + r, s, g), fkh = ldf(lds + KHT, 16 * rb + r, s, g);
                const bf16x8 frb = ldf(lds + ARB, 16 * cb + r, s, g), frk = ldf(lds + ARK, 16 * cb + r, s, g), fbhc = ldf(lds + BHT, 16 * cb + r, s, g), fu0c = ldf(lds + U0T, 16 * cb + r, s, g), fvtc = ldf(lds + VTT, 16 * cb + r, s, g);
                crh = mma(fah, frb, crh);
                co0 = mma(fu0, frb, co0); co0 = mma(fvt, frk, co0);
                cp = mma(fah, fbhc, cp);
                cq = mma(fbh, fu0c, cq); cq = mma(fkh, fvtc, cq);
            }
            crh = crh + unpack4(*(const LAS v2u*)(lds + RT_ + (16 * cb + r) * 144 + (16 * rb + 4 * g) * 2));
            if (rb == cb) {
#pragma unroll
                for (int e = 0; e < 4; ++e) if (4 * g + e == r) cp[e] += *(const LAS float*)(lds + GCV + (16 * rb + 4 * g + e) * 4);
            }
            const size_t tok = row0 + 16 * cb + r;
            if (!dummy) {
            *(GAS v2u*)(A.Rh + tok * A.ldo + h * 64 + 16 * rb + 4 * g) = pack4(crh);
            *(GAS v2u*)(A.O0 + tok * A.ldo + h * 64 + 16 * rb + 4 * g) = pack4(co0);
            const size_t su = (size_t)(((cidx >> 7) * 8 + h) * 128 + c_in_b);
            *(GAS v2u*)(A.Pst + su * 4096 + (16 * cb + r) * 64 + 32 * (rb >> 1) + 8 * g + 4 * (rb & 1)) = pack4(cp);
            *(GAS v2u*)(A.Qst + su * 4096 + (16 * cb + r) * 64 + 16 * g + 4 * rb) = pack4(cq);
            }
        }
    }
    LDS_BAR();
}

struct PQ { v4u p[4][2]; v4u q[2]; };
constexpr int S2_NS = 8, S2_SLOTB = 2048, S2_FLAGS = 4 * S2_NS * S2_SLOTB;
__device__ __forceinline__ void s2_chain(LAS unsigned char* lds, const bf16* Pst, const bf16* Qst, const int bh, const int vb, const int lane) {
    const int r = lane & 15, g = lane >> 4;
    f32x4 S[4];
#pragma unroll
    for (int i = 0; i < 4; ++i) S[i] = (f32x4){0.f, 0.f, 0.f, 0.f};
    const size_t ustep = (size_t)4096;
    const bf16* Pp = Pst + ((size_t)bh * 128) * 4096 + r * 64 + 8 * g;
    const bf16* Qp = Qst + ((size_t)bh * 128) * 4096 + (16 * vb + r) * 64 + 16 * g;
    LAS unsigned char* ring = lds + vb * (S2_NS * S2_SLOTB) + r * 128 + g * 8;
    volatile LAS int* prod = (volatile LAS int*)(lds + S2_FLAGS + vb * 64);
    volatile LAS int* cons = (volatile LAS int*)(lds + S2_FLAGS + 256 + vb * 64);
#define S2_GLD(DST, PTR) asm volatile("global_load_dwordx4 %0, %1, off" : "=v"(DST) : "v"(PTR) : "memory")
#define S2_LOAD(B, C) do { const int c_ = (C) < 128 ? (C) : 127; const bf16* P_ = Pp + (size_t)c_ * ustep; const bf16* Q_ = Qp + (size_t)c_ * ustep; \
        _Pragma("unroll") for (int i = 0; i < 4; ++i) { S2_GLD(B.p[i][0], P_ + (16 * i) * 64); S2_GLD(B.p[i][1], P_ + (16 * i) * 64 + 32); } \
        S2_GLD(B.q[0], Q_); S2_GLD(B.q[1], Q_ + 8); } while (0)
#define S2_READY(B, N) asm volatile("s_waitcnt vmcnt(" #N ")" : "+v"(B.p[0][0]), "+v"(B.p[0][1]), "+v"(B.p[1][0]), "+v"(B.p[1][1]), "+v"(B.p[2][0]), "+v"(B.p[2][1]), "+v"(B.p[3][0]), "+v"(B.p[3][1]), "+v"(B.q[0]), "+v"(B.q[1]) :: "memory")
#define S2_STEP(B, C) do { v2u sb_[4]; \
        { unsigned sp_ = 0; while ((C) - *cons >= S2_NS && ++sp_ < (1u << 22)) __builtin_amdgcn_s_sleep(1); } asm volatile("" ::: "memory");   \
        _Pragma("unroll") for (int i = 0; i < 4; ++i) { sb_[i] = pack4(S[i]); *(LAS v2u*)(ring + ((C) & (S2_NS - 1)) * S2_SLOTB + 32 * i) = sb_[i]; } \
        asm volatile("s_waitcnt lgkmcnt(0)" ::: "memory"); if (lane == 0) *prod = (C) + 1; \
        _Pragma("unroll") for (int i = 0; i < 4; ++i) { v2u qi_; qi_.x = (i & 1) ? B.q[i >> 1].z : B.q[i >> 1].x; qi_.y = (i & 1) ? B.q[i >> 1].w : B.q[i >> 1].y; f32x4 n_ = unpack4(qi_); \
            _Pragma("unroll") for (int s_ = 0; s_ < 2; ++s_) { \
                v4u bw_; bw_.x = sb_[2 * s_].x; bw_.y = sb_[2 * s_].y; bw_.z = sb_[2 * s_ + 1].x; bw_.w = sb_[2 * s_ + 1].y; \
                n_ = mma(__builtin_bit_cast(bf16x8, B.p[i][s_]), __builtin_bit_cast(bf16x8, bw_), n_); } \
            S[i] = n_; } } while (0)
#define PIN() asm volatile("" ::: "memory")
    PQ B0, B1, B2, B3;
    asm volatile("s_waitcnt vmcnt(0)" ::: "memory");
    S2_LOAD(B0, 0); S2_LOAD(B1, 1); S2_LOAD(B2, 2);
    for (int c = 0; c < 128; c += 4) {
        S2_LOAD(B3, c + 3); S2_READY(B0, 30); S2_STEP(B0, c);
        S2_LOAD(B0, c + 4); S2_READY(B1, 30); S2_STEP(B1, c + 1);
        S2_LOAD(B1, c + 5); S2_READY(B2, 30); S2_STEP(B2, c + 2);
        S2_LOAD(B2, c + 6); S2_READY(B3, 30); S2_STEP(B3, c + 3);
    }
    asm volatile("s_waitcnt vmcnt(0)" : "+v"(B0.p[0][0]), "+v"(B0.p[0][1]), "+v"(B0.p[1][0]), "+v"(B0.p[1][1]), "+v"(B0.p[2][0]), "+v"(B0.p[2][1]), "+v"(B0.p[3][0]), "+v"(B0.p[3][1]), "+v"(B0.q[0]), "+v"(B0.q[1]),
                 "+v"(B1.p[0][0]), "+v"(B1.p[0][1]), "+v"(B1.p[1][0]), "+v"(B1.p[1][1]), "+v"(B1.p[2][0]), "+v"(B1.p[2][1]), "+v"(B1.p[3][0]), "+v"(B1.p[3][1]), "+v"(B1.q[0]), "+v"(B1.q[1]) :: "memory");
    asm volatile("" : "+v"(B2.p[0][0]), "+v"(B2.p[0][1]), "+v"(B2.p[1][0]), "+v"(B2.p[1][1]), "+v"(B2.p[2][0]), "+v"(B2.p[2][1]), "+v"(B2.p[3][0]), "+v"(B2.p[3][1]), "+v"(B2.q[0]), "+v"(B2.q[1]) :: "memory");
#undef S2_LOAD
#undef S2_STEP
}
__device__ __forceinline__ void s2_storer(LAS unsigned char* lds, bf16* Sst, const int bh, const int vb, const int lane) {
    volatile LAS int* prod = (volatile LAS int*)(lds + S2_FLAGS + vb * 64);
    volatile LAS int* cons = (volatile LAS int*)(lds + S2_FLAGS + 256 + vb * 64);
    const LAS unsigned char* ring = lds + vb * (S2_NS * S2_SLOTB) + lane * 32;
    bf16* Sp = Sst + ((size_t)bh * 128) * 4096 + (16 * vb) * 64 + lane * 16;
    for (int c = 0; c < 128; ++c) {
        { unsigned sp_ = 0; while (*prod <= c && ++sp_ < (1u << 22)) __builtin_amdgcn_s_sleep(1); }
        asm volatile("" ::: "memory");
        const v4u a_ = *(const LAS v4u*)(ring + (c & (S2_NS - 1)) * S2_SLOTB), b_ = *(const LAS v4u*)(ring + (c & (S2_NS - 1)) * S2_SLOTB + 16);
        asm volatile("s_waitcnt lgkmcnt(0)" ::: "memory");
        if (lane == 0) *cons = c + 1;
        *(GAS v4u*)(Sp + (size_t)c * 4096) = a_; *(GAS v4u*)(Sp + (size_t)c * 4096 + 8) = b_;
    }
}

struct S3Args { const bf16 *Rh, *O0; int ldo; const bf16* Vp; int ldv; const bf16 *Gf, *Sst; const float *bonus, *lnx_g, *lnx_b; bf16* Y; int ldy; };
__device__ __forceinline__ void s3_unit(const S3Args& A, const int unit, const int lane) {
    const int r = lane & 15, g = lane >> 4;
    const int h = unit & 7, cidx = unit >> 3;
    bf16x8 sf[4][2];
#pragma unroll
    for (int i = 0; i < 4; ++i)
#pragma unroll
        for (int s = 0; s < 2; ++s) sf[i][s] = *(const GAS bf16x8*)(A.Sst + (size_t)(((cidx >> 7) * 8 + h) * 128 + (cidx & 127)) * 4096 + (16 * i + r) * 64 + 32 * s + 8 * g);
#pragma unroll
    for (int tb = 0; tb < 4; ++tb) {
        const size_t tok = (size_t)cidx * 64 + 16 * tb + r;
        f32x4 o[4];
        bf16x8 fr[2];
#pragma unroll
        for (int s = 0; s < 2; ++s) fr[s] = *(const GAS bf16x8*)(A.Rh + tok * A.ldo + h * 64 + 32 * s + 8 * g);
#pragma unroll
        for (int i = 0; i < 4; ++i) {
            o[i] = unpack4(*(const GAS v2u*)(A.O0 + tok * A.ldo + h * 64 + 16 * i + 4 * g));
#pragma unroll
            for (int s = 0; s < 2; ++s) o[i] = mma(sf[i][s], fr[s], o[i]);
        }
        float sm = 0.f;
#pragma unroll
        for (int i = 0; i < 4; ++i) sm += (o[i][0] + o[i][1]) + (o[i][2] + o[i][3]);
        sm += __shfl_xor(sm, 16); sm += __shfl_xor(sm, 32);
        const float mean = sm * (1.0f / 64.0f); float sq = 0.f;
#pragma unroll
        for (int i = 0; i < 4; ++i) { o[i] = o[i] - mean; sq += (o[i][0] * o[i][0] + o[i][1] * o[i][1]) + (o[i][2] * o[i][2] + o[i][3] * o[i][3]); }
        sq += __shfl_xor(sq, 16); sq += __shfl_xor(sq, 32);
        const float rstd = 1.0f / sqrtf(sq * (1.0f / 64.0f) + 64e-5f);
        const float bon = ((const GAS float*)A.bonus)[tok * 8 + h];
#pragma unroll
        for (int i = 0; i < 4; ++i) {
            const int hv = h * 64 + 16 * i + 4 * g;
            const f32x4 lg = *(const GAS f32x4*)(A.lnx_g + hv), lb = *(const GAS f32x4*)(A.lnx_b + hv);
            const f32x4 vv = unpack4(*(const GAS v2u*)(A.Vp + tok * A.ldv + hv)), gg = unpack4(*(const GAS v2u*)(A.Gf + tok * W + hv));
            const f32x4 y = (o[i] * rstd * lg + lb + vv * bon) * gg;
            *(GAS v2u*)(A.Y + tok * A.ldy + hv) = pack4(y);
        }
    }
}
}
namespace moba {
typedef short bf16x8 __attribute__((ext_vector_type(8)));
constexpr int OSP = 132;
constexpr int OSLOT = 0, LSUM = OSLOT + 4 * 256 * OSP, KMF = LSUM + 4 * 256 * 4, CNT = KMF + 8192, OFFS = CNT + 128, FILL = OFFS + 128, QLIST = FILL + 128, QSLOT = QLIST + 1024, ITEMS = QSLOT + 1024, ICTR = ITEMS + 1024, MOBA_LDS = ICTR + 64;
static_assert(MOBA_LDS <= 153600 - 1024, "MoBA LDS map below the control words");
__device__ __forceinline__ f32x4 mma(bf16x8 a, bf16x8 b, f32x4 c) { return __builtin_amdgcn_mfma_f32_16x16x32_bf16(a, b, c, 0, 0, 0); }
struct Args { bf16* AT; const bf16* VT; const float* KM; };
struct KV { bf16x8 k[2][2]; bf16x8 v[4]; };
__device__ __forceinline__ void item(LAS unsigned char* lds, const Args& A, const int b, const int h, const int qb, const int kblk, const int off, const int cnt, const int nkc, const bool own, const int lane) {
    const int r = lane & 15, g = lane >> 4;
    const float slope2 = exp2f(-(float)(h + 1)) * 1.4426950408889634f;
    int ql[2]; float aq[2];
    bf16x8 qf[2][2];
#pragma unroll
    for (int qt = 0; qt < 2; ++qt) {
        const int li = qt * 16 + r;
        int qv = -1;
        if (own) qv = off + li; else if (li < cnt) qv = (int)*(const LAS unsigned char*)(lds + QLIST + off + li);
        ql[qt] = qv;
        const int qrow = (qv >= 0) ? qv : 0;
        aq[qt] = (qv >= 0) ? -slope2 * (float)(256 * (qb - kblk) + qrow) : -1e30f;
    }
    const bf16* kbase = A.AT + ((size_t)b * T + kblk * 256 + 8 * (r >> 2) + (r & 3)) * NAT + 512 + h * 64 + 8 * g;
    const bf16* vbase = A.VT + (((size_t)(b * NH + h) * (T / 32) + kblk * 8) * 64 + r) * 32 + 8 * g;
    f32x4 o[4][2]; float l[2] = {0.f, 0.f};
#pragma unroll
    for (int db = 0; db < 4; ++db) { o[db][0] = (f32x4){0.f, 0.f, 0.f, 0.f}; o[db][1] = (f32x4){0.f, 0.f, 0.f, 0.f}; }
#define GLD16(DST, PTR) asm volatile("global_load_dwordx4 %0, %1, off" : "=v"(DST) : "v"(PTR) : "memory")
#define MOBA_LOAD(B, KC) do { const int kc_ = (KC) < nkc ? (KC) : nkc - 1; \
        _Pragma("unroll") for (int kt = 0; kt < 2; ++kt) { const bf16* kp_ = kbase + (size_t)(kc_ * 32 + kt * 4) * NAT; GLD16(B.k[kt][0], kp_); GLD16(B.k[kt][1], kp_ + 32); } \
        _Pragma("unroll") for (int db = 0; db < 4; ++db) { const bf16* vp_ = vbase + (size_t)kc_ * (64 * 32) + (16 * db) * 32; GLD16(B.v[db], vp_); } } while (0)
#define MOBA_READY(B, N) asm volatile("s_waitcnt vmcnt(" #N ")" : "+v"(B.k[0][0]), "+v"(B.k[0][1]), "+v"(B.k[1][0]), "+v"(B.k[1][1]), "+v"(B.v[0]), "+v"(B.v[1]), "+v"(B.v[2]), "+v"(B.v[3]) :: "memory")
#define MOBA_COMPUTE(B, KC) do { v4u pb_[2]; const int kb_ = (KC) * 32 + 8 * g; const bool dg_ = own && ((KC) == nkc - 1); \
        _Pragma("unroll") for (int qt = 0; qt < 2; ++qt) { unsigned pw_[4]; const float bs_ = aq[qt] + slope2 * (float)kb_; const int dl_ = ql[qt] - kb_; \
            _Pragma("unroll") for (int kt = 0; kt < 2; ++kt) { f32x4 st_ = {0.f, 0.f, 0.f, 0.f}; \
                st_ = mma(B.k[kt][0], qf[qt][0], st_); st_ = mma(B.k[kt][1], qf[qt][1], st_); f32x4 p_; \
                if (dg_) { _Pragma("unroll") for (int e = 0; e < 4; ++e) { float x_ = (st_[e] + bs_) + cst[kt * 4 + e]; if (4 * kt + e > dl_) x_ = -1e30f; p_[e] = __builtin_amdgcn_exp2f(x_); } } \
                else { _Pragma("unroll") for (int e = 0; e < 4; ++e) p_[e] = __builtin_amdgcn_exp2f((st_[e] + bs_) + cst[kt * 4 + e]); } \
                l[qt] += (p_[0] + p_[1]) + (p_[2] + p_[3]); pw_[2 * kt] = pk2(p_[0], p_[1]); pw_[2 * kt + 1] = pk2(p_[2], p_[3]); } \
            pb_[qt].x = pw_[0]; pb_[qt].y = pw_[1]; pb_[qt].z = pw_[2]; pb_[qt].w = pw_[3]; } \
        _Pragma("unroll") for (int db = 0; db < 4; ++db) { _Pragma("unroll") for (int qt = 0; qt < 2; ++qt) o[db][qt] = mma(B.v[db], __builtin_bit_cast(bf16x8, pb_[qt]), o[db][qt]); } } while (0)
    float cst[8];
#pragma unroll
    for (int j = 0; j < 8; ++j) cst[j] = slope2 * (float)j;
    KV B0, B1, B2;
    MOBA_LOAD(B0, 0); MOBA_LOAD(B1, 1);
#pragma unroll
    for (int qt = 0; qt < 2; ++qt) { const int qrow = (ql[qt] >= 0) ? ql[qt] : 0; const bf16* qp = A.AT + ((size_t)b * T + qb * 256 + qrow) * NAT + h * 64 + 8 * g;
        qf[qt][0] = *(const GAS bf16x8*)qp; qf[qt][1] = *(const GAS bf16x8*)(qp + 32); }
    asm volatile("" :: "v"(qf[0][0]), "v"(qf[0][1]), "v"(qf[1][0]), "v"(qf[1][1]) : "memory");
    for (int kc = 0; kc < nkc; kc += 3) {
        MOBA_LOAD(B2, kc + 2); MOBA_READY(B0, 16); MOBA_COMPUTE(B0, kc);
        if (kc + 1 < nkc) { MOBA_LOAD(B0, kc + 3); MOBA_READY(B1, 16); MOBA_COMPUTE(B1, kc + 1); }
        if (kc + 2 < nkc) { MOBA_LOAD(B1, kc + 4); MOBA_READY(B2, 16); MOBA_COMPUTE(B2, kc + 2); }
    }
    asm volatile("s_waitcnt vmcnt(0)" : "+v"(B0.k[0][0]), "+v"(B0.k[0][1]), "+v"(B0.k[1][0]), "+v"(B0.k[1][1]), "+v"(B0.v[0]), "+v"(B0.v[1]), "+v"(B0.v[2]), "+v"(B0.v[3]),
                 "+v"(B1.k[0][0]), "+v"(B1.k[0][1]), "+v"(B1.k[1][0]), "+v"(B1.k[1][1]), "+v"(B1.v[0]), "+v"(B1.v[1]), "+v"(B1.v[2]), "+v"(B1.v[3]),
                 "+v"(B2.k[0][0]), "+v"(B2.k[0][1]), "+v"(B2.k[1][0]), "+v"(B2.k[1][1]), "+v"(B2.v[0]), "+v"(B2.v[1]), "+v"(B2.v[2]), "+v"(B2.v[3]) :: "memory");
#undef MOBA_LOAD
#undef MOBA_COMPUTE
#pragma unroll
    for (int qt = 0; qt < 2; ++qt) {
        float ls = l[qt]; ls += __shfl_xor(ls, 16); ls += __shfl_xor(ls, 32);
        if (ql[qt] >= 0) {
            const int slot = own ? 0 : (int)*(const LAS unsigned char*)(lds + QSLOT + off + qt * 16 + r);
            LAS unsigned char* op = lds + OSLOT + (slot * 256 + ql[qt]) * OSP + g * 8;
#pragma unroll
            for (int db = 0; db < 4; ++db) { *(LAS unsigned*)(op + db * 32) = pk2(o[db][qt][0], o[db][qt][1]); *(LAS unsigned*)(op + db * 32 + 4) = pk2(o[db][qt][2], o[db][qt][3]); }
            if (g == 0) *((LAS float*)(lds + LSUM) + slot * 256 + ql[qt]) = ls;
        }
    }
}
__device__ __forceinline__ void unit(LAS unsigned char* lds, const Args& A, const int b, const int h, const int qb, const int tid, const bool dummy = false) {
    const int lane = tid & 63;
    for (int i = tid; i < qb * 64; i += 512) ((LAS float*)(lds + KMF))[i] = ((const GAS float*)A.KM)[((size_t)(b * NH + h) * NBLK) * 64 + i];
    if (tid < 96) ((LAS int*)(lds + CNT))[tid] = 0;
    if (tid == 0) *(LAS int*)(lds + ICTR) = 0;
    RW_BAR();
    int s0 = -1, s1 = -1, s2 = -1;
    if (tid < 256 && qb > 0) {
        float q[64];
        const GAS v4u* qp = (const GAS v4u*)(A.AT + ((size_t)b * T + qb * 256 + tid) * NAT + h * 64);
#pragma unroll
        for (int c = 0; c < 8; ++c) { const v4u w = qp[c]; q[8*c+0] = bflo(w.x); q[8*c+1] = bfhi(w.x); q[8*c+2] = bflo(w.y); q[8*c+3] = bfhi(w.y); q[8*c+4] = bflo(w.z); q[8*c+5] = bfhi(w.z); q[8*c+6] = bflo(w.w); q[8*c+7] = bfhi(w.w); }
        float g0 = -3e38f, g1 = -3e38f, g2 = -3e38f;
        for (int n = 0; n < qb; ++n) {
            const LAS f32x4* km = (const LAS f32x4*)(lds + KMF + n * 256); float gt = 0.f;
#pragma unroll
            for (int d = 0; d < 16; ++d) { const f32x4 k4 = km[d]; gt += q[4*d] * k4.x + q[4*d+1] * k4.y + q[4*d+2] * k4.z + q[4*d+3] * k4.w; }
            if (gt > g0) { g2 = g1; s2 = s1; g1 = g0; s1 = s0; g0 = gt; s0 = n; }
            else if (gt > g1) { g2 = g1; s2 = s1; g1 = gt; s1 = n; }
            else if (gt > g2) { g2 = gt; s2 = n; }
        }
        if (s0 >= 0) __hip_atomic_fetch_add((LAS int*)(lds + CNT) + s0, 1, __ATOMIC_RELAXED, __HIP_MEMORY_SCOPE_WORKGROUP);
        if (s1 >= 0) __hip_atomic_fetch_add((LAS int*)(lds + CNT) + s1, 1, __ATOMIC_RELAXED, __HIP_MEMORY_SCOPE_WORKGROUP);
        if (s2 >= 0) __hip_atomic_fetch_add((LAS int*)(lds + CNT) + s2, 1, __ATOMIC_RELAXED, __HIP_MEMORY_SCOPE_WORKGROUP);
    }
    RW_BAR();
    if (tid == 0) {
        int run = 0, ni = 0;
        for (int n = 0; n < qb; ++n) { const int c = ((LAS int*)(lds + CNT))[n]; ((LAS int*)(lds + OFFS))[n] = run;
            for (int k = 0; k < c; k += 32) { ((LAS int*)(lds + ITEMS))[2 * ni] = n | ((c - k < 32 ? c - k : 32) << 8); ((LAS int*)(lds + ITEMS))[2 * ni + 1] = run + k; ++ni; }
            run += c; }
        for (int i = 7; i >= 0; --i) { ((LAS int*)(lds + ITEMS))[2 * ni] = qb | (32 << 8) | (1 << 16) | ((i + 1) << 20); ((LAS int*)(lds + ITEMS))[2 * ni + 1] = 32 * i; ++ni; }
        *(LAS int*)(lds + ICTR + 4) = ni;
    }
    RW_BAR();
    if (tid < 256) {
        if (s0 >= 0) { const int p = __hip_atomic_fetch_add((LAS int*)(lds + FILL) + s0, 1, __ATOMIC_RELAXED, __HIP_MEMORY_SCOPE_WORKGROUP); *(LAS unsigned char*)(lds + QLIST + ((LAS int*)(lds + OFFS))[s0] + p) = (unsigned char)tid; *(LAS unsigned char*)(lds + QSLOT + ((LAS int*)(lds + OFFS))[s0] + p) = (unsigned char)1; }
        if (s1 >= 0) { const int p = __hip_atomic_fetch_add((LAS int*)(lds + FILL) + s1, 1, __ATOMIC_RELAXED, __HIP_MEMORY_SCOPE_WORKGROUP); *(LAS unsigned char*)(lds + QLIST + ((LAS int*)(lds + OFFS))[s1] + p) = (unsigned char)tid; *(LAS unsigned char*)(lds + QSLOT + ((LAS int*)(lds + OFFS))[s1] + p) = (unsigned char)2; }
        if (s2 >= 0) { const int p = __hip_atomic_fetch_add((LAS int*)(lds + FILL) + s2, 1, __ATOMIC_RELAXED, __HIP_MEMORY_SCOPE_WORKGROUP); *(LAS unsigned char*)(lds + QLIST + ((LAS int*)(lds + OFFS))[s2] + p) = (unsigned char)tid; *(LAS unsigned char*)(lds + QSLOT + ((LAS int*)(lds + OFFS))[s2] + p) = (unsigned char)3; }
    }
    RW_BAR();
    {
        const int ni = *(const LAS int*)(lds + ICTR + 4);
        for (;;) {
            int idx = 0; if (lane == 0) idx = __hip_atomic_fetch_add((LAS int*)(lds + ICTR), 1, __ATOMIC_RELAXED, __HIP_MEMORY_SCOPE_WORKGROUP);
            idx = __builtin_amdgcn_readfirstlane(idx);
            if (idx >= ni) break;
            const int w0 = __builtin_amdgcn_readfirstlane(((const LAS int*)(lds + ITEMS))[2 * idx]), w1 = __builtin_amdgcn_readfirstlane(((const LAS int*)(lds + ITEMS))[2 * idx + 1]);
            const bool own = (w0 >> 16) & 1;
            item(lds, A, b, h, qb, w0 & 255, w1, (w0 >> 8) & 255, own ? (w0 >> 20) : 8, own, lane);
        }
    }
    RW_BAR();
    if (!dummy) {
        const int qloc = tid >> 1, half = tid & 1;
        const int nslot = 1 + (qb < 3 ? qb : 3);
        float acc[32]; float lt = 0.f;
#pragma unroll
        for (int d = 0; d < 32; ++d) acc[d] = 0.f;
        for (int sl = 0; sl < nslot; ++sl) {
            const LAS unsigned* op = (const LAS unsigned*)(lds + OSLOT + (sl * 256 + qloc) * OSP + half * 64);
#pragma unroll
            for (int d = 0; d < 16; ++d) { const unsigned w = op[d]; acc[2 * d] += bflo(w); acc[2 * d + 1] += bfhi(w); }
            lt += *((const LAS float*)(lds + LSUM) + sl * 256 + qloc);
        }
        const float inv = 1.0f / lt;
        bf16* yp = A.AT + ((size_t)b * T + qb * 256 + qloc) * NAT + h * 64 + half * 32;
#pragma unroll
        for (int c = 0; c < 4; ++c) { v4u w; w.x = pk2(acc[8*c] * inv, acc[8*c+1] * inv); w.y = pk2(acc[8*c+2] * inv, acc[8*c+3] * inv); w.z = pk2(acc[8*c+4] * inv, acc[8*c+5] * inv); w.w = pk2(acc[8*c+6] * inv, acc[8*c+7] * inv); *(GAS v4u*)(yp + 8 * c) = w; }
    }
    RW_BAR();
}
}

__global__ void __launch_bounds__(NWAVES * 64, 2) mk_fwd(Args args) {
    extern __shared__ __attribute__((aligned(16))) unsigned char lds_raw[];
    LAS unsigned char* lds = (LAS unsigned char*)lds_raw;
    const int tid0 = threadIdx.x;
    const int G = gridDim.x;
    unsigned char* ws0 = args.ws;
    const int lo = args.ph_lo, hi = args.ph_hi;
    const int NGW = G * NWAVES;
    const bool fused = args.fused != 0;
    volatile LAS unsigned* MISC = (volatile LAS unsigned*)(lds + MISC_OFF);
    for (int u = tid0; u < (LDS_BYTES - LDSCTL_OFF) / 4; u += NWAVES * 64) ((LAS unsigned*)(lds + LDSCTL_OFF))[u] = 0u;
    __syncthreads();
    XcdBarrier bar; bar.bar = (unsigned*)(ws0 + WS_CTL) + CW_BAR; bar.x = 0; bar.st = nullptr;
    if (fused) bar = xcd_barrier_post((unsigned*)(ws0 + WS_CTL) + CW_BAR, MISC + 8);
#define IN(k) (lo <= (k) && (k) < hi && (rep == 1 || (k) <= args.probe_upto || (k) == args.probe_dup))
#define SEAM(k) do { if (fused && !((k) == PH_FF2 && L == args.l_hi - 1)) xcd_barrier(bar); } while (0)

    for (int L = args.l_lo; L < args.l_hi; ++L)
    for (int rep = (args.probe_upto >= 0 || args.probe_dup >= 0) ? 0 : 1; rep < 2; ++rep) {
    const float* xsrc = (L == 0) ? args.in[I_X] : args.out;
    int tidL = threadIdx.x; asm volatile("" : "+v"(tidL));
    const int tid = tidL, lane = tid & 63, wave = __builtin_amdgcn_readfirstlane(tid >> 6), gw = blockIdx.x * NWAVES + wave;
    if (IN(PH_CONV)) {
        unsigned char* ws = args.ws; asm volatile("" : "+s"(ws));
        LAS float* scr = (LAS float*)(lds + RING_OFF + wave * 16384);
        const float* w_in = args.in[I_WIN] + (size_t)L * D * NIN;
        const float* w_br = args.in[I_WBR] + (size_t)L * 3 * W * D;
        const float* w_out = args.in[I_WOUT] + (size_t)L * D * D;
        const float* w_f1 = args.in[I_FF1] + (size_t)L * D * FF;
        const float* w_f2 = args.in[I_FF2] + (size_t)L * FF * D;
        constexpr int I_IN = (D / 64) * (NIN / 32), I_B = (W / 64) * (D / 32), I_O = (D / 64) * (D / 32), I_1 = (D / 64) * (FF / 32), I_2 = (FF / 64) * (D / 32);
        constexpr int I_LU = 16, I_LG = 32;
        constexpr int NITEMS = I_IN + 2 * I_B + I_O + I_1 + I_2 + 2 * I_LU + I_LG;
        bf16* WupT = (bf16*)(ws + WS_LORA); bf16* AupT = WupT + 512 * 64; bf16* GupT = AupT + 512 * 64;
        for (int it = gw; it < NITEMS; it += NGW) {
            int r = it;
            if (r < I_IN) { p0_transpose_item(w_in, D, NIN, ((bf16*)(ws + WS_WIN)), scr, r, lane); continue; } r -= I_IN;
            if (r < I_B) { p0_transpose_item(w_br, W, D, ((bf16*)(ws + WS_WB)), scr, r, lane); continue; } r -= I_B;
            if (r < I_B) { p0_transpose_item(w_br + (size_t)W * D, W, D, ((bf16*)(ws + WS_WB)) + (size_t)D * W, scr, r, lane); continue; } r -= I_B;
            if (r < I_O) { p0_transpose_item(w_out, D, D, ((bf16*)(ws + WS_WO)), scr, r, lane); continue; } r -= I_O;
            if (r < I_1) { p0_transpose_item(w_f1, D, FF, ((bf16*)(ws + WS_W1)), scr, r, lane); continue; } r -= I_1;
            if (r < I_2) { p0_transpose_item(w_f2, FF, D, ((bf16*)(ws + WS_W2)), scr, r, lane); continue; } r -= I_2;
            if (r < I_LU) { p0_transpose_item(args.in[I_WUP] + (size_t)L * 64 * W, 64, W, WupT, scr, r, lane); continue; } r -= I_LU;
            if (r < I_LU) { p0_transpose_item(args.in[I_AUP] + (size_t)L * 64 * W, 64, W, AupT, scr, r, lane); continue; } r -= I_LU;
            p0_transpose_item(args.in[I_GUP] + (size_t)L * 128 * W, 128, W, GupT, scr, r, lane);
        }
        const float* pw = args.in[I_POOLW] + (size_t)L * 4 * 128 * 128; const float* ps = args.in[I_POOLS] + (size_t)L * W; const float* wb2 = w_br + (size_t)2 * W * D;
        bf16* WeT = ((bf16*)(ws + WS_WB)) + (size_t)2 * D * W;
        for (int idx = blockIdx.x * (NWAVES * 64) + tid; idx < W * D; idx += G * NWAVES * 64) {
            const int gc = idx / D, dout = idx % D, g = gc >> 7;
            const GAS float* pwr = (const GAS float*)pw + (size_t)gc * 128; float acc = 0.f;
            for (int dp = 0; dp < 128; ++dp) acc += pwr[dp] * ((const GAS float*)ps)[g * 128 + dp] * ((const GAS float*)wb2)[(size_t)(g * 128 + dp) * D + dout];
            ((GAS bf16*)WeT)[(size_t)dout * W + gc] = (bf16)f2bf(acc);
        }
        rms_rows(xsrc, args.in[I_N1G] + (size_t)L * D, ((bf16*)(ws + WS_H)), gw, NGW, lane);
        SEAM(PH_CONV);
    }
    if (IN(PH_GEMMA)) {
        unsigned char* ws = args.ws; asm volatile("" : "+s"(ws));
        pg8::Gemm g{((bf16*)(ws + WS_H)), ((bf16*)(ws + WS_WIN)), M, NA, D, D, D}; pg8::StaticOrder S; S.init(M, NA, G, (int)blockIdx.x);
        pg8::EpiA E{(bf16*)(ws + WS_RW), (bf16*)(ws + WS_AT), (bf16*)(ws + WS_PL), (bf16*)(ws + WS_SB), (bf16*)(ws + WS_HB)};
        pg8::gemm_phase<pg8::EpiA, pg8::StaticOrder, true, true>(lds + RING_OFF, g, S, E, tidL);
        SEAM(PH_GEMMA);
    }
    if (IN(PH_MIX1)) {
        unsigned char* ws = args.ws; asm volatile("" : "+s"(ws));
        ph_attn_prep(lds, (bf16*)(ws + WS_AT), (bf16*)(ws + WS_VT), args.in[I_QNG] + L * 64, args.in[I_KNG] + L * 64, (float*)(ws + WS_KM), G, tidL);
        ph_pool((bf16*)(ws + WS_PL), (const bf16*)(ws + WS_HB), G, tidL);
        __syncthreads();
        rw::S1Args A1; A1.RW = (bf16*)(ws + WS_RW); A1.SB = (const bf16*)(ws + WS_SB);
        A1.mu = args.in[I_MU] + L * NRW; A1.w0 = args.in[I_W0] + L * W; A1.a0 = args.in[I_A0] + L * W; A1.k_k = args.in[I_KK] + L * W; A1.k_a = args.in[I_KA] + L * W; A1.r_k = args.in[I_RK] + L * W;
        A1.WupT = (const bf16*)(ws + WS_LORA); A1.AupT = A1.WupT + 512 * 64; A1.GupT = A1.AupT + 512 * 64;
        A1.Gf = (bf16*)(ws + WS_GF); A1.Pst = (bf16*)(ws + WS_PST); A1.Qst = (bf16*)(ws + WS_QST); A1.bonus = (float*)(ws + WS_BON);
        A1.Rh = (bf16*)(ws + WS_RW); A1.O0 = (bf16*)(ws + WS_RW) + 512; A1.ldo = NRW; A1.Vm = (bf16*)(ws + WS_RW) + 1024; A1.ldv = NRW;
        int hprev = -1;
        for (int unit = blockIdx.x; unit < NB * 128 * NH; unit += G) rw::s1_unit(lds, A1, unit, tidL, hprev);
        SEAM(PH_MIX1);
    }
    if (IN(PH_MIX2)) {
        unsigned char* ws = args.ws; asm volatile("" : "+s"(ws));
        { moba::Args MA; MA.AT = (bf16*)(ws + WS_AT); MA.VT = (const bf16*)(ws + WS_VT); MA.KM = (const float*)(ws + WS_KM);
          if (G == 256) {
              const int xcd = blockIdx.x & 7, slot = blockIdx.x >> 3;
              if (slot < 4) {
                  if (tid < 8) *(volatile LAS int*)(lds + rw::S2_FLAGS + tid * 64) = 0;
                  __syncthreads();
                  if (wave < 4) rw::s2_chain(lds, (const bf16*)(ws + WS_PST), (const bf16*)(ws + WS_QST), slot * 8 + xcd, wave, lane);
                  else rw::s2_storer(lds, (bf16*)(ws + WS_SST), slot * 8 + xcd, wave - 4, lane);
              }
              volatile LAS int* qslot = (volatile LAS int*)(lds + LDSCTL_OFF + 64);
              for (int qx = 0; qx < 8; ++qx) {
                  const int x = (xcd + qx) & 7;
                  gu32* qw = (gu32*)(ws + WS_CTL) + CW_Q + (L * 8 + x) * 64;
                  for (;;) {
                      __syncthreads();
                      if (tid == 0) *qslot = (int)__hip_atomic_fetch_add(qw, 1u, RLX_AGENT);
                      __syncthreads();
                      const int u = *qslot;
                      if (u >= 128) break;
                      const int pair = (u >> 5) * 8 + x;
                      int tq = tidL; asm volatile("" : "+v"(tq));
#ifdef PROBE_MOBA2
                      moba::unit(lds, MA, pair >> 3, pair & 7, 31 - (u & 31), tq, true);
#endif
                      moba::unit(lds, MA, pair >> 3, pair & 7, 31 - (u & 31), tq);
                  }
              }
          } else {
              for (int bh = blockIdx.x; bh < NB * NH; bh += G) {
                  __syncthreads();
                  if (tid < 8) *(volatile LAS int*)(lds + rw::S2_FLAGS + tid * 64) = 0;
                  __syncthreads();
                  if (wave < 4) rw::s2_chain(lds, (const bf16*)(ws + WS_PST), (const bf16*)(ws + WS_QST), bh, wave, lane);
                  else rw::s2_storer(lds, (bf16*)(ws + WS_SST), bh, wave - 4, lane);
              }
              __syncthreads();
              for (int u = blockIdx.x; u < NB * NH * NBLK; u += G) moba::unit(lds, MA, u >> 8, (u >> 5) & 7, u & 31, tidL); } }
        SEAM(PH_MIX2);
    }
    if (IN(PH_S3)) {
        unsigned char* ws = args.ws; asm volatile("" : "+s"(ws));
        rw::S3Args A3; A3.Rh = (const bf16*)(ws + WS_RW); A3.O0 = A3.Rh + 512; A3.ldo = NRW; A3.Vp = A3.Rh + 1024; A3.ldv = NRW; A3.Gf = (const bf16*)(ws + WS_GF); A3.Sst = (const bf16*)(ws + WS_SST);
        A3.bonus = (const float*)(ws + WS_BON); A3.lnx_g = args.in[I_LNG] + L * W; A3.lnx_b = args.in[I_LNB] + L * W; A3.Y = (bf16*)(ws + WS_RW); A3.ldy = NRW;
        for (int unit = gw; unit < NB * 128 * NH; unit += NGW) rw::s3_unit(A3, unit, lane);
        SEAM(PH_S3);
    }
    if (IN(PH_GB)) {
        unsigned char* ws = args.ws; asm volatile("" : "+s"(ws));
        bf16* GBp = (bf16*)(ws + WS_GB); bf16* MBp = (bf16*)(ws + WS_MB);
        pg8::StaticOrder S; S.init(M, D, G, (int)blockIdx.x);
#pragma unroll
        for (int b = 0; b < 3; ++b) {
            { int tv = tidL; asm volatile("" : "+v"(tv)); pg8::Gemm g{((bf16*)(ws + WS_H)), ((bf16*)(ws + WS_WIN)) + (size_t)(NA + b * D) * D, M, D, D, D, D}; pg8::EpiAct<1> E{GBp, D};
              pg8::gemm_phase<pg8::EpiAct<1>, pg8::StaticOrder, true, true>(lds + RING_OFF, g, S, E, tv); }
            __syncthreads();
            { int tv = tidL; asm volatile("" : "+v"(tv)); const bf16* Ysrc = (b == 0) ? (const bf16*)(ws + WS_RW) : (b == 1 ? (const bf16*)(ws + WS_AT) : (const bf16*)(ws + WS_PL));
              pg8::Gemm g{Ysrc, ((bf16*)(ws + WS_WB)) + (size_t)b * D * W, M, D, W, (b == 0) ? NRW : (b == 1 ? NAT : NPL), W};
              if (b == 0) { pg8::EpiBr<true> E{GBp, MBp}; pg8::gemm_phase<pg8::EpiBr<true>, pg8::StaticOrder, true, true>(lds + RING_OFF, g, S, E, tv); }
              else { pg8::EpiBr<false> E{GBp, MBp}; pg8::gemm_phase<pg8::EpiBr<false>, pg8::StaticOrder, true, true>(lds + RING_OFF, g, S, E, tv); } }
            __syncthreads();
        }
        SEAM(PH_GB);
    }
    if (IN(PH_GO)) {
        unsigned char* ws = args.ws; asm volatile("" : "+s"(ws));
        pg8::Gemm g{(const bf16*)(ws + WS_MB), ((bf16*)(ws + WS_WO)), M, D, D, D, D}; pg8::StaticOrder S; S.init(M, D, G, (int)blockIdx.x);
        pg8::EpiRes E{xsrc, args.out};
        pg8::gemm_phase<pg8::EpiRes, pg8::StaticOrder, true, true>(lds + RING_OFF, g, S, E, tidL);
        SEAM(PH_GO);
    }
    if (IN(PH_NORM2)) { unsigned char* ws = args.ws; asm volatile("" : "+s"(ws)); rms_rows(args.out, args.in[I_N2G] + (size_t)L * D, ((bf16*)(ws + WS_H)), gw, NGW, lane); SEAM(PH_NORM2); }
        unsigned char* ws = args.ws; asm volatile("" : "+s"(ws));
    if (IN(PH_FF1)) {
        unsigned char* ws = args.ws; asm volatile("" : "+s"(ws));
        pg8::Gemm g{((bf16*)(ws + WS_H)), ((bf16*)(ws + WS_W1)), M, FF, D, D, D}; pg8::StaticOrder S; S.init(M, FF, G, (int)blockIdx.x);
        pg8::EpiAct<2> E{(bf16*)(ws + WS_HID), FF};
        pg8::gemm_phase<pg8::EpiAct<2>, pg8::StaticOrder, true, true>(lds + RING_OFF, g, S, E, tidL);
        SEAM(PH_FF1);
    }
    if (IN(PH_FF2)) {
        unsigned char* ws = args.ws; asm volatile("" : "+s"(ws));
        pg8::Gemm g{(const bf16*)(ws + WS_HID), ((bf16*)(ws + WS_W2)), M, D, FF, FF, FF}; pg8::StaticOrder S; S.init(M, D, G, (int)blockIdx.x);
        pg8::EpiRes E{args.out, args.out};
        pg8::gemm_phase<pg8::EpiRes, pg8::StaticOrder, true, true>(lds + RING_OFF, g, S, E, tidL);
        SEAM(PH_FF2);
    }
    }
#undef IN
#undef SEAM
}

#ifndef MK_MULTI
#define MK_MULTI 0
#endif
#ifndef PROBE_UPTO
#define PROBE_UPTO (-1)
#endif
#ifndef PROBE_DUP
#define PROBE_DUP (-1)
#endif
extern "C" void kernel_launch(void* const* d_in, const int* in_sizes, int n_in, void* d_out, int out_size, void* d_ws, size_t ws_size, hipStream_t stream) {
    static int grid = 0;
    if (grid == 0) {
        if (n_in != 23 || in_sizes[0] != M * D || out_size != M * D || ws_size < WS_END) { fprintf(stderr, "kernel_launch: unexpected shapes (n_in %d, in0 %d, out %d, ws %zu)\n", n_in, n_in > 0 ? in_sizes[0] : -1, out_size, ws_size); grid = -1; return; }
        int dev = 0, cus = 0;
        if (hipGetDevice(&dev) != hipSuccess || hipDeviceGetAttribute(&cus, hipDeviceAttributeMultiprocessorCount, dev) != hipSuccess) { grid = -1; return; }
        if (hipFuncSetAttribute((const void*)mk_fwd, hipFuncAttributeMaxDynamicSharedMemorySize, LDS_BYTES) != hipSuccess) { fprintf(stderr, "kernel_launch: hipFuncSetAttribute failed\n"); grid = -1; return; }
        int per_cu = 0;
        if (hipOccupancyMaxActiveBlocksPerMultiprocessor(&per_cu, (const void*)mk_fwd, NWAVES * 64, LDS_BYTES) != hipSuccess || per_cu < 1) fprintf(stderr, "kernel_launch: occupancy query reports %d\n", per_cu);
        (void)hipGetLastError();
        grid = cus;
    }
    if (grid < 0) return;
    unsigned char* ws = (unsigned char*)d_ws;
    (void)hipMemsetAsync(ws + WS_CTL, 0, CTL_ZERO_BYTES, stream);
    Args a{};
    for (int i = 0; i < 23; ++i) a.in[i] = (const float*)d_in[i];
    a.out = (float*)d_out; a.ws = ws;
#if MK_MULTI
    for (int L = 0; L < 2; ++L) for (int p = 0; p < PH_N; ++p) { a.ph_lo = p; a.ph_hi = p + 1; a.l_lo = L; a.l_hi = L + 1; a.fused = 0; a.probe_upto = -1; a.probe_dup = -1; hipLaunchKernelGGL(mk_fwd, dim3(grid), dim3(NWAVES * 64), LDS_BYTES, stream, a); }
#else
    a.ph_lo = 0; a.ph_hi = PH_N; a.l_lo = 0; a.l_hi = 2; a.fused = 1; a.probe_upto = PROBE_UPTO; a.probe_dup = PROBE_DUP;
    hipLaunchKernelGGL(mk_fwd, dim3(grid), dim3(NWAVES * 64), LDS_BYTES, stream, a);
#endif
}
```

```cpp
#include <hip/hip_runtime.h>
#include <cstdio>
#include <cstdint>
#define GAS __attribute__((address_space(1)))
namespace pg8 {
#define PG8_LAS __attribute__((address_space(3)))
typedef unsigned short bf16_t;
typedef short bf16x8 __attribute__((ext_vector_type(8)));
typedef float f32x4 __attribute__((ext_vector_type(4)));
typedef unsigned u32x4 __attribute__((ext_vector_type(4)));
constexpr int BM = 256, BK = 64, HALF = 128, HTB = HALF * BK * 2  , STAGE_BYTES = 8 * HTB, NXCD = 8, WGM = 8;

__host__ __device__ __forceinline__ int lds_byte(int r, int c) { const int st = (r >> 4) * 2 + (c >> 5), rr = r & 15, cc = c & 31, ob = rr * 64 + cc * 2; return st * 1024 + (ob ^ (((ob >> 9) & 1) << 5)); }
__host__ __device__ __forceinline__ void stage_rc(int b, int& R, int& C) { const int st = b / 1024, sb = b % 1024, swz = sb ^ (((sb >> 9) & 1) << 5); R = (st >> 1) * 16 + swz / 64; C = (st & 1) * 32 + (swz % 64) / 2; }
__host__ __device__ __forceinline__ int perm32(int rho) { const int n = rho >> 4, i = rho & 15; return 8 * (i >> 2) + 4 * n + (i & 3); }

struct Unit { int pm, pn; };
struct Gemm { const bf16_t* A; const bf16_t* Bt; int M, N, K, lda, ldb; };

struct StaticOrder {
    int nM, nN, nwg, G, c;
    __host__ __device__ void init(int M, int N, int G_, int c_) { nM = M / BM; nN = N / BM; nwg = nM * nN; G = G_; c = c_; }
    __host__ __device__ bool next(int i, Unit& u) const {
        const long L = (long)i * G + c; if (L >= nwg) return false;
        int wgid = (int)L; { const int q = nwg / NXCD, r = nwg % NXCD, xcd = wgid % NXCD, off = wgid / NXCD; wgid = (xcd < r ? xcd * (q + 1) : r * (q + 1) + (xcd - r) * q) + off; }
        const int nig = WGM * nN, gid = wgid / nig, fm = gid * WGM, gsz = (nM - fm) < WGM ? (nM - fm) : WGM;
        u.pm = fm + ((wgid % nig) % gsz); u.pn = (wgid % nig) / gsz; return true;
    }
    __device__ __forceinline__ void a_ready(const Unit&) const {}
    __device__ __forceinline__ void done(const Unit&) const {}
};

__device__ __forceinline__ unsigned cvt_pk_bf16(float lo, float hi) { unsigned r; asm volatile("v_cvt_pk_bf16_f32 %0, %1, %2" : "=v"(r) : "v"(lo), "v"(hi)); return r; }
__device__ __forceinline__ float sigm(float x) { return 1.0f / (1.0f + __expf(-x)); }
__device__ __forceinline__ float bf_lo(unsigned w) { return __builtin_bit_cast(float, w << 16); }
__device__ __forceinline__ float bf_hi(unsigned w) { return __builtin_bit_cast(float, w & 0xffff0000u); }
struct EpiA {
    static constexpr bool PERM = true, AFTER_DRAIN = false;
    bf16_t *RW, *AT, *PL, *SB, *HB;
    __device__ __forceinline__ void operator()(const f32x4 (&acc)[2][2][4][2], const Unit& u, int wr, int wc, int fr, int fq) const {
        bf16_t* base; int ldc, colt;
        if (u.pn < 7) { base = RW; ldc = 1792; colt = u.pn * 256; } else if (u.pn < 13) { base = AT; ldc = 1536; colt = (u.pn - 7) * 256; } else { base = PL; ldc = 512; colt = (u.pn - 13) * 256; }
        const int row0 = u.pm * BM + wr * 64 + fr, col0 = colt + wc * 32 + 8 * fq;
#pragma unroll
        for (int ai = 0; ai < 2; ++ai)
#pragma unroll
            for (int m = 0; m < 4; ++m) { bf16_t* rowp = base + (size_t)(row0 + ai * HALF + m * 16) * ldc + col0;
#pragma unroll
                for (int bj = 0; bj < 2; ++bj) { const f32x4 v0 = acc[ai][bj][m][0], v1 = acc[ai][bj][m][1];
                    u32x4 w; w.x = cvt_pk_bf16(v0[0], v0[1]); w.y = cvt_pk_bf16(v0[2], v0[3]); w.z = cvt_pk_bf16(v1[0], v1[1]); w.w = cvt_pk_bf16(v1[2], v1[3]);
                    *(GAS u32x4*)(rowp + bj * HALF) = w;
                    if (u.pn < 7 && m == 3 && fr == 15) *(GAS u32x4*)(SB + (size_t)((row0 + ai * HALF + 48) >> 6) * 1792 + col0 + bj * HALF) = w;
                    if (u.pn >= 13 && m == 3 && wr == 1 && fr >= 1) *(GAS u32x4*)(HB + ((size_t)((row0 + ai * HALF + 48) >> 7) * 15 + (fr - 1)) * 512 + col0 + bj * HALF) = w; } }
    }
};
template <int MODE> struct EpiAct {
    static constexpr bool PERM = true, AFTER_DRAIN = false;
    bf16_t* O; int ldc;
    __device__ __forceinline__ void operator()(const f32x4 (&acc)[2][2][4][2], const Unit& u, int wr, int wc, int fr, int fq) const {
        const int row0 = u.pm * BM + wr * 64 + fr, col0 = u.pn * BM + wc * 32 + 8 * fq;
#pragma unroll
        for (int ai = 0; ai < 2; ++ai)
#pragma unroll
            for (int m = 0; m < 4; ++m) { bf16_t* rowp = O + (size_t)(row0 + ai * HALF + m * 16) * ldc + col0;
#pragma unroll
                for (int bj = 0; bj < 2; ++bj) { f32x4 v0 = acc[ai][bj][m][0], v1 = acc[ai][bj][m][1];
#pragma unroll
                    for (int e = 0; e < 4; ++e) {
                        if (MODE == 1) { v0[e] = sigm(v0[e]); v1[e] = sigm(v1[e]); }
                        if (MODE == 2) { const float a = fmaxf(v0[e], 0.f), b = fmaxf(v1[e], 0.f); v0[e] = a * a; v1[e] = b * b; } }
                    u32x4 w; w.x = cvt_pk_bf16(v0[0], v0[1]); w.y = cvt_pk_bf16(v0[2], v0[3]); w.z = cvt_pk_bf16(v1[0], v1[1]); w.w = cvt_pk_bf16(v1[2], v1[3]);
                    *(GAS u32x4*)(rowp + bj * HALF) = w; } }
    }
};
template <bool FIRST> struct EpiBr {
    static constexpr bool PERM = true, AFTER_DRAIN = false;
    const bf16_t* GB; bf16_t* MBuf;
    __device__ __forceinline__ void operator()(const f32x4 (&acc)[2][2][4][2], const Unit& u, int wr, int wc, int fr, int fq) const {
        const int row0 = u.pm * BM + wr * 64 + fr, col0 = u.pn * BM + wc * 32 + 8 * fq;
#pragma unroll
        for (int ai = 0; ai < 2; ++ai)
#pragma unroll
            for (int m = 0; m < 4; ++m) { const size_t off = (size_t)(row0 + ai * HALF + m * 16) * 1024 + col0;
#pragma unroll
                for (int bj = 0; bj < 2; ++bj) { const f32x4 v0 = acc[ai][bj][m][0], v1 = acc[ai][bj][m][1];
                    const u32x4 gw = *(const GAS u32x4*)(GB + off + bj * HALF);
                    float o[8] = {bf_lo(gw.x) * v0[0], bf_hi(gw.x) * v0[1], bf_lo(gw.y) * v0[2], bf_hi(gw.y) * v0[3], bf_lo(gw.z) * v1[0], bf_hi(gw.z) * v1[1], bf_lo(gw.w) * v1[2], bf_hi(gw.w) * v1[3]};
                    if (!FIRST) { const u32x4 mw = *(const GAS u32x4*)(MBuf + off + bj * HALF);
                        o[0] += bf_lo(mw.x); o[1] += bf_hi(mw.x); o[2] += bf_lo(mw.y); o[3] += bf_hi(mw.y); o[4] += bf_lo(mw.z); o[5] += bf_hi(mw.z); o[6] += bf_lo(mw.w); o[7] += bf_hi(mw.w); }
                    u32x4 w; w.x = cvt_pk_bf16(o[0], o[1]); w.y = cvt_pk_bf16(o[2], o[3]); w.z = cvt_pk_bf16(o[4], o[5]); w.w = cvt_pk_bf16(o[6], o[7]);
                    *(GAS u32x4*)(MBuf + off + bj * HALF) = w; } }
    }
};
struct EpiRes {
    static constexpr bool PERM = false, AFTER_DRAIN = false;
    const float* base; float* out;
    __device__ __forceinline__ void operator()(const f32x4 (&acc)[2][2][4][2], const Unit& u, int wr, int wc, int fr, int fq) const {
        const int row0 = u.pm * BM + wr * 64 + fr, col0 = u.pn * BM + wc * 32 + 4 * fq;
#pragma unroll
        for (int ai = 0; ai < 2; ++ai)
#pragma unroll
            for (int m = 0; m < 4; ++m) { const size_t off = (size_t)(row0 + ai * HALF + m * 16) * 1024 + col0;
#pragma unroll
                for (int bj = 0; bj < 2; ++bj)
#pragma unroll
                    for (int n = 0; n < 2; ++n) { const f32x4 bs = *(const GAS f32x4*)(base + off + bj * HALF + n * 16); *(GAS f32x4*)(out + off + bj * HALF + n * 16) = bs + acc[ai][bj][m][n]; } }
    }
};
template <class Epi, class Sched, bool ALIGN_EPI = false, bool SP2 = false>
__device__ __forceinline__ void gemm_phase(PG8_LAS unsigned char* lds, const Gemm g, const Sched& S, const Epi& E, const int tid) {
    const int wid = __builtin_amdgcn_readfirstlane(tid >> 6), lane = tid & 63, wr = wid >> 2, wc = wid & 3, fr = lane & 15, fq = lane >> 4;
    const int K = g.K, nt = K / BK;
    unsigned voffA[2], voffB[2];
#pragma unroll
    for (int i = 0; i < 2; ++i) { int R, C; stage_rc(tid * 16 + i * 8192, R, C); const int Rb = Epi::PERM ? ((R & ~31) + perm32(R & 31)) : R;
        voffA[i] = (unsigned)(R * g.lda + C) * 2u; voffB[i] = (unsigned)(Rb * g.ldb + C) * 2u; }
    const size_t kstep = (size_t)(BK * 2);
    const size_t hstepA = (size_t)HALF * g.lda * 2, hstepB = (size_t)HALF * g.ldb * 2;
    const size_t tstepA = 2 * hstepA, tstepB = 2 * hstepB;
    const unsigned ldsw = (unsigned)wid * 1024u;
    const int aoff = lds_byte(wr * 64 + fr, fq * 8), boff = lds_byte(wc * 32 + fr, fq * 8);
#define PG8_SA(b, h) (((b) * 2 + (h)) * HTB)
#define PG8_SB(b, h) ((4 + (b) * 2 + (h)) * HTB)
#define PG8_STAGE(bufoff, gbase, voff) do { _Pragma("unroll") for (int _i = 0; _i < 2; ++_i) \
        __builtin_amdgcn_global_load_lds((const unsigned*)((const char*)(gbase) + (voff)[_i]), (PG8_LAS unsigned*)(lds + (bufoff) + ldsw + _i * 8192), 16, 0, 0); } while (0)
#define PG8_LDA(dst, b, h) do { _Pragma("unroll") for (int m = 0; m < 4; ++m) _Pragma("unroll") for (int k = 0; k < 2; ++k) dst[m][k] = *(const PG8_LAS bf16x8*)(lds + PG8_SA(b, h) + aoff + m * 2048 + k * 1024); } while (0)
#define PG8_LDB(dst, b, h) do { _Pragma("unroll") for (int n = 0; n < 2; ++n) _Pragma("unroll") for (int k = 0; k < 2; ++k) dst[n][k] = *(const PG8_LAS bf16x8*)(lds + PG8_SB(b, h) + boff + n * 2048 + k * 1024); } while (0)
#define PG8_MMA(ai, bj, At, Bt) do { __builtin_amdgcn_s_setprio(1); _Pragma("unroll") for (int m = 0; m < 4; ++m) _Pragma("unroll") for (int n = 0; n < 2; ++n) _Pragma("unroll") for (int k = 0; k < 2; ++k) \
        acc[ai][bj][m][n] = __builtin_amdgcn_mfma_f32_16x16x32_bf16(Bt[n][k], At[m][k], acc[ai][bj][m][n], 0, 0, 0); __builtin_amdgcn_s_setprio(0); } while (0)
#define PG8_WAIT_V(n) asm volatile("s_waitcnt vmcnt(" #n ")" ::: "memory")
#define PG8_WAIT_L(n) asm volatile("s_waitcnt lgkmcnt(" #n ")" ::: "memory")
#define PG8_BAR __builtin_amdgcn_s_barrier()
#define PG8_SCHED __builtin_amdgcn_sched_barrier(0)
    Unit cur, nxt; int ui = 0;
    if (!S.next(0, cur)) return;
    f32x4 acc[2][2][4][2];
#pragma unroll
    for (int a = 0; a < 2; ++a)
#pragma unroll
        for (int b = 0; b < 2; ++b)
#pragma unroll
            for (int m = 0; m < 4; ++m)
#pragma unroll
                for (int n = 0; n < 2; ++n) acc[a][b][m][n] = (f32x4){0.f, 0.f, 0.f, 0.f};
    bf16x8 At[4][2], B0[2][2], B1[2][2];
    const char* cA = (const char*)g.A + (size_t)cur.pm * tstepA; const char* cB = (const char*)g.Bt + (size_t)cur.pn * tstepB;
    S.a_ready(cur);
    if constexpr (SP2) {
        PG8_STAGE(PG8_SB(0, 0), cB, voffB); PG8_STAGE(PG8_SB(0, 1), cB + hstepB, voffB); PG8_STAGE(PG8_SA(0, 0), cA, voffA); PG8_STAGE(PG8_SA(0, 1), cA + hstepA, voffA);
        if (wr == 1) PG8_BAR;
        PG8_WAIT_V(2); PG8_BAR;
        PG8_STAGE(PG8_SB(1, 0), cB + kstep, voffB); PG8_STAGE(PG8_SA(1, 0), cA + kstep, voffA); PG8_STAGE(PG8_SB(1, 1), cB + hstepB + kstep, voffB);
        PG8_WAIT_V(6); PG8_BAR;
    } else {
        PG8_STAGE(PG8_SB(0, 0), cB, voffB); PG8_STAGE(PG8_SA(0, 0), cA, voffA); PG8_STAGE(PG8_SB(0, 1), cB + hstepB, voffB); PG8_STAGE(PG8_SA(0, 1), cA + hstepA, voffA);
        if (wr == 1) PG8_BAR;
        PG8_WAIT_V(4); PG8_BAR;
        PG8_STAGE(PG8_SB(1, 0), cB + kstep, voffB); PG8_STAGE(PG8_SA(1, 0), cA + kstep, voffA); PG8_STAGE(PG8_SB(1, 1), cB + hstepB + kstep, voffB);
        PG8_WAIT_V(6); PG8_BAR;
    }
    for (;;) {
        const bool has_next = S.next(ui + 1, nxt);
        const char* nA = has_next ? (const char*)g.A + (size_t)nxt.pm * tstepA : cA; const char* nB = has_next ? (const char*)g.Bt + (size_t)nxt.pn * tstepB : cB;
        for (int t = 0; t < nt; t += 2) {
            const bool last = (t == nt - 2);
            const char* a1 = cA + (size_t)(t + 1) * kstep;
            const char* a2 = last ? nA : cA + (size_t)(t + 2) * kstep; const char* b2 = last ? nB : cB + (size_t)(t + 2) * kstep;
            const char* a3 = a2 + kstep; const char* b3 = b2 + kstep;
            if (last && has_next) S.a_ready(nxt);
            if constexpr (SP2) {
            PG8_LDB(B0, 0, 0); PG8_LDB(B1, 0, 1); PG8_SCHED; PG8_LDA(At, 0, 0); PG8_STAGE(PG8_SA(1, 1), a1 + hstepA, voffA);
            PG8_WAIT_V(8); PG8_WAIT_L(0); PG8_BAR; PG8_MMA(0, 0, At, B0); PG8_MMA(0, 1, At, B1); PG8_BAR; PG8_SCHED;
            PG8_LDA(At, 0, 1); PG8_STAGE(PG8_SB(0, 0), b2, voffB); PG8_STAGE(PG8_SB(0, 1), b2 + hstepB, voffB); PG8_STAGE(PG8_SA(0, 0), a2, voffA);
            PG8_WAIT_V(8); PG8_WAIT_L(0); PG8_BAR; PG8_MMA(1, 0, At, B0); PG8_MMA(1, 1, At, B1); PG8_BAR; PG8_SCHED;
            PG8_LDB(B0, 1, 0); PG8_LDB(B1, 1, 1); PG8_SCHED; PG8_LDA(At, 1, 0); PG8_STAGE(PG8_SA(0, 1), a2 + hstepA, voffA);
            PG8_WAIT_V(8); PG8_WAIT_L(0); PG8_BAR; PG8_MMA(0, 0, At, B0); PG8_MMA(0, 1, At, B1); PG8_BAR; PG8_SCHED;
            PG8_LDA(At, 1, 1); PG8_STAGE(PG8_SB(1, 0), b3, voffB); PG8_STAGE(PG8_SB(1, 1), b3 + hstepB, voffB); PG8_STAGE(PG8_SA(1, 0), a3, voffA);
            PG8_WAIT_V(8); PG8_WAIT_L(0); PG8_BAR; PG8_MMA(1, 0, At, B0); PG8_MMA(1, 1, At, B1); PG8_BAR; PG8_SCHED;
            } else {
            PG8_LDB(B0, 0, 0); PG8_SCHED; PG8_LDA(At, 0, 0); PG8_STAGE(PG8_SA(1, 1), a1 + hstepA, voffA);
            PG8_WAIT_L(8); PG8_BAR; PG8_WAIT_L(0); PG8_MMA(0, 0, At, B0); PG8_BAR; PG8_SCHED;
            PG8_LDB(B1, 0, 1); PG8_STAGE(PG8_SB(0, 0), b2, voffB);
            PG8_BAR; PG8_WAIT_L(0); PG8_MMA(0, 1, At, B1); PG8_BAR;
            PG8_LDA(At, 0, 1); PG8_STAGE(PG8_SA(0, 0), a2, voffA);
            PG8_BAR; PG8_WAIT_L(0); PG8_MMA(1, 0, At, B0); PG8_BAR; PG8_SCHED;
            PG8_STAGE(PG8_SB(0, 1), b2 + hstepB, voffB);
            PG8_WAIT_V(6); PG8_BAR; PG8_MMA(1, 1, At, B1); PG8_BAR;
            PG8_LDB(B0, 1, 0); PG8_SCHED; PG8_LDA(At, 1, 0); PG8_STAGE(PG8_SA(0, 1), a2 + hstepA, voffA);
            PG8_WAIT_L(8); PG8_BAR; PG8_WAIT_L(0); PG8_MMA(0, 0, At, B0); PG8_BAR; PG8_SCHED;
            PG8_LDB(B1, 1, 1); PG8_STAGE(PG8_SB(1, 0), b3, voffB);
            PG8_BAR; PG8_WAIT_L(0); PG8_MMA(0, 1, At, B1); PG8_BAR;
            PG8_LDA(At, 1, 1); PG8_STAGE(PG8_SA(1, 0), a3, voffA);
            PG8_BAR; PG8_WAIT_L(0); PG8_MMA(1, 0, At, B0); PG8_BAR; PG8_SCHED;
            PG8_STAGE(PG8_SB(1, 1), b3 + hstepB, voffB);
            PG8_WAIT_V(6); PG8_BAR; PG8_MMA(1, 1, At, B1); PG8_BAR;
            }
        }
        if constexpr (ALIGN_EPI) { if (wr == 0) PG8_BAR; }
        if constexpr (!Epi::AFTER_DRAIN) { E(acc, cur, wr, wc, fr, fq); S.done(cur); }
        if (!has_next) break;
#pragma unroll
        for (int a = 0; a < 2; ++a)
#pragma unroll
            for (int b = 0; b < 2; ++b)
#pragma unroll
                for (int m = 0; m < 4; ++m)
#pragma unroll
                    for (int n = 0; n < 2; ++n) acc[a][b][m][n] = (f32x4){0.f, 0.f, 0.f, 0.f};
        cur = nxt; cA = nA; cB = nB; ++ui;
        if constexpr (ALIGN_EPI) { if (wr == 1) PG8_BAR; }
    }
    PG8_WAIT_V(0);
    if constexpr (!ALIGN_EPI) { if (wr == 0) PG8_BAR; }
    PG8_BAR;
    if constexpr (Epi::AFTER_DRAIN) { E.fused(acc, cur, wr, wc, fr, fq, lds, wid, lane); S.done(cur); }
#undef PG8_SA
#undef PG8_SB
#undef PG8_STAGE
#undef PG8_LDA
#undef PG8_LDB
#undef PG8_MMA
#undef PG8_WAIT_V
#undef PG8_WAIT_L
#undef PG8_BAR
#undef PG8_SCHED
}
}
constexpr int NB = 4, T = 8192, D = 1024, M = NB * T, FF = 4096;
constexpr int NRW = 1792, NAT = 1536, NPL = 512, NA = NRW + NAT + NPL  , NG = 3072, NIN = NA + NG  , W = 512;
constexpr int NH = 8, HD = 64, MB_BLK = 256, NBLK = T / MB_BLK  ;
constexpr int NWAVES = 8;
typedef unsigned short bf16;
typedef unsigned v4u __attribute__((ext_vector_type(4)));
typedef unsigned v2u __attribute__((ext_vector_type(2)));
typedef float f32x4 __attribute__((ext_vector_type(4)));
#define LAS __attribute__((address_space(3)))
typedef GAS unsigned gu32;
#define RLX_AGENT __ATOMIC_RELAXED, __HIP_MEMORY_SCOPE_AGENT
#define LDS_WAIT() asm volatile("s_waitcnt lgkmcnt(0)" ::: "memory")
#define VM_WAIT() asm volatile("s_waitcnt vmcnt(0)" ::: "memory")
__device__ __forceinline__ unsigned f2bf(float f) { unsigned u = __builtin_bit_cast(unsigned, f); return (u + 0x7fffu + ((u >> 16) & 1u)) >> 16; }
typedef float f32x2_t __attribute__((ext_vector_type(2)));
typedef __bf16 bf16x2_t __attribute__((ext_vector_type(2)));
__device__ __forceinline__ unsigned pk2(float lo, float hi) { f32x2_t v = {lo, hi}; bf16x2_t b = __builtin_convertvector(v, bf16x2_t); return __builtin_bit_cast(unsigned, b); }
__device__ __forceinline__ float bf2f(unsigned b) { return __builtin_bit_cast(float, b << 16); }
__device__ __forceinline__ float bflo(unsigned w) { return __builtin_bit_cast(float, w << 16); }
__device__ __forceinline__ float bfhi(unsigned w) { return __builtin_bit_cast(float, w & 0xffff0000u); }
__device__ __forceinline__ float sigmoidf_(float x) { return 1.0f / (1.0f + __expf(-x)); }
__device__ __forceinline__ float fsig(float x) { return __builtin_amdgcn_rcpf(1.0f + __builtin_amdgcn_exp2f(-1.4426950408889634f * x)); }
__device__ __forceinline__ float ftanh(float x) { return 2.0f * fsig(2.0f * x) - 1.0f; }
__device__ __forceinline__ float wave_sum(float v) {
#pragma unroll
    for (int o = 1; o < 64; o <<= 1) v += __shfl_xor(v, o);
    return v;
}

constexpr size_t MiB = 1u << 20;
constexpr size_t WS_CTL = 0, CTL_ZERO_BYTES = 1 * MiB;
constexpr size_t WS_WIN = 1 * MiB, WS_WB = 15 * MiB, WS_WO = 18 * MiB, WS_W1 = 20 * MiB, WS_W2 = 28 * MiB, WS_KM = 36 * MiB, WS_LORA = 37 * MiB;
constexpr size_t WS_H = 40 * MiB, WS_RW = 104 * MiB, WS_AT = 216 * MiB, WS_PL = 312 * MiB  , WS_VT = 344 * MiB  ;
constexpr size_t WS_GF = 376 * MiB, WS_PST = 408 * MiB, WS_QST = 440 * MiB, WS_SST = 472 * MiB, WS_BON = 504 * MiB, WS_SB = 505 * MiB, WS_HB = 507 * MiB, WS_END = 511 * MiB;
constexpr size_t WS_GB = 376 * MiB, WS_MB = 440 * MiB, WS_HID = 104 * MiB;
constexpr int CW_BAR = 4096, CW_Q = 8192;
constexpr int RING_OFF = 0, RING_BYTES = 131072;
constexpr int LDS_BYTES = 153600, LDSCTL_OFF = LDS_BYTES - 1024, MISC_OFF = LDSCTL_OFF + 320;
#define XB_TMO      128
#define XB_XCNT(j)  (256  + 64 * (j))
#define XB_XSUB(j)  (1280 + 64 * (j))
#define XB_XGEN(j)  (2304 + 64 * (j))
#define XB_TOP      3328
#define XB_TOPGEN   3392
#define XCD_BAR_WORDS 3456
#define XB_SPIN_CAP (1u << 18)
__device__ __forceinline__ unsigned xb_ld(unsigned* p)              { return __hip_atomic_load(p, __ATOMIC_RELAXED, __HIP_MEMORY_SCOPE_AGENT); }
__device__ __forceinline__ unsigned xb_add(unsigned* p, unsigned v) { return __hip_atomic_fetch_add(p, v, __ATOMIC_RELAXED, __HIP_MEMORY_SCOPE_AGENT); }
__device__ __forceinline__ unsigned xb_xcc_id() { return (unsigned)__builtin_amdgcn_s_getreg((3 << 11) | 20) & 0xFu; }
#define XB_SPIN(cond, bar) do { unsigned _sp = 0; while (cond) { __builtin_amdgcn_s_sleep(1); \
    if ((++_sp & 255u) == 0u) { if (xb_ld(&(bar)[XB_TMO])) break; if (_sp > XB_SPIN_CAP) { atomicAdd(&(bar)[XB_TMO], 1u); break; } } } } while (0)
struct XcdBarrier { unsigned* bar; unsigned x; volatile LAS unsigned* st; };
__device__ __forceinline__ XcdBarrier xcd_barrier_post(unsigned* bar, volatile LAS unsigned* st) {
    XcdBarrier b; b.bar = bar; b.x = xb_xcc_id(); b.st = st;
    if (threadIdx.x == 0) (void)xb_add(&bar[XB_XCNT(b.x)], 1u);
    return b;
}
__device__ __forceinline__ void xcd_barrier_complete(unsigned* bar, unsigned x, unsigned& nloc, unsigned& nx) {
    const unsigned G = gridDim.x * gridDim.y * gridDim.z;
    unsigned sum, cnt, mine, sp = 0u;
    for (;;) {
        sum = 0u; cnt = 0u; mine = 0u;
#pragma unroll
        for (unsigned j = 0; j < 16; ++j) { const unsigned c = xb_ld(&bar[XB_XCNT(j)]); sum += c; cnt += (c > 0u) ? 1u : 0u; mine = (j == x) ? c : mine; }
        if (sum == G) break;
        __builtin_amdgcn_s_sleep(1);
        if ((++sp & 255u) == 0u) { if (xb_ld(&bar[XB_TMO])) break; if (sp > XB_SPIN_CAP) { atomicAdd(&bar[XB_TMO], 1u); break; } }
    }
    nloc = mine > 0u ? mine : 1u; nx = cnt > 0u ? cnt : 1u;
}
__device__ __forceinline__ void xcd_barrier(const XcdBarrier& b) {
    asm volatile("s_waitcnt vmcnt(0)" ::: "memory");
    __syncthreads();
    if (threadIdx.x == 0) {
        unsigned* bar = b.bar;
        __builtin_amdgcn_s_waitcnt(0);
        unsigned nloc = b.st[0], nx = b.st[1];
        if (nloc == 0u) { xcd_barrier_complete(bar, b.x, nloc, nx); b.st[0] = nloc; b.st[1] = nx; }
        const unsigned old = xb_add(&bar[XB_XSUB(b.x)], 1u);
        const unsigned gen = old / nloc;
        if (old + 1u == (gen + 1u) * nloc) {
            __builtin_amdgcn_fence(__ATOMIC_RELEASE, "agent");
            asm volatile("s_waitcnt vmcnt(0)" ::: "memory");
            const unsigned og = xb_add(&bar[XB_TOP], 1u);
            const unsigned tg = og / nx;
            if (og + 1u == (tg + 1u) * nx) xb_add(&bar[XB_TOPGEN], 1u);
            else XB_SPIN(xb_ld(&bar[XB_TOPGEN]) == tg, bar);
            __builtin_amdgcn_fence(__ATOMIC_ACQUIRE, "agent");
            xb_add(&bar[XB_XGEN(b.x)], 1u);
            asm volatile("s_waitcnt vmcnt(0)" ::: "memory");
        } else {
            XB_SPIN(xb_ld(&bar[XB_XGEN(b.x)]) == gen, bar);
            __builtin_amdgcn_fence(__ATOMIC_ACQUIRE, "agent");
            asm volatile("s_waitcnt vmcnt(0)" ::: "memory");
        }
    }
    __syncthreads();
}

struct Args { const float* in[23]; float* out; unsigned char* ws; int ph_lo, ph_hi, l_lo, l_hi, fused, probe_upto, probe_dup, pad; };
enum Phase { PH_CONV = 0, PH_GEMMA, PH_MIX1, PH_MIX2, PH_S3, PH_GB, PH_GO, PH_NORM2, PH_FF1, PH_FF2, PH_N };
enum In { I_X = 0, I_N1G, I_WIN, I_MU, I_W0, I_WUP, I_A0, I_AUP, I_GUP, I_KK, I_KA, I_RK, I_LNG, I_LNB, I_QNG, I_KNG, I_POOLW, I_POOLS, I_WBR, I_WOUT, I_N2G, I_FF1, I_FF2 };

__device__ __forceinline__ void p0_transpose_item(const float* Wm, int K, int N, bf16* WT, LAS float* scr, int item, int lane) {
    const int nblk = N / 32, kb = item / nblk, nb = item % nblk, k0 = 64 * kb, n0 = 32 * nb;
#pragma unroll 8
    for (int i = 0; i < 32; ++i) { const int kk = 2 * i + (lane >> 5); scr[kk * 33 + (lane & 31)] = ((const GAS float*)Wm)[(size_t)(k0 + kk) * N + n0 + (lane & 31)]; }
    LDS_WAIT(); asm volatile("" ::: "memory");
    const int c = lane & 7;
#pragma unroll
    for (int j = 0; j < 4; ++j) { const int n = (lane >> 3) + 8 * j; const LAS float* s = scr + (8 * c) * 33 + n;
        v4u o; o.x = pk2(s[0 * 33], s[1 * 33]); o.y = pk2(s[2 * 33], s[3 * 33]); o.z = pk2(s[4 * 33], s[5 * 33]); o.w = pk2(s[6 * 33], s[7 * 33]);
        *(GAS v4u*)(WT + (size_t)(n0 + n) * K + k0 + 8 * c) = o; }
    LDS_WAIT(); asm volatile("" ::: "memory");
}
__device__ __forceinline__ void rms_rows(const float* x, const float* g, bf16* out, int gw, int NGW, int lane) {
    f32x4 gv[4];
#pragma unroll
    for (int j = 0; j < 4; ++j) gv[j] = ((const GAS f32x4*)g)[lane + 64 * j];
    for (int m0 = gw; m0 < M; m0 += 4 * NGW) {
        f32x4 v[4][4];
#pragma unroll
        for (int rr = 0; rr < 4; ++rr) { const int m = m0 + rr * NGW; if (m < M) { const GAS f32x4* xr = (const GAS f32x4*)(x + (size_t)m * D) + lane;
#pragma unroll
            for (int j = 0; j < 4; ++j) v[rr][j] = xr[64 * j]; } }
#pragma unroll
        for (int rr = 0; rr < 4; ++rr) { const int m = m0 + rr * NGW; if (m < M) {
            float s_ = 0.f;
#pragma unroll
            for (int j = 0; j < 4; ++j) s_ += (v[rr][j].x * v[rr][j].x + v[rr][j].y * v[rr][j].y) + (v[rr][j].z * v[rr][j].z + v[rr][j].w * v[rr][j].w);
            const float rstd = 1.0f / sqrtf(wave_sum(s_) * (1.0f / D) + 1e-6f);
            GAS unsigned long long* o8 = (GAS unsigned long long*)(out + (size_t)m * D) + lane;
#pragma unroll
            for (int j = 0; j < 4; ++j) { const f32x4 y = v[rr][j] * rstd * gv[j]; o8[64 * j] = (unsigned long long)pk2(y.x, y.y) | ((unsigned long long)pk2(y.z, y.w) << 32); } } }
    }
}

__device__ __forceinline__ void ph_attn_prep(LAS unsigned char* lds, bf16* AT, bf16* VT, const float* qg, const float* kg, float* KM, int G, const int tid) {
    LAS float* red = (LAS float*)lds;
    LAS unsigned char* vt = lds + 2048;
    const int lane = tid & 63, wave = tid >> 6, tsub = lane >> 3, dq = lane & 7;
    float gq[8], gk[8];
#pragma unroll
    for (int e = 0; e < 8; ++e) { gq[e] = ((const GAS float*)qg)[dq * 8 + e] * (0.125f * 1.4426950408889634f); gk[e] = ((const GAS float*)kg)[dq * 8 + e]; }
    for (int bid = blockIdx.x; bid < NB * NBLK * NH; bid += G) {
        const int h = bid & 7, n = (bid >> 3) & 31, b = bid >> 8;
        v4u qv[4], kv[4], vv[4];
#pragma unroll
        for (int j = 0; j < 4; ++j) { const size_t row = (size_t)b * T + n * 256 + wave * 32 + 8 * j + tsub; const bf16* qp = AT + row * NAT + h * 64 + dq * 8;
            qv[j] = *(const GAS v4u*)qp; kv[j] = *(const GAS v4u*)(qp + 512); vv[j] = *(const GAS v4u*)(qp + 1024); }
        float ksum[8];
#pragma unroll
        for (int e = 0; e < 8; ++e) ksum[e] = 0.f;
#pragma unroll
        for (int j = 0; j < 4; ++j) {
            const int tok = wave * 32 + 8 * j + tsub; const size_t row = (size_t)b * T + n * 256 + tok; bf16* qp = AT + row * NAT + h * 64 + dq * 8;
            float q[8], k[8];
            q[0] = bflo(qv[j].x); q[1] = bfhi(qv[j].x); q[2] = bflo(qv[j].y); q[3] = bfhi(qv[j].y); q[4] = bflo(qv[j].z); q[5] = bfhi(qv[j].z); q[6] = bflo(qv[j].w); q[7] = bfhi(qv[j].w);
            k[0] = bflo(kv[j].x); k[1] = bfhi(kv[j].x); k[2] = bflo(kv[j].y); k[3] = bfhi(kv[j].y); k[4] = bflo(kv[j].z); k[5] = bfhi(kv[j].z); k[6] = bflo(kv[j].w); k[7] = bfhi(kv[j].w);
            float qs = 0.f, ks = 0.f;
#pragma unroll
            for (int e = 0; e < 8; ++e) { qs += q[e] * q[e]; ks += k[e] * k[e]; }
            qs += __shfl_xor(qs, 1); qs += __shfl_xor(qs, 2); qs += __shfl_xor(qs, 4);
            ks += __shfl_xor(ks, 1); ks += __shfl_xor(ks, 2); ks += __shfl_xor(ks, 4);
            const float rq = 1.0f / sqrtf(qs * (1.0f / 64.0f) + 1e-6f), rk = 1.0f / sqrtf(ks * (1.0f / 64.0f) + 1e-6f);
#pragma unroll
            for (int e = 0; e < 8; ++e) { q[e] = q[e] * rq * gq[e]; k[e] = k[e] * rk * gk[e]; ksum[e] += k[e]; }
            v4u w; w.x = pk2(q[0], q[1]); w.y = pk2(q[2], q[3]); w.z = pk2(q[4], q[5]); w.w = pk2(q[6], q[7]); *(GAS v4u*)qp = w;
            w.x = pk2(k[0], k[1]); w.y = pk2(k[2], k[3]); w.z = pk2(k[4], k[5]); w.w = pk2(k[6], k[7]); *(GAS v4u*)(qp + 512) = w;
            const unsigned vw[4] = {vv[j].x, vv[j].y, vv[j].z, vv[j].w};
#pragma unroll
            for (int e = 0; e < 8; ++e) *(LAS bf16*)(vt + (dq * 8 + e) * 520 + tok * 2) = (bf16)((e & 1) ? (vw[e >> 1] >> 16) : (vw[e >> 1] & 0xffffu));
        }
#pragma unroll
        for (int e = 0; e < 8; ++e) { float s_ = ksum[e]; s_ += __shfl_xor(s_, 8); s_ += __shfl_xor(s_, 16); s_ += __shfl_xor(s_, 32); if (tsub == 0) red[wave * 64 + dq * 8 + e] = s_; }
        __syncthreads();
        if (wave == 0) { float s_ = 0.f; for (int w = 0; w < 8; ++w) s_ += red[w * 64 + lane]; ((GAS float*)KM)[(((size_t)b * NH + h) * NBLK + n) * 64 + lane] = s_ * (1.0f / 256.0f); }
#pragma unroll
        for (int j = 0; j < 4; ++j) { const int c = tid + 512 * j, dim = c >> 5, part = c & 31;
            const v2u lo = *(const LAS v2u*)(vt + dim * 520 + part * 16), hi = *(const LAS v2u*)(vt + dim * 520 + part * 16 + 8);
            v4u w; w.x = lo.x; w.y = lo.y; w.z = hi.x; w.w = hi.y;
            *(GAS v4u*)(VT + (((size_t)(b * NH + h) * (T / 32) + n * 8 + (part >> 2)) * 64 + dim) * 32 + (part & 3) * 8) = w; }
        __syncthreads();
    }
}
__device__ __forceinline__ void ph_pool(bf16* PL_, const bf16* HB_, int G, const int tid) {
    GAS bf16* PL = (GAS bf16*)PL_; const GAS bf16* HB = (const GAS bf16*)HB_;
    const int ch = tid, wdw = 2 << (ch >> 7);
    for (int u = blockIdx.x; u < M / 128; u += G) {
        float ring[16];
        const int tb0 = (u * 128) & (T - 1);
#pragma unroll
        for (int k = 0; k < 16; ++k) ring[k] = 0.f;
        unsigned short hv[15], cu[16], nx[16];
        if (tb0 > 0) {
#pragma unroll
            for (int j = 0; j < 15; ++j) hv[j] = HB[((size_t)(u - 1) * 15 + j) * 512 + ch];
        }
#pragma unroll
        for (int tt = 0; tt < 16; ++tt) cu[tt] = PL[((size_t)u * 128 + tt) * NPL + ch];
        if (tb0 > 0) {
#pragma unroll
            for (int j = 0; j < 15; ++j) ring[1 + j] = bf2f(hv[j]);
        }
#pragma unroll
        for (int t0 = 0; t0 < 128; t0 += 16) {
            if (t0 + 16 < 128) {
#pragma unroll
                for (int tt = 0; tt < 16; ++tt) nx[tt] = PL[((size_t)u * 128 + t0 + 16 + tt) * NPL + ch];
            }
#pragma unroll
            for (int tt = 0; tt < 16; ++tt) {
                const float cur = bf2f(cu[tt]);
                ring[tt] = cur;
                float sm = 0.f;
#pragma unroll
                for (int i = 0; i < 16; ++i) sm += (i < wdw) ? ring[(tt - i) & 15] : 0.f;
                const int tpos = tb0 + t0 + tt; const int cnt = (tpos + 1 < wdw) ? (tpos + 1) : wdw;
                PL[((size_t)u * 128 + t0 + tt) * NPL + ch] = (bf16)f2bf(sm / (float)cnt - cur);
            }
#pragma unroll
            for (int tt = 0; tt < 16; ++tt) cu[tt] = nx[tt];
        }
    }
}
namespace rw {
typedef short bf16x8 __attribute__((ext_vector_type(8)));
constexpr int MATB = 64 * 144;
constexpr int FPB = 64 * 272;
constexpr int X0 = 0, ACTW = X0, ACTA = X0 + MATB, ACTG = X0 + 2 * MATB  , AAB = X0, AAK = X0 + MATB, ARB = X0 + 2 * MATB, ARK = X0 + 3 * MATB;
constexpr int Y0 = 4 * MATB, LWP = Y0, AIP = Y0 + FPB, LGO = AIP, TOT = Y0 + 2 * FPB  , GCV = TOT + 2048  , DG = Y0  , TI = Y0 + 4096  , U0T = Y0 + 8192;
constexpr int PTAB = GCV + 256  ;
constexpr int Z0 = Y0 + 2 * FPB + 2048 + 256 + 3072, AT_ = Z0, BT_ = Z0 + MATB, KT_ = Z0 + 2 * MATB, RT_ = Z0 + 3 * MATB, ATT = Z0 + 4 * MATB, BHT = Z0 + 5 * MATB, KHT = Z0 + 6 * MATB, VTT = Z0 + 7 * MATB;
constexpr int S1_LDS = Z0 + 8 * MATB;
static_assert(S1_LDS <= 153600 - 1024, "S1 LDS map below the control words");
static_assert(U0T + MATB <= TOT, "U0T inside the dead f32 region");
__device__ __forceinline__ f32x4 mma(bf16x8 a, bf16x8 b, f32x4 c) { return __builtin_amdgcn_mfma_f32_16x16x32_bf16(a, b, c, 0, 0, 0); }
__device__ __forceinline__ bf16x8 ldf(const LAS unsigned char* mat, int row, int s, int g) { return *(const LAS bf16x8*)(mat + row * 144 + s * 64 + g * 16); }
__device__ __forceinline__ v2u pack4(f32x4 v) { v2u w; w.x = pk2(v[0], v[1]); w.y = pk2(v[2], v[3]); return w; }
__device__ __forceinline__ f32x4 unpack4(v2u w) { return (f32x4){bflo(w.x), bfhi(w.x), bflo(w.y), bfhi(w.y)}; }
__device__ __forceinline__ void unpack8(v4u w, float* o) { o[0] = bflo(w.x); o[1] = bfhi(w.x); o[2] = bflo(w.y); o[3] = bfhi(w.y); o[4] = bflo(w.z); o[5] = bfhi(w.z); o[6] = bflo(w.w); o[7] = bfhi(w.w); }
__device__ __forceinline__ v4u pack8(const float* o) { v4u w; w.x = pk2(o[0], o[1]); w.y = pk2(o[2], o[3]); w.z = pk2(o[4], o[5]); w.w = pk2(o[6], o[7]); return w; }
#define LDS_BAR() do { asm volatile("s_waitcnt lgkmcnt(0)" ::: "memory"); __builtin_amdgcn_s_barrier(); asm volatile("" ::: "memory"); } while (0)
#define RW_BAR() do { asm volatile("s_waitcnt vmcnt(0) lgkmcnt(0)" ::: "memory"); __builtin_amdgcn_s_barrier(); asm volatile("" ::: "memory"); } while (0)

struct S1Args {
    bf16* RW; const bf16* SB;
    const float *mu, *w0, *a0, *k_k, *k_a, *r_k;
    const bf16 *WupT, *AupT, *GupT;
    bf16 *Gf, *Pst, *Qst; float* bonus;
    bf16 *Rh, *O0; int ldo;
    bf16* Vm; int ldv;
};
__device__ __forceinline__ void s1_unit(LAS unsigned char* lds, const S1Args& A, const int unit, const int tid, int& hprev, const bool dummy = false) {
    const int lane = tid & 63, wave = __builtin_amdgcn_readfirstlane(tid >> 6), r = lane & 15, g = lane >> 4;
    const int h = unit & 7, cidx = unit >> 3  , c_in_b = cidx & 127;
    const size_t row0 = (size_t)cidx * 64;
    const int t = tid >> 3, q = tid & 7;
    float rp[8], kp[8], lwv[8], av[8], kk[8], vp[8];
    if (h != hprev) {
        LAS float* pt = (LAS float*)(lds + PTAB);
        for (int i = tid; i < 768; i += 512) {
            float v_;
            if (i < 192) v_ = ((const GAS float*)A.mu)[(i >> 6) * 512 + h * 64 + (i & 63)];
            else if (i < 448) v_ = ((const GAS float*)A.mu)[1536 + (i - 192)];
            else { const int j = i - 448, c_ = h * 64 + (j & 63); const int w_ = j >> 6; const float* pp_ = (w_ == 0) ? A.w0 : (w_ == 1) ? A.a0 : (w_ == 2) ? A.k_k : (w_ == 3) ? A.k_a : A.r_k; v_ = ((const GAS float*)pp_)[c_]; }
            pt[i] = v_;
        }
        hprev = h;
        LDS_BAR();
    }
    const LAS float* PT = (const LAS float*)(lds + PTAB);
    bf16x8 fw[2], fa[2], fg[4];
    {
        const int cb = wave >> 1;
        const bf16* wu = A.WupT + (size_t)(h * 64 + 16 * cb + r) * 64 + 8 * g;
        const bf16* au = A.AupT + (size_t)(h * 64 + 16 * cb + r) * 64 + 8 * g;
        const bf16* gu = A.GupT + (size_t)(h * 64 + 16 * cb + r) * 128 + 8 * g;
#pragma unroll
        for (int s = 0; s < 2; ++s) { fw[s] = *(const GAS bf16x8*)(wu + 32 * s); fa[s] = *(const GAS bf16x8*)(au + 32 * s); }
#pragma unroll
        for (int s = 0; s < 4; ++s) fg[s] = *(const GAS bf16x8*)(gu + 32 * s);
    }
    {
        const bf16* cur = A.RW + (row0 + t) * NRW;
        const bf16* prv = (t > 0) ? (cur - NRW) : (A.SB + (size_t)(cidx - 1) * NRW);
        const bool hasprev = (t > 0) || (c_in_b > 0);
        float c8[8], p8[8];
#define MIXLOAD(COL, MUO, DST) do { unpack8(*(const GAS v4u*)(cur + (COL)), c8); if (hasprev) unpack8(*(const GAS v4u*)(prv + (COL)), p8); \
            _Pragma("unroll") for (int e = 0; e < 8; ++e) { const float pv_ = hasprev ? p8[e] : 0.f; DST[e] = c8[e] + (pv_ - c8[e]) * PT[(MUO) + e]; } } while (0)
        MIXLOAD(h * 64 + 8 * q, 8 * q, rp); MIXLOAD(512 + h * 64 + 8 * q, 64 + 8 * q, kp); MIXLOAD(1024 + h * 64 + 8 * q, 128 + 8 * q, vp);
#pragma unroll
        for (int e = 0; e < 8; ++e) *(LAS bf16*)(lds + VTT + (8 * q + e) * 144 + t * 2) = (bf16)f2bf(vp[e]);
        float x8[8];
        MIXLOAD(1536 + 8 * q, 192 + 8 * q, x8);
#pragma unroll
        for (int e = 0; e < 8; ++e) x8[e] = ftanh(x8[e]);
        *(LAS v4u*)(lds + ACTW + t * 144 + q * 16) = pack8(x8);
        MIXLOAD(1600 + 8 * q, 256 + 8 * q, x8);
        *(LAS v4u*)(lds + ACTA + t * 144 + q * 16) = pack8(x8);
        MIXLOAD(1664 + 16 * q, 320 + 16 * q, x8);
#pragma unroll
        for (int e = 0; e < 8; ++e) x8[e] = fsig(x8[e]);
        *(LAS v4u*)(lds + ACTG + t * 272 + q * 32) = pack8(x8);
        MIXLOAD(1664 + 16 * q + 8, 320 + 16 * q + 8, x8);
#pragma unroll
        for (int e = 0; e < 8; ++e) x8[e] = fsig(x8[e]);
        *(LAS v4u*)(lds + ACTG + t * 272 + q * 32 + 16) = pack8(x8);
#undef MIXLOAD
    }
    LDS_BAR();
    if (!dummy) *(GAS v4u*)(A.Vm + (row0 + t) * A.ldv + h * 64 + 8 * q) = pack8(vp);
    {
        const int cb = wave >> 1;
#pragma unroll
        for (int i = 0; i < 2; ++i) {
            const int tb = 2 * (wave & 1) + i;
            f32x4 cw = {0.f, 0.f, 0.f, 0.f}, ca = {0.f, 0.f, 0.f, 0.f}, cg = {0.f, 0.f, 0.f, 0.f};
#pragma unroll
            for (int s = 0; s < 2; ++s) { cw = mma(fw[s], ldf(lds + ACTW, 16 * tb + r, s, g), cw); ca = mma(fa[s], ldf(lds + ACTA, 16 * tb + r, s, g), ca); }
#pragma unroll
            for (int s = 0; s < 4; ++s) cg = mma(fg[s], *(const LAS bf16x8*)(lds + ACTG + (16 * tb + r) * 272 + s * 64 + g * 16), cg);
            *(LAS f32x4*)(lds + LWP + (16 * tb + r) * 272 + (16 * cb + 4 * g) * 4) = cw;
            *(LAS f32x4*)(lds + AIP + (16 * tb + r) * 272 + (16 * cb + 4 * g) * 4) = ca;
            if (!dummy) *(GAS v2u*)(A.Gf + (row0 + 16 * tb + r) * W + h * 64 + 16 * cb + 4 * g) = pack4(cg);
        }
    }
    LDS_BAR();
    {
        const f32x4 l0 = *(const LAS f32x4*)(lds + LWP + t * 272 + q * 32), l1 = *(const LAS f32x4*)(lds + LWP + t * 272 + q * 32 + 16);
        const f32x4 a0v = *(const LAS f32x4*)(lds + AIP + t * 272 + q * 32), a1v = *(const LAS f32x4*)(lds + AIP + t * 272 + q * 32 + 16);
        float ss = 0.f, bon = 0.f;
#pragma unroll
        for (int e = 0; e < 8; ++e) { const int hc = 8 * q + e;
            const float lp = (e < 4) ? l0[e & 3] : l1[e & 3], ap = (e < 4) ? a0v[e & 3] : a1v[e & 3];
            lwv[e] = -0.60653065971263342f * fsig(PT[448 + hc] + lp);
            av[e] = fsig(PT[512 + hc] + ap);
            kk[e] = kp[e] * PT[576 + hc]; ss += kk[e] * kk[e];
            kp[e] = kp[e] * (1.0f + (av[e] - 1.0f) * PT[640 + hc]);
            bon += rp[e] * kp[e] * PT[704 + hc]; }
        ss += __shfl_xor(ss, 1); ss += __shfl_xor(ss, 2); ss += __shfl_xor(ss, 4);
        bon += __shfl_xor(bon, 1); bon += __shfl_xor(bon, 2); bon += __shfl_xor(bon, 4);
        const float inv = 1.0f / fmaxf(sqrtf(ss), 1e-12f);
#pragma unroll
        for (int e = 0; e < 8; ++e) kk[e] *= inv;
        if (q == 0 && !dummy) ((GAS float*)A.bonus)[(row0 + t) * 8 + h] = bon;
        *(LAS f32x4*)(lds + LWP + t * 272 + q * 32) = (f32x4){lwv[0], lwv[1], lwv[2], lwv[3]};
        *(LAS f32x4*)(lds + LWP + t * 272 + q * 32 + 16) = (f32x4){lwv[4], lwv[5], lwv[6], lwv[7]};
    }
    LDS_BAR();
    {
        const int c = tid & 63, seg = tid >> 6; float x[8]; float run = 0.f;
#pragma unroll
        for (int i = 0; i < 8; ++i) { run += *(const LAS float*)(lds + LWP + (8 * seg + i) * 272 + c * 4); x[i] = run; }
        *(LAS float*)(lds + TOT + (seg * 64 + c) * 4) = run;
        LDS_BAR();
        float off = 0.f;
        for (int s2 = 0; s2 < seg; ++s2) off += *(const LAS float*)(lds + TOT + (s2 * 64 + c) * 4);
#pragma unroll
        for (int i = 0; i < 8; ++i) *(LAS float*)(lds + LGO + (8 * seg + i) * 272 + c * 4) = x[i] + off;
    }
    LDS_BAR();
    {
        const f32x4 g0 = *(const LAS f32x4*)(lds + LGO + t * 272 + q * 32), g1 = *(const LAS f32x4*)(lds + LGO + t * 272 + q * 32 + 16);
        const f32x4 e0 = *(const LAS f32x4*)(lds + LGO + 63 * 272 + q * 32), e1 = *(const LAS f32x4*)(lds + LGO + 63 * 272 + q * 32 + 16);
        float at[8], bt[8], kt[8], rt[8], bh[8], kh[8];
#pragma unroll
        for (int e = 0; e < 8; ++e) { const float lg = (e < 4) ? g0[e & 3] : g1[e & 3], lc = (e < 4) ? e0[e & 3] : e1[e & 3];
            const float gm1 = __expf(lg - lwv[e]), gi = __expf(-lg), gt = __expf(lg), gr = __expf(lc - lg);
            const float bb = kk[e] * av[e];
            at[e] = -kk[e] * gm1; bt[e] = bb * gi; kt[e] = kp[e] * gi; rt[e] = rp[e] * gt; bh[e] = bb * gr; kh[e] = kp[e] * gr;
            if (t == 63) *(LAS float*)(lds + GCV + (8 * q + e) * 4) = __expf(lc); }
        *(LAS v4u*)(lds + AT_ + t * 144 + q * 16) = pack8(at); *(LAS v4u*)(lds + BT_ + t * 144 + q * 16) = pack8(bt);
        *(LAS v4u*)(lds + KT_ + t * 144 + q * 16) = pack8(kt); *(LAS v4u*)(lds + RT_ + t * 144 + q * 16) = pack8(rt);
#pragma unroll
        for (int e = 0; e < 8; ++e) { const int o = (8 * q + e) * 144 + t * 2;
            *(LAS bf16*)(lds + ATT + o) = (bf16)f2bf(at[e]); *(LAS bf16*)(lds + BHT + o) = (bf16)f2bf(bh[e]); *(LAS bf16*)(lds + KHT + o) = (bf16)f2bf(kh[e]); }
    }
    LDS_BAR();
    {
        const int hv_tb[10] = {0, 1, 1, 2, 2, 2, 3, 3, 3, 3}, hv_jb[10] = {0, 0, 1, 0, 1, 2, 0, 1, 2, 3};
        const int z_tb[6] = {0, 0, 0, 1, 1, 2}, z_jb[6] = {1, 2, 3, 2, 3, 3};
#pragma unroll
        for (int pass = 0; pass < 2; ++pass) {
            const int hi = (pass == 0) ? wave : (wave < 2 ? 8 + wave : -1);
            if (hi >= 0) {
                int tb = 0, jb = 0;
#pragma unroll
                for (int k = 0; k < 10; ++k) if (k == hi) { tb = hv_tb[k]; jb = hv_jb[k]; }
                f32x4 cab = {0.f, 0.f, 0.f, 0.f}, cak = cab, crb = cab, crk = cab;
#pragma unroll
                for (int s = 0; s < 2; ++s) { const bf16x8 fb = ldf(lds + BT_, 16 * jb + r, s, g), fk = ldf(lds + KT_, 16 * jb + r, s, g), fa = ldf(lds + AT_, 16 * tb + r, s, g), fr = ldf(lds + RT_, 16 * tb + r, s, g);
                    cab = mma(fb, fa, cab); cak = mma(fk, fa, cak); crb = mma(fb, fr, crb); crk = mma(fk, fr, crk); }
                const int tt = 16 * tb + r;
#pragma unroll
                for (int e = 0; e < 4; ++e) { const int j = 16 * jb + 4 * g + e; if (!(j < tt)) { cab[e] = 0.f; cak[e] = 0.f; } if (!(j <= tt)) { crb[e] = 0.f; crk[e] = 0.f; } }
                const int o = tt * 144 + (16 * jb + 4 * g) * 2;
                *(LAS v2u*)(lds + AAB + o) = pack4(cab); *(LAS v2u*)(lds + AAK + o) = pack4(cak); *(LAS v2u*)(lds + ARB + o) = pack4(crb); *(LAS v2u*)(lds + ARK + o) = pack4(crk);
                if (tb == jb) *(LAS f32x4*)(lds + DG + ((tb * 16 + r) * 16 + 4 * g) * 4) = cab;
            }
        }
        if (wave >= 2) {
            int tb = 0, jb = 0;
#pragma unroll
            for (int k = 0; k < 6; ++k) if (k == wave - 2) { tb = z_tb[k]; jb = z_jb[k]; }
            const int o = (16 * tb + r) * 144 + (16 * jb + 4 * g) * 2; const v2u z = {0u, 0u};
            *(LAS v2u*)(lds + AAB + o) = z; *(LAS v2u*)(lds + AAK + o) = z; *(LAS v2u*)(lds + ARB + o) = z; *(LAS v2u*)(lds + ARK + o) = z;
        }
    }
    LDS_BAR();
    f32x4 Y[4];
    if (wave == 7) {
        const int blk = lane >> 4, col = lane & 15; float x[16];
#pragma unroll
        for (int tt = 0; tt < 16; ++tt) {
            float acc = (tt == col) ? 1.0f : 0.0f;
            const LAS float* nrow = (const LAS float*)(lds + DG + ((blk * 16 + tt) * 16) * 4);
#pragma unroll
            for (int j = 0; j < 16; ++j) if (j < tt) acc += nrow[j] * x[j];
            x[tt] = acc;
            *(LAS bf16*)(lds + TI + ((blk * 16 + tt) * 16 + col) * 2) = (bf16)f2bf(acc);
        }
    }
    if (wave < 4) {
#pragma unroll
        for (int i = 0; i < 4; ++i) { Y[i] = (f32x4){0.f, 0.f, 0.f, 0.f};
#pragma unroll
            for (int s = 0; s < 2; ++s) Y[i] = mma(ldf(lds + AAK, 16 * i + r, s, g), ldf(lds + VTT, 16 * wave + r, s, g), Y[i]); }
    } else {
#pragma unroll
        for (int i = 0; i < 4; ++i) Y[i] = unpack4(*(const LAS v2u*)(lds + ATT + (16 * (wave - 4) + r) * 144 + (16 * i + 4 * g) * 2));
    }
    LDS_BAR();
    {
        v2u Xb[4];
        const bf16x8 zf = {0, 0, 0, 0, 0, 0, 0, 0};
#pragma unroll
        for (int i = 0; i < 4; ++i) {
            if (i >= 1) {
                v4u bw; bw.x = Xb[0].x; bw.y = Xb[0].y; bw.z = (i >= 2) ? Xb[1].x : 0u; bw.w = (i >= 2) ? Xb[1].y : 0u;
                v4u aw; const v2u a0 = *(const LAS v2u*)(lds + AAB + (16 * i + r) * 144 + (4 * g) * 2), a1 = *(const LAS v2u*)(lds + AAB + (16 * i + r) * 144 + (16 + 4 * g) * 2);
                aw.x = a0.x; aw.y = a0.y; aw.z = a1.x; aw.w = a1.y;
                Y[i] = mma(__builtin_bit_cast(bf16x8, aw), __builtin_bit_cast(bf16x8, bw), Y[i]);
            }
            if (i >= 3) {
                v4u bw; bw.x = Xb[2].x; bw.y = Xb[2].y; bw.z = 0u; bw.w = 0u;
                v4u aw; const v2u a0 = *(const LAS v2u*)(lds + AAB + (16 * i + r) * 144 + (32 + 4 * g) * 2);
                aw.x = a0.x; aw.y = a0.y; aw.z = 0u; aw.w = 0u;
                Y[i] = mma(__builtin_bit_cast(bf16x8, aw), __builtin_bit_cast(bf16x8, bw), Y[i]);
            }
            v4u tw; const v2u t0 = *(const LAS v2u*)(lds + TI + ((i * 16 + r) * 16 + 4 * g) * 2); tw.x = t0.x; tw.y = t0.y; tw.z = 0u; tw.w = 0u;
            v4u yw; const v2u yp = pack4(Y[i]); yw.x = yp.x; yw.y = yp.y; yw.z = 0u; yw.w = 0u;
            const f32x4 X = mma(__builtin_bit_cast(bf16x8, tw), __builtin_bit_cast(bf16x8, yw), (f32x4){0.f, 0.f, 0.f, 0.f});
            Xb[i] = pack4(X);
            const int dst = (wave < 4) ? (U0T + (16 * wave + r) * 144) : (ATT + (16 * (wave - 4) + r) * 144);
            *(LAS v2u*)(lds + dst + (16 * i + 4 * g) * 2) = Xb[i];
        }
        (void)zf;
    }
    LDS_BAR();
    {
#pragma unroll
        for (int i = 0; i < 2; ++i) {
            const int qq = 2 * wave + i, rb = qq >> 2, cb = qq & 3;
            f32x4 crh = {0.f, 0.f, 0.f, 0.f}, co0 = crh, cp = crh, cq = crh;
#pragma unroll
            for (int s = 0; s < 2; ++s) {
                const bf16x8 fah = ldf(lds + ATT, 16 * rb + r, s, g), fu0 = ldf(lds + U0T, 16 * rb + r, s, g), fvt = ldf(lds + VTT, 16 * rb + r, s, g), fbh = ldf(lds + BHT, 16 * rb + r, s, g), fkh = ldf(lds + KHT, 16 * rb + r, s, g);
                const bf16x8 frb = ldf(lds + ARB, 16 * cb + r, s, g), frk = ldf(lds + ARK, 16 * cb + r, s, g), fbhc = ldf(lds + BHT, 16 * cb + r, s, g), fu0c = ldf(lds + U0T, 16 * cb + r, s, g), fvtc = ldf(lds + VTT, 16 * cb + r, s, g);
                crh = mma(fah, frb, crh);
                co0 = mma(fu0, frb, co0); co0 = mma(fvt, frk, co0);
                cp = mma(fah, fbhc, cp);
                cq = mma(fbh, fu0c, cq); cq = mma(fkh, fvtc, cq);
            }
            crh = crh + unpack4(*(const LAS v2u*)(lds + RT_ + (16 * cb + r) * 144 + (16 * rb + 4 * g) * 2));
            if (rb == cb) {
#pragma unroll
                for (int e = 0; e < 4; ++e) if (4 * g + e == r) cp[e] += *(const LAS float*)(lds + GCV + (16 * rb + 4 * g + e) * 4);
            }
            const size_t tok = row0 + 16 * cb + r;
            if (!dummy) {
            *(GAS v2u*)(A.Rh + tok * A.ldo + h * 64 + 16 * rb + 4 * g) = pack4(crh);
            *(GAS v2u*)(A.O0 + tok * A.ldo + h * 64 + 16 * rb + 4 * g) = pack4(co0);
            const size_t su = (size_t)(((cidx >> 7) * 8 + h) * 128 + c_in_b);
            *(GAS v2u*)(A.Pst + su * 4096 + (16 * cb + r) * 64 + 32 * (rb >> 1) + 8 * g + 4 * (rb & 1)) = pack4(cp);
            *(GAS v2u*)(A.Qst + su * 4096 + (16 * cb + r) * 64 + 16 * g + 4 * rb) = pack4(cq);
            }
        }
    }
    LDS_BAR();
}

struct PQ { v4u p[4][2]; v4u q[2]; };
constexpr int S2_NS = 8, S2_SLOTB = 2048, S2_FLAGS = 4 * S2_NS * S2_SLOTB;
__device__ __forceinline__ void s2_chain(LAS unsigned char* lds, const bf16* Pst, const bf16* Qst, const int bh, const int vb, const int lane) {
    const int r = lane & 15, g = lane >> 4;
    f32x4 S[4];
#pragma unroll
    for (int i = 0; i < 4; ++i) S[i] = (f32x4){0.f, 0.f, 0.f, 0.f};
    const size_t ustep = (size_t)4096;
    const bf16* Pp = Pst + ((size_t)bh * 128) * 4096 + r * 64 + 8 * g;
    const bf16* Qp = Qst + ((size_t)bh * 128) * 4096 + (16 * vb + r) * 64 + 16 * g;
    LAS unsigned char* ring = lds + vb * (S2_NS * S2_SLOTB) + r * 128 + g * 8;
    volatile LAS int* prod = (volatile LAS int*)(lds + S2_FLAGS + vb * 64);
    volatile LAS int* cons = (volatile LAS int*)(lds + S2_FLAGS + 256 + vb * 64);
#define S2_GLD(DST, PTR) asm volatile("global_load_dwordx4 %0, %1, off" : "=v"(DST) : "v"(PTR) : "memory")
#define S2_LOAD(B, C) do { const int c_ = (C) < 128 ? (C) : 127; const bf16* P_ = Pp + (size_t)c_ * ustep; const bf16* Q_ = Qp + (size_t)c_ * ustep; \
        _Pragma("unroll") for (int i = 0; i < 4; ++i) { S2_GLD(B.p[i][0], P_ + (16 * i) * 64); S2_GLD(B.p[i][1], P_ + (16 * i) * 64 + 32); } \
        S2_GLD(B.q[0], Q_); S2_GLD(B.q[1], Q_ + 8); } while (0)
#define S2_READY(B, N) asm volatile("s_waitcnt vmcnt(" #N ")" : "+v"(B.p[0][0]), "+v"(B.p[0][1]), "+v"(B.p[1][0]), "+v"(B.p[1][1]), "+v"(B.p[2][0]), "+v"(B.p[2][1]), "+v"(B.p[3][0]), "+v"(B.p[3][1]), "+v"(B.q[0]), "+v"(B.q[1]) :: "memory")
#define S2_STEP(B, C) do { v2u sb_[4]; \
        { unsigned sp_ = 0; while ((C) - *cons >= S2_NS && ++sp_ < (1u << 22)) __builtin_amdgcn_s_sleep(1); } asm volatile("" ::: "memory");   \
        _Pragma("unroll") for (int i = 0; i < 4; ++i) { sb_[i] = pack4(S[i]); *(LAS v2u*)(ring + ((C) & (S2_NS - 1)) * S2_SLOTB + 32 * i) = sb_[i]; } \
        asm volatile("s_waitcnt lgkmcnt(0)" ::: "memory"); if (lane == 0) *prod = (C) + 1; \
        _Pragma("unroll") for (int i = 0; i < 4; ++i) { v2u qi_; qi_.x = (i & 1) ? B.q[i >> 1].z : B.q[i >> 1].x; qi_.y = (i & 1) ? B.q[i >> 1].w : B.q[i >> 1].y; f32x4 n_ = unpack4(qi_); \
            _Pragma("unroll") for (int s_ = 0; s_ < 2; ++s_) { \
                v4u bw_; bw_.x = sb_[2 * s_].x; bw_.y = sb_[2 * s_].y; bw_.z = sb_[2 * s_ + 1].x; bw_.w = sb_[2 * s_ + 1].y; \
                n_ = mma(__builtin_bit_cast(bf16x8, B.p[i][s_]), __builtin_bit_cast(bf16x8, bw_), n_); } \
            S[i] = n_; } } while (0)
#define PIN() asm volatile("" ::: "memory")
    PQ B0, B1, B2, B3;
    asm volatile("s_waitcnt vmcnt(0)" ::: "memory");
    S2_LOAD(B0, 0); S2_LOAD(B1, 1); S2_LOAD(B2, 2);
    for (int c = 0; c < 128; c += 4) {
        S2_LOAD(B3, c + 3); S2_READY(B0, 30); S2_STEP(B0, c);
        S2_LOAD(B0, c + 4); S2_READY(B1, 30); S2_STEP(B1, c + 1);
        S2_LOAD(B1, c + 5); S2_READY(B2, 30); S2_STEP(B2, c + 2);
        S2_LOAD(B2, c + 6); S2_READY(B3, 30); S2_STEP(B3, c + 3);
    }
    asm volatile("s_waitcnt vmcnt(0)" : "+v"(B0.p[0][0]), "+v"(B0.p[0][1]), "+v"(B0.p[1][0]), "+v"(B0.p[1][1]), "+v"(B0.p[2][0]), "+v"(B0.p[2][1]), "+v"(B0.p[3][0]), "+v"(B0.p[3][1]), "+v"(B0.q[0]), "+v"(B0.q[1]),
                 "+v"(B1.p[0][0]), "+v"(B1.p[0][1]), "+v"(B1.p[1][0]), "+v"(B1.p[1][1]), "+v"(B1.p[2][0]), "+v"(B1.p[2][1]), "+v"(B1.p[3][0]), "+v"(B1.p[3][1]), "+v"(B1.q[0]), "+v"(B1.q[1]) :: "memory");
    asm volatile("" : "+v"(B2.p[0][0]), "+v"(B2.p[0][1]), "+v"(B2.p[1][0]), "+v"(B2.p[1][1]), "+v"(B2.p[2][0]), "+v"(B2.p[2][1]), "+v"(B2.p[3][0]), "+v"(B2.p[3][1]), "+v"(B2.q[0]), "+v"(B2.q[1]) :: "memory");
#undef S2_LOAD
#undef S2_STEP
}
__device__ __forceinline__ void s2_storer(LAS unsigned char* lds, bf16* Sst, const int bh, const int vb, const int lane) {
    volatile LAS int* prod = (volatile LAS int*)(lds + S2_FLAGS + vb * 64);
    volatile LAS int* cons = (volatile LAS int*)(lds + S2_FLAGS + 256 + vb * 64);
    const LAS unsigned char* ring = lds + vb * (S2_NS * S2_SLOTB) + lane * 32;
    bf16* Sp = Sst + ((size_t)bh * 128) * 4096 + (16 * vb) * 64 + lane * 16;
    for (int c = 0; c < 128; ++c) {
        { unsigned sp_ = 0; while (*prod <= c && ++sp_ < (1u << 22)) __builtin_amdgcn_s_sleep(1); }
        asm volatile("" ::: "memory");
        const v4u a_ = *(const LAS v4u*)(ring + (c & (S2_NS - 1)) * S2_SLOTB), b_ = *(const LAS v4u*)(ring + (c & (S2_NS - 1)) * S2_SLOTB + 16);
        asm volatile("s_waitcnt lgkmcnt(0)" ::: "memory");
        if (lane == 0) *cons = c + 1;
        *(GAS v4u*)(Sp + (size_t)c * 4096) = a_; *(GAS v4u*)(Sp + (size_t)c * 4096 + 8) = b_;
    }
}

struct S3Args { const bf16 *Rh, *O0; int ldo; const bf16* Vp; int ldv; const bf16 *Gf, *Sst; const float *bonus, *lnx_g, *lnx_b; bf16* Y; int ldy; };
__device__ __forceinline__ void s3_unit(const S3Args& A, const int unit, const int lane) {
    const int r = lane & 15, g = lane >> 4;
    const int h = unit & 7, cidx = unit >> 3;
    bf16x8 sf[4][2];
#pragma unroll
    for (int i = 0; i < 4; ++i)
#pragma unroll
        for (int s = 0; s < 2; ++s) sf[i][s] = *(const GAS bf16x8*)(A.Sst + (size_t)(((cidx >> 7) * 8 + h) * 128 + (cidx & 127)) * 4096 + (16 * i + r) * 64 + 32 * s + 8 * g);
#pragma unroll
    for (int tb = 0; tb < 4; ++tb) {
        const size_t tok = (size_t)cidx * 64 + 16 * tb + r;
        f32x4 o[4];
        bf16x8 fr[2];
#pragma unroll
        for (int s = 0; s < 2; ++s) fr[s] = *(const GAS bf16x8*)(A.Rh + tok * A.ldo + h * 64 + 32 * s + 8 * g);
#pragma unroll
        for (int i = 0; i < 4; ++i) {
            o[i] = unpack4(*(const GAS v2u*)(A.O0 + tok * A.ldo + h * 64 + 16 * i + 4 * g));
#pragma unroll
            for (int s = 0; s < 2; ++s) o[i] = mma(sf[i][s], fr[s], o[i]);
        }
        float sm = 0.f;
#pragma unroll
        for (int i = 0; i < 4; ++i) sm += (o[i][0] + o[i][1]) + (o[i][2] + o[i][3]);
        sm += __shfl_xor(sm, 16); sm += __shfl_xor(sm, 32);
        const float mean = sm * (1.0f / 64.0f); float sq = 0.f;
#pragma unroll
        for (int i = 0; i < 4; ++i) { o[i] = o[i] - mean; sq += (o[i][0] * o[i][0] + o[i][1] * o[i][1]) + (o[i][2] * o[i][2] + o[i][3] * o[i][3]); }
        sq += __shfl_xor(sq, 16); sq += __shfl_xor(sq, 32);
        const float rstd = 1.0f / sqrtf(sq * (1.0f / 64.0f) + 64e-5f);
        const float bon = ((const GAS float*)A.bonus)[tok * 8 + h];
#pragma unroll
        for (int i = 0; i < 4; ++i) {
            const int hv = h * 64 + 16 * i + 4 * g;
            const f32x4 lg = *(const GAS f32x4*)(A.lnx_g + hv), lb = *(const GAS f32x4*)(A.lnx_b + hv);
            const f32x4 vv = unpack4(*(const GAS v2u*)(A.Vp + tok * A.ldv + hv)), gg = unpack4(*(const GAS v2u*)(A.Gf + tok * W + hv));
            const f32x4 y = (o[i] * rstd * lg + lb + vv * bon) * gg;
            *(GAS v2u*)(A.Y + tok * A.ldy + hv) = pack4(y);
        }
    }
}
}
namespace moba {
typedef short bf16x8 __attribute__((ext_vector_type(8)));
constexpr int OSP = 132;
constexpr int OSLOT = 0, LSUM = OSLOT + 4 * 256 * OSP, KMF = LSUM + 4 * 256 * 4, CNT = KMF + 8192, OFFS = CNT + 128, FILL = OFFS + 128, QLIST = FILL + 128, QSLOT = QLIST + 1024, ITEMS = QSLOT + 1024, ICTR = ITEMS + 1024, NVQ = ICTR + 64  , MOBA_LDS = NVQ + 256;
static_assert(MOBA_LDS <= 153600 - 1024, "MoBA LDS map below the control words");
__device__ __forceinline__ f32x4 mma(bf16x8 a, bf16x8 b, f32x4 c) { return __builtin_amdgcn_mfma_f32_16x16x32_bf16(a, b, c, 0, 0, 0); }
struct Args { bf16* AT; const bf16* VT; const float* KM; const float *qg, *kg; };
struct KV { bf16x8 k[2][2]; bf16x8 v[4]; };
__device__ __forceinline__ void item(LAS unsigned char* lds, const Args& A, const int b, const int h, const int qb, const int kblk, const int off, const int cnt, const int nkc, const bool own, const int lane) {
    const int r = lane & 15, g = lane >> 4;
    const float slope2 = exp2f(-(float)(h + 1)) * 1.4426950408889634f;
    int ql[2]; float aq[2];
    bf16x8 qf[2][2];
#pragma unroll
    for (int qt = 0; qt < 2; ++qt) {
        const int li = qt * 16 + r;
        int qv = -1;
        if (own) qv = off + li; else if (li < cnt) qv = (int)*(const LAS unsigned char*)(lds + QLIST + off + li);
        ql[qt] = qv;
        const int qrow = (qv >= 0) ? qv : 0;
        aq[qt] = (qv >= 0) ? -slope2 * (float)(256 * (qb - kblk) + qrow) : -1e30f;
    }
    const bf16* kbase = A.AT + ((size_t)b * T + kblk * 256 + 8 * (r >> 2) + (r & 3)) * NAT + 512 + h * 64 + 8 * g;
    const bf16* vbase = A.VT + (((size_t)(b * NH + h) * (T / 32) + kblk * 8) * 64 + r) * 32 + 8 * g;
    f32x4 o[4][2]; float l[2] = {0.f, 0.f};
#pragma unroll
    for (int db = 0; db < 4; ++db) { o[db][0] = (f32x4){0.f, 0.f, 0.f, 0.f}; o[db][1] = (f32x4){0.f, 0.f, 0.f, 0.f}; }
#define GLD16(DST, PTR) asm volatile("global_load_dwordx4 %0, %1, off" : "=v"(DST) : "v"(PTR) : "memory")
#define MOBA_LOAD(B, KC) do { const int kc_ = (KC) < nkc ? (KC) : nkc - 1; \
        _Pragma("unroll") for (int kt = 0; kt < 2; ++kt) { const bf16* kp_ = kbase + (size_t)(kc_ * 32 + kt * 4) * NAT; GLD16(B.k[kt][0], kp_); GLD16(B.k[kt][1], kp_ + 32); } \
        _Pragma("unroll") for (int db = 0; db < 4; ++db) { const bf16* vp_ = vbase + (size_t)kc_ * (64 * 32) + (16 * db) * 32; GLD16(B.v[db], vp_); } } while (0)
#define MOBA_READY(B, N) asm volatile("s_waitcnt vmcnt(" #N ")" : "+v"(B.k[0][0]), "+v"(B.k[0][1]), "+v"(B.k[1][0]), "+v"(B.k[1][1]), "+v"(B.v[0]), "+v"(B.v[1]), "+v"(B.v[2]), "+v"(B.v[3]) :: "memory")
#define MOBA_COMPUTE(B, KC) do { v4u pb_[2]; const int kb_ = (KC) * 32 + 8 * g; const bool dg_ = own && ((KC) == nkc - 1); \
        _Pragma("unroll") for (int qt = 0; qt < 2; ++qt) { unsigned pw_[4]; const float bs_ = aq[qt] + slope2 * (float)kb_; const int dl_ = ql[qt] - kb_; \
            _Pragma("unroll") for (int kt = 0; kt < 2; ++kt) { f32x4 st_ = {0.f, 0.f, 0.f, 0.f}; \
                st_ = mma(B.k[kt][0], qf[qt][0], st_); st_ = mma(B.k[kt][1], qf[qt][1], st_); f32x4 p_; \
                if (dg_) { _Pragma("unroll") for (int e = 0; e < 4; ++e) { float x_ = (st_[e] + bs_) + cst[kt * 4 + e]; if (4 * kt + e > dl_) x_ = -1e30f; p_[e] = __builtin_amdgcn_exp2f(x_); } } \
                else { _Pragma("unroll") for (int e = 0; e < 4; ++e) p_[e] = __builtin_amdgcn_exp2f((st_[e] + bs_) + cst[kt * 4 + e]); } \
                l[qt] += (p_[0] + p_[1]) + (p_[2] + p_[3]); pw_[2 * kt] = pk2(p_[0], p_[1]); pw_[2 * kt + 1] = pk2(p_[2], p_[3]); } \
            pb_[qt].x = pw_[0]; pb_[qt].y = pw_[1]; pb_[qt].z = pw_[2]; pb_[qt].w = pw_[3]; } \
        _Pragma("unroll") for (int db = 0; db < 4; ++db) { _Pragma("unroll") for (int qt = 0; qt < 2; ++qt) o[db][qt] = mma(B.v[db], __builtin_bit_cast(bf16x8, pb_[qt]), o[db][qt]); } } while (0)
    float cst[8];
#pragma unroll
    for (int j = 0; j < 8; ++j) cst[j] = slope2 * (float)j;
    KV B0, B1, B2;
    MOBA_LOAD(B0, 0); MOBA_LOAD(B1, 1);
#pragma unroll
    for (int qt = 0; qt < 2; ++qt) { const int qrow = (ql[qt] >= 0) ? ql[qt] : 0; const bf16* qp = A.AT + ((size_t)b * T + qb * 256 + qrow) * NAT + h * 64 + 8 * g;
        qf[qt][0] = *(const GAS bf16x8*)qp; qf[qt][1] = *(const GAS bf16x8*)(qp + 32); }
    asm volatile("" :: "v"(qf[0][0]), "v"(qf[0][1]), "v"(qf[1][0]), "v"(qf[1][1]) : "memory");
    for (int kc = 0; kc < nkc; kc += 3) {
        MOBA_LOAD(B2, kc + 2); MOBA_READY(B0, 16); MOBA_COMPUTE(B0, kc);
        if (kc + 1 < nkc) { MOBA_LOAD(B0, kc + 3); MOBA_READY(B1, 16); MOBA_COMPUTE(B1, kc + 1); }
        if (kc + 2 < nkc) { MOBA_LOAD(B1, kc + 4); MOBA_READY(B2, 16); MOBA_COMPUTE(B2, kc + 2); }
    }
    asm volatile("s_waitcnt vmcnt(0)" : "+v"(B0.k[0][0]), "+v"(B0.k[0][1]), "+v"(B0.k[1][0]), "+v"(B0.k[1][1]), "+v"(B0.v[0]), "+v"(B0.v[1]), "+v"(B0.v[2]), "+v"(B0.v[3]),
                 "+v"(B1.k[0][0]), "+v"(B1.k[0][1]), "+v"(B1.k[1][0]), "+v"(B1.k[1][1]), "+v"(B1.v[0]), "+v"(B1.v[1]), "+v"(B1.v[2]), "+v"(B1.v[3]),
                 "+v"(B2.k[0][0]), "+v"(B2.k[0][1]), "+v"(B2.k[1][0]), "+v"(B2.k[1][1]), "+v"(B2.v[0]), "+v"(B2.v[1]), "+v"(B2.v[2]), "+v"(B2.v[3]) :: "memory");
#undef MOBA_LOAD
#undef MOBA_COMPUTE
#pragma unroll
    for (int qt = 0; qt < 2; ++qt) {
        float ls = l[qt]; ls += __shfl_xor(ls, 16); ls += __shfl_xor(ls, 32);
        if (ql[qt] >= 0) {
            const int slot = own ? 0 : (int)*(const LAS unsigned char*)(lds + QSLOT + off + qt * 16 + r);
            LAS unsigned char* op = lds + OSLOT + (slot * 256 + ql[qt]) * OSP + g * 8;
#pragma unroll
            for (int db = 0; db < 4; ++db) { *(LAS unsigned*)(op + db * 32) = pk2(o[db][qt][0], o[db][qt][1]); *(LAS unsigned*)(op + db * 32 + 4) = pk2(o[db][qt][2], o[db][qt][3]); }
            if (g == 0) *((LAS float*)(lds + LSUM) + slot * 256 + ql[qt]) = ls;
        }
    }
}
__device__ __forceinline__ void unit(LAS unsigned char* lds, const Args& A, const int b, const int h, const int qb, const int tid, const bool dummy = false) {
    const int lane = tid & 63;
    for (int i = tid; i < qb * 64; i += 512) ((LAS float*)(lds + KMF))[i] = ((const GAS float*)A.KM)[((size_t)(b * NH + h) * NBLK) * 64 + i];
    if (tid < 96) ((LAS int*)(lds + CNT))[tid] = 0;
    if (tid == 0) *(LAS int*)(lds + ICTR) = 0;
    if (tid < 64) {
        float mq = fabsf(((const GAS float*)A.qg)[lane]), mk = fabsf(((const GAS float*)A.kg)[lane]);
#pragma unroll
        for (int o_ = 1; o_ < 64; o_ <<= 1) { mq = fmaxf(mq, __shfl_xor(mq, o_)); mk = fmaxf(mk, __shfl_xor(mk, o_)); }
        const float B2 = 64.0f * (0.125f * 1.4426950408889634f) * mq * mk * 1.02f, sl2 = exp2f(-(float)(h + 1)) * 1.4426950408889634f;
        const float dmin = ((B2 + 152.0f) / sl2 - 1.0f) * (1.0f / 256.0f);
        if (lane == 0) *(LAS int*)(lds + ICTR + 8) = (int)floorf(dmin) + 2;
    }
    RW_BAR();
    int s0 = -1, s1 = -1, s2 = -1, sl0 = 0, sl1 = 0, sl2q = 0, nv = 1;
    if (tid < 256 && qb > 0) {
        float q[64];
        const GAS v4u* qp = (const GAS v4u*)(A.AT + ((size_t)b * T + qb * 256 + tid) * NAT + h * 64);
#pragma unroll
        for (int c = 0; c < 8; ++c) { const v4u w = qp[c]; q[8*c+0] = bflo(w.x); q[8*c+1] = bfhi(w.x); q[8*c+2] = bflo(w.y); q[8*c+3] = bfhi(w.y); q[8*c+4] = bflo(w.z); q[8*c+5] = bfhi(w.z); q[8*c+6] = bflo(w.w); q[8*c+7] = bfhi(w.w); }
        float g0 = -3e38f, g1 = -3e38f, g2 = -3e38f;
        for (int n = 0; n < qb; ++n) {
            const LAS f32x4* km = (const LAS f32x4*)(lds + KMF + n * 256); float gt = 0.f;
#pragma unroll
            for (int d = 0; d < 16; ++d) { const f32x4 k4 = km[d]; gt += q[4*d] * k4.x + q[4*d+1] * k4.y + q[4*d+2] * k4.z + q[4*d+3] * k4.w; }
            if (gt > g0) { g2 = g1; s2 = s1; g1 = g0; s1 = s0; g0 = gt; s0 = n; }
            else if (gt > g1) { g2 = g1; s2 = s1; g1 = gt; s1 = n; }
            else if (gt > g2) { g2 = gt; s2 = n; }
        }
        { const int Dd = *(const LAS int*)(lds + ICTR + 8);
          if (s0 >= 0 && qb - s0 >= Dd) s0 = -1; if (s0 >= 0) sl0 = nv++;
          if (s1 >= 0 && qb - s1 >= Dd) s1 = -1; if (s1 >= 0) sl1 = nv++;
          if (s2 >= 0 && qb - s2 >= Dd) s2 = -1; if (s2 >= 0) sl2q = nv++; }
        if (s0 >= 0) __hip_atomic_fetch_add((LAS int*)(lds + CNT) + s0, 1, __ATOMIC_RELAXED, __HIP_MEMORY_SCOPE_WORKGROUP);
        if (s1 >= 0) __hip_atomic_fetch_add((LAS int*)(lds + CNT) + s1, 1, __ATOMIC_RELAXED, __HIP_MEMORY_SCOPE_WORKGROUP);
        if (s2 >= 0) __hip_atomic_fetch_add((LAS int*)(lds + CNT) + s2, 1, __ATOMIC_RELAXED, __HIP_MEMORY_SCOPE_WORKGROUP);
    }
    if (tid < 256) *(LAS unsigned char*)(lds + NVQ + tid) = (unsigned char)nv;
    RW_BAR();
    if (tid == 0) {
        int run = 0, ni = 0;
        for (int n = 0; n < qb; ++n) { const int c = ((LAS int*)(lds + CNT))[n]; ((LAS int*)(lds + OFFS))[n] = run;
            for (int k = 0; k < c; k += 32) { ((LAS int*)(lds + ITEMS))[2 * ni] = n | ((c - k < 32 ? c - k : 32) << 8); ((LAS int*)(lds + ITEMS))[2 * ni + 1] = run + k; ++ni; }
            run += c; }
        for (int i = 7; i >= 0; --i) { ((LAS int*)(lds + ITEMS))[2 * ni] = qb | (32 << 8) | (1 << 16) | ((i + 1) << 20); ((LAS int*)(lds + ITEMS))[2 * ni + 1] = 32 * i; ++ni; }
        *(LAS int*)(lds + ICTR + 4) = ni;
    }
    RW_BAR();
    if (tid < 256) {
        if (s0 >= 0) { const int p = __hip_atomic_fetch_add((LAS int*)(lds + FILL) + s0, 1, __ATOMIC_RELAXED, __HIP_MEMORY_SCOPE_WORKGROUP); *(LAS unsigned char*)(lds + QLIST + ((LAS int*)(lds + OFFS))[s0] + p) = (unsigned char)tid; *(LAS unsigned char*)(lds + QSLOT + ((LAS int*)(lds + OFFS))[s0] + p) = (unsigned char)sl0; }
        if (s1 >= 0) { const int p = __hip_atomic_fetch_add((LAS int*)(lds + FILL) + s1, 1, __ATOMIC_RELAXED, __HIP_MEMORY_SCOPE_WORKGROUP); *(LAS unsigned char*)(lds + QLIST + ((LAS int*)(lds + OFFS))[s1] + p) = (unsigned char)tid; *(LAS unsigned char*)(lds + QSLOT + ((LAS int*)(lds + OFFS))[s1] + p) = (unsigned char)sl1; }
        if (s2 >= 0) { const int p = __hip_atomic_fetch_add((LAS int*)(lds + FILL) + s2, 1, __ATOMIC_RELAXED, __HIP_MEMORY_SCOPE_WORKGROUP); *(LAS unsigned char*)(lds + QLIST + ((LAS int*)(lds + OFFS))[s2] + p) = (unsigned char)tid; *(LAS unsigned char*)(lds + QSLOT + ((LAS int*)(lds + OFFS))[s2] + p) = (unsigned char)sl2q; }
    }
    RW_BAR();
    {
        const int ni = *(const LAS int*)(lds + ICTR + 4);
        for (;;) {
            int idx = 0; if (lane == 0) idx = __hip_atomic_fetch_add((LAS int*)(lds + ICTR), 1, __ATOMIC_RELAXED, __HIP_MEMORY_SCOPE_WORKGROUP);
            idx = __builtin_amdgcn_readfirstlane(idx);
            if (idx >= ni) break;
            const int w0 = __builtin_amdgcn_readfirstlane(((const LAS int*)(lds + ITEMS))[2 * idx]), w1 = __builtin_amdgcn_readfirstlane(((const LAS int*)(lds + ITEMS))[2 * idx + 1]);
            const bool own = (w0 >> 16) & 1;
            item(lds, A, b, h, qb, w0 & 255, w1, (w0 >> 8) & 255, own ? (w0 >> 20) : 8, own, lane);
        }
    }
    RW_BAR();
    if (!dummy) {
        const int qloc = tid >> 1, half = tid & 1;
        const int nslot = (int)*(const LAS unsigned char*)(lds + NVQ + qloc);
        float acc[32]; float lt = 0.f;
#pragma unroll
        for (int d = 0; d < 32; ++d) acc[d] = 0.f;
        for (int sl = 0; sl < nslot; ++sl) {
            const LAS unsigned* op = (const LAS unsigned*)(lds + OSLOT + (sl * 256 + qloc) * OSP + half * 64);
#pragma unroll
            for (int d = 0; d < 16; ++d) { const unsigned w = op[d]; acc[2 * d] += bflo(w); acc[2 * d + 1] += bfhi(w); }
            lt += *((const LAS float*)(lds + LSUM) + sl * 256 + qloc);
        }
        const float inv = 1.0f / lt;
        bf16* yp = A.AT + ((size_t)b * T + qb * 256 + qloc) * NAT + h * 64 + half * 32;
#pragma unroll
        for (int c = 0; c < 4; ++c) { v4u w; w.x = pk2(acc[8*c] * inv, acc[8*c+1] * inv); w.y = pk2(acc[8*c+2] * inv, acc[8*c+3] * inv); w.z = pk2(acc[8*c+4] * inv, acc[8*c+5] * inv); w.w = pk2(acc[8*c+6] * inv, acc[8*c+7] * inv); *(GAS v4u*)(yp + 8 * c) = w; }
    }
    RW_BAR();
}
}

__global__ void __launch_bounds__(NWAVES * 64, 2) mk_fwd(Args args) {
    extern __shared__ __attribute__((aligned(16))) unsigned char lds_raw[];
    LAS unsigned char* lds = (LAS unsigned char*)lds_raw;
    const int tid0 = threadIdx.x;
    const int G = gridDim.x;
    unsigned char* ws0 = args.ws;
    const int lo = args.ph_lo, hi = args.ph_hi;
    const int NGW = G * NWAVES;
    const bool fused = args.fused != 0;
    volatile LAS unsigned* MISC = (volatile LAS unsigned*)(lds + MISC_OFF);
    for (int u = tid0; u < (LDS_BYTES - LDSCTL_OFF) / 4; u += NWAVES * 64) ((LAS unsigned*)(lds + LDSCTL_OFF))[u] = 0u;
    __syncthreads();
    XcdBarrier bar; bar.bar = (unsigned*)(ws0 + WS_CTL) + CW_BAR; bar.x = 0; bar.st = nullptr;
    if (fused) bar = xcd_barrier_post((unsigned*)(ws0 + WS_CTL) + CW_BAR, MISC + 8);
#define IN(k) (lo <= (k) && (k) < hi && (rep == 1 || (k) <= args.probe_upto || (k) == args.probe_dup))
#define SEAM(k) do { if (fused && !((k) == PH_FF2 && L == args.l_hi - 1)) xcd_barrier(bar); } while (0)

    for (int L = args.l_lo; L < args.l_hi; ++L)
    for (int rep = (args.probe_upto >= 0 || args.probe_dup >= 0) ? 0 : 1; rep < 2; ++rep) {
    const float* xsrc = (L == 0) ? args.in[I_X] : args.out;
    int tidL = threadIdx.x; asm volatile("" : "+v"(tidL));
    const int tid = tidL, lane = tid & 63, wave = __builtin_amdgcn_readfirstlane(tid >> 6), gw = blockIdx.x * NWAVES + wave;
    if (IN(PH_CONV)) {
        unsigned char* ws = args.ws; asm volatile("" : "+s"(ws));
        LAS float* scr = (LAS float*)(lds + RING_OFF + wave * 16384);
        const float* w_in = args.in[I_WIN] + (size_t)L * D * NIN;
        const float* w_br = args.in[I_WBR] + (size_t)L * 3 * W * D;
        const float* w_out = args.in[I_WOUT] + (size_t)L * D * D;
        const float* w_f1 = args.in[I_FF1] + (size_t)L * D * FF;
        const float* w_f2 = args.in[I_FF2] + (size_t)L * FF * D;
        constexpr int I_IN = (D / 64) * (NIN / 32), I_B = (W / 64) * (D / 32), I_O = (D / 64) * (D / 32), I_1 = (D / 64) * (FF / 32), I_2 = (FF / 64) * (D / 32);
        constexpr int I_LU = 16, I_LG = 32;
        constexpr int NITEMS = I_IN + 2 * I_B + I_O + I_1 + I_2 + 2 * I_LU + I_LG;
        bf16* WupT = (bf16*)(ws + WS_LORA); bf16* AupT = WupT + 512 * 64; bf16* GupT = AupT + 512 * 64;
        for (int it = gw; it < NITEMS; it += NGW) {
            int r = it;
            if (r < I_IN) { p0_transpose_item(w_in, D, NIN, ((bf16*)(ws + WS_WIN)), scr, r, lane); continue; } r -= I_IN;
            if (r < I_B) { p0_transpose_item(w_br, W, D, ((bf16*)(ws + WS_WB)), scr, r, lane); continue; } r -= I_B;
            if (r < I_B) { p0_transpose_item(w_br + (size_t)W * D, W, D, ((bf16*)(ws + WS_WB)) + (size_t)D * W, scr, r, lane); continue; } r -= I_B;
            if (r < I_O) { p0_transpose_item(w_out, D, D, ((bf16*)(ws + WS_WO)), scr, r, lane); continue; } r -= I_O;
            if (r < I_1) { p0_transpose_item(w_f1, D, FF, ((bf16*)(ws + WS_W1)), scr, r, lane); continue; } r -= I_1;
            if (r < I_2) { p0_transpose_item(w_f2, FF, D, ((bf16*)(ws + WS_W2)), scr, r, lane); continue; } r -= I_2;
            if (r < I_LU) { p0_transpose_item(args.in[I_WUP] + (size_t)L * 64 * W, 64, W, WupT, scr, r, lane); continue; } r -= I_LU;
            if (r < I_LU) { p0_transpose_item(args.in[I_AUP] + (size_t)L * 64 * W, 64, W, AupT, scr, r, lane); continue; } r -= I_LU;
            p0_transpose_item(args.in[I_GUP] + (size_t)L * 128 * W, 128, W, GupT, scr, r, lane);
        }
        const float* pw = args.in[I_POOLW] + (size_t)L * 4 * 128 * 128; const float* ps = args.in[I_POOLS] + (size_t)L * W; const float* wb2 = w_br + (size_t)2 * W * D;
        bf16* WeT = ((bf16*)(ws + WS_WB)) + (size_t)2 * D * W;
        for (int idx = blockIdx.x * (NWAVES * 64) + tid; idx < W * D; idx += G * NWAVES * 64) {
            const int gc = idx / D, dout = idx % D, g = gc >> 7;
            const GAS float* pwr = (const GAS float*)pw + (size_t)gc * 128; float acc = 0.f;
            for (int dp = 0; dp < 128; ++dp) acc += pwr[dp] * ((const GAS float*)ps)[g * 128 + dp] * ((const GAS float*)wb2)[(size_t)(g * 128 + dp) * D + dout];
            ((GAS bf16*)WeT)[(size_t)dout * W + gc] = (bf16)f2bf(acc);
        }
        rms_rows(xsrc, args.in[I_N1G] + (size_t)L * D, ((bf16*)(ws + WS_H)), gw, NGW, lane);
        SEAM(PH_CONV);
    }
    if (IN(PH_GEMMA)) {
        unsigned char* ws = args.ws; asm volatile("" : "+s"(ws));
        pg8::Gemm g{((bf16*)(ws + WS_H)), ((bf16*)(ws + WS_WIN)), M, NA, D, D, D}; pg8::StaticOrder S; S.init(M, NA, G, (int)blockIdx.x);
        pg8::EpiA E{(bf16*)(ws + WS_RW), (bf16*)(ws + WS_AT), (bf16*)(ws + WS_PL), (bf16*)(ws + WS_SB), (bf16*)(ws + WS_HB)};
        pg8::gemm_phase<pg8::EpiA, pg8::StaticOrder, true, true>(lds + RING_OFF, g, S, E, tidL);
        SEAM(PH_GEMMA);
    }
    if (IN(PH_MIX1)) {
        unsigned char* ws = args.ws; asm volatile("" : "+s"(ws));
        ph_attn_prep(lds, (bf16*)(ws + WS_AT), (bf16*)(ws + WS_VT), args.in[I_QNG] + L * 64, args.in[I_KNG] + L * 64, (float*)(ws + WS_KM), G, tidL);
        ph_pool((bf16*)(ws + WS_PL), (const bf16*)(ws + WS_HB), G, tidL);
        __syncthreads();
        rw::S1Args A1; A1.RW = (bf16*)(ws + WS_RW); A1.SB = (const bf16*)(ws + WS_SB);
        A1.mu = args.in[I_MU] + L * NRW; A1.w0 = args.in[I_W0] + L * W; A1.a0 = args.in[I_A0] + L * W; A1.k_k = args.in[I_KK] + L * W; A1.k_a = args.in[I_KA] + L * W; A1.r_k = args.in[I_RK] + L * W;
        A1.WupT = (const bf16*)(ws + WS_LORA); A1.AupT = A1.WupT + 512 * 64; A1.GupT = A1.AupT + 512 * 64;
        A1.Gf = (bf16*)(ws + WS_GF); A1.Pst = (bf16*)(ws + WS_PST); A1.Qst = (bf16*)(ws + WS_QST); A1.bonus = (float*)(ws + WS_BON);
        A1.Rh = (bf16*)(ws + WS_RW); A1.O0 = (bf16*)(ws + WS_RW) + 512; A1.ldo = NRW; A1.Vm = (bf16*)(ws + WS_RW) + 1024; A1.ldv = NRW;
        int hprev = -1;
        for (int unit = blockIdx.x; unit < NB * 128 * NH; unit += G) rw::s1_unit(lds, A1, unit, tidL, hprev);
        SEAM(PH_MIX1);
    }
    if (IN(PH_MIX2)) {
        unsigned char* ws = args.ws; asm volatile("" : "+s"(ws));
        { moba::Args MA; MA.AT = (bf16*)(ws + WS_AT); MA.VT = (const bf16*)(ws + WS_VT); MA.KM = (const float*)(ws + WS_KM); MA.qg = args.in[I_QNG] + L * 64; MA.kg = args.in[I_KNG] + L * 64;
          if (G == 256) {
              const int xcd = blockIdx.x & 7, slot = blockIdx.x >> 3;
              if (slot < 4) {
                  if (tid < 8) *(volatile LAS int*)(lds + rw::S2_FLAGS + tid * 64) = 0;
                  __syncthreads();
                  if (wave < 4) rw::s2_chain(lds, (const bf16*)(ws + WS_PST), (const bf16*)(ws + WS_QST), slot * 8 + xcd, wave, lane);
                  else rw::s2_storer(lds, (bf16*)(ws + WS_SST), slot * 8 + xcd, wave - 4, lane);
              }
              volatile LAS int* qslot = (volatile LAS int*)(lds + LDSCTL_OFF + 64);
              for (int qx = 0; qx < 8; ++qx) {
                  const int x = (xcd + qx) & 7;
                  gu32* qw = (gu32*)(ws + WS_CTL) + CW_Q + (L * 8 + x) * 64;
                  for (;;) {
                      __syncthreads();
                      if (tid == 0) *qslot = (int)__hip_atomic_fetch_add(qw, 1u, RLX_AGENT);
                      __syncthreads();
                      const int u = *qslot;
                      if (u >= 128) break;
                      const int pb_ = u >> 5, ph_ = (pb_ & 1) ? 7 - x : x;
                      int tq = tidL; asm volatile("" : "+v"(tq));
#ifdef PROBE_MOBA2
                      moba::unit(lds, MA, pb_, ph_, 31 - (u & 31), tq, true);
#endif
                      moba::unit(lds, MA, pb_, ph_, 31 - (u & 31), tq);
                  }
              }
          } else {
              for (int bh = blockIdx.x; bh < NB * NH; bh += G) {
                  __syncthreads();
                  if (tid < 8) *(volatile LAS int*)(lds + rw::S2_FLAGS + tid * 64) = 0;
                  __syncthreads();
                  if (wave < 4) rw::s2_chain(lds, (const bf16*)(ws + WS_PST), (const bf16*)(ws + WS_QST), bh, wave, lane);
                  else rw::s2_storer(lds, (bf16*)(ws + WS_SST), bh, wave - 4, lane);
              }
              __syncthreads();
              for (int u = blockIdx.x; u < NB * NH * NBLK; u += G) moba::unit(lds, MA, u >> 8, (u >> 5) & 7, u & 31, tidL); } }
        SEAM(PH_MIX2);
    }
    if (IN(PH_S3)) {
        unsigned char* ws = args.ws; asm volatile("" : "+s"(ws));
        rw::S3Args A3; A3.Rh = (const bf16*)(ws + WS_RW); A3.O0 = A3.Rh + 512; A3.ldo = NRW; A3.Vp = A3.Rh + 1024; A3.ldv = NRW; A3.Gf = (const bf16*)(ws + WS_GF); A3.Sst = (const bf16*)(ws + WS_SST);
        A3.bonus = (const float*)(ws + WS_BON); A3.lnx_g = args.in[I_LNG] + L * W; A3.lnx_b = args.in[I_LNB] + L * W; A3.Y = (bf16*)(ws + WS_RW); A3.ldy = NRW;
        for (int unit = gw; unit < NB * 128 * NH; unit += NGW) rw::s3_unit(A3, unit, lane);
        SEAM(PH_S3);
    }
    if (IN(PH_GB)) {
        unsigned char* ws = args.ws; asm volatile("" : "+s"(ws));
        bf16* GBp = (bf16*)(ws + WS_GB); bf16* MBp = (bf16*)(ws + WS_MB);
        pg8::StaticOrder S; S.init(M, D, G, (int)blockIdx.x);
#pragma unroll
        for (int b = 0; b < 3; ++b) {
            { int tv = tidL; asm volatile("" : "+v"(tv)); pg8::Gemm g{((bf16*)(ws + WS_H)), ((bf16*)(ws + WS_WIN)) + (size_t)(NA + b * D) * D, M, D, D, D, D}; pg8::EpiAct<1> E{GBp, D};
              pg8::gemm_phase<pg8::EpiAct<1>, pg8::StaticOrder, true, true>(lds + RING_OFF, g, S, E, tv); }
            __syncthreads();
            { int tv = tidL; asm volatile("" : "+v"(tv)); const bf16* Ysrc = (b == 0) ? (const bf16*)(ws + WS_RW) : (b == 1 ? (const bf16*)(ws + WS_AT) : (const bf16*)(ws + WS_PL));
              pg8::Gemm g{Ysrc, ((bf16*)(ws + WS_WB)) + (size_t)b * D * W, M, D, W, (b == 0) ? NRW : (b == 1 ? NAT : NPL), W};
              if (b == 0) { pg8::EpiBr<true> E{GBp, MBp}; pg8::gemm_phase<pg8::EpiBr<true>, pg8::StaticOrder, true, true>(lds + RING_OFF, g, S, E, tv); }
              else { pg8::EpiBr<false> E{GBp, MBp}; pg8::gemm_phase<pg8::EpiBr<false>, pg8::StaticOrder, true, true>(lds + RING_OFF, g, S, E, tv); } }
            __syncthreads();
        }
        SEAM(PH_GB);
    }
    if (IN(PH_GO)) {
        unsigned char* ws = args.ws; asm volatile("" : "+s"(ws));
        pg8::Gemm g{(const bf16*)(ws + WS_MB), ((bf16*)(ws + WS_WO)), M, D, D, D, D}; pg8::StaticOrder S; S.init(M, D, G, (int)blockIdx.x);
        pg8::EpiRes E{xsrc, args.out};
        pg8::gemm_phase<pg8::EpiRes, pg8::StaticOrder, true, true>(lds + RING_OFF, g, S, E, tidL);
        SEAM(PH_GO);
    }
    if (IN(PH_NORM2)) { unsigned char* ws = args.ws; asm volatile("" : "+s"(ws)); rms_rows(args.out, args.in[I_N2G] + (size_t)L * D, ((bf16*)(ws + WS_H)), gw, NGW, lane); SEAM(PH_NORM2); }
        unsigned char* ws = args.ws; asm volatile("" : "+s"(ws));
    if (IN(PH_FF1)) {
        unsigned char* ws = args.ws; asm volatile("" : "+s"(ws));
        pg8::Gemm g{((bf16*)(ws + WS_H)), ((bf16*)(ws + WS_W1)), M, FF, D, D, D}; pg8::StaticOrder S; S.init(M, FF, G, (int)blockIdx.x);
        pg8::EpiAct<2> E{(bf16*)(ws + WS_HID), FF};
        pg8::gemm_phase<pg8::EpiAct<2>, pg8::StaticOrder, true, true>(lds + RING_OFF, g, S, E, tidL);
        SEAM(PH_FF1);
    }
    if (IN(PH_FF2)) {
        unsigned char* ws = args.ws; asm volatile("" : "+s"(ws));
        pg8::Gemm g{(const bf16*)(ws + WS_HID), ((bf16*)(ws + WS_W2)), M, D, FF, FF, FF}; pg8::StaticOrder S; S.init(M, D, G, (int)blockIdx.x);
        pg8::EpiRes E{args.out, args.out};
        pg8::gemm_phase<pg8::EpiRes, pg8::StaticOrder, true, true>(lds + RING_OFF, g, S, E, tidL);
        SEAM(PH_FF2);
    }
    }
#undef IN
#undef SEAM
}

#ifndef MK_MULTI
#define MK_MULTI 0
#endif
#ifndef PROBE_UPTO
#define PROBE_UPTO (-1)
#endif
#ifndef PROBE_DUP
#define PROBE_DUP (-1)
#endif
extern "C" void kernel_launch(void* const* d_in, const int* in_sizes, int n_in, void* d_out, int out_size, void* d_ws, size_t ws_size, hipStream_t stream) {
    static int grid = 0;
    if (grid == 0) {
        if (n_in != 23 || in_sizes[0] != M * D || out_size != M * D || ws_size < WS_END) { fprintf(stderr, "kernel_launch: unexpected shapes (n_in %d, in0 %d, out %d, ws %zu)\n", n_in, n_in > 0 ? in_sizes[0] : -1, out_size, ws_size); grid = -1; return; }
        int dev = 0, cus = 0;
        if (hipGetDevice(&dev) != hipSuccess || hipDeviceGetAttribute(&cus, hipDeviceAttributeMultiprocessorCount, dev) != hipSuccess) { grid = -1; return; }
        if (hipFuncSetAttribute((const void*)mk_fwd, hipFuncAttributeMaxDynamicSharedMemorySize, LDS_BYTES) != hipSuccess) { fprintf(stderr, "kernel_launch: hipFuncSetAttribute failed\n"); grid = -1; return; }
        int per_cu = 0;
        if (hipOccupancyMaxActiveBlocksPerMultiprocessor(&per_cu, (const void*)mk_fwd, NWAVES * 64, LDS_BYTES) != hipSuccess || per_cu < 1) fprintf(stderr, "kernel_launch: occupancy query reports %d\n", per_cu);
        (void)hipGetLastError();
        grid = cus;
    }
    if (grid < 0) return;
    unsigned char* ws = (unsigned char*)d_ws;
    (void)hipMemsetAsync(ws + WS_CTL, 0, CTL_ZERO_BYTES, stream);
    Args a{};
    for (int i = 0; i < 23; ++i) a.in[i] = (const float*)d_in[i];
    a.out = (float*)d_out; a.ws = ws;
#if MK_MULTI
    for (int L = 0; L < 2; ++L) for (int p = 0; p < PH_N; ++p) { a.ph_lo = p; a.ph_hi = p + 1; a.l_lo = L; a.l_hi = L + 1; a.fused = 0; a.probe_upto = -1; a.probe_dup = -1; hipLaunchKernelGGL(mk_fwd, dim3(grid), dim3(NWAVES * 64), LDS_BYTES, stream, a); }
#else
    a.ph_lo = 0; a.ph_hi = PH_N; a.l_lo = 0; a.l_hi = 2; a.fused = 1; a.probe_upto = PROBE_UPTO; a.probe_dup = PROBE_DUP;
    hipLaunchKernelGGL(mk_fwd, dim3(grid), dim3(NWAVES * 64), LDS_BYTES, stream, a);
#endif
}
```

```cpp
#include <hip/hip_runtime.h>
#include <cstdio>
#include <cstdint>
#define GAS __attribute__((address_space(1)))
namespace pg8 {
#define PG8_LAS __attribute__((address_space(3)))
typedef unsigned short bf16_t;
typedef short bf16x8 __attribute__((ext_vector_type(8)));
typedef float f32x4 __attribute__((ext_vector_type(4)));
typedef unsigned u32x4 __attribute__((ext_vector_type(4)));
constexpr int BM = 256, BK = 64, HALF = 128, HTB = HALF * BK * 2  , STAGE_BYTES = 8 * HTB, NXCD = 8, WGM = 8;

__host__ __device__ __forceinline__ int lds_byte(int r, int c) { const int st = (r >> 4) * 2 + (c >> 5), rr = r & 15, cc = c & 31, ob = rr * 64 + cc * 2; return st * 1024 + (ob ^ (((ob >> 9) & 1) << 5)); }
__host__ __device__ __forceinline__ void stage_rc(int b, int& R, int& C) { const int st = b / 1024, sb = b % 1024, swz = sb ^ (((sb >> 9) & 1) << 5); R = (st >> 1) * 16 + swz / 64; C = (st & 1) * 32 + (swz % 64) / 2; }
__host__ __device__ __forceinline__ int perm32(int rho) { const int n = rho >> 4, i = rho & 15; return 8 * (i >> 2) + 4 * n + (i & 3); }

struct Unit { int pm, pn; };
struct Gemm { const bf16_t* A; const bf16_t* Bt; int M, N, K, lda, ldb; };

struct StaticOrder {
    int nM, nN, nwg, G, c;
    __host__ __device__ void init(int M, int N, int G_, int c_) { nM = M / BM; nN = N / BM; nwg = nM * nN; G = G_; c = c_; }
    __host__ __device__ bool next(int i, Unit& u) const {
        const long L = (long)i * G + c; if (L >= nwg) return false;
        int wgid = (int)L; { const int q = nwg / NXCD, r = nwg % NXCD, xcd = wgid % NXCD, off = wgid / NXCD; wgid = (xcd < r ? xcd * (q + 1) : r * (q + 1) + (xcd - r) * q) + off; }
        const int nig = WGM * nN, gid = wgid / nig, fm = gid * WGM, gsz = (nM - fm) < WGM ? (nM - fm) : WGM;
        u.pm = fm + ((wgid % nig) % gsz); u.pn = (wgid % nig) / gsz; return true;
    }
    __device__ __forceinline__ void a_ready(const Unit&) const {}
    __device__ __forceinline__ void done(const Unit&) const {}
};

__device__ __forceinline__ unsigned cvt_pk_bf16(float lo, float hi) { unsigned r; asm volatile("v_cvt_pk_bf16_f32 %0, %1, %2" : "=v"(r) : "v"(lo), "v"(hi)); return r; }
__device__ __forceinline__ float sigm(float x) { return 1.0f / (1.0f + __expf(-x)); }
__device__ __forceinline__ float bf_lo(unsigned w) { return __builtin_bit_cast(float, w << 16); }
__device__ __forceinline__ float bf_hi(unsigned w) { return __builtin_bit_cast(float, w & 0xffff0000u); }
struct EpiA {
    static constexpr bool PERM = true, AFTER_DRAIN = false;
    bf16_t *RW, *AT, *PL, *SB, *HB;
    __device__ __forceinline__ void operator()(const f32x4 (&acc)[2][2][4][2], const Unit& u, int wr, int wc, int fr, int fq) const {
        bf16_t* base; int ldc, colt;
        if (u.pn < 7) { base = RW; ldc = 1792; colt = u.pn * 256; } else if (u.pn < 13) { base = AT; ldc = 1536; colt = (u.pn - 7) * 256; } else { base = PL; ldc = 512; colt = (u.pn - 13) * 256; }
        const int row0 = u.pm * BM + wr * 64 + fr, col0 = colt + wc * 32 + 8 * fq;
#pragma unroll
        for (int ai = 0; ai < 2; ++ai)
#pragma unroll
            for (int m = 0; m < 4; ++m) { bf16_t* rowp = base + (size_t)(row0 + ai * HALF + m * 16) * ldc + col0;
#pragma unroll
                for (int bj = 0; bj < 2; ++bj) { const f32x4 v0 = acc[ai][bj][m][0], v1 = acc[ai][bj][m][1];
                    u32x4 w; w.x = cvt_pk_bf16(v0[0], v0[1]); w.y = cvt_pk_bf16(v0[2], v0[3]); w.z = cvt_pk_bf16(v1[0], v1[1]); w.w = cvt_pk_bf16(v1[2], v1[3]);
                    *(GAS u32x4*)(rowp + bj * HALF) = w;
                    if (u.pn < 7 && m == 3 && fr == 15) *(GAS u32x4*)(SB + (size_t)((row0 + ai * HALF + 48) >> 6) * 1792 + col0 + bj * HALF) = w;
                    if (u.pn >= 13 && m == 3 && wr == 1 && fr >= 1) *(GAS u32x4*)(HB + ((size_t)((row0 + ai * HALF + 48) >> 7) * 15 + (fr - 1)) * 512 + col0 + bj * HALF) = w; } }
    }
};
template <int MODE> struct EpiAct {
    static constexpr bool PERM = true, AFTER_DRAIN = false;
    bf16_t* O; int ldc;
    __device__ __forceinline__ void operator()(const f32x4 (&acc)[2][2][4][2], const Unit& u, int wr, int wc, int fr, int fq) const {
        const int row0 = u.pm * BM + wr * 64 + fr, col0 = u.pn * BM + wc * 32 + 8 * fq;
#pragma unroll
        for (int ai = 0; ai < 2; ++ai)
#pragma unroll
            for (int m = 0; m < 4; ++m) { bf16_t* rowp = O + (size_t)(row0 + ai * HALF + m * 16) * ldc + col0;
#pragma unroll
                for (int bj = 0; bj < 2; ++bj) { f32x4 v0 = acc[ai][bj][m][0], v1 = acc[ai][bj][m][1];
#pragma unroll
                    for (int e = 0; e < 4; ++e) {
                        if (MODE == 1) { v0[e] = sigm(v0[e]); v1[e] = sigm(v1[e]); }
                        if (MODE == 2) { const float a = fmaxf(v0[e], 0.f), b = fmaxf(v1[e], 0.f); v0[e] = a * a; v1[e] = b * b; } }
                    u32x4 w; w.x = cvt_pk_bf16(v0[0], v0[1]); w.y = cvt_pk_bf16(v0[2], v0[3]); w.z = cvt_pk_bf16(v1[0], v1[1]); w.w = cvt_pk_bf16(v1[2], v1[3]);
                    *(GAS u32x4*)(rowp + bj * HALF) = w; } }
    }
};
template <bool FIRST> struct EpiBr {
    static constexpr bool PERM = true, AFTER_DRAIN = false;
    const bf16_t* GB; bf16_t* MBuf;
    __device__ __forceinline__ void operator()(const f32x4 (&acc)[2][2][4][2], const Unit& u, int wr, int wc, int fr, int fq) const {
        const int row0 = u.pm * BM + wr * 64 + fr, col0 = u.pn * BM + wc * 32 + 8 * fq;
#pragma unroll
        for (int ai = 0; ai < 2; ++ai)
#pragma unroll
            for (int m = 0; m < 4; ++m) { const size_t off = (size_t)(row0 + ai * HALF + m * 16) * 1024 + col0;
#pragma unroll
                for (int bj = 0; bj < 2; ++bj) { const f32x4 v0 = acc[ai][bj][m][0], v1 = acc[ai][bj][m][1];
                    const u32x4 gw = *(const GAS u32x4*)(GB + off + bj * HALF);
                    float o[8] = {bf_lo(gw.x) * v0[0], bf_hi(gw.x) * v0[1], bf_lo(gw.y) * v0[2], bf_hi(gw.y) * v0[3], bf_lo(gw.z) * v1[0], bf_hi(gw.z) * v1[1], bf_lo(gw.w) * v1[2], bf_hi(gw.w) * v1[3]};
                    if (!FIRST) { const u32x4 mw = *(const GAS u32x4*)(MBuf + off + bj * HALF);
                        o[0] += bf_lo(mw.x); o[1] += bf_hi(mw.x); o[2] += bf_lo(mw.y); o[3] += bf_hi(mw.y); o[4] += bf_lo(mw.z); o[5] += bf_hi(mw.z); o[6] += bf_lo(mw.w); o[7] += bf_hi(mw.w); }
                    u32x4 w; w.x = cvt_pk_bf16(o[0], o[1]); w.y = cvt_pk_bf16(o[2], o[3]); w.z = cvt_pk_bf16(o[4], o[5]); w.w = cvt_pk_bf16(o[6], o[7]);
                    *(GAS u32x4*)(MBuf + off + bj * HALF) = w; } }
    }
};
struct EpiRes {
    static constexpr bool PERM = false, AFTER_DRAIN = false;
    const float* base; float* out;
    __device__ __forceinline__ void operator()(const f32x4 (&acc)[2][2][4][2], const Unit& u, int wr, int wc, int fr, int fq) const {
        const int row0 = u.pm * BM + wr * 64 + fr, col0 = u.pn * BM + wc * 32 + 4 * fq;
#pragma unroll
        for (int ai = 0; ai < 2; ++ai)
#pragma unroll
            for (int m = 0; m < 4; ++m) { const size_t off = (size_t)(row0 + ai * HALF + m * 16) * 1024 + col0;
#pragma unroll
                for (int bj = 0; bj < 2; ++bj)
#pragma unroll
                    for (int n = 0; n < 2; ++n) { const f32x4 bs = *(const GAS f32x4*)(base + off + bj * HALF + n * 16); *(GAS f32x4*)(out + off + bj * HALF + n * 16) = bs + acc[ai][bj][m][n]; } }
    }
};
template <class Epi, class Sched, bool ALIGN_EPI = false, bool SP2 = false>
__device__ __forceinline__ void gemm_phase(PG8_LAS unsigned char* lds, const Gemm g, const Sched& S, const Epi& E, const int tid) {
    const int wid = __builtin_amdgcn_readfirstlane(tid >> 6), lane = tid & 63, wr = wid >> 2, wc = wid & 3, fr = lane & 15, fq = lane >> 4;
    const int K = g.K, nt = K / BK;
    unsigned voffA[2], voffB[2];
#pragma unroll
    for (int i = 0; i < 2; ++i) { int R, C; stage_rc(tid * 16 + i * 8192, R, C); const int Rb = Epi::PERM ? ((R & ~31) + perm32(R & 31)) : R;
        voffA[i] = (unsigned)(R * g.lda + C) * 2u; voffB[i] = (unsigned)(Rb * g.ldb + C) * 2u; }
    const size_t kstep = (size_t)(BK * 2);
    const size_t hstepA = (size_t)HALF * g.lda * 2, hstepB = (size_t)HALF * g.ldb * 2;
    const size_t tstepA = 2 * hstepA, tstepB = 2 * hstepB;
    const unsigned ldsw = (unsigned)wid * 1024u;
    const int aoff = lds_byte(wr * 64 + fr, fq * 8), boff = lds_byte(wc * 32 + fr, fq * 8);
#define PG8_SA(b, h) (((b) * 2 + (h)) * HTB)
#define PG8_SB(b, h) ((4 + (b) * 2 + (h)) * HTB)
#define PG8_STAGE(bufoff, gbase, voff) do { _Pragma("unroll") for (int _i = 0; _i < 2; ++_i) \
        __builtin_amdgcn_global_load_lds((const unsigned*)((const char*)(gbase) + (voff)[_i]), (PG8_LAS unsigned*)(lds + (bufoff) + ldsw + _i * 8192), 16, 0, 0); } while (0)
#define PG8_LDA(dst, b, h) do { _Pragma("unroll") for (int m = 0; m < 4; ++m) _Pragma("unroll") for (int k = 0; k < 2; ++k) dst[m][k] = *(const PG8_LAS bf16x8*)(lds + PG8_SA(b, h) + aoff + m * 2048 + k * 1024); } while (0)
#define PG8_LDB(dst, b, h) do { _Pragma("unroll") for (int n = 0; n < 2; ++n) _Pragma("unroll") for (int k = 0; k < 2; ++k) dst[n][k] = *(const PG8_LAS bf16x8*)(lds + PG8_SB(b, h) + boff + n * 2048 + k * 1024); } while (0)
#define PG8_MMA(ai, bj, At, Bt) do { __builtin_amdgcn_s_setprio(1); _Pragma("unroll") for (int m = 0; m < 4; ++m) _Pragma("unroll") for (int n = 0; n < 2; ++n) _Pragma("unroll") for (int k = 0; k < 2; ++k) \
        acc[ai][bj][m][n] = __builtin_amdgcn_mfma_f32_16x16x32_bf16(Bt[n][k], At[m][k], acc[ai][bj][m][n], 0, 0, 0); __builtin_amdgcn_s_setprio(0); } while (0)
#define PG8_WAIT_V(n) asm volatile("s_waitcnt vmcnt(" #n ")" ::: "memory")
#define PG8_WAIT_L(n) asm volatile("s_waitcnt lgkmcnt(" #n ")" ::: "memory")
#define PG8_BAR __builtin_amdgcn_s_barrier()
#define PG8_SCHED __builtin_amdgcn_sched_barrier(0)
    Unit cur, nxt; int ui = 0;
    if (!S.next(0, cur)) return;
    f32x4 acc[2][2][4][2];
#pragma unroll
    for (int a = 0; a < 2; ++a)
#pragma unroll
        for (int b = 0; b < 2; ++b)
#pragma unroll
            for (int m = 0; m < 4; ++m)
#pragma unroll
                for (int n = 0; n < 2; ++n) acc[a][b][m][n] = (f32x4){0.f, 0.f, 0.f, 0.f};
    bf16x8 At[4][2], B0[2][2], B1[2][2];
    const char* cA = (const char*)g.A + (size_t)cur.pm * tstepA; const char* cB = (const char*)g.Bt + (size_t)cur.pn * tstepB;
    S.a_ready(cur);
    if constexpr (SP2) {
        PG8_STAGE(PG8_SB(0, 0), cB, voffB); PG8_STAGE(PG8_SB(0, 1), cB + hstepB, voffB); PG8_STAGE(PG8_SA(0, 0), cA, voffA); PG8_STAGE(PG8_SA(0, 1), cA + hstepA, voffA);
        if (wr == 1) PG8_BAR;
        PG8_WAIT_V(2); PG8_BAR;
        PG8_STAGE(PG8_SB(1, 0), cB + kstep, voffB); PG8_STAGE(PG8_SA(1, 0), cA + kstep, voffA); PG8_STAGE(PG8_SB(1, 1), cB + hstepB + kstep, voffB);
        PG8_WAIT_V(6); PG8_BAR;
    } else {
        PG8_STAGE(PG8_SB(0, 0), cB, voffB); PG8_STAGE(PG8_SA(0, 0), cA, voffA); PG8_STAGE(PG8_SB(0, 1), cB + hstepB, voffB); PG8_STAGE(PG8_SA(0, 1), cA + hstepA, voffA);
        if (wr == 1) PG8_BAR;
        PG8_WAIT_V(4); PG8_BAR;
        PG8_STAGE(PG8_SB(1, 0), cB + kstep, voffB); PG8_STAGE(PG8_SA(1, 0), cA + kstep, voffA); PG8_STAGE(PG8_SB(1, 1), cB + hstepB + kstep, voffB);
        PG8_WAIT_V(6); PG8_BAR;
    }
    for (;;) {
        const bool has_next = S.next(ui + 1, nxt);
        const char* nA = has_next ? (const char*)g.A + (size_t)nxt.pm * tstepA : cA; const char* nB = has_next ? (const char*)g.Bt + (size_t)nxt.pn * tstepB : cB;
        for (int t = 0; t < nt; t += 2) {
            const bool last = (t == nt - 2);
            const char* a1 = cA + (size_t)(t + 1) * kstep;
            const char* a2 = last ? nA : cA + (size_t)(t + 2) * kstep; const char* b2 = last ? nB : cB + (size_t)(t + 2) * kstep;
            const char* a3 = a2 + kstep; const char* b3 = b2 + kstep;
            if (last && has_next) S.a_ready(nxt);
            if constexpr (SP2) {
            PG8_LDB(B0, 0, 0); PG8_LDB(B1, 0, 1); PG8_SCHED; PG8_LDA(At, 0, 0); PG8_STAGE(PG8_SA(1, 1), a1 + hstepA, voffA);
            PG8_WAIT_V(8); PG8_WAIT_L(0); PG8_BAR; PG8_MMA(0, 0, At, B0); PG8_MMA(0, 1, At, B1); PG8_BAR; PG8_SCHED;
            PG8_LDA(At, 0, 1); PG8_STAGE(PG8_SB(0, 0), b2, voffB); PG8_STAGE(PG8_SB(0, 1), b2 + hstepB, voffB); PG8_STAGE(PG8_SA(0, 0), a2, voffA);
            PG8_WAIT_V(8); PG8_WAIT_L(0); PG8_BAR; PG8_MMA(1, 0, At, B0); PG8_MMA(1, 1, At, B1); PG8_BAR; PG8_SCHED;
            PG8_LDB(B0, 1, 0); PG8_LDB(B1, 1, 1); PG8_SCHED; PG8_LDA(At, 1, 0); PG8_STAGE(PG8_SA(0, 1), a2 + hstepA, voffA);
            PG8_WAIT_V(8); PG8_WAIT_L(0); PG8_BAR; PG8_MMA(0, 0, At, B0); PG8_MMA(0, 1, At, B1); PG8_BAR; PG8_SCHED;
            PG8_LDA(At, 1, 1); PG8_STAGE(PG8_SB(1, 0), b3, voffB); PG8_STAGE(PG8_SB(1, 1), b3 + hstepB, voffB); PG8_STAGE(PG8_SA(1, 0), a3, voffA);
            PG8_WAIT_V(8); PG8_WAIT_L(0); PG8_BAR; PG8_MMA(1, 0, At, B0); PG8_MMA(1, 1, At, B1); PG8_BAR; PG8_SCHED;
            } else {
            PG8_LDB(B0, 0, 0); PG8_SCHED; PG8_LDA(At, 0, 0); PG8_STAGE(PG8_SA(1, 1), a1 + hstepA, voffA);
            PG8_WAIT_L(8); PG8_BAR; PG8_WAIT_L(0); PG8_MMA(0, 0, At, B0); PG8_BAR; PG8_SCHED;
            PG8_LDB(B1, 0, 1); PG8_STAGE(PG8_SB(0, 0), b2, voffB);
            PG8_BAR; PG8_WAIT_L(0); PG8_MMA(0, 1, At, B1); PG8_BAR;
            PG8_LDA(At, 0, 1); PG8_STAGE(PG8_SA(0, 0), a2, voffA);
            PG8_BAR; PG8_WAIT_L(0); PG8_MMA(1, 0, At, B0); PG8_BAR; PG8_SCHED;
            PG8_STAGE(PG8_SB(0, 1), b2 + hstepB, voffB);
            PG8_WAIT_V(6); PG8_BAR; PG8_MMA(1, 1, At, B1); PG8_BAR;
            PG8_LDB(B0, 1, 0); PG8_SCHED; PG8_LDA(At, 1, 0); PG8_STAGE(PG8_SA(0, 1), a2 + hstepA, voffA);
            PG8_WAIT_L(8); PG8_BAR; PG8_WAIT_L(0); PG8_MMA(0, 0, At, B0); PG8_BAR; PG8_SCHED;
            PG8_LDB(B1, 1, 1); PG8_STAGE(PG8_SB(1, 0), b3, voffB);
            PG8_BAR; PG8_WAIT_L(0); PG8_MMA(0, 1, At, B1); PG8_BAR;
            PG8_LDA(At, 1, 1); PG8_STAGE(PG8_SA(1, 0), a3, voffA);
            PG8_BAR; PG8_WAIT_L(0); PG8_MMA(1, 0, At, B0); PG8_BAR; PG8_SCHED;
            PG8_STAGE(PG8_SB(1, 1), b3 + hstepB, voffB);
            PG8_WAIT_V(6); PG8_BAR; PG8_MMA(1, 1, At, B1); PG8_BAR;
            }
        }
        if constexpr (ALIGN_EPI) { if (wr == 0) PG8_BAR; }
        if constexpr (!Epi::AFTER_DRAIN) { E(acc, cur, wr, wc, fr, fq); S.done(cur); }
        if (!has_next) break;
#pragma unroll
        for (int a = 0; a < 2; ++a)
#pragma unroll
            for (int b = 0; b < 2; ++b)
#pragma unroll
                for (int m = 0; m < 4; ++m)
#pragma unroll
                    for (int n = 0; n < 2; ++n) acc[a][b][m][n] = (f32x4){0.f, 0.f, 0.f, 0.f};
        cur = nxt; cA = nA; cB = nB; ++ui;
        if constexpr (ALIGN_EPI) { if (wr == 1) PG8_BAR; }
    }
    PG8_WAIT_V(0);
    if constexpr (!ALIGN_EPI) { if (wr == 0) PG8_BAR; }
    PG8_BAR;
    if constexpr (Epi::AFTER_DRAIN) { E.fused(acc, cur, wr, wc, fr, fq, lds, wid, lane); S.done(cur); }
#undef PG8_SA
#undef PG8_SB
#undef PG8_STAGE
#undef PG8_LDA
#undef PG8_LDB
#undef PG8_MMA
#undef PG8_WAIT_V
#undef PG8_WAIT_L
#undef PG8_BAR
#undef PG8_SCHED
}
}
constexpr int NB = 4, T = 8192, D = 1024, M = NB * T, FF = 4096;
constexpr int NRW = 1792, NAT = 1536, NPL = 512, NA = NRW + NAT + NPL  , NG = 3072, NIN = NA + NG  , W = 512;
constexpr int NH = 8, HD = 64, MB_BLK = 256, NBLK = T / MB_BLK  ;
constexpr int NWAVES = 8;
typedef unsigned short bf16;
typedef unsigned v4u __attribute__((ext_vector_type(4)));
typedef unsigned v2u __attribute__((ext_vector_type(2)));
typedef float f32x4 __attribute__((ext_vector_type(4)));
#define LAS __attribute__((address_space(3)))
typedef GAS unsigned gu32;
#define RLX_AGENT __ATOMIC_RELAXED, __HIP_MEMORY_SCOPE_AGENT
#define LDS_WAIT() asm volatile("s_waitcnt lgkmcnt(0)" ::: "memory")
#define VM_WAIT() asm volatile("s_waitcnt vmcnt(0)" ::: "memory")
__device__ __forceinline__ unsigned f2bf(float f) { unsigned u = __builtin_bit_cast(unsigned, f); return (u + 0x7fffu + ((u >> 16) & 1u)) >> 16; }
typedef float f32x2_t __attribute__((ext_vector_type(2)));
typedef __bf16 bf16x2_t __attribute__((ext_vector_type(2)));
__device__ __forceinline__ unsigned pk2(float lo, float hi) { f32x2_t v = {lo, hi}; bf16x2_t b = __builtin_convertvector(v, bf16x2_t); return __builtin_bit_cast(unsigned, b); }
__device__ __forceinline__ float bf2f(unsigned b) { return __builtin_bit_cast(float, b << 16); }
__device__ __forceinline__ float bflo(unsigned w) { return __builtin_bit_cast(float, w << 16); }
__device__ __forceinline__ float bfhi(unsigned w) { return __builtin_bit_cast(float, w & 0xffff0000u); }
__device__ __forceinline__ float sigmoidf_(float x) { return 1.0f / (1.0f + __expf(-x)); }
__device__ __forceinline__ float fsig(float x) { return __builtin_amdgcn_rcpf(1.0f + __builtin_amdgcn_exp2f(-1.4426950408889634f * x)); }
__device__ __forceinline__ float ftanh(float x) { return 2.0f * fsig(2.0f * x) - 1.0f; }
__device__ __forceinline__ float wave_sum(float v) {
#pragma unroll
    for (int o = 1; o < 64; o <<= 1) v += __shfl_xor(v, o);
    return v;
}

constexpr size_t MiB = 1u << 20;
constexpr size_t WS_CTL = 0, CTL_ZERO_BYTES = 1 * MiB;
constexpr size_t WS_WIN = 1 * MiB, WS_WB = 15 * MiB, WS_WO = 18 * MiB, WS_W1 = 20 * MiB, WS_W2 = 28 * MiB, WS_KM = 36 * MiB, WS_LORA = 37 * MiB;
constexpr size_t WS_H = 40 * MiB, WS_RW = 104 * MiB, WS_AT = 216 * MiB, WS_PL = 312 * MiB  , WS_VT = 344 * MiB  ;
constexpr size_t WS_GF = 376 * MiB, WS_PST = 408 * MiB, WS_QST = 440 * MiB, WS_SST = 472 * MiB, WS_BON = 504 * MiB, WS_SB = 505 * MiB, WS_HB = 507 * MiB, WS_END = 511 * MiB;
constexpr size_t WS_GB = 376 * MiB, WS_MB = 440 * MiB, WS_HID = 104 * MiB;
constexpr int CW_BAR = 4096, CW_Q = 8192;
constexpr int RING_OFF = 0, RING_BYTES = 131072;
constexpr int LDS_BYTES = 153600, LDSCTL_OFF = LDS_BYTES - 1024, MISC_OFF = LDSCTL_OFF + 320;
#define XB_TMO      128
#define XB_XCNT(j)  (256  + 64 * (j))
#define XB_XSUB(j)  (1280 + 64 * (j))
#define XB_XGEN(j)  (2304 + 64 * (j))
#define XB_TOP      3328
#define XB_TOPGEN   3392
#define XCD_BAR_WORDS 3456
#define XB_SPIN_CAP (1u << 18)
__device__ __forceinline__ unsigned xb_ld(unsigned* p)              { return __hip_atomic_load(p, __ATOMIC_RELAXED, __HIP_MEMORY_SCOPE_AGENT); }
__device__ __forceinline__ unsigned xb_add(unsigned* p, unsigned v) { return __hip_atomic_fetch_add(p, v, __ATOMIC_RELAXED, __HIP_MEMORY_SCOPE_AGENT); }
__device__ __forceinline__ unsigned xb_xcc_id() { return (unsigned)__builtin_amdgcn_s_getreg((3 << 11) | 20) & 0xFu; }
#define XB_SPIN(cond, bar) do { unsigned _sp = 0; while (cond) { __builtin_amdgcn_s_sleep(1); \
    if ((++_sp & 255u) == 0u) { if (xb_ld(&(bar)[XB_TMO])) break; if (_sp > XB_SPIN_CAP) { atomicAdd(&(bar)[XB_TMO], 1u); break; } } } } while (0)
struct XcdBarrier { unsigned* bar; unsigned x; volatile LAS unsigned* st; };
__device__ __forceinline__ XcdBarrier xcd_barrier_post(unsigned* bar, volatile LAS unsigned* st) {
    XcdBarrier b; b.bar = bar; b.x = xb_xcc_id(); b.st = st;
    if (threadIdx.x == 0) (void)xb_add(&bar[XB_XCNT(b.x)], 1u);
    return b;
}
__device__ __forceinline__ void xcd_barrier_complete(unsigned* bar, unsigned x, unsigned& nloc, unsigned& nx) {
    const unsigned G = gridDim.x * gridDim.y * gridDim.z;
    unsigned sum, cnt, mine, sp = 0u;
    for (;;) {
        sum = 0u; cnt = 0u; mine = 0u;
#pragma unroll
        for (unsigned j = 0; j < 16; ++j) { const unsigned c = xb_ld(&bar[XB_XCNT(j)]); sum += c; cnt += (c > 0u) ? 1u : 0u; mine = (j == x) ? c : mine; }
        if (sum == G) break;
        __builtin_amdgcn_s_sleep(1);
        if ((++sp & 255u) == 0u) { if (xb_ld(&bar[XB_TMO])) break; if (sp > XB_SPIN_CAP) { atomicAdd(&bar[XB_TMO], 1u); break; } }
    }
    nloc = mine > 0u ? mine : 1u; nx = cnt > 0u ? cnt : 1u;
}
__device__ __forceinline__ void xcd_barrier(const XcdBarrier& b) {
    asm volatile("s_waitcnt vmcnt(0)" ::: "memory");
    __syncthreads();
    if (threadIdx.x == 0) {
        unsigned* bar = b.bar;
        __builtin_amdgcn_s_waitcnt(0);
        unsigned nloc = b.st[0], nx = b.st[1];
        if (nloc == 0u) { xcd_barrier_complete(bar, b.x, nloc, nx); b.st[0] = nloc; b.st[1] = nx; }
        const unsigned old = xb_add(&bar[XB_XSUB(b.x)], 1u);
        const unsigned gen = old / nloc;
        if (old + 1u == (gen + 1u) * nloc) {
            __builtin_amdgcn_fence(__ATOMIC_RELEASE, "agent");
            asm volatile("s_waitcnt vmcnt(0)" ::: "memory");
            const unsigned og = xb_add(&bar[XB_TOP], 1u);
            const unsigned tg = og / nx;
            if (og + 1u == (tg + 1u) * nx) xb_add(&bar[XB_TOPGEN], 1u);
            else XB_SPIN(xb_ld(&bar[XB_TOPGEN]) == tg, bar);
            __builtin_amdgcn_fence(__ATOMIC_ACQUIRE, "agent");
            xb_add(&bar[XB_XGEN(b.x)], 1u);
            asm volatile("s_waitcnt vmcnt(0)" ::: "memory");
        } else {
            XB_SPIN(xb_ld(&bar[XB_XGEN(b.x)]) == gen, bar);
            __builtin_amdgcn_fence(__ATOMIC_ACQUIRE, "agent");
            asm volatile("s_waitcnt vmcnt(0)" ::: "memory");
        }
    }
    __syncthreads();
}

struct Args { const float* in[23]; float* out; unsigned char* ws; int ph_lo, ph_hi, l_lo, l_hi, fused, probe_upto, probe_dup, pad; };
enum Phase { PH_CONV = 0, PH_GEMMA, PH_MIX1, PH_MIX2, PH_S3, PH_GB, PH_GO, PH_NORM2, PH_FF1, PH_FF2, PH_N };
enum In { I_X = 0, I_N1G, I_WIN, I_MU, I_W0, I_WUP, I_A0, I_AUP, I_GUP, I_KK, I_KA, I_RK, I_LNG, I_LNB, I_QNG, I_KNG, I_POOLW, I_POOLS, I_WBR, I_WOUT, I_N2G, I_FF1, I_FF2 };

__device__ __forceinline__ void p0_transpose_item(const float* Wm, int K, int N, bf16* WT, LAS float* scr, int item, int lane) {
    const int nblk = N / 32, kb = item / nblk, nb = item % nblk, k0 = 64 * kb, n0 = 32 * nb;
#pragma unroll 8
    for (int i = 0; i < 32; ++i) { const int kk = 2 * i + (lane >> 5); scr[kk * 33 + (lane & 31)] = ((const GAS float*)Wm)[(size_t)(k0 + kk) * N + n0 + (lane & 31)]; }
    LDS_WAIT(); asm volatile("" ::: "memory");
    const int c = lane & 7;
#pragma unroll
    for (int j = 0; j < 4; ++j) { const int n = (lane >> 3) + 8 * j; const LAS float* s = scr + (8 * c) * 33 + n;
        v4u o; o.x = pk2(s[0 * 33], s[1 * 33]); o.y = pk2(s[2 * 33], s[3 * 33]); o.z = pk2(s[4 * 33], s[5 * 33]); o.w = pk2(s[6 * 33], s[7 * 33]);
        *(GAS v4u*)(WT + (size_t)(n0 + n) * K + k0 + 8 * c) = o; }
    LDS_WAIT(); asm volatile("" ::: "memory");
}
__device__ __forceinline__ void rms_rows(const float* x, const float* g, bf16* out, int gw, int NGW, int lane) {
    f32x4 gv[4];
#pragma unroll
    for (int j = 0; j < 4; ++j) gv[j] = ((const GAS f32x4*)g)[lane + 64 * j];
    for (int m0 = gw; m0 < M; m0 += 4 * NGW) {
        f32x4 v[4][4];
#pragma unroll
        for (int rr = 0; rr < 4; ++rr) { const int m = m0 + rr * NGW; if (m < M) { const GAS f32x4* xr = (const GAS f32x4*)(x + (size_t)m * D) + lane;
#pragma unroll
            for (int j = 0; j < 4; ++j) v[rr][j] = xr[64 * j]; } }
#pragma unroll
        for (int rr = 0; rr < 4; ++rr) { const int m = m0 + rr * NGW; if (m < M) {
            float s_ = 0.f;
#pragma unroll
            for (int j = 0; j < 4; ++j) s_ += (v[rr][j].x * v[rr][j].x + v[rr][j].y * v[rr][j].y) + (v[rr][j].z * v[rr][j].z + v[rr][j].w * v[rr][j].w);
            const float rstd = 1.0f / sqrtf(wave_sum(s_) * (1.0f / D) + 1e-6f);
            GAS unsigned long long* o8 = (GAS unsigned long long*)(out + (size_t)m * D) + lane;
#pragma unroll
            for (int j = 0; j < 4; ++j) { const f32x4 y = v[rr][j] * rstd * gv[j]; o8[64 * j] = (unsigned long long)pk2(y.x, y.y) | ((unsigned long long)pk2(y.z, y.w) << 32); } } }
    }
}

__device__ __forceinline__ void ph_attn_prep(LAS unsigned char* lds, bf16* AT, bf16* VT, const float* qg, const float* kg, float* KM, int G, const int tid) {
    LAS float* red = (LAS float*)lds;
    LAS unsigned char* vt = lds + 2048;
    const int lane = tid & 63, wave = tid >> 6, tsub = lane >> 3, dq = lane & 7;
    float gq[8], gk[8];
#pragma unroll
    for (int e = 0; e < 8; ++e) { gq[e] = ((const GAS float*)qg)[dq * 8 + e] * (0.125f * 1.4426950408889634f); gk[e] = ((const GAS float*)kg)[dq * 8 + e]; }
    for (int bid = blockIdx.x; bid < NB * NBLK * NH; bid += G) {
        const int h = bid & 7, n = (bid >> 3) & 31, b = bid >> 8;
        v4u qv[4], kv[4], vv[4];
#pragma unroll
        for (int j = 0; j < 4; ++j) { const size_t row = (size_t)b * T + n * 256 + wave * 32 + 8 * j + tsub; const bf16* qp = AT + row * NAT + h * 64 + dq * 8;
            qv[j] = *(const GAS v4u*)qp; kv[j] = *(const GAS v4u*)(qp + 512); vv[j] = *(const GAS v4u*)(qp + 1024); }
        float ksum[8];
#pragma unroll
        for (int e = 0; e < 8; ++e) ksum[e] = 0.f;
#pragma unroll
        for (int j = 0; j < 4; ++j) {
            const int tok = wave * 32 + 8 * j + tsub; const size_t row = (size_t)b * T + n * 256 + tok; bf16* qp = AT + row * NAT + h * 64 + dq * 8;
            float q[8], k[8];
            q[0] = bflo(qv[j].x); q[1] = bfhi(qv[j].x); q[2] = bflo(qv[j].y); q[3] = bfhi(qv[j].y); q[4] = bflo(qv[j].z); q[5] = bfhi(qv[j].z); q[6] = bflo(qv[j].w); q[7] = bfhi(qv[j].w);
            k[0] = bflo(kv[j].x); k[1] = bfhi(kv[j].x); k[2] = bflo(kv[j].y); k[3] = bfhi(kv[j].y); k[4] = bflo(kv[j].z); k[5] = bfhi(kv[j].z); k[6] = bflo(kv[j].w); k[7] = bfhi(kv[j].w);
            float qs = 0.f, ks = 0.f;
#pragma unroll
            for (int e = 0; e < 8; ++e) { qs += q[e] * q[e]; ks += k[e] * k[e]; }
            qs += __shfl_xor(qs, 1); qs += __shfl_xor(qs, 2); qs += __shfl_xor(qs, 4);
            ks += __shfl_xor(ks, 1); ks += __shfl_xor(ks, 2); ks += __shfl_xor(ks, 4);
            const float rq = 1.0f / sqrtf(qs * (1.0f / 64.0f) + 1e-6f), rk = 1.0f / sqrtf(ks * (1.0f / 64.0f) + 1e-6f);
#pragma unroll
            for (int e = 0; e < 8; ++e) { q[e] = q[e] * rq * gq[e]; k[e] = k[e] * rk * gk[e]; ksum[e] += k[e]; }
            v4u w; w.x = pk2(q[0], q[1]); w.y = pk2(q[2], q[3]); w.z = pk2(q[4], q[5]); w.w = pk2(q[6], q[7]); *(GAS v4u*)qp = w;
            w.x = pk2(k[0], k[1]); w.y = pk2(k[2], k[3]); w.z = pk2(k[4], k[5]); w.w = pk2(k[6], k[7]); *(GAS v4u*)(qp + 512) = w;
            const unsigned vw[4] = {vv[j].x, vv[j].y, vv[j].z, vv[j].w};
#pragma unroll
            for (int e = 0; e < 8; ++e) *(LAS bf16*)(vt + (dq * 8 + e) * 520 + tok * 2) = (bf16)((e & 1) ? (vw[e >> 1] >> 16) : (vw[e >> 1] & 0xffffu));
        }
#pragma unroll
        for (int e = 0; e < 8; ++e) { float s_ = ksum[e]; s_ += __shfl_xor(s_, 8); s_ += __shfl_xor(s_, 16); s_ += __shfl_xor(s_, 32); if (tsub == 0) red[wave * 64 + dq * 8 + e] = s_; }
        __syncthreads();
        if (wave == 0) { float s_ = 0.f; for (int w = 0; w < 8; ++w) s_ += red[w * 64 + lane]; ((GAS float*)KM)[(((size_t)b * NH + h) * NBLK + n) * 64 + lane] = s_ * (1.0f / 256.0f); }
#pragma unroll
        for (int j = 0; j < 4; ++j) { const int c = tid + 512 * j, dim = c >> 5, part = c & 31;
            const v2u lo = *(const LAS v2u*)(vt + dim * 520 + part * 16), hi = *(const LAS v2u*)(vt + dim * 520 + part * 16 + 8);
            v4u w; w.x = lo.x; w.y = lo.y; w.z = hi.x; w.w = hi.y;
            *(GAS v4u*)(VT + (((size_t)(b * NH + h) * (T / 32) + n * 8 + (part >> 2)) * 64 + dim) * 32 + (part & 3) * 8) = w; }
        __syncthreads();
    }
}
__device__ __forceinline__ void ph_pool(bf16* PL_, const bf16* HB_, int G, const int tid) {
    GAS bf16* PL = (GAS bf16*)PL_; const GAS bf16* HB = (const GAS bf16*)HB_;
    const int ch = tid, wdw = 2 << (ch >> 7);
    for (int u = blockIdx.x; u < M / 128; u += G) {
        float ring[16];
        const int tb0 = (u * 128) & (T - 1);
#pragma unroll
        for (int k = 0; k < 16; ++k) ring[k] = 0.f;
        unsigned short hv[15], cu[16], nx[16];
        if (tb0 > 0) {
#pragma unroll
            for (int j = 0; j < 15; ++j) hv[j] = HB[((size_t)(u - 1) * 15 + j) * 512 + ch];
        }
#pragma unroll
        for (int tt = 0; tt < 16; ++tt) cu[tt] = PL[((size_t)u * 128 + tt) * NPL + ch];
        if (tb0 > 0) {
#pragma unroll
            for (int j = 0; j < 15; ++j) ring[1 + j] = bf2f(hv[j]);
        }
#pragma unroll
        for (int t0 = 0; t0 < 128; t0 += 16) {
            if (t0 + 16 < 128) {
#pragma unroll
                for (int tt = 0; tt < 16; ++tt) nx[tt] = PL[((size_t)u * 128 + t0 + 16 + tt) * NPL + ch];
            }
#pragma unroll
            for (int tt = 0; tt < 16; ++tt) {
                const float cur = bf2f(cu[tt]);
                ring[tt] = cur;
                float sm = 0.f;
#pragma unroll
                for (int i = 0; i < 16; ++i) sm += (i < wdw) ? ring[(tt - i) & 15] : 0.f;
                const int tpos = tb0 + t0 + tt; const int cnt = (tpos + 1 < wdw) ? (tpos + 1) : wdw;
                PL[((size_t)u * 128 + t0 + tt) * NPL + ch] = (bf16)f2bf(sm / (float)cnt - cur);
            }
#pragma unroll
            for (int tt = 0; tt < 16; ++tt) cu[tt] = nx[tt];
        }
    }
}
namespace rw {
typedef short bf16x8 __attribute__((ext_vector_type(8)));
constexpr int MATB = 64 * 144;
constexpr int FPB = 64 * 272;
constexpr int X0 = 0, ACTW = X0, ACTA = X0 + MATB, ACTG = X0 + 2 * MATB  , AAB = X0, AAK = X0 + MATB, ARB = X0 + 2 * MATB, ARK = X0 + 3 * MATB;
constexpr int Y0 = 4 * MATB, LWP = Y0, AIP = Y0 + FPB, LGO = AIP, TOT = Y0 + 2 * FPB  , GCV = TOT + 2048  , DG = Y0  , TI = Y0 + 4096  , U0T = Y0 + 8192;
constexpr int PTAB = GCV + 256  ;
constexpr int Z0 = Y0 + 2 * FPB + 2048 + 256 + 3072, AT_ = Z0, BT_ = Z0 + MATB, KT_ = Z0 + 2 * MATB, RT_ = Z0 + 3 * MATB, ATT = Z0 + 4 * MATB, BHT = Z0 + 5 * MATB, KHT = Z0 + 6 * MATB, VTT = Z0 + 7 * MATB;
constexpr int S1_LDS = Z0 + 8 * MATB;
static_assert(S1_LDS <= 153600 - 1024, "S1 LDS map below the control words");
static_assert(U0T + MATB <= TOT, "U0T inside the dead f32 region");
__device__ __forceinline__ f32x4 mma(bf16x8 a, bf16x8 b, f32x4 c) { return __builtin_amdgcn_mfma_f32_16x16x32_bf16(a, b, c, 0, 0, 0); }
__device__ __forceinline__ bf16x8 ldf(const LAS unsigned char* mat, int row, int s, int g) { return *(const LAS bf16x8*)(mat + row * 144 + s * 64 + g * 16); }
__device__ __forceinline__ v2u pack4(f32x4 v) { v2u w; w.x = pk2(v[0], v[1]); w.y = pk2(v[2], v[3]); return w; }
__device__ __forceinline__ f32x4 unpack4(v2u w) { return (f32x4){bflo(w.x), bfhi(w.x), bflo(w.y), bfhi(w.y)}; }
__device__ __forceinline__ void unpack8(v4u w, float* o) { o[0] = bflo(w.x); o[1] = bfhi(w.x); o[2] = bflo(w.y); o[3] = bfhi(w.y); o[4] = bflo(w.z); o[5] = bfhi(w.z); o[6] = bflo(w.w); o[7] = bfhi(w.w); }
__device__ __forceinline__ v4u pack8(const float* o) { v4u w; w.x = pk2(o[0], o[1]); w.y = pk2(o[2], o[3]); w.z = pk2(o[4], o[5]); w.w = pk2(o[6], o[7]); return w; }
#define LDS_BAR() do { asm volatile("s_waitcnt lgkmcnt(0)" ::: "memory"); __builtin_amdgcn_s_barrier(); asm volatile("" ::: "memory"); } while (0)
#define RW_BAR() do { asm volatile("s_waitcnt vmcnt(0) lgkmcnt(0)" ::: "memory"); __builtin_amdgcn_s_barrier(); asm volatile("" ::: "memory"); } while (0)

struct S1Args {
    bf16* RW; const bf16* SB;
    const float *mu, *w0, *a0, *k_k, *k_a, *r_k;
    const bf16 *WupT, *AupT, *GupT;
    bf16 *Gf, *Pst, *Qst; float* bonus;
    bf16 *Rh, *O0; int ldo;
    bf16* Vm; int ldv;
};
__device__ __forceinline__ void s1_unit(LAS unsigned char* lds, const S1Args& A, const int unit, const int tid, int& hprev, const bool dummy = false) {
    const int lane = tid & 63, wave = __builtin_amdgcn_readfirstlane(tid >> 6), r = lane & 15, g = lane >> 4;
    const int h = unit & 7, cidx = unit >> 3  , c_in_b = cidx & 127;
    const size_t row0 = (size_t)cidx * 64;
    const int t = tid >> 3, q = tid & 7;
    float rp[8], kp[8], lwv[8], av[8], kk[8], vp[8];
    if (h != hprev) {
        LAS float* pt = (LAS float*)(lds + PTAB);
        for (int i = tid; i < 768; i += 512) {
            float v_;
            if (i < 192) v_ = ((const GAS float*)A.mu)[(i >> 6) * 512 + h * 64 + (i & 63)];
            else if (i < 448) v_ = ((const GAS float*)A.mu)[1536 + (i - 192)];
            else { const int j = i - 448, c_ = h * 64 + (j & 63); const int w_ = j >> 6; const float* pp_ = (w_ == 0) ? A.w0 : (w_ == 1) ? A.a0 : (w_ == 2) ? A.k_k : (w_ == 3) ? A.k_a : A.r_k; v_ = ((const GAS float*)pp_)[c_]; }
            pt[i] = v_;
        }
        hprev = h;
        LDS_BAR();
    }
    const LAS float* PT = (const LAS float*)(lds + PTAB);
    bf16x8 fw[2], fa[2], fg[4];
    {
        const int cb = wave >> 1;
        const bf16* wu = A.WupT + (size_t)(h * 64 + 16 * cb + r) * 64 + 8 * g;
        const bf16* au = A.AupT + (size_t)(h * 64 + 16 * cb + r) * 64 + 8 * g;
        const bf16* gu = A.GupT + (size_t)(h * 64 + 16 * cb + r) * 128 + 8 * g;
#pragma unroll
        for (int s = 0; s < 2; ++s) { fw[s] = *(const GAS bf16x8*)(wu + 32 * s); fa[s] = *(const GAS bf16x8*)(au + 32 * s); }
#pragma unroll
        for (int s = 0; s < 4; ++s) fg[s] = *(const GAS bf16x8*)(gu + 32 * s);
    }
    {
        const bf16* cur = A.RW + (row0 + t) * NRW;
        const bf16* prv = (t > 0) ? (cur - NRW) : (A.SB + (size_t)(cidx - 1) * NRW);
        const bool hasprev = (t > 0) || (c_in_b > 0);
        float c8[8], p8[8];
#define MIXLOAD(COL, MUO, DST) do { unpack8(*(const GAS v4u*)(cur + (COL)), c8); if (hasprev) unpack8(*(const GAS v4u*)(prv + (COL)), p8); \
            _Pragma("unroll") for (int e = 0; e < 8; ++e) { const float pv_ = hasprev ? p8[e] : 0.f; DST[e] = c8[e] + (pv_ - c8[e]) * PT[(MUO) + e]; } } while (0)
        MIXLOAD(h * 64 + 8 * q, 8 * q, rp); MIXLOAD(512 + h * 64 + 8 * q, 64 + 8 * q, kp); MIXLOAD(1024 + h * 64 + 8 * q, 128 + 8 * q, vp);
#pragma unroll
        for (int e = 0; e < 8; ++e) *(LAS bf16*)(lds + VTT + (8 * q + e) * 144 + t * 2) = (bf16)f2bf(vp[e]);
        float x8[8];
        MIXLOAD(1536 + 8 * q, 192 + 8 * q, x8);
#pragma unroll
        for (int e = 0; e < 8; ++e) x8[e] = ftanh(x8[e]);
        *(LAS v4u*)(lds + ACTW + t * 144 + q * 16) = pack8(x8);
        MIXLOAD(1600 + 8 * q, 256 + 8 * q, x8);
        *(LAS v4u*)(lds + ACTA + t * 144 + q * 16) = pack8(x8);
        MIXLOAD(1664 + 16 * q, 320 + 16 * q, x8);
#pragma unroll
        for (int e = 0; e < 8; ++e) x8[e] = fsig(x8[e]);
        *(LAS v4u*)(lds + ACTG + t * 272 + q * 32) = pack8(x8);
        MIXLOAD(1664 + 16 * q + 8, 320 + 16 * q + 8, x8);
#pragma unroll
        for (int e = 0; e < 8; ++e) x8[e] = fsig(x8[e]);
        *(LAS v4u*)(lds + ACTG + t * 272 + q * 32 + 16) = pack8(x8);
#undef MIXLOAD
    }
    LDS_BAR();
    if (!dummy) *(GAS v4u*)(A.Vm + (row0 + t) * A.ldv + h * 64 + 8 * q) = pack8(vp);
    {
        const int cb = wave >> 1;
#pragma unroll
        for (int i = 0; i < 2; ++i) {
            const int tb = 2 * (wave & 1) + i;
            f32x4 cw = {0.f, 0.f, 0.f, 0.f}, ca = {0.f, 0.f, 0.f, 0.f}, cg = {0.f, 0.f, 0.f, 0.f};
#pragma unroll
            for (int s = 0; s < 2; ++s) { cw = mma(fw[s], ldf(lds + ACTW, 16 * tb + r, s, g), cw); ca = mma(fa[s], ldf(lds + ACTA, 16 * tb + r, s, g), ca); }
#pragma unroll
            for (int s = 0; s < 4; ++s) cg = mma(fg[s], *(const LAS bf16x8*)(lds + ACTG + (16 * tb + r) * 272 + s * 64 + g * 16), cg);
            *(LAS f32x4*)(lds + LWP + (16 * tb + r) * 272 + (16 * cb + 4 * g) * 4) = cw;
            *(LAS f32x4*)(lds + AIP + (16 * tb + r) * 272 + (16 * cb + 4 * g) * 4) = ca;
            if (!dummy) *(GAS v2u*)(A.Gf + (row0 + 16 * tb + r) * W + h * 64 + 16 * cb + 4 * g) = pack4(cg);
        }
    }
    LDS_BAR();
    {
        const f32x4 l0 = *(const LAS f32x4*)(lds + LWP + t * 272 + q * 32), l1 = *(const LAS f32x4*)(lds + LWP + t * 272 + q * 32 + 16);
        const f32x4 a0v = *(const LAS f32x4*)(lds + AIP + t * 272 + q * 32), a1v = *(const LAS f32x4*)(lds + AIP + t * 272 + q * 32 + 16);
        float ss = 0.f, bon = 0.f;
#pragma unroll
        for (int e = 0; e < 8; ++e) { const int hc = 8 * q + e;
            const float lp = (e < 4) ? l0[e & 3] : l1[e & 3], ap = (e < 4) ? a0v[e & 3] : a1v[e & 3];
            lwv[e] = -0.60653065971263342f * fsig(PT[448 + hc] + lp);
            av[e] = fsig(PT[512 + hc] + ap);
            kk[e] = kp[e] * PT[576 + hc]; ss += kk[e] * kk[e];
            kp[e] = kp[e] * (1.0f + (av[e] - 1.0f) * PT[640 + hc]);
            bon += rp[e] * kp[e] * PT[704 + hc]; }
        ss += __shfl_xor(ss, 1); ss += __shfl_xor(ss, 2); ss += __shfl_xor(ss, 4);
        bon += __shfl_xor(bon, 1); bon += __shfl_xor(bon, 2); bon += __shfl_xor(bon, 4);
        const float inv = 1.0f / fmaxf(sqrtf(ss), 1e-12f);
#pragma unroll
        for (int e = 0; e < 8; ++e) kk[e] *= inv;
        if (q == 0 && !dummy) ((GAS float*)A.bonus)[(row0 + t) * 8 + h] = bon;
        *(LAS f32x4*)(lds + LWP + t * 272 + q * 32) = (f32x4){lwv[0], lwv[1], lwv[2], lwv[3]};
        *(LAS f32x4*)(lds + LWP + t * 272 + q * 32 + 16) = (f32x4){lwv[4], lwv[5], lwv[6], lwv[7]};
    }
    LDS_BAR();
    {
        const int c = tid & 63, seg = tid >> 6; float x[8]; float run = 0.f;
#pragma unroll
        for (int i = 0; i < 8; ++i) { run += *(const LAS float*)(lds + LWP + (8 * seg + i) * 272 + c * 4); x[i] = run; }
        *(LAS float*)(lds + TOT + (seg * 64 + c) * 4) = run;
        LDS_BAR();
        float off = 0.f;
        for (int s2 = 0; s2 < seg; ++s2) off += *(const LAS float*)(lds + TOT + (s2 * 64 + c) * 4);
#pragma unroll
        for (int i = 0; i < 8; ++i) *(LAS float*)(lds + LGO + (8 * seg + i) * 272 + c * 4) = x[i] + off;
    }
    LDS_BAR();
    {
        const f32x4 g0 = *(const LAS f32x4*)(lds + LGO + t * 272 + q * 32), g1 = *(const LAS f32x4*)(lds + LGO + t * 272 + q * 32 + 16);
        const f32x4 e0 = *(const LAS f32x4*)(lds + LGO + 63 * 272 + q * 32), e1 = *(const LAS f32x4*)(lds + LGO + 63 * 272 + q * 32 + 16);
        float at[8], bt[8], kt[8], rt[8], bh[8], kh[8];
#pragma unroll
        for (int e = 0; e < 8; ++e) { const float lg = (e < 4) ? g0[e & 3] : g1[e & 3], lc = (e < 4) ? e0[e & 3] : e1[e & 3];
            const float gm1 = __expf(lg - lwv[e]), gi = __expf(-lg), gt = __expf(lg), gr = __expf(lc - lg);
            const float bb = kk[e] * av[e];
            at[e] = -kk[e] * gm1; bt[e] = bb * gi; kt[e] = kp[e] * gi; rt[e] = rp[e] * gt; bh[e] = bb * gr; kh[e] = kp[e] * gr;
            if (t == 63) *(LAS float*)(lds + GCV + (8 * q + e) * 4) = __expf(lc); }
        *(LAS v4u*)(lds + AT_ + t * 144 + q * 16) = pack8(at); *(LAS v4u*)(lds + BT_ + t * 144 + q * 16) = pack8(bt);
        *(LAS v4u*)(lds + KT_ + t * 144 + q * 16) = pack8(kt); *(LAS v4u*)(lds + RT_ + t * 144 + q * 16) = pack8(rt);
#pragma unroll
        for (int e = 0; e < 8; ++e) { const int o = (8 * q + e) * 144 + t * 2;
            *(LAS bf16*)(lds + ATT + o) = (bf16)f2bf(at[e]); *(LAS bf16*)(lds + BHT + o) = (bf16)f2bf(bh[e]); *(LAS bf16*)(lds + KHT + o) = (bf16)f2bf(kh[e]); }
    }
    LDS_BAR();
    {
        const int hv_tb[10] = {0, 1, 1, 2, 2, 2, 3, 3, 3, 3}, hv_jb[10] = {0, 0, 1, 0, 1, 2, 0, 1, 2, 3};
        const int z_tb[6] = {0, 0, 0, 1, 1, 2}, z_jb[6] = {1, 2, 3, 2, 3, 3};
#pragma unroll
        for (int pass = 0; pass < 2; ++pass) {
            const int hi = (pass == 0) ? wave : (wave < 2 ? 8 + wave : -1);
            if (hi >= 0) {
                int tb = 0, jb = 0;
#pragma unroll
                for (int k = 0; k < 10; ++k) if (k == hi) { tb = hv_tb[k]; jb = hv_jb[k]; }
                f32x4 cab = {0.f, 0.f, 0.f, 0.f}, cak = cab, crb = cab, crk = cab;
#pragma unroll
                for (int s = 0; s < 2; ++s) { const bf16x8 fb = ldf(lds + BT_, 16 * jb + r, s, g), fk = ldf(lds + KT_, 16 * jb + r, s, g), fa = ldf(lds + AT_, 16 * tb + r, s, g), fr = ldf(lds + RT_, 16 * tb + r, s, g);
                    cab = mma(fb, fa, cab); cak = mma(fk, fa, cak); crb = mma(fb, fr, crb); crk = mma(fk, fr, crk); }
                const int tt = 16 * tb + r;
#pragma unroll
                for (int e = 0; e < 4; ++e) { const int j = 16 * jb + 4 * g + e; if (!(j < tt)) { cab[e] = 0.f; cak[e] = 0.f; } if (!(j <= tt)) { crb[e] = 0.f; crk[e] = 0.f; } }
                const int o = tt * 144 + (16 * jb + 4 * g) * 2;
                *(LAS v2u*)(lds + AAB + o) = pack4(cab); *(LAS v2u*)(lds + AAK + o) = pack4(cak); *(LAS v2u*)(lds + ARB + o) = pack4(crb); *(LAS v2u*)(lds + ARK + o) = pack4(crk);
                if (tb == jb) *(LAS f32x4*)(lds + DG + ((tb * 16 + r) * 16 + 4 * g) * 4) = cab;
            }
        }
        if (wave >= 2) {
            int tb = 0, jb = 0;
#pragma unroll
            for (int k = 0; k < 6; ++k) if (k == wave - 2) { tb = z_tb[k]; jb = z_jb[k]; }
            const int o = (16 * tb + r) * 144 + (16 * jb + 4 * g) * 2; const v2u z = {0u, 0u};
            *(LAS v2u*)(lds + AAB + o) = z; *(LAS v2u*)(lds + AAK + o) = z; *(LAS v2u*)(lds + ARB + o) = z; *(LAS v2u*)(lds + ARK + o) = z;
        }
    }
    LDS_BAR();
    f32x4 Y[4];
    if (wave == 7) {
        const int blk = lane >> 4, col = lane & 15; float x[16];
#pragma unroll
        for (int tt = 0; tt < 16; ++tt) {
            float acc = (tt == col) ? 1.0f : 0.0f;
            const LAS float* nrow = (const LAS float*)(lds + DG + ((blk * 16 + tt) * 16) * 4);
#pragma unroll
            for (int j = 0; j < 16; ++j) if (j < tt) acc += nrow[j] * x[j];
            x[tt] = acc;
            *(LAS bf16*)(lds + TI + ((blk * 16 + tt) * 16 + col) * 2) = (bf16)f2bf(acc);
        }
    }
    if (wave < 4) {
#pragma unroll
        for (int i = 0; i < 4; ++i) { Y[i] = (f32x4){0.f, 0.f, 0.f, 0.f};
#pragma unroll
            for (int s = 0; s < 2; ++s) Y[i] = mma(ldf(lds + AAK, 16 * i + r, s, g), ldf(lds + VTT, 16 * wave + r, s, g), Y[i]); }
    } else {
#pragma unroll
        for (int i = 0; i < 4; ++i) Y[i] = unpack4(*(const LAS v2u*)(lds + ATT + (16 * (wave - 4) + r) * 144 + (16 * i + 4 * g) * 2));
    }
    LDS_BAR();
    {
        v2u Xb[4];
        const bf16x8 zf = {0, 0, 0, 0, 0, 0, 0, 0};
#pragma unroll
        for (int i = 0; i < 4; ++i) {
            if (i >= 1) {
                v4u bw; bw.x = Xb[0].x; bw.y = Xb[0].y; bw.z = (i >= 2) ? Xb[1].x : 0u; bw.w = (i >= 2) ? Xb[1].y : 0u;
                v4u aw; const v2u a0 = *(const LAS v2u*)(lds + AAB + (16 * i + r) * 144 + (4 * g) * 2), a1 = *(const LAS v2u*)(lds + AAB + (16 * i + r) * 144 + (16 + 4 * g) * 2);
                aw.x = a0.x; aw.y = a0.y; aw.z = a1.x; aw.w = a1.y;
                Y[i] = mma(__builtin_bit_cast(bf16x8, aw), __builtin_bit_cast(bf16x8, bw), Y[i]);
            }
            if (i >= 3) {
                v4u bw; bw.x = Xb[2].x; bw.y = Xb[2].y; bw.z = 0u; bw.w = 0u;
                v4u aw; const v2u a0 = *(const LAS v2u*)(lds + AAB + (16 * i + r) * 144 + (32 + 4 * g) * 2);
                aw.x = a0.x; aw.y = a0.y; aw.z = 0u; aw.w = 0u;
                Y[i] = mma(__builtin_bit_cast(bf16x8, aw), __builtin_bit_cast(bf16x8, bw), Y[i]);
            }
            v4u tw; const v2u t0 = *(const LAS v2u*)(lds + TI + ((i * 16 + r) * 16 + 4 * g) * 2); tw.x = t0.x; tw.y = t0.y; tw.z = 0u; tw.w = 0u;
            v4u yw; const v2u yp = pack4(Y[i]); yw.x = yp.x; yw.y = yp.y; yw.z = 0u; yw.w = 0u;
            const f32x4 X = mma(__builtin_bit_cast(bf16x8, tw), __builtin_bit_cast(bf16x8, yw), (f32x4){0.f, 0.f, 0.f, 0.f});
            Xb[i] = pack4(X);
            const int dst = (wave < 4) ? (U0T + (16 * wave + r) * 144) : (ATT + (16 * (wave - 4) + r) * 144);
            *(LAS v2u*)(lds + dst + (16 * i + 4 * g) * 2) = Xb[i];
        }
        (void)zf;
    }
    LDS_BAR();
    {
#pragma unroll
        for (int i = 0; i < 2; ++i) {
            const int qq = 2 * wave + i, rb = qq >> 2, cb = qq & 3;
            f32x4 crh = {0.f, 0.f, 0.f, 0.f}, co0 = crh, cp = crh, cq = crh;
#pragma unroll
            for (int s = 0; s < 2; ++s) {
                const bf16x8 fah = ldf(lds + ATT, 16 * rb + r, s, g), fu0 = ldf(lds + U0T, 16 * rb + r, s, g), fvt = ldf(lds + VTT, 16 * rb + r, s, g), fbh = ldf(lds + BHT, 16 * rb + r, s, g), fkh = ldf(lds + KHT, 16 * rb + r, s, g);
                const bf16x8 frb = ldf(lds + ARB, 16 * cb + r, s, g), frk = ldf(lds + ARK, 16 * cb + r, s, g), fbhc = ldf(lds + BHT, 16 * cb + r, s, g), fu0c = ldf(lds + U0T, 16 * cb + r, s, g), fvtc = ldf(lds + VTT, 16 * cb + r, s, g);
                crh = mma(fah, frb, crh);
                co0 = mma(fu0, frb, co0); co0 = mma(fvt, frk, co0);
                cp = mma(fah, fbhc, cp);
                cq = mma(fbh, fu0c, cq); cq = mma(fkh, fvtc, cq);
            }
            crh = crh + unpack4(*(const LAS v2u*)(lds + RT_ + (16 * cb + r) * 144 + (16 * rb + 4 * g) * 2));
            if (rb == cb) {
#pragma unroll
                for (int e = 0; e < 4; ++e) if (4 * g + e == r) cp[e] += *(const LAS float*)(lds + GCV + (16 * rb + 4 * g + e) * 4);
            }
            const size_t tok = row0 + 16 * cb + r;
            if (!dummy) {
            *(GAS v2u*)(A.Rh + tok * A.ldo + h * 64 + 16 * rb + 4 * g) = pack4(crh);
            *(GAS v2u*)(A.O0 + tok * A.ldo + h * 64 + 16 * rb + 4 * g) = pack4(co0);
            const size_t su = (size_t)(((cidx >> 7) * 8 + h) * 128 + c_in_b);
            *(GAS v2u*)(A.Pst + su * 4096 + (16 * cb + r) * 64 + 32 * (rb >> 1) + 8 * g + 4 * (rb & 1)) = pack4(cp);
            *(GAS v2u*)(A.Qst + su * 4096 + (16 * cb + r) * 64 + 16 * g + 4 * rb) = pack4(cq);
            }
        }
    }
    LDS_BAR();
}

struct PQ { v4u p[4][2]; v4u q[2]; };
constexpr int S2_NS = 8, S2_SLOTB = 2048, S2_FLAGS = 4 * S2_NS * S2_SLOTB;
__device__ __forceinline__ void s2_chain(LAS unsigned char* lds, const bf16* Pst, const bf16* Qst, const int bh, const int vb, const int lane) {
    const int r = lane & 15, g = lane >> 4;
    f32x4 S[4];
#pragma unroll
    for (int i = 0; i < 4; ++i) S[i] = (f32x4){0.f, 0.f, 0.f, 0.f};
    const size_t ustep = (size_t)4096;
    const bf16* Pp = Pst + ((size_t)bh * 128) * 4096 + r * 64 + 8 * g;
    const bf16* Qp = Qst + ((size_t)bh * 128) * 4096 + (16 * vb + r) * 64 + 16 * g;
    LAS unsigned char* ring = lds + vb * (S2_NS * S2_SLOTB) + r * 128 + g * 8;
    volatile LAS int* prod = (volatile LAS int*)(lds + S2_FLAGS + vb * 64);
    volatile LAS int* cons = (volatile LAS int*)(lds + S2_FLAGS + 256 + vb * 64);
#define S2_GLD(DST, PTR) asm volatile("global_load_dwordx4 %0, %1, off" : "=v"(DST) : "v"(PTR) : "memory")
#define S2_LOAD(B, C) do { const int c_ = (C) < 128 ? (C) : 127; const bf16* P_ = Pp + (size_t)c_ * ustep; const bf16* Q_ = Qp + (size_t)c_ * ustep; \
        _Pragma("unroll") for (int i = 0; i < 4; ++i) { S2_GLD(B.p[i][0], P_ + (16 * i) * 64); S2_GLD(B.p[i][1], P_ + (16 * i) * 64 + 32); } \
        S2_GLD(B.q[0], Q_); S2_GLD(B.q[1], Q_ + 8); } while (0)
#define S2_READY(B, N) asm volatile("s_waitcnt vmcnt(" #N ")" : "+v"(B.p[0][0]), "+v"(B.p[0][1]), "+v"(B.p[1][0]), "+v"(B.p[1][1]), "+v"(B.p[2][0]), "+v"(B.p[2][1]), "+v"(B.p[3][0]), "+v"(B.p[3][1]), "+v"(B.q[0]), "+v"(B.q[1]) :: "memory")
#define S2_STEP(B, C) do { v2u sb_[4]; \
        { unsigned sp_ = 0; while ((C) - *cons >= S2_NS && ++sp_ < (1u << 22)) __builtin_amdgcn_s_sleep(1); } asm volatile("" ::: "memory");   \
        _Pragma("unroll") for (int i = 0; i < 4; ++i) { sb_[i] = pack4(S[i]); *(LAS v2u*)(ring + ((C) & (S2_NS - 1)) * S2_SLOTB + 32 * i) = sb_[i]; } \
        asm volatile("s_waitcnt lgkmcnt(0)" ::: "memory"); if (lane == 0) *prod = (C) + 1; \
        _Pragma("unroll") for (int i = 0; i < 4; ++i) { v2u qi_; qi_.x = (i & 1) ? B.q[i >> 1].z : B.q[i >> 1].x; qi_.y = (i & 1) ? B.q[i >> 1].w : B.q[i >> 1].y; f32x4 n_ = unpack4(qi_); \
            _Pragma("unroll") for (int s_ = 0; s_ < 2; ++s_) { \
                v4u bw_; bw_.x = sb_[2 * s_].x; bw_.y = sb_[2 * s_].y; bw_.z = sb_[2 * s_ + 1].x; bw_.w = sb_[2 * s_ + 1].y; \
                n_ = mma(__builtin_bit_cast(bf16x8, B.p[i][s_]), __builtin_bit_cast(bf16x8, bw_), n_); } \
            S[i] = n_; } } while (0)
#define PIN() asm volatile("" ::: "memory")
    PQ B0, B1, B2, B3;
    asm volatile("s_waitcnt vmcnt(0)" ::: "memory");
    S2_LOAD(B0, 0); S2_LOAD(B1, 1); S2_LOAD(B2, 2);
    for (int c = 0; c < 128; c += 4) {
        S2_LOAD(B3, c + 3); S2_READY(B0, 30); S2_STEP(B0, c);
        S2_LOAD(B0, c + 4); S2_READY(B1, 30); S2_STEP(B1, c + 1);
        S2_LOAD(B1, c + 5); S2_READY(B2, 30); S2_STEP(B2, c + 2);
        S2_LOAD(B2, c + 6); S2_READY(B3, 30); S2_STEP(B3, c + 3);
    }
    asm volatile("s_waitcnt vmcnt(0)" : "+v"(B0.p[0][0]), "+v"(B0.p[0][1]), "+v"(B0.p[1][0]), "+v"(B0.p[1][1]), "+v"(B0.p[2][0]), "+v"(B0.p[2][1]), "+v"(B0.p[3][0]), "+v"(B0.p[3][1]), "+v"(B0.q[0]), "+v"(B0.q[1]),
                 "+v"(B1.p[0][0]), "+v"(B1.p[0][1]), "+v"(B1.p[1][0]), "+v"(B1.p[1][1]), "+v"(B1.p[2][0]), "+v"(B1.p[2][1]), "+v"(B1.p[3][0]), "+v"(B1.p[3][1]), "+v"(B1.q[0]), "+v"(B1.q[1]) :: "memory");
    asm volatile("" : "+v"(B2.p[0][0]), "+v"(B2.p[0][1]), "+v"(B2.p[1][0]), "+v"(B2.p[1][1]), "+v"(B2.p[2][0]), "+v"(B2.p[2][1]), "+v"(B2.p[3][0]), "+v"(B2.p[3][1]), "+v"(B2.q[0]), "+v"(B2.q[1]) :: "memory");
#undef S2_LOAD
#undef S2_STEP
}
__device__ __forceinline__ void s2_storer(LAS unsigned char* lds, bf16* Sst, const int bh, const int vb, const int lane) {
    volatile LAS int* prod = (volatile LAS int*)(lds + S2_FLAGS + vb * 64);
    volatile LAS int* cons = (volatile LAS int*)(lds + S2_FLAGS + 256 + vb * 64);
    const LAS unsigned char* ring = lds + vb * (S2_NS * S2_SLOTB) + lane * 32;
    bf16* Sp = Sst + ((size_t)bh * 128) * 4096 + (16 * vb) * 64 + lane * 16;
    for (int c = 0; c < 128; ++c) {
        { unsigned sp_ = 0; while (*prod <= c && ++sp_ < (1u << 22)) __builtin_amdgcn_s_sleep(1); }
        asm volatile("" ::: "memory");
        const v4u a_ = *(const LAS v4u*)(ring + (c & (S2_NS - 1)) * S2_SLOTB), b_ = *(const LAS v4u*)(ring + (c & (S2_NS - 1)) * S2_SLOTB + 16);
        asm volatile("s_waitcnt lgkmcnt(0)" ::: "memory");
        if (lane == 0) *cons = c + 1;
        *(GAS v4u*)(Sp + (size_t)c * 4096) = a_; *(GAS v4u*)(Sp + (size_t)c * 4096 + 8) = b_;
    }
}

struct S3Args { const bf16 *Rh, *O0; int ldo; const bf16* Vp; int ldv; const bf16 *Gf, *Sst; const float *bonus, *lnx_g, *lnx_b; bf16* Y; int ldy; };
__device__ __forceinline__ void s3_unit(const S3Args& A, const int unit, const int lane) {
    const int r = lane & 15, g = lane >> 4;
    const int h = unit & 7, cidx = unit >> 3;
    bf16x8 sf[4][2];
#pragma unroll
    for (int i = 0; i < 4; ++i)
#pragma unroll
        for (int s = 0; s < 2; ++s) sf[i][s] = *(const GAS bf16x8*)(A.Sst + (size_t)(((cidx >> 7) * 8 + h) * 128 + (cidx & 127)) * 4096 + (16 * i + r) * 64 + 32 * s + 8 * g);
#pragma unroll
    for (int tb = 0; tb < 4; ++tb) {
        const size_t tok = (size_t)cidx * 64 + 16 * tb + r;
        f32x4 o[4];
        bf16x8 fr[2];
#pragma unroll
        for (int s = 0; s < 2; ++s) fr[s] = *(const GAS bf16x8*)(A.Rh + tok * A.ldo + h * 64 + 32 * s + 8 * g);
#pragma unroll
        for (int i = 0; i < 4; ++i) {
            o[i] = unpack4(*(const GAS v2u*)(A.O0 + tok * A.ldo + h * 64 + 16 * i + 4 * g));
#pragma unroll
            for (int s = 0; s < 2; ++s) o[i] = mma(sf[i][s], fr[s], o[i]);
        }
        float sm = 0.f;
#pragma unroll
        for (int i = 0; i < 4; ++i) sm += (o[i][0] + o[i][1]) + (o[i][2] + o[i][3]);
        sm += __shfl_xor(sm, 16); sm += __shfl_xor(sm, 32);
        const float mean = sm * (1.0f / 64.0f); float sq = 0.f;
#pragma unroll
        for (int i = 0; i < 4; ++i) { o[i] = o[i] - mean; sq += (o[i][0] * o[i][0] + o[i][1] * o[i][1]) + (o[i][2] * o[i][2] + o[i][3] * o[i][3]); }
        sq += __shfl_xor(sq, 16); sq += __shfl_xor(sq, 32);
        const float rstd = 1.0f / sqrtf(sq * (1.0f / 64.0f) + 64e-5f);
        const float bon = ((const GAS float*)A.bonus)[tok * 8 + h];
#pragma unroll
        for (int i = 0; i < 4; ++i) {
            const int hv = h * 64 + 16 * i + 4 * g;
            const f32x4 lg = *(const GAS f32x4*)(A.lnx_g + hv), lb = *(const GAS f32x4*)(A.lnx_b + hv);
            const f32x4 vv = unpack4(*(const GAS v2u*)(A.Vp + tok * A.ldv + hv)), gg = unpack4(*(const GAS v2u*)(A.Gf + tok * W + hv));
            const f32x4 y = (o[i] * rstd * lg + lb + vv * bon) * gg;
            *(GAS v2u*)(A.Y + tok * A.ldy + hv) = pack4(y);
        }
    }
}
}
namespace moba {
typedef short bf16x8 __attribute__((ext_vector_type(8)));
constexpr int OSP = 132;
constexpr int OSLOT = 0, LSUM = OSLOT + 4 * 256 * OSP, KMF = LSUM + 4 * 256 * 4, CNT = KMF + 8192, OFFS = CNT + 128, FILL = OFFS + 128, QLIST = FILL + 128, QSLOT = QLIST + 1024, ITEMS = QSLOT + 1024, ICTR = ITEMS + 1024, NVQ = ICTR + 64  , MOBA_LDS = NVQ + 256;
static_assert(MOBA_LDS <= 153600 - 1024, "MoBA LDS map below the control words");
__device__ __forceinline__ f32x4 mma(bf16x8 a, bf16x8 b, f32x4 c) { return __builtin_amdgcn_mfma_f32_16x16x32_bf16(a, b, c, 0, 0, 0); }
struct Args { bf16* AT; const bf16* VT; const float* KM; const float *qg, *kg; };
struct KV { bf16x8 k[2][2]; bf16x8 v[4]; };
__device__ __forceinline__ void item(LAS unsigned char* lds, const Args& A, const int b, const int h, const int qb, const int kblk, const int off, const int cnt, const int nkc, const bool own, const int lane) {
    const int r = lane & 15, g = lane >> 4;
    const float slope2 = exp2f(-(float)(h + 1)) * 1.4426950408889634f;
    int ql[2]; float aq[2];
    bf16x8 qf[2][2];
#pragma unroll
    for (int qt = 0; qt < 2; ++qt) {
        const int li = qt * 16 + r;
        int qv = -1;
        if (own) qv = off + li; else if (li < cnt) qv = (int)*(const LAS unsigned char*)(lds + QLIST + off + li);
        ql[qt] = qv;
        const int qrow = (qv >= 0) ? qv : 0;
        aq[qt] = (qv >= 0) ? -slope2 * (float)(256 * (qb - kblk) + qrow) : -1e30f;
    }
    const bf16* kbase = A.AT + ((size_t)b * T + kblk * 256 + 8 * (r >> 2) + (r & 3)) * NAT + 512 + h * 64 + 8 * g;
    const bf16* vbase = A.VT + (((size_t)(b * NH + h) * (T / 32) + kblk * 8) * 64 + r) * 32 + 8 * g;
    f32x4 o[4][2]; float l[2] = {0.f, 0.f};
#pragma unroll
    for (int db = 0; db < 4; ++db) { o[db][0] = (f32x4){0.f, 0.f, 0.f, 0.f}; o[db][1] = (f32x4){0.f, 0.f, 0.f, 0.f}; }
#define GLD16(DST, PTR) asm volatile("global_load_dwordx4 %0, %1, off" : "=v"(DST) : "v"(PTR) : "memory")
#define MOBA_LOAD(B, KC) do { const int kc_ = (KC) < nkc ? (KC) : nkc - 1; \
        _Pragma("unroll") for (int kt = 0; kt < 2; ++kt) { const bf16* kp_ = kbase + (size_t)(kc_ * 32 + kt * 4) * NAT; GLD16(B.k[kt][0], kp_); GLD16(B.k[kt][1], kp_ + 32); } \
        _Pragma("unroll") for (int db = 0; db < 4; ++db) { const bf16* vp_ = vbase + (size_t)kc_ * (64 * 32) + (16 * db) * 32; GLD16(B.v[db], vp_); } } while (0)
#define MOBA_READY(B, N) asm volatile("s_waitcnt vmcnt(" #N ")" : "+v"(B.k[0][0]), "+v"(B.k[0][1]), "+v"(B.k[1][0]), "+v"(B.k[1][1]), "+v"(B.v[0]), "+v"(B.v[1]), "+v"(B.v[2]), "+v"(B.v[3]) :: "memory")
#define MOBA_COMPUTE(B, KC) do { v4u pb_[2]; const int kb_ = (KC) * 32 + 8 * g; const bool dg_ = own && ((KC) == nkc - 1); \
        _Pragma("unroll") for (int qt = 0; qt < 2; ++qt) { unsigned pw_[4]; const float bs_ = aq[qt] + slope2 * (float)kb_; const int dl_ = ql[qt] - kb_; \
            _Pragma("unroll") for (int kt = 0; kt < 2; ++kt) { f32x4 st_ = {0.f, 0.f, 0.f, 0.f}; \
                st_ = mma(B.k[kt][0], qf[qt][0], st_); st_ = mma(B.k[kt][1], qf[qt][1], st_); f32x4 p_; \
                if (dg_) { _Pragma("unroll") for (int e = 0; e < 4; ++e) { float x_ = (st_[e] + bs_) + cst[kt * 4 + e]; if (4 * kt + e > dl_) x_ = -1e30f; p_[e] = __builtin_amdgcn_exp2f(x_); } } \
                else { _Pragma("unroll") for (int e = 0; e < 4; ++e) p_[e] = __builtin_amdgcn_exp2f((st_[e] + bs_) + cst[kt * 4 + e]); } \
                l[qt] += (p_[0] + p_[1]) + (p_[2] + p_[3]); pw_[2 * kt] = pk2(p_[0], p_[1]); pw_[2 * kt + 1] = pk2(p_[2], p_[3]); } \
            pb_[qt].x = pw_[0]; pb_[qt].y = pw_[1]; pb_[qt].z = pw_[2]; pb_[qt].w = pw_[3]; } \
        _Pragma("unroll") for (int db = 0; db < 4; ++db) { _Pragma("unroll") for (int qt = 0; qt < 2; ++qt) o[db][qt] = mma(B.v[db], __builtin_bit_cast(bf16x8, pb_[qt]), o[db][qt]); } } while (0)
    float cst[8];
#pragma unroll
    for (int j = 0; j < 8; ++j) cst[j] = slope2 * (float)j;
    KV B0, B1, B2;
    MOBA_LOAD(B0, 0); MOBA_LOAD(B1, 1);
#pragma unroll
    for (int qt = 0; qt < 2; ++qt) { const int qrow = (ql[qt] >= 0) ? ql[qt] : 0; const bf16* qp = A.AT + ((size_t)b * T + qb * 256 + qrow) * NAT + h * 64 + 8 * g;
        qf[qt][0] = *(const GAS bf16x8*)qp; qf[qt][1] = *(const GAS bf16x8*)(qp + 32); }
    asm volatile("" :: "v"(qf[0][0]), "v"(qf[0][1]), "v"(qf[1][0]), "v"(qf[1][1]) : "memory");
    for (int kc = 0; kc < nkc; kc += 3) {
        MOBA_LOAD(B2, kc + 2); MOBA_READY(B0, 16); MOBA_COMPUTE(B0, kc);
        if (kc + 1 < nkc) { MOBA_LOAD(B0, kc + 3); MOBA_READY(B1, 16); MOBA_COMPUTE(B1, kc + 1); }
        if (kc + 2 < nkc) { MOBA_LOAD(B1, kc + 4); MOBA_READY(B2, 16); MOBA_COMPUTE(B2, kc + 2); }
    }
    asm volatile("s_waitcnt vmcnt(0)" : "+v"(B0.k[0][0]), "+v"(B0.k[0][1]), "+v"(B0.k[1][0]), "+v"(B0.k[1][1]), "+v"(B0.v[0]), "+v"(B0.v[1]), "+v"(B0.v[2]), "+v"(B0.v[3]),
                 "+v"(B1.k[0][0]), "+v"(B1.k[0][1]), "+v"(B1.k[1][0]), "+v"(B1.k[1][1]), "+v"(B1.v[0]), "+v"(B1.v[1]), "+v"(B1.v[2]), "+v"(B1.v[3]),
                 "+v"(B2.k[0][0]), "+v"(B2.k[0][1]), "+v"(B2.k[1][0]), "+v"(B2.k[1][1]), "+v"(B2.v[0]), "+v"(B2.v[1]), "+v"(B2.v[2]), "+v"(B2.v[3]) :: "memory");
#undef MOBA_LOAD
#undef MOBA_COMPUTE
#pragma unroll
    for (int qt = 0; qt < 2; ++qt) {
        float ls = l[qt]; ls += __shfl_xor(ls, 16); ls += __shfl_xor(ls, 32);
        if (ql[qt] >= 0) {
            const int slot = own ? 0 : (int)*(const LAS unsigned char*)(lds + QSLOT + off + qt * 16 + r);
            LAS unsigned char* op = lds + OSLOT + (slot * 256 + ql[qt]) * OSP + g * 8;
#pragma unroll
            for (int db = 0; db < 4; ++db) { *(LAS unsigned*)(op + db * 32) = pk2(o[db][qt][0], o[db][qt][1]); *(LAS unsigned*)(op + db * 32 + 4) = pk2(o[db][qt][2], o[db][qt][3]); }
            if (g == 0) *((LAS float*)(lds + LSUM) + slot * 256 + ql[qt]) = ls;
        }
    }
}
__device__ __forceinline__ void unit(LAS unsigned char* lds, const Args& A, const int b, const int h, const int qb, const int tid, const bool dummy = false) {
    const int lane = tid & 63;
    const int wave = __builtin_amdgcn_readfirstlane(tid >> 6);
    if (tid < 96) ((LAS int*)(lds + CNT))[tid] = 0;
    if (tid == 0) *(LAS int*)(lds + ICTR) = 0;
    if (tid < 64) {
        float mq = fabsf(((const GAS float*)A.qg)[lane]), mk = fabsf(((const GAS float*)A.kg)[lane]);
#pragma unroll
        for (int o_ = 1; o_ < 64; o_ <<= 1) { mq = fmaxf(mq, __shfl_xor(mq, o_)); mk = fmaxf(mk, __shfl_xor(mk, o_)); }
        const float B2 = 64.0f * (0.125f * 1.4426950408889634f) * mq * mk * 1.02f, sl2 = exp2f(-(float)(h + 1)) * 1.4426950408889634f;
        const float dmin = ((B2 + 152.0f) / sl2 - 1.0f) * (1.0f / 256.0f);
        if (lane == 0) *(LAS int*)(lds + ICTR + 8) = (int)floorf(dmin) + 2;
    }
    int s0 = -1, s1 = -1, s2 = -1, sl0 = 0, sl1 = 0, sl2q = 0, nv = 1;
    if (qb > 0) {
        const int r = lane & 15, g = lane >> 4;
        bf16x8 qf[2][2];
#pragma unroll
        for (int nt = 0; nt < 2; ++nt) { const bf16* qp = A.AT + ((size_t)b * T + qb * 256 + wave * 32 + nt * 16 + r) * NAT + h * 64 + 8 * g;
            qf[nt][0] = *(const GAS bf16x8*)qp; qf[nt][1] = *(const GAS bf16x8*)(qp + 32); }
        f32x4 ga[2][2];
#pragma unroll
        for (int mt = 0; mt < 2; ++mt) {
            ga[mt][0] = (f32x4){0.f, 0.f, 0.f, 0.f}; ga[mt][1] = (f32x4){0.f, 0.f, 0.f, 0.f};
            const float* kmp = A.KM + ((size_t)(b * NH + h) * NBLK + mt * 16 + r) * 64 + 8 * g;
#pragma unroll
            for (int ks = 0; ks < 2; ++ks) {
                const f32x4 x0 = *(const GAS f32x4*)(kmp + 32 * ks), x1 = *(const GAS f32x4*)(kmp + 32 * ks + 4);
                v4u wh, wl;
                wh.x = pk2(x0[0], x0[1]); wh.y = pk2(x0[2], x0[3]); wh.z = pk2(x1[0], x1[1]); wh.w = pk2(x1[2], x1[3]);
                wl.x = pk2(x0[0] - bflo(wh.x), x0[1] - bfhi(wh.x)); wl.y = pk2(x0[2] - bflo(wh.y), x0[3] - bfhi(wh.y));
                wl.z = pk2(x1[0] - bflo(wh.z), x1[1] - bfhi(wh.z)); wl.w = pk2(x1[2] - bflo(wh.w), x1[3] - bfhi(wh.w));
#pragma unroll
                for (int nt = 0; nt < 2; ++nt) { ga[mt][nt] = mma(__builtin_bit_cast(bf16x8, wh), qf[nt][ks], ga[mt][nt]); ga[mt][nt] = mma(__builtin_bit_cast(bf16x8, wl), qf[nt][ks], ga[mt][nt]); }
            }
        }
        float tg0[2], tg1[2], tg2[2]; int ts0[2], ts1[2], ts2[2];
#define MOBA_INS(V, I) do { const float v_ = (V); const int i_ = (I); \
            if (v_ > g0 || (v_ == g0 && i_ < t0)) { g2 = g1; t2 = t1; g1 = g0; t1 = t0; g0 = v_; t0 = i_; } \
            else if (v_ > g1 || (v_ == g1 && i_ < t1)) { g2 = g1; t2 = t1; g1 = v_; t1 = i_; } \
            else if (v_ > g2 || (v_ == g2 && i_ < t2)) { g2 = v_; t2 = i_; } } while (0)
#pragma unroll
        for (int nt = 0; nt < 2; ++nt) {
            float g0 = -3e38f, g1 = -3e38f, g2 = -3e38f; int t0 = -1, t1 = -1, t2 = -1;
#pragma unroll
            for (int mt = 0; mt < 2; ++mt) {
#pragma unroll
                for (int e = 0; e < 4; ++e) { const int n = 16 * mt + 4 * g + e; const float gt = (n < qb) ? ga[mt][nt][e] : -3e38f;
                    if (gt > g0) { g2 = g1; t2 = t1; g1 = g0; t1 = t0; g0 = gt; t0 = n; }
                    else if (gt > g1) { g2 = g1; t2 = t1; g1 = gt; t1 = n; }
                    else if (gt > g2) { g2 = gt; t2 = n; } }
            }
#pragma unroll
            for (int o_ = 16; o_ <= 32; o_ <<= 1) {
                const float b0 = __shfl_xor(g0, o_), b1 = __shfl_xor(g1, o_), b2 = __shfl_xor(g2, o_);
                const int j0 = __shfl_xor(t0, o_), j1 = __shfl_xor(t1, o_), j2 = __shfl_xor(t2, o_);
                MOBA_INS(b0, j0); MOBA_INS(b1, j1); MOBA_INS(b2, j2);
            }
            tg0[nt] = g0; tg1[nt] = g1; tg2[nt] = g2; ts0[nt] = t0; ts1[nt] = t1; ts2[nt] = t2;
        }
#undef MOBA_INS
        if (lane < 32) { s0 = g ? ts0[1] : ts0[0]; s1 = g ? ts1[1] : ts1[0]; s2 = g ? ts2[1] : ts2[0]; }
        (void)tg0; (void)tg1; (void)tg2;
    }
    const int qid = wave * 32 + lane;
    RW_BAR();
    if (lane < 32) {
        const int Dd = *(const LAS int*)(lds + ICTR + 8);
        if (s0 >= 0 && qb - s0 >= Dd) s0 = -1; if (s0 >= 0) sl0 = nv++;
        if (s1 >= 0 && qb - s1 >= Dd) s1 = -1; if (s1 >= 0) sl1 = nv++;
        if (s2 >= 0 && qb - s2 >= Dd) s2 = -1; if (s2 >= 0) sl2q = nv++;
        if (s0 >= 0) __hip_atomic_fetch_add((LAS int*)(lds + CNT) + s0, 1, __ATOMIC_RELAXED, __HIP_MEMORY_SCOPE_WORKGROUP);
        if (s1 >= 0) __hip_atomic_fetch_add((LAS int*)(lds + CNT) + s1, 1, __ATOMIC_RELAXED, __HIP_MEMORY_SCOPE_WORKGROUP);
        if (s2 >= 0) __hip_atomic_fetch_add((LAS int*)(lds + CNT) + s2, 1, __ATOMIC_RELAXED, __HIP_MEMORY_SCOPE_WORKGROUP);
        *(LAS unsigned char*)(lds + NVQ + qid) = (unsigned char)nv;
    }
    RW_BAR();
    if (tid < 64) {
        const int c = (lane < qb) ? ((LAS int*)(lds + CNT))[lane] : 0, nit = (c + 31) >> 5;
        int run = c, irun = nit;
#pragma unroll
        for (int o_ = 1; o_ < 32; o_ <<= 1) { const int t_ = __shfl_up(run, o_), u_ = __shfl_up(irun, o_); if (lane >= o_) { run += t_; irun += u_; } }
        const int tot = __shfl(irun, 31), off = run - c, ib = irun - nit;
        if (lane < qb) ((LAS int*)(lds + OFFS))[lane] = off;
        for (int k = 0; k < nit; ++k) { ((LAS int*)(lds + ITEMS))[2 * (ib + k)] = lane | ((c - 32 * k < 32 ? c - 32 * k : 32) << 8); ((LAS int*)(lds + ITEMS))[2 * (ib + k) + 1] = off + 32 * k; }
        if (lane >= 32 && lane < 40) { const int i = 39 - lane; ((LAS int*)(lds + ITEMS))[2 * (tot + lane - 32)] = qb | (32 << 8) | (1 << 16) | ((i + 1) << 20); ((LAS int*)(lds + ITEMS))[2 * (tot + lane - 32) + 1] = 32 * i; }
        if (lane == 0) *(LAS int*)(lds + ICTR + 4) = tot + 8;
    }
    RW_BAR();
    if (lane < 32) {
        if (s0 >= 0) { const int p = __hip_atomic_fetch_add((LAS int*)(lds + FILL) + s0, 1, __ATOMIC_RELAXED, __HIP_MEMORY_SCOPE_WORKGROUP); *(LAS unsigned char*)(lds + QLIST + ((LAS int*)(lds + OFFS))[s0] + p) = (unsigned char)qid; *(LAS unsigned char*)(lds + QSLOT + ((LAS int*)(lds + OFFS))[s0] + p) = (unsigned char)sl0; }
        if (s1 >= 0) { const int p = __hip_atomic_fetch_add((LAS int*)(lds + FILL) + s1, 1, __ATOMIC_RELAXED, __HIP_MEMORY_SCOPE_WORKGROUP); *(LAS unsigned char*)(lds + QLIST + ((LAS int*)(lds + OFFS))[s1] + p) = (unsigned char)qid; *(LAS unsigned char*)(lds + QSLOT + ((LAS int*)(lds + OFFS))[s1] + p) = (unsigned char)sl1; }
        if (s2 >= 0) { const int p = __hip_atomic_fetch_add((LAS int*)(lds + FILL) + s2, 1, __ATOMIC_RELAXED, __HIP_MEMORY_SCOPE_WORKGROUP); *(LAS unsigned char*)(lds + QLIST + ((LAS int*)(lds + OFFS))[s2] + p) = (unsigned char)qid; *(LAS unsigned char*)(lds + QSLOT + ((LAS int*)(lds + OFFS))[s2] + p) = (unsigned char)sl2q; }
    }
    RW_BAR();
    {
        const int ni = *(const LAS int*)(lds + ICTR + 4);
        for (;;) {
            int idx = 0; if (lane == 0) idx = __hip_atomic_fetch_add((LAS int*)(lds + ICTR), 1, __ATOMIC_RELAXED, __HIP_MEMORY_SCOPE_WORKGROUP);
            idx = __builtin_amdgcn_readfirstlane(idx);
            if (idx >= ni) break;
            const int w0 = __builtin_amdgcn_readfirstlane(((const LAS int*)(lds + ITEMS))[2 * idx]), w1 = __builtin_amdgcn_readfirstlane(((const LAS int*)(lds + ITEMS))[2 * idx + 1]);
            const bool own = (w0 >> 16) & 1;
            item(lds, A, b, h, qb, w0 & 255, w1, (w0 >> 8) & 255, own ? (w0 >> 20) : 8, own, lane);
        }
    }
    RW_BAR();
    if (!dummy) {
        const int qloc = tid >> 1, half = tid & 1;
        const int nslot = (int)*(const LAS unsigned char*)(lds + NVQ + qloc);
        float acc[32]; float lt = 0.f;
#pragma unroll
        for (int d = 0; d < 32; ++d) acc[d] = 0.f;
        for (int sl = 0; sl < nslot; ++sl) {
            const LAS unsigned* op = (const LAS unsigned*)(lds + OSLOT + (sl * 256 + qloc) * OSP + half * 64);
#pragma unroll
            for (int d = 0; d < 16; ++d) { const unsigned w = op[d]; acc[2 * d] += bflo(w); acc[2 * d + 1] += bfhi(w); }
            lt += *((const LAS float*)(lds + LSUM) + sl * 256 + qloc);
        }
        const float inv = 1.0f / lt;
        bf16* yp = A.AT + ((size_t)b * T + qb * 256 + qloc) * NAT + h * 64 + half * 32;
#pragma unroll
        for (int c = 0; c < 4; ++c) { v4u w; w.x = pk2(acc[8*c] * inv, acc[8*c+1] * inv); w.y = pk2(acc[8*c+2] * inv, acc[8*c+3] * inv); w.z = pk2(acc[8*c+4] * inv, acc[8*c+5] * inv); w.w = pk2(acc[8*c+6] * inv, acc[8*c+7] * inv); *(GAS v4u*)(yp + 8 * c) = w; }
    }
    RW_BAR();
}
}

__global__ void __launch_bounds__(NWAVES * 64, 2) mk_fwd(Args args) {
    extern __shared__ __attribute__((aligned(16))) unsigned char lds_raw[];
    LAS unsigned char* lds = (LAS unsigned char*)lds_raw;
    const int tid0 = threadIdx.x;
    const int G = gridDim.x;
    unsigned char* ws0 = args.ws;
    const int lo = args.ph_lo, hi = args.ph_hi;
    const int NGW = G * NWAVES;
    const bool fused = args.fused != 0;
    volatile LAS unsigned* MISC = (volatile LAS unsigned*)(lds + MISC_OFF);
    for (int u = tid0; u < (LDS_BYTES - LDSCTL_OFF) / 4; u += NWAVES * 64) ((LAS unsigned*)(lds + LDSCTL_OFF))[u] = 0u;
    __syncthreads();
    XcdBarrier bar; bar.bar = (unsigned*)(ws0 + WS_CTL) + CW_BAR; bar.x = 0; bar.st = nullptr;
    if (fused) bar = xcd_barrier_post((unsigned*)(ws0 + WS_CTL) + CW_BAR, MISC + 8);
#define IN(k) (lo <= (k) && (k) < hi && (rep == 1 || (k) <= args.probe_upto || (k) == args.probe_dup))
#define SEAM(k) do { if (fused && !((k) == PH_FF2 && L == args.l_hi - 1)) xcd_barrier(bar); } while (0)

    for (int L = args.l_lo; L < args.l_hi; ++L)
    for (int rep = (args.probe_upto >= 0 || args.probe_dup >= 0) ? 0 : 1; rep < 2; ++rep) {
    const float* xsrc = (L == 0) ? args.in[I_X] : args.out;
    int tidL = threadIdx.x; asm volatile("" : "+v"(tidL));
    const int tid = tidL, lane = tid & 63, wave = __builtin_amdgcn_readfirstlane(tid >> 6), gw = blockIdx.x * NWAVES + wave;
    if (IN(PH_CONV)) {
        unsigned char* ws = args.ws; asm volatile("" : "+s"(ws));
        LAS float* scr = (LAS float*)(lds + RING_OFF + wave * 16384);
        const float* w_in = args.in[I_WIN] + (size_t)L * D * NIN;
        const float* w_br = args.in[I_WBR] + (size_t)L * 3 * W * D;
        const float* w_out = args.in[I_WOUT] + (size_t)L * D * D;
        const float* w_f1 = args.in[I_FF1] + (size_t)L * D * FF;
        const float* w_f2 = args.in[I_FF2] + (size_t)L * FF * D;
        constexpr int I_IN = (D / 64) * (NIN / 32), I_B = (W / 64) * (D / 32), I_O = (D / 64) * (D / 32), I_1 = (D / 64) * (FF / 32), I_2 = (FF / 64) * (D / 32);
        constexpr int I_LU = 16, I_LG = 32;
        constexpr int NITEMS = I_IN + 2 * I_B + I_O + I_1 + I_2 + 2 * I_LU + I_LG;
        bf16* WupT = (bf16*)(ws + WS_LORA); bf16* AupT = WupT + 512 * 64; bf16* GupT = AupT + 512 * 64;
        for (int it = gw; it < NITEMS; it += NGW) {
            int r = it;
            if (r < I_IN) { p0_transpose_item(w_in, D, NIN, ((bf16*)(ws + WS_WIN)), scr, r, lane); continue; } r -= I_IN;
            if (r < I_B) { p0_transpose_item(w_br, W, D, ((bf16*)(ws + WS_WB)), scr, r, lane); continue; } r -= I_B;
            if (r < I_B) { p0_transpose_item(w_br + (size_t)W * D, W, D, ((bf16*)(ws + WS_WB)) + (size_t)D * W, scr, r, lane); continue; } r -= I_B;
            if (r < I_O) { p0_transpose_item(w_out, D, D, ((bf16*)(ws + WS_WO)), scr, r, lane); continue; } r -= I_O;
            if (r < I_1) { p0_transpose_item(w_f1, D, FF, ((bf16*)(ws + WS_W1)), scr, r, lane); continue; } r -= I_1;
            if (r < I_2) { p0_transpose_item(w_f2, FF, D, ((bf16*)(ws + WS_W2)), scr, r, lane); continue; } r -= I_2;
            if (r < I_LU) { p0_transpose_item(args.in[I_WUP] + (size_t)L * 64 * W, 64, W, WupT, scr, r, lane); continue; } r -= I_LU;
            if (r < I_LU) { p0_transpose_item(args.in[I_AUP] + (size_t)L * 64 * W, 64, W, AupT, scr, r, lane); continue; } r -= I_LU;
            p0_transpose_item(args.in[I_GUP] + (size_t)L * 128 * W, 128, W, GupT, scr, r, lane);
        }
        const float* pw = args.in[I_POOLW] + (size_t)L * 4 * 128 * 128; const float* ps = args.in[I_POOLS] + (size_t)L * W; const float* wb2 = w_br + (size_t)2 * W * D;
        bf16* WeT = ((bf16*)(ws + WS_WB)) + (size_t)2 * D * W;
        for (int idx = blockIdx.x * (NWAVES * 64) + tid; idx < W * D; idx += G * NWAVES * 64) {
            const int gc = idx / D, dout = idx % D, g = gc >> 7;
            const GAS float* pwr = (const GAS float*)pw + (size_t)gc * 128; float acc = 0.f;
            for (int dp = 0; dp < 128; ++dp) acc += pwr[dp] * ((const GAS float*)ps)[g * 128 + dp] * ((const GAS float*)wb2)[(size_t)(g * 128 + dp) * D + dout];
            ((GAS bf16*)WeT)[(size_t)dout * W + gc] = (bf16)f2bf(acc);
        }
        rms_rows(xsrc, args.in[I_N1G] + (size_t)L * D, ((bf16*)(ws + WS_H)), gw, NGW, lane);
        SEAM(PH_CONV);
    }
    if (IN(PH_GEMMA)) {
        unsigned char* ws = args.ws; asm volatile("" : "+s"(ws));
        pg8::Gemm g{((bf16*)(ws + WS_H)), ((bf16*)(ws + WS_WIN)), M, NA, D, D, D}; pg8::StaticOrder S; S.init(M, NA, G, (int)blockIdx.x);
        pg8::EpiA E{(bf16*)(ws + WS_RW), (bf16*)(ws + WS_AT), (bf16*)(ws + WS_PL), (bf16*)(ws + WS_SB), (bf16*)(ws + WS_HB)};
        pg8::gemm_phase<pg8::EpiA, pg8::StaticOrder, true, true>(lds + RING_OFF, g, S, E, tidL);
        SEAM(PH_GEMMA);
    }
    if (IN(PH_MIX1)) {
        unsigned char* ws = args.ws; asm volatile("" : "+s"(ws));
        ph_attn_prep(lds, (bf16*)(ws + WS_AT), (bf16*)(ws + WS_VT), args.in[I_QNG] + L * 64, args.in[I_KNG] + L * 64, (float*)(ws + WS_KM), G, tidL);
        ph_pool((bf16*)(ws + WS_PL), (const bf16*)(ws + WS_HB), G, tidL);
        __syncthreads();
        rw::S1Args A1; A1.RW = (bf16*)(ws + WS_RW); A1.SB = (const bf16*)(ws + WS_SB);
        A1.mu = args.in[I_MU] + L * NRW; A1.w0 = args.in[I_W0] + L * W; A1.a0 = args.in[I_A0] + L * W; A1.k_k = args.in[I_KK] + L * W; A1.k_a = args.in[I_KA] + L * W; A1.r_k = args.in[I_RK] + L * W;
        A1.WupT = (const bf16*)(ws + WS_LORA); A1.AupT = A1.WupT + 512 * 64; A1.GupT = A1.AupT + 512 * 64;
        A1.Gf = (bf16*)(ws + WS_GF); A1.Pst = (bf16*)(ws + WS_PST); A1.Qst = (bf16*)(ws + WS_QST); A1.bonus = (float*)(ws + WS_BON);
        A1.Rh = (bf16*)(ws + WS_RW); A1.O0 = (bf16*)(ws + WS_RW) + 512; A1.ldo = NRW; A1.Vm = (bf16*)(ws + WS_RW) + 1024; A1.ldv = NRW;
        int hprev = -1;
        for (int unit = blockIdx.x; unit < NB * 128 * NH; unit += G) rw::s1_unit(lds, A1, unit, tidL, hprev);
        SEAM(PH_MIX1);
    }
    if (IN(PH_MIX2)) {
        unsigned char* ws = args.ws; asm volatile("" : "+s"(ws));
        { moba::Args MA; MA.AT = (bf16*)(ws + WS_AT); MA.VT = (const bf16*)(ws + WS_VT); MA.KM = (const float*)(ws + WS_KM); MA.qg = args.in[I_QNG] + L * 64; MA.kg = args.in[I_KNG] + L * 64;
          if (G == 256) {
              const int xcd = blockIdx.x & 7, slot = blockIdx.x >> 3;
              if (slot < 4) {
                  if (tid < 8) *(volatile LAS int*)(lds + rw::S2_FLAGS + tid * 64) = 0;
                  __syncthreads();
                  if (wave < 4) rw::s2_chain(lds, (const bf16*)(ws + WS_PST), (const bf16*)(ws + WS_QST), slot * 8 + xcd, wave, lane);
                  else rw::s2_storer(lds, (bf16*)(ws + WS_SST), slot * 8 + xcd, wave - 4, lane);
              }
              volatile LAS int* qslot = (volatile LAS int*)(lds + LDSCTL_OFF + 64);
              for (int qx = 0; qx < 8; ++qx) {
                  const int x = (xcd + qx) & 7;
                  gu32* qw = (gu32*)(ws + WS_CTL) + CW_Q + (L * 8 + x) * 64;
                  for (;;) {
                      __syncthreads();
                      if (tid == 0) *qslot = (int)__hip_atomic_fetch_add(qw, 1u, RLX_AGENT);
                      __syncthreads();
                      const int u = *qslot;
                      if (u >= 128) break;
                      const int pb_ = u >> 5, ph_ = (pb_ & 1) ? 7 - x : x;
                      int tq = tidL; asm volatile("" : "+v"(tq));
#ifdef PROBE_MOBA2
                      moba::unit(lds, MA, pb_, ph_, 31 - (u & 31), tq, true);
#endif
                      moba::unit(lds, MA, pb_, ph_, 31 - (u & 31), tq);
                  }
              }
          } else {
              for (int bh = blockIdx.x; bh < NB * NH; bh += G) {
                  __syncthreads();
                  if (tid < 8) *(volatile LAS int*)(lds + rw::S2_FLAGS + tid * 64) = 0;
                  __syncthreads();
                  if (wave < 4) rw::s2_chain(lds, (const bf16*)(ws + WS_PST), (const bf16*)(ws + WS_QST), bh, wave, lane);
                  else rw::s2_storer(lds, (bf16*)(ws + WS_SST), bh, wave - 4, lane);
              }
              __syncthreads();
              for (int u = blockIdx.x; u < NB * NH * NBLK; u += G) { int tq = tidL; asm volatile("" : "+v"(tq)); moba::unit(lds, MA, u >> 8, (u >> 5) & 7, u & 31, tq); } } }
        SEAM(PH_MIX2);
    }
    if (IN(PH_S3)) {
        unsigned char* ws = args.ws; asm volatile("" : "+s"(ws));
        rw::S3Args A3; A3.Rh = (const bf16*)(ws + WS_RW); A3.O0 = A3.Rh + 512; A3.ldo = NRW; A3.Vp = A3.Rh + 1024; A3.ldv = NRW; A3.Gf = (const bf16*)(ws + WS_GF); A3.Sst = (const bf16*)(ws + WS_SST);
        A3.bonus = (const float*)(ws + WS_BON); A3.lnx_g = args.in[I_LNG] + L * W; A3.lnx_b = args.in[I_LNB] + L * W; A3.Y = (bf16*)(ws + WS_RW); A3.ldy = NRW;
        for (int unit = gw; unit < NB * 128 * NH; unit += NGW) rw::s3_unit(A3, unit, lane);
        SEAM(PH_S3);
    }
    if (IN(PH_GB)) {
        unsigned char* ws = args.ws; asm volatile("" : "+s"(ws));
        bf16* GBp = (bf16*)(ws + WS_GB); bf16* MBp = (bf16*)(ws + WS_MB);
        pg8::StaticOrder S; S.init(M, D, G, (int)blockIdx.x);
#pragma unroll
        for (int b = 0; b < 3; ++b) {
            { int tv = tidL; asm volatile("" : "+v"(tv)); pg8::Gemm g{((bf16*)(ws + WS_H)), ((bf16*)(ws + WS_WIN)) + (size_t)(NA + b * D) * D, M, D, D, D, D}; pg8::EpiAct<1> E{GBp, D};
              pg8::gemm_phase<pg8::EpiAct<1>, pg8::StaticOrder, true, true>(lds + RING_OFF, g, S, E, tv); }
            __syncthreads();
            { int tv = tidL; asm volatile("" : "+v"(tv)); const bf16* Ysrc = (b == 0) ? (const bf16*)(ws + WS_RW) : (b == 1 ? (const bf16*)(ws + WS_AT) : (const bf16*)(ws + WS_PL));
              pg8::Gemm g{Ysrc, ((bf16*)(ws + WS_WB)) + (size_t)b * D * W, M, D, W, (b == 0) ? NRW : (b == 1 ? NAT : NPL), W};
              if (b == 0) { pg8::EpiBr<true> E{GBp, MBp}; pg8::gemm_phase<pg8::EpiBr<true>, pg8::StaticOrder, true, true>(lds + RING_OFF, g, S, E, tv); }
              else { pg8::EpiBr<false> E{GBp, MBp}; pg8::gemm_phase<pg8::EpiBr<false>, pg8::StaticOrder, true, true>(lds + RING_OFF, g, S, E, tv); } }
            __syncthreads();
        }
        SEAM(PH_GB);
    }
    if (IN(PH_GO)) {
        unsigned char* ws = args.ws; asm volatile("" : "+s"(ws));
        pg8::Gemm g{(const bf16*)(ws + WS_MB), ((bf16*)(ws + WS_WO)), M, D, D, D, D}; pg8::StaticOrder S; S.init(M, D, G, (int)blockIdx.x);
        pg8::EpiRes E{xsrc, args.out};
        pg8::gemm_phase<pg8::EpiRes, pg8::StaticOrder, true, true>(lds + RING_OFF, g, S, E, tidL);
        SEAM(PH_GO);
    }
    if (IN(PH_NORM2)) { unsigned char* ws = args.ws; asm volatile("" : "+s"(ws)); rms_rows(args.out, args.in[I_N2G] + (size_t)L * D, ((bf16*)(ws + WS_H)), gw, NGW, lane); SEAM(PH_NORM2); }
        unsigned char* ws = args.ws; asm volatile("" : "+s"(ws));
    if (IN(PH_FF1)) {
        unsigned char* ws = args.ws; asm volatile("" : "+s"(ws));
        pg8::Gemm g{((bf16*)(ws + WS_H)), ((bf16*)(ws + WS_W1)), M, FF, D, D, D}; pg8::StaticOrder S; S.init(M, FF, G, (int)blockIdx.x);
        pg8::EpiAct<2> E{(bf16*)(ws + WS_HID), FF};
        pg8::gemm_phase<pg8::EpiAct<2>, pg8::StaticOrder, true, true>(lds + RING_OFF, g, S, E, tidL);
        SEAM(PH_FF1);
    }
    if (IN(PH_FF2)) {
        unsigned char* ws = args.ws; asm volatile("" : "+s"(ws));
        pg8::Gemm g{(const bf16*)(ws + WS_HID), ((bf16*)(ws + WS_W2)), M, D, FF, FF, FF}; pg8::StaticOrder S; S.init(M, D, G, (int)blockIdx.x);
        pg8::EpiRes E{args.out, args.out};
        pg8::gemm_phase<pg8::EpiRes, pg8::StaticOrder, true, true>(lds + RING_OFF, g, S, E, tidL);
        SEAM(PH_FF2);
    }
    }
#undef IN
#undef SEAM
}

#ifndef MK_MULTI
#define MK_MULTI 0
#endif
#ifndef PROBE_UPTO
#define PROBE_UPTO (-1)
#endif
#ifndef PROBE_DUP
#define PROBE_DUP (-1)
#endif
extern "C" void kernel_launch(void* const* d_in, const int* in_sizes, int n_in, void* d_out, int out_size, void* d_ws, size_t ws_size, hipStream_t stream) {
    static int grid = 0;
    if (grid == 0) {
        if (n_in != 23 || in_sizes[0] != M * D || out_size != M * D || ws_size < WS_END) { fprintf(stderr, "kernel_launch: unexpected shapes (n_in %d, in0 %d, out %d, ws %zu)\n", n_in, n_in > 0 ? in_sizes[0] : -1, out_size, ws_size); grid = -1; return; }
        int dev = 0, cus = 0;
        if (hipGetDevice(&dev) != hipSuccess || hipDeviceGetAttribute(&cus, hipDeviceAttributeMultiprocessorCount, dev) != hipSuccess) { grid = -1; return; }
        if (hipFuncSetAttribute((const void*)mk_fwd, hipFuncAttributeMaxDynamicSharedMemorySize, LDS_BYTES) != hipSuccess) { fprintf(stderr, "kernel_launch: hipFuncSetAttribute failed\n"); grid = -1; return; }
        int per_cu = 0;
        if (hipOccupancyMaxActiveBlocksPerMultiprocessor(&per_cu, (const void*)mk_fwd, NWAVES * 64, LDS_BYTES) != hipSuccess || per_cu < 1) fprintf(stderr, "kernel_launch: occupancy query reports %d\n", per_cu);
        (void)hipGetLastError();
        grid = cus;
    }
    if (grid < 0) return;
    unsigned char* ws = (unsigned char*)d_ws;
    (void)hipMemsetAsync(ws + WS_CTL, 0, CTL_ZERO_BYTES, stream);
    Args a{};
    for (int i = 0; i < 23; ++i) a.in[i] = (const float*)d_in[i];
    a.out = (float*)d_out; a.ws = ws;
#if MK_MULTI
    for (int L = 0; L < 2; ++L) for (int p = 0; p < PH_N; ++p) { a.ph_lo = p; a.ph_hi = p + 1; a.l_lo = L; a.l_hi = L + 1; a.fused = 0; a.probe_upto = -1; a.probe_dup = -1; hipLaunchKernelGGL(mk_fwd, dim3(grid), dim3(NWAVES * 64), LDS_BYTES, stream, a); }
#else
    a.ph_lo = 0; a.ph_hi = PH_N; a.l_lo = 0; a.l_hi = 2; a.fused = 1; a.probe_upto = PROBE_UPTO; a.probe_dup = PROBE_DUP;
    hipLaunchKernelGGL(mk_fwd, dim3(grid), dim3(NWAVES * 64), LDS_BYTES, stream, a);
#endif
}
```

```cpp
#include <hip/hip_runtime.h>
#include <cstdio>
#include <cstdint>
#define GAS __attribute__((address_space(1)))
namespace pg8 {
#define PG8_LAS __attribute__((address_space(3)))
typedef unsigned short bf16_t;
typedef short bf16x8 __attribute__((ext_vector_type(8)));
typedef float f32x4 __attribute__((ext_vector_type(4)));
typedef unsigned u32x4 __attribute__((ext_vector_type(4)));
constexpr int BM = 256, BK = 64, HALF = 128, HTB = HALF * BK * 2  , STAGE_BYTES = 8 * HTB, NXCD = 8, WGM = 8;

__host__ __device__ __forceinline__ int lds_byte(int r, int c) { const int st = (r >> 4) * 2 + (c >> 5), rr = r & 15, cc = c & 31, ob = rr * 64 + cc * 2; return st * 1024 + (ob ^ (((ob >> 9) & 1) << 5)); }
__host__ __device__ __forceinline__ void stage_rc(int b, int& R, int& C) { const int st = b / 1024, sb = b % 1024, swz = sb ^ (((sb >> 9) & 1) << 5); R = (st >> 1) * 16 + swz / 64; C = (st & 1) * 32 + (swz % 64) / 2; }
__host__ __device__ __forceinline__ int perm32(int rho) { const int n = rho >> 4, i = rho & 15; return 8 * (i >> 2) + 4 * n + (i & 3); }

struct Unit { int pm, pn; };
struct Gemm { const bf16_t* A; const bf16_t* Bt; int M, N, K, lda, ldb; };

struct StaticOrder {
    int nM, nN, nwg, G, c;
    __host__ __device__ void init(int M, int N, int G_, int c_) { nM = M / BM; nN = N / BM; nwg = nM * nN; G = G_; c = c_; }
    __host__ __device__ bool next(int i, Unit& u) const {
        const long L = (long)i * G + c; if (L >= nwg) return false;
        int wgid = (int)L; { const int q = nwg / NXCD, r = nwg % NXCD, xcd = wgid % NXCD, off = wgid / NXCD; wgid = (xcd < r ? xcd * (q + 1) : r * (q + 1) + (xcd - r) * q) + off; }
        const int nig = WGM * nN, gid = wgid / nig, fm = gid * WGM, gsz = (nM - fm) < WGM ? (nM - fm) : WGM;
        u.pm = fm + ((wgid % nig) % gsz); u.pn = (wgid % nig) / gsz; return true;
    }
    __device__ __forceinline__ void a_ready(const Unit&) const {}
    __device__ __forceinline__ void done(const Unit&) const {}
};

__device__ __forceinline__ unsigned cvt_pk_bf16(float lo, float hi) { unsigned r; asm volatile("v_cvt_pk_bf16_f32 %0, %1, %2" : "=v"(r) : "v"(lo), "v"(hi)); return r; }
__device__ __forceinline__ float sigm(float x) { return 1.0f / (1.0f + __expf(-x)); }
__device__ __forceinline__ float bf_lo(unsigned w) { return __builtin_bit_cast(float, w << 16); }
__device__ __forceinline__ float bf_hi(unsigned w) { return __builtin_bit_cast(float, w & 0xffff0000u); }
struct EpiA {
    static constexpr bool PERM = true, AFTER_DRAIN = false;
    bf16_t *RW, *AT, *PL, *SB, *HB;
    __device__ __forceinline__ void operator()(const f32x4 (&acc)[2][2][4][2], const Unit& u, int wr, int wc, int fr, int fq) const {
        bf16_t* base; int ldc, colt;
        if (u.pn < 7) { base = RW; ldc = 1792; colt = u.pn * 256; } else if (u.pn < 13) { base = AT; ldc = 1536; colt = (u.pn - 7) * 256; } else { base = PL; ldc = 512; colt = (u.pn - 13) * 256; }
        const int row0 = u.pm * BM + wr * 64 + fr, col0 = colt + wc * 32 + 8 * fq;
#pragma unroll
        for (int ai = 0; ai < 2; ++ai)
#pragma unroll
            for (int m = 0; m < 4; ++m) { bf16_t* rowp = base + (size_t)(row0 + ai * HALF + m * 16) * ldc + col0;
#pragma unroll
                for (int bj = 0; bj < 2; ++bj) { const f32x4 v0 = acc[ai][bj][m][0], v1 = acc[ai][bj][m][1];
                    u32x4 w; w.x = cvt_pk_bf16(v0[0], v0[1]); w.y = cvt_pk_bf16(v0[2], v0[3]); w.z = cvt_pk_bf16(v1[0], v1[1]); w.w = cvt_pk_bf16(v1[2], v1[3]);
                    *(GAS u32x4*)(rowp + bj * HALF) = w;
                    if (u.pn < 7 && m == 3 && fr == 15) *(GAS u32x4*)(SB + (size_t)((row0 + ai * HALF + 48) >> 6) * 1792 + col0 + bj * HALF) = w;
                    if (u.pn >= 13 && m == 3 && wr == 1 && fr >= 1) *(GAS u32x4*)(HB + ((size_t)((row0 + ai * HALF + 48) >> 7) * 15 + (fr - 1)) * 512 + col0 + bj * HALF) = w; } }
    }
};
template <int MODE> struct EpiAct {
    static constexpr bool PERM = true, AFTER_DRAIN = false;
    bf16_t* O; int ldc;
    __device__ __forceinline__ void operator()(const f32x4 (&acc)[2][2][4][2], const Unit& u, int wr, int wc, int fr, int fq) const {
        const int row0 = u.pm * BM + wr * 64 + fr, col0 = u.pn * BM + wc * 32 + 8 * fq;
#pragma unroll
        for (int ai = 0; ai < 2; ++ai)
#pragma unroll
            for (int m = 0; m < 4; ++m) { bf16_t* rowp = O + (size_t)(row0 + ai * HALF + m * 16) * ldc + col0;
#pragma unroll
                for (int bj = 0; bj < 2; ++bj) { f32x4 v0 = acc[ai][bj][m][0], v1 = acc[ai][bj][m][1];
#pragma unroll
                    for (int e = 0; e < 4; ++e) {
                        if (MODE == 1) { v0[e] = sigm(v0[e]); v1[e] = sigm(v1[e]); }
                        if (MODE == 2) { const float a = fmaxf(v0[e], 0.f), b = fmaxf(v1[e], 0.f); v0[e] = a * a; v1[e] = b * b; } }
                    u32x4 w; w.x = cvt_pk_bf16(v0[0], v0[1]); w.y = cvt_pk_bf16(v0[2], v0[3]); w.z = cvt_pk_bf16(v1[0], v1[1]); w.w = cvt_pk_bf16(v1[2], v1[3]);
                    *(GAS u32x4*)(rowp + bj * HALF) = w; } }
    }
};
template <bool FIRST> struct EpiBr {
    static constexpr bool PERM = true, AFTER_DRAIN = false;
    const bf16_t* GB; bf16_t* MBuf;
    __device__ __forceinline__ void operator()(const f32x4 (&acc)[2][2][4][2], const Unit& u, int wr, int wc, int fr, int fq) const {
        const int row0 = u.pm * BM + wr * 64 + fr, col0 = u.pn * BM + wc * 32 + 8 * fq;
#pragma unroll
        for (int ai = 0; ai < 2; ++ai) {
            u32x4 gw[4][2], mw[4][2];
#pragma unroll
            for (int m = 0; m < 4; ++m) { const size_t off = (size_t)(row0 + ai * HALF + m * 16) * 1024 + col0;
#pragma unroll
                for (int bj = 0; bj < 2; ++bj) { gw[m][bj] = *(const GAS u32x4*)(GB + off + bj * HALF); if (!FIRST) mw[m][bj] = *(const GAS u32x4*)(MBuf + off + bj * HALF); } }
#pragma unroll
            for (int m = 0; m < 4; ++m) { const size_t off = (size_t)(row0 + ai * HALF + m * 16) * 1024 + col0;
#pragma unroll
                for (int bj = 0; bj < 2; ++bj) { const f32x4 v0 = acc[ai][bj][m][0], v1 = acc[ai][bj][m][1]; const u32x4 g_ = gw[m][bj];
                    float o[8] = {bf_lo(g_.x) * v0[0], bf_hi(g_.x) * v0[1], bf_lo(g_.y) * v0[2], bf_hi(g_.y) * v0[3], bf_lo(g_.z) * v1[0], bf_hi(g_.z) * v1[1], bf_lo(g_.w) * v1[2], bf_hi(g_.w) * v1[3]};
                    if (!FIRST) { const u32x4 m_ = mw[m][bj];
                        o[0] += bf_lo(m_.x); o[1] += bf_hi(m_.x); o[2] += bf_lo(m_.y); o[3] += bf_hi(m_.y); o[4] += bf_lo(m_.z); o[5] += bf_hi(m_.z); o[6] += bf_lo(m_.w); o[7] += bf_hi(m_.w); }
                    u32x4 w; w.x = cvt_pk_bf16(o[0], o[1]); w.y = cvt_pk_bf16(o[2], o[3]); w.z = cvt_pk_bf16(o[4], o[5]); w.w = cvt_pk_bf16(o[6], o[7]);
                    *(GAS u32x4*)(MBuf + off + bj * HALF) = w; } }
        }
    }
};
struct EpiRes {
    static constexpr bool PERM = false, AFTER_DRAIN = false;
    const float* base; float* out;
    __device__ __forceinline__ void operator()(const f32x4 (&acc)[2][2][4][2], const Unit& u, int wr, int wc, int fr, int fq) const {
        const int row0 = u.pm * BM + wr * 64 + fr, col0 = u.pn * BM + wc * 32 + 4 * fq;
#pragma unroll
        for (int ai = 0; ai < 2; ++ai) {
            f32x4 bs[4][2][2];
#pragma unroll
            for (int m = 0; m < 4; ++m) { const size_t off = (size_t)(row0 + ai * HALF + m * 16) * 1024 + col0;
#pragma unroll
                for (int bj = 0; bj < 2; ++bj)
#pragma unroll
                    for (int n = 0; n < 2; ++n) bs[m][bj][n] = *(const GAS f32x4*)(base + off + bj * HALF + n * 16); }
#pragma unroll
            for (int m = 0; m < 4; ++m) { const size_t off = (size_t)(row0 + ai * HALF + m * 16) * 1024 + col0;
#pragma unroll
                for (int bj = 0; bj < 2; ++bj)
#pragma unroll
                    for (int n = 0; n < 2; ++n) *(GAS f32x4*)(out + off + bj * HALF + n * 16) = bs[m][bj][n] + acc[ai][bj][m][n]; }
        }
    }
};
template <class Epi, class Sched, bool ALIGN_EPI = false, bool SP2 = false>
__device__ __forceinline__ void gemm_phase(PG8_LAS unsigned char* lds, const Gemm g, const Sched& S, const Epi& E, const int tid) {
    const int wid = __builtin_amdgcn_readfirstlane(tid >> 6), lane = tid & 63, wr = wid >> 2, wc = wid & 3, fr = lane & 15, fq = lane >> 4;
    const int K = g.K, nt = K / BK;
    unsigned voffA[2], voffB[2];
#pragma unroll
    for (int i = 0; i < 2; ++i) { int R, C; stage_rc(tid * 16 + i * 8192, R, C); const int Rb = Epi::PERM ? ((R & ~31) + perm32(R & 31)) : R;
        voffA[i] = (unsigned)(R * g.lda + C) * 2u; voffB[i] = (unsigned)(Rb * g.ldb + C) * 2u; }
    const size_t kstep = (size_t)(BK * 2);
    const size_t hstepA = (size_t)HALF * g.lda * 2, hstepB = (size_t)HALF * g.ldb * 2;
    const size_t tstepA = 2 * hstepA, tstepB = 2 * hstepB;
    const unsigned ldsw = (unsigned)wid * 1024u;
    const int aoff = lds_byte(wr * 64 + fr, fq * 8), boff = lds_byte(wc * 32 + fr, fq * 8);
#define PG8_SA(b, h) (((b) * 2 + (h)) * HTB)
#define PG8_SB(b, h) ((4 + (b) * 2 + (h)) * HTB)
#define PG8_STAGE(bufoff, gbase, voff) do { _Pragma("unroll") for (int _i = 0; _i < 2; ++_i) \
        __builtin_amdgcn_global_load_lds((const unsigned*)((const char*)(gbase) + (voff)[_i]), (PG8_LAS unsigned*)(lds + (bufoff) + ldsw + _i * 8192), 16, 0, 0); } while (0)
#define PG8_LDA(dst, b, h) do { _Pragma("unroll") for (int m = 0; m < 4; ++m) _Pragma("unroll") for (int k = 0; k < 2; ++k) dst[m][k] = *(const PG8_LAS bf16x8*)(lds + PG8_SA(b, h) + aoff + m * 2048 + k * 1024); } while (0)
#define PG8_LDB(dst, b, h) do { _Pragma("unroll") for (int n = 0; n < 2; ++n) _Pragma("unroll") for (int k = 0; k < 2; ++k) dst[n][k] = *(const PG8_LAS bf16x8*)(lds + PG8_SB(b, h) + boff + n * 2048 + k * 1024); } while (0)
#define PG8_MMA(ai, bj, At, Bt) do { __builtin_amdgcn_s_setprio(1); _Pragma("unroll") for (int m = 0; m < 4; ++m) _Pragma("unroll") for (int n = 0; n < 2; ++n) _Pragma("unroll") for (int k = 0; k < 2; ++k) \
        acc[ai][bj][m][n] = __builtin_amdgcn_mfma_f32_16x16x32_bf16(Bt[n][k], At[m][k], acc[ai][bj][m][n], 0, 0, 0); __builtin_amdgcn_s_setprio(0); } while (0)
#define PG8_WAIT_V(n) asm volatile("s_waitcnt vmcnt(" #n ")" ::: "memory")
#define PG8_WAIT_L(n) asm volatile("s_waitcnt lgkmcnt(" #n ")" ::: "memory")
#define PG8_BAR __builtin_amdgcn_s_barrier()
#define PG8_SCHED __builtin_amdgcn_sched_barrier(0)
    Unit cur, nxt; int ui = 0;
    if (!S.next(0, cur)) return;
    f32x4 acc[2][2][4][2];
#pragma unroll
    for (int a = 0; a < 2; ++a)
#pragma unroll
        for (int b = 0; b < 2; ++b)
#pragma unroll
            for (int m = 0; m < 4; ++m)
#pragma unroll
                for (int n = 0; n < 2; ++n) acc[a][b][m][n] = (f32x4){0.f, 0.f, 0.f, 0.f};
    bf16x8 At[4][2], B0[2][2], B1[2][2];
    const char* cA = (const char*)g.A + (size_t)cur.pm * tstepA; const char* cB = (const char*)g.Bt + (size_t)cur.pn * tstepB;
    S.a_ready(cur);
    if constexpr (SP2) {
        PG8_STAGE(PG8_SB(0, 0), cB, voffB); PG8_STAGE(PG8_SB(0, 1), cB + hstepB, voffB); PG8_STAGE(PG8_SA(0, 0), cA, voffA); PG8_STAGE(PG8_SA(0, 1), cA + hstepA, voffA);
        if (wr == 1) PG8_BAR;
        PG8_WAIT_V(2); PG8_BAR;
        PG8_STAGE(PG8_SB(1, 0), cB + kstep, voffB); PG8_STAGE(PG8_SA(1, 0), cA + kstep, voffA); PG8_STAGE(PG8_SB(1, 1), cB + hstepB + kstep, voffB);
        PG8_WAIT_V(6); PG8_BAR;
    } else {
        PG8_STAGE(PG8_SB(0, 0), cB, voffB); PG8_STAGE(PG8_SA(0, 0), cA, voffA); PG8_STAGE(PG8_SB(0, 1), cB + hstepB, voffB); PG8_STAGE(PG8_SA(0, 1), cA + hstepA, voffA);
        if (wr == 1) PG8_BAR;
        PG8_WAIT_V(4); PG8_BAR;
        PG8_STAGE(PG8_SB(1, 0), cB + kstep, voffB); PG8_STAGE(PG8_SA(1, 0), cA + kstep, voffA); PG8_STAGE(PG8_SB(1, 1), cB + hstepB + kstep, voffB);
        PG8_WAIT_V(6); PG8_BAR;
    }
    for (;;) {
        const bool has_next = S.next(ui + 1, nxt);
        const char* nA = has_next ? (const char*)g.A + (size_t)nxt.pm * tstepA : cA; const char* nB = has_next ? (const char*)g.Bt + (size_t)nxt.pn * tstepB : cB;
        for (int t = 0; t < nt; t += 2) {
            const bool last = (t == nt - 2);
            const char* a1 = cA + (size_t)(t + 1) * kstep;
            const char* a2 = last ? nA : cA + (size_t)(t + 2) * kstep; const char* b2 = last ? nB : cB + (size_t)(t + 2) * kstep;
            const char* a3 = a2 + kstep; const char* b3 = b2 + kstep;
            if (last && has_next) S.a_ready(nxt);
            if constexpr (SP2) {
            PG8_LDB(B0, 0, 0); PG8_LDB(B1, 0, 1); PG8_SCHED; PG8_LDA(At, 0, 0); PG8_STAGE(PG8_SA(1, 1), a1 + hstepA, voffA);
            PG8_WAIT_V(8); PG8_WAIT_L(0); PG8_BAR; PG8_MMA(0, 0, At, B0); PG8_MMA(0, 1, At, B1); PG8_BAR; PG8_SCHED;
            PG8_LDA(At, 0, 1); PG8_STAGE(PG8_SB(0, 0), b2, voffB); PG8_STAGE(PG8_SB(0, 1), b2 + hstepB, voffB); PG8_STAGE(PG8_SA(0, 0), a2, voffA);
            PG8_WAIT_V(8); PG8_WAIT_L(0); PG8_BAR; PG8_MMA(1, 0, At, B0); PG8_MMA(1, 1, At, B1); PG8_BAR; PG8_SCHED;
            PG8_LDB(B0, 1, 0); PG8_LDB(B1, 1, 1); PG8_SCHED; PG8_LDA(At, 1, 0); PG8_STAGE(PG8_SA(0, 1), a2 + hstepA, voffA);
            PG8_WAIT_V(8); PG8_WAIT_L(0); PG8_BAR; PG8_MMA(0, 0, At, B0); PG8_MMA(0, 1, At, B1); PG8_BAR; PG8_SCHED;
            PG8_LDA(At, 1, 1); PG8_STAGE(PG8_SB(1, 0), b3, voffB); PG8_STAGE(PG8_SB(1, 1), b3 + hstepB, voffB); PG8_STAGE(PG8_SA(1, 0), a3, voffA);
            PG8_WAIT_V(8); PG8_WAIT_L(0); PG8_BAR; PG8_MMA(1, 0, At, B0); PG8_MMA(1, 1, At, B1); PG8_BAR; PG8_SCHED;
            } else {
            PG8_LDB(B0, 0, 0); PG8_SCHED; PG8_LDA(At, 0, 0); PG8_STAGE(PG8_SA(1, 1), a1 + hstepA, voffA);
            PG8_WAIT_L(8); PG8_BAR; PG8_WAIT_L(0); PG8_MMA(0, 0, At, B0); PG8_BAR; PG8_SCHED;
            PG8_LDB(B1, 0, 1); PG8_STAGE(PG8_SB(0, 0), b2, voffB);
            PG8_BAR; PG8_WAIT_L(0); PG8_MMA(0, 1, At, B1); PG8_BAR;
            PG8_LDA(At, 0, 1); PG8_STAGE(PG8_SA(0, 0), a2, voffA);
            PG8_BAR; PG8_WAIT_L(0); PG8_MMA(1, 0, At, B0); PG8_BAR; PG8_SCHED;
            PG8_STAGE(PG8_SB(0, 1), b2 + hstepB, voffB);
            PG8_WAIT_V(6); PG8_BAR; PG8_MMA(1, 1, At, B1); PG8_BAR;
            PG8_LDB(B0, 1, 0); PG8_SCHED; PG8_LDA(At, 1, 0); PG8_STAGE(PG8_SA(0, 1), a2 + hstepA, voffA);
            PG8_WAIT_L(8); PG8_BAR; PG8_WAIT_L(0); PG8_MMA(0, 0, At, B0); PG8_BAR; PG8_SCHED;
            PG8_LDB(B1, 1, 1); PG8_STAGE(PG8_SB(1, 0), b3, voffB);
            PG8_BAR; PG8_WAIT_L(0); PG8_MMA(0, 1, At, B1); PG8_BAR;
            PG8_LDA(At, 1, 1); PG8_STAGE(PG8_SA(1, 0), a3, voffA);
            PG8_BAR; PG8_WAIT_L(0); PG8_MMA(1, 0, At, B0); PG8_BAR; PG8_SCHED;
            PG8_STAGE(PG8_SB(1, 1), b3 + hstepB, voffB);
            PG8_WAIT_V(6); PG8_BAR; PG8_MMA(1, 1, At, B1); PG8_BAR;
            }
        }
        if constexpr (ALIGN_EPI) { if (wr == 0) PG8_BAR; }
        if constexpr (!Epi::AFTER_DRAIN) { E(acc, cur, wr, wc, fr, fq); S.done(cur); }
        if (!has_next) break;
#pragma unroll
        for (int a = 0; a < 2; ++a)
#pragma unroll
            for (int b = 0; b < 2; ++b)
#pragma unroll
                for (int m = 0; m < 4; ++m)
#pragma unroll
                    for (int n = 0; n < 2; ++n) acc[a][b][m][n] = (f32x4){0.f, 0.f, 0.f, 0.f};
        cur = nxt; cA = nA; cB = nB; ++ui;
        if constexpr (ALIGN_EPI) { if (wr == 1) PG8_BAR; }
    }
    PG8_WAIT_V(0);
    if constexpr (!ALIGN_EPI) { if (wr == 0) PG8_BAR; }
    PG8_BAR;
    if constexpr (Epi::AFTER_DRAIN) { E.fused(acc, cur, wr, wc, fr, fq, lds, wid, lane); S.done(cur); }
#undef PG8_SA
#undef PG8_SB
#undef PG8_STAGE
#undef PG8_LDA
#undef PG8_LDB
#undef PG8_MMA
#undef PG8_WAIT_V
#undef PG8_WAIT_L
#undef PG8_BAR
#undef PG8_SCHED
}
}
constexpr int NB = 4, T = 8192, D = 1024, M = NB * T, FF = 4096;
constexpr int NRW = 1792, NAT = 1536, NPL = 512, NA = NRW + NAT + NPL  , NG = 3072, NIN = NA + NG  , W = 512;
constexpr int NH = 8, HD = 64, MB_BLK = 256, NBLK = T / MB_BLK  ;
constexpr int NWAVES = 8;
typedef unsigned short bf16;
typedef unsigned v4u __attribute__((ext_vector_type(4)));
typedef unsigned v2u __attribute__((ext_vector_type(2)));
typedef float f32x4 __attribute__((ext_vector_type(4)));
#define LAS __attribute__((address_space(3)))
typedef GAS unsigned gu32;
#define RLX_AGENT __ATOMIC_RELAXED, __HIP_MEMORY_SCOPE_AGENT
#define LDS_WAIT() asm volatile("s_waitcnt lgkmcnt(0)" ::: "memory")
#define VM_WAIT() asm volatile("s_waitcnt vmcnt(0)" ::: "memory")
__device__ __forceinline__ unsigned f2bf(float f) { unsigned u = __builtin_bit_cast(unsigned, f); return (u + 0x7fffu + ((u >> 16) & 1u)) >> 16; }
typedef float f32x2_t __attribute__((ext_vector_type(2)));
typedef __bf16 bf16x2_t __attribute__((ext_vector_type(2)));
__device__ __forceinline__ unsigned pk2(float lo, float hi) { f32x2_t v = {lo, hi}; bf16x2_t b = __builtin_convertvector(v, bf16x2_t); return __builtin_bit_cast(unsigned, b); }
__device__ __forceinline__ float bf2f(unsigned b) { return __builtin_bit_cast(float, b << 16); }
__device__ __forceinline__ float bflo(unsigned w) { return __builtin_bit_cast(float, w << 16); }
__device__ __forceinline__ float bfhi(unsigned w) { return __builtin_bit_cast(float, w & 0xffff0000u); }
__device__ __forceinline__ float sigmoidf_(float x) { return 1.0f / (1.0f + __expf(-x)); }
__device__ __forceinline__ float fsig(float x) { return __builtin_amdgcn_rcpf(1.0f + __builtin_amdgcn_exp2f(-1.4426950408889634f * x)); }
__device__ __forceinline__ float ftanh(float x) { return 2.0f * fsig(2.0f * x) - 1.0f; }
__device__ __forceinline__ float wave_sum(float v) {
#pragma unroll
    for (int o = 1; o < 64; o <<= 1) v += __shfl_xor(v, o);
    return v;
}

constexpr size_t MiB = 1u << 20;
constexpr size_t WS_CTL = 0, CTL_ZERO_BYTES = 1 * MiB;
constexpr size_t WS_WIN = 1 * MiB, WS_WB = 15 * MiB, WS_WO = 18 * MiB, WS_W1 = 20 * MiB, WS_W2 = 28 * MiB, WS_KM = 36 * MiB, WS_LORA = 37 * MiB;
constexpr size_t WS_H = 40 * MiB, WS_RW = 104 * MiB, WS_AT = 216 * MiB, WS_PL = 312 * MiB  , WS_VT = 344 * MiB  ;
constexpr size_t WS_GF = 376 * MiB, WS_PST = 408 * MiB, WS_QST = 440 * MiB, WS_SST = 472 * MiB, WS_BON = 504 * MiB, WS_SB = 505 * MiB, WS_HB = 507 * MiB, WS_END = 511 * MiB;
constexpr size_t WS_GB = 376 * MiB, WS_MB = 440 * MiB, WS_HID = 104 * MiB;
constexpr int CW_BAR = 4096, CW_Q = 8192, CW_S3F = 10240  , CW_S3Q = 11264  ;
constexpr int RING_OFF = 0, RING_BYTES = 131072;
constexpr int LDS_BYTES = 153600, LDSCTL_OFF = LDS_BYTES - 1024, MISC_OFF = LDSCTL_OFF + 320;
#define XB_TMO      128
#define XB_XCNT(j)  (256  + 64 * (j))
#define XB_XSUB(j)  (1280 + 64 * (j))
#define XB_XGEN(j)  (2304 + 64 * (j))
#define XB_TOP      3328
#define XB_TOPGEN   3392
#define XCD_BAR_WORDS 3456
#define XB_SPIN_CAP (1u << 18)
__device__ __forceinline__ unsigned xb_ld(unsigned* p)              { return __hip_atomic_load(p, __ATOMIC_RELAXED, __HIP_MEMORY_SCOPE_AGENT); }
__device__ __forceinline__ unsigned xb_add(unsigned* p, unsigned v) { return __hip_atomic_fetch_add(p, v, __ATOMIC_RELAXED, __HIP_MEMORY_SCOPE_AGENT); }
__device__ __forceinline__ unsigned xb_xcc_id() { return (unsigned)__builtin_amdgcn_s_getreg((3 << 11) | 20) & 0xFu; }
#define XB_SPIN(cond, bar) do { unsigned _sp = 0; while (cond) { __builtin_amdgcn_s_sleep(1); \
    if ((++_sp & 255u) == 0u) { if (xb_ld(&(bar)[XB_TMO])) break; if (_sp > XB_SPIN_CAP) { atomicAdd(&(bar)[XB_TMO], 1u); break; } } } } while (0)
struct XcdBarrier { unsigned* bar; unsigned x; volatile LAS unsigned* st; };
__device__ __forceinline__ XcdBarrier xcd_barrier_post(unsigned* bar, volatile LAS unsigned* st) {
    XcdBarrier b; b.bar = bar; b.x = xb_xcc_id(); b.st = st;
    if (threadIdx.x == 0) (void)xb_add(&bar[XB_XCNT(b.x)], 1u);
    return b;
}
__device__ __forceinline__ void xcd_barrier_complete(unsigned* bar, unsigned x, unsigned& nloc, unsigned& nx) {
    const unsigned G = gridDim.x * gridDim.y * gridDim.z;
    unsigned sum, cnt, mine, sp = 0u;
    for (;;) {
        sum = 0u; cnt = 0u; mine = 0u;
#pragma unroll
        for (unsigned j = 0; j < 16; ++j) { const unsigned c = xb_ld(&bar[XB_XCNT(j)]); sum += c; cnt += (c > 0u) ? 1u : 0u; mine = (j == x) ? c : mine; }
        if (sum == G) break;
        __builtin_amdgcn_s_sleep(1);
        if ((++sp & 255u) == 0u) { if (xb_ld(&bar[XB_TMO])) break; if (sp > XB_SPIN_CAP) { atomicAdd(&bar[XB_TMO], 1u); break; } }
    }
    nloc = mine > 0u ? mine : 1u; nx = cnt > 0u ? cnt : 1u;
}
__device__ __forceinline__ void xcd_barrier(const XcdBarrier& b, const bool t0) {
    asm volatile("s_waitcnt vmcnt(0)" ::: "memory");
    __syncthreads();
    if (t0) {
        unsigned* bar = b.bar;
        __builtin_amdgcn_s_waitcnt(0);
        unsigned nloc = b.st[0], nx = b.st[1];
        if (nloc == 0u) { xcd_barrier_complete(bar, b.x, nloc, nx); b.st[0] = nloc; b.st[1] = nx; }
        const unsigned old = xb_add(&bar[XB_XSUB(b.x)], 1u);
        const unsigned gen = old / nloc;
        if (old + 1u == (gen + 1u) * nloc) {
            __builtin_amdgcn_fence(__ATOMIC_RELEASE, "agent");
            asm volatile("s_waitcnt vmcnt(0)" ::: "memory");
            const unsigned og = xb_add(&bar[XB_TOP], 1u);
            const unsigned tg = og / nx;
            if (og + 1u == (tg + 1u) * nx) xb_add(&bar[XB_TOPGEN], 1u);
            else XB_SPIN(xb_ld(&bar[XB_TOPGEN]) == tg, bar);
            __builtin_amdgcn_fence(__ATOMIC_ACQUIRE, "agent");
            xb_add(&bar[XB_XGEN(b.x)], 1u);
            asm volatile("s_waitcnt vmcnt(0)" ::: "memory");
        } else {
            XB_SPIN(xb_ld(&bar[XB_XGEN(b.x)]) == gen, bar);
            __builtin_amdgcn_fence(__ATOMIC_ACQUIRE, "agent");
            asm volatile("s_waitcnt vmcnt(0)" ::: "memory");
        }
    }
    __syncthreads();
}

struct Args { const float* in[23]; float* out; unsigned char* ws; int ph_lo, ph_hi, l_lo, l_hi, fused, probe_upto, probe_dup, pad; };
enum Phase { PH_CONV = 0, PH_GEMMA, PH_MIX1, PH_MIX2, PH_S3, PH_GB, PH_GO, PH_NORM2, PH_FF1, PH_FF2, PH_N };
enum In { I_X = 0, I_N1G, I_WIN, I_MU, I_W0, I_WUP, I_A0, I_AUP, I_GUP, I_KK, I_KA, I_RK, I_LNG, I_LNB, I_QNG, I_KNG, I_POOLW, I_POOLS, I_WBR, I_WOUT, I_N2G, I_FF1, I_FF2 };

__device__ __forceinline__ void p0_transpose_item(const float* Wm, int K, int N, bf16* WT, LAS float* scr, int item, int lane) {
    const int nblk = N / 32, kb = item / nblk, nb = item % nblk, k0 = 64 * kb, n0 = 32 * nb;
#pragma unroll 8
    for (int i = 0; i < 32; ++i) { const int kk = 2 * i + (lane >> 5); scr[kk * 33 + (lane & 31)] = ((const GAS float*)Wm)[(size_t)(k0 + kk) * N + n0 + (lane & 31)]; }
    LDS_WAIT(); asm volatile("" ::: "memory");
    const int c = lane & 7;
#pragma unroll
    for (int j = 0; j < 4; ++j) { const int n = (lane >> 3) + 8 * j; const LAS float* s = scr + (8 * c) * 33 + n;
        v4u o; o.x = pk2(s[0 * 33], s[1 * 33]); o.y = pk2(s[2 * 33], s[3 * 33]); o.z = pk2(s[4 * 33], s[5 * 33]); o.w = pk2(s[6 * 33], s[7 * 33]);
        *(GAS v4u*)(WT + (size_t)(n0 + n) * K + k0 + 8 * c) = o; }
    LDS_WAIT(); asm volatile("" ::: "memory");
}
__device__ __forceinline__ void rms_rows(const float* x, const float* g, bf16* out, int gw, int NGW, int lane) {
    f32x4 gv[4];
#pragma unroll
    for (int j = 0; j < 4; ++j) gv[j] = ((const GAS f32x4*)g)[lane + 64 * j];
    for (int m0 = gw; m0 < M; m0 += 4 * NGW) {
        f32x4 v[4][4];
#pragma unroll
        for (int rr = 0; rr < 4; ++rr) { const int m = m0 + rr * NGW; if (m < M) { const GAS f32x4* xr = (const GAS f32x4*)(x + (size_t)m * D) + lane;
#pragma unroll
            for (int j = 0; j < 4; ++j) v[rr][j] = xr[64 * j]; } }
#pragma unroll
        for (int rr = 0; rr < 4; ++rr) { const int m = m0 + rr * NGW; if (m < M) {
            float s_ = 0.f;
#pragma unroll
            for (int j = 0; j < 4; ++j) s_ += (v[rr][j].x * v[rr][j].x + v[rr][j].y * v[rr][j].y) + (v[rr][j].z * v[rr][j].z + v[rr][j].w * v[rr][j].w);
            const float rstd = 1.0f / sqrtf(wave_sum(s_) * (1.0f / D) + 1e-6f);
            GAS unsigned long long* o8 = (GAS unsigned long long*)(out + (size_t)m * D) + lane;
#pragma unroll
            for (int j = 0; j < 4; ++j) { const f32x4 y = v[rr][j] * rstd * gv[j]; o8[64 * j] = (unsigned long long)pk2(y.x, y.y) | ((unsigned long long)pk2(y.z, y.w) << 32); } } }
    }
}

__device__ __forceinline__ void ph_attn_prep(LAS unsigned char* lds, bf16* AT, bf16* VT, const float* qg, const float* kg, float* KM, int G, const int tid) {
    LAS float* red = (LAS float*)lds;
    LAS unsigned char* vt = lds + 2048;
    const int lane = tid & 63, wave = tid >> 6, tsub = lane >> 3, dq = lane & 7;
    float gq[8], gk[8];
#pragma unroll
    for (int e = 0; e < 8; ++e) { gq[e] = ((const GAS float*)qg)[dq * 8 + e] * (0.125f * 1.4426950408889634f); gk[e] = ((const GAS float*)kg)[dq * 8 + e]; }
    for (int bid = blockIdx.x; bid < NB * NBLK * NH; bid += G) {
        const int h = bid & 7, n = (bid >> 3) & 31, b = bid >> 8;
        v4u qv[4], kv[4], vv[4];
#pragma unroll
        for (int j = 0; j < 4; ++j) { const size_t row = (size_t)b * T + n * 256 + wave * 32 + 8 * j + tsub; const bf16* qp = AT + row * NAT + h * 64 + dq * 8;
            qv[j] = *(const GAS v4u*)qp; kv[j] = *(const GAS v4u*)(qp + 512); vv[j] = *(const GAS v4u*)(qp + 1024); }
        float ksum[8];
#pragma unroll
        for (int e = 0; e < 8; ++e) ksum[e] = 0.f;
#pragma unroll
        for (int j = 0; j < 4; ++j) {
            const int tok = wave * 32 + 8 * j + tsub; const size_t row = (size_t)b * T + n * 256 + tok; bf16* qp = AT + row * NAT + h * 64 + dq * 8;
            float q[8], k[8];
            q[0] = bflo(qv[j].x); q[1] = bfhi(qv[j].x); q[2] = bflo(qv[j].y); q[3] = bfhi(qv[j].y); q[4] = bflo(qv[j].z); q[5] = bfhi(qv[j].z); q[6] = bflo(qv[j].w); q[7] = bfhi(qv[j].w);
            k[0] = bflo(kv[j].x); k[1] = bfhi(kv[j].x); k[2] = bflo(kv[j].y); k[3] = bfhi(kv[j].y); k[4] = bflo(kv[j].z); k[5] = bfhi(kv[j].z); k[6] = bflo(kv[j].w); k[7] = bfhi(kv[j].w);
            float qs = 0.f, ks = 0.f;
#pragma unroll
            for (int e = 0; e < 8; ++e) { qs += q[e] * q[e]; ks += k[e] * k[e]; }
            qs += __shfl_xor(qs, 1); qs += __shfl_xor(qs, 2); qs += __shfl_xor(qs, 4);
            ks += __shfl_xor(ks, 1); ks += __shfl_xor(ks, 2); ks += __shfl_xor(ks, 4);
            const float rq = 1.0f / sqrtf(qs * (1.0f / 64.0f) + 1e-6f), rk = 1.0f / sqrtf(ks * (1.0f / 64.0f) + 1e-6f);
#pragma unroll
            for (int e = 0; e < 8; ++e) { q[e] = q[e] * rq * gq[e]; k[e] = k[e] * rk * gk[e]; ksum[e] += k[e]; }
            v4u w; w.x = pk2(q[0], q[1]); w.y = pk2(q[2], q[3]); w.z = pk2(q[4], q[5]); w.w = pk2(q[6], q[7]); *(GAS v4u*)qp = w;
            w.x = pk2(k[0], k[1]); w.y = pk2(k[2], k[3]); w.z = pk2(k[4], k[5]); w.w = pk2(k[6], k[7]); *(GAS v4u*)(qp + 512) = w;
            const unsigned vw[4] = {vv[j].x, vv[j].y, vv[j].z, vv[j].w};
#pragma unroll
            for (int e = 0; e < 8; ++e) *(LAS bf16*)(vt + (dq * 8 + e) * 520 + tok * 2) = (bf16)((e & 1) ? (vw[e >> 1] >> 16) : (vw[e >> 1] & 0xffffu));
        }
#pragma unroll
        for (int e = 0; e < 8; ++e) { float s_ = ksum[e]; s_ += __shfl_xor(s_, 8); s_ += __shfl_xor(s_, 16); s_ += __shfl_xor(s_, 32); if (tsub == 0) red[wave * 64 + dq * 8 + e] = s_; }
        __syncthreads();
        if (wave == 0) { float s_ = 0.f; for (int w = 0; w < 8; ++w) s_ += red[w * 64 + lane]; ((GAS float*)KM)[(((size_t)b * NH + h) * NBLK + n) * 64 + lane] = s_ * (1.0f / 256.0f); }
#pragma unroll
        for (int j = 0; j < 4; ++j) { const int c = tid + 512 * j, dim = c >> 5, part = c & 31;
            const v2u lo = *(const LAS v2u*)(vt + dim * 520 + part * 16), hi = *(const LAS v2u*)(vt + dim * 520 + part * 16 + 8);
            v4u w; w.x = lo.x; w.y = lo.y; w.z = hi.x; w.w = hi.y;
            *(GAS v4u*)(VT + (((size_t)(b * NH + h) * (T / 32) + n * 8 + (part >> 2)) * 64 + dim) * 32 + (part & 3) * 8) = w; }
        __syncthreads();
    }
}
__device__ __forceinline__ void ph_pool(bf16* PL_, const bf16* HB_, int G, const int tid) {
    GAS bf16* PL = (GAS bf16*)PL_; const GAS bf16* HB = (const GAS bf16*)HB_;
    const int ch = tid, wdw = 2 << (ch >> 7);
    for (int u = blockIdx.x; u < M / 128; u += G) {
        float ring[16];
        const int tb0 = (u * 128) & (T - 1);
#pragma unroll
        for (int k = 0; k < 16; ++k) ring[k] = 0.f;
        unsigned short hv[15], cu[16], nx[16];
        if (tb0 > 0) {
#pragma unroll
            for (int j = 0; j < 15; ++j) hv[j] = HB[((size_t)(u - 1) * 15 + j) * 512 + ch];
        }
#pragma unroll
        for (int tt = 0; tt < 16; ++tt) cu[tt] = PL[((size_t)u * 128 + tt) * NPL + ch];
        if (tb0 > 0) {
#pragma unroll
            for (int j = 0; j < 15; ++j) ring[1 + j] = bf2f(hv[j]);
        }
#pragma unroll
        for (int t0 = 0; t0 < 128; t0 += 16) {
            if (t0 + 16 < 128) {
#pragma unroll
                for (int tt = 0; tt < 16; ++tt) nx[tt] = PL[((size_t)u * 128 + t0 + 16 + tt) * NPL + ch];
            }
#pragma unroll
            for (int tt = 0; tt < 16; ++tt) {
                const float cur = bf2f(cu[tt]);
                ring[tt] = cur;
                float sm = 0.f;
#pragma unroll
                for (int i = 0; i < 16; ++i) sm += (i < wdw) ? ring[(tt - i) & 15] : 0.f;
                const int tpos = tb0 + t0 + tt; const int cnt = (tpos + 1 < wdw) ? (tpos + 1) : wdw;
                PL[((size_t)u * 128 + t0 + tt) * NPL + ch] = (bf16)f2bf(sm / (float)cnt - cur);
            }
#pragma unroll
            for (int tt = 0; tt < 16; ++tt) cu[tt] = nx[tt];
        }
    }
}
namespace rw {
typedef short bf16x8 __attribute__((ext_vector_type(8)));
constexpr int MATB = 64 * 144;
constexpr int FPB = 64 * 272;
constexpr int X0 = 0, ACTW = X0, ACTA = X0 + MATB, ACTG = X0 + 2 * MATB  , AAB = X0, AAK = X0 + MATB, ARB = X0 + 2 * MATB, ARK = X0 + 3 * MATB;
constexpr int Y0 = 4 * MATB, LWP = Y0, AIP = Y0 + FPB, LGO = AIP, TOT = Y0 + 2 * FPB  , GCV = TOT + 2048  , DG = Y0  , TI = Y0 + 4096  , U0T = Y0 + 8192;
constexpr int PTAB = GCV + 256  ;
constexpr int Z0 = Y0 + 2 * FPB + 2048 + 256 + 3072, AT_ = Z0, BT_ = Z0 + MATB, KT_ = Z0 + 2 * MATB, RT_ = Z0 + 3 * MATB, ATT = Z0 + 4 * MATB, BHT = Z0 + 5 * MATB, KHT = Z0 + 6 * MATB, VTT = Z0 + 7 * MATB;
constexpr int S1_LDS = Z0 + 8 * MATB;
static_assert(S1_LDS <= 153600 - 1024, "S1 LDS map below the control words");
static_assert(U0T + MATB <= TOT, "U0T inside the dead f32 region");
__device__ __forceinline__ f32x4 mma(bf16x8 a, bf16x8 b, f32x4 c) { return __builtin_amdgcn_mfma_f32_16x16x32_bf16(a, b, c, 0, 0, 0); }
__device__ __forceinline__ bf16x8 ldf(const LAS unsigned char* mat, int row, int s, int g) { return *(const LAS bf16x8*)(mat + row * 144 + s * 64 + g * 16); }
__device__ __forceinline__ v2u pack4(f32x4 v) { v2u w; w.x = pk2(v[0], v[1]); w.y = pk2(v[2], v[3]); return w; }
__device__ __forceinline__ f32x4 unpack4(v2u w) { return (f32x4){bflo(w.x), bfhi(w.x), bflo(w.y), bfhi(w.y)}; }
__device__ __forceinline__ void unpack8(v4u w, float* o) { o[0] = bflo(w.x); o[1] = bfhi(w.x); o[2] = bflo(w.y); o[3] = bfhi(w.y); o[4] = bflo(w.z); o[5] = bfhi(w.z); o[6] = bflo(w.w); o[7] = bfhi(w.w); }
__device__ __forceinline__ v4u pack8(const float* o) { v4u w; w.x = pk2(o[0], o[1]); w.y = pk2(o[2], o[3]); w.z = pk2(o[4], o[5]); w.w = pk2(o[6], o[7]); return w; }
#define LDS_BAR() do { asm volatile("s_waitcnt lgkmcnt(0)" ::: "memory"); __builtin_amdgcn_s_barrier(); asm volatile("" ::: "memory"); } while (0)
#define RW_BAR() do { asm volatile("s_waitcnt vmcnt(0) lgkmcnt(0)" ::: "memory"); __builtin_amdgcn_s_barrier(); asm volatile("" ::: "memory"); } while (0)

struct S1Args {
    bf16* RW; const bf16* SB;
    const float *mu, *w0, *a0, *k_k, *k_a, *r_k;
    const bf16 *WupT, *AupT, *GupT;
    bf16 *Gf, *Pst, *Qst; float* bonus;
    bf16 *Rh, *O0; int ldo;
    bf16* Vm; int ldv;
};
__device__ __forceinline__ void s1_unit(LAS unsigned char* lds, const S1Args& A, const int unit, const int tid, int& hprev, const bool dummy = false) {
    const int lane = tid & 63, wave = __builtin_amdgcn_readfirstlane(tid >> 6), r = lane & 15, g = lane >> 4;
    const int h = unit & 7, cidx = unit >> 3  , c_in_b = cidx & 127;
    const size_t row0 = (size_t)cidx * 64;
    const int t = tid >> 3, q = tid & 7;
    float rp[8], kp[8], lwv[8], av[8], kk[8], vp[8];
    if (h != hprev) {
        LAS float* pt = (LAS float*)(lds + PTAB);
        for (int i = tid; i < 768; i += 512) {
            float v_;
            if (i < 192) v_ = ((const GAS float*)A.mu)[(i >> 6) * 512 + h * 64 + (i & 63)];
            else if (i < 448) v_ = ((const GAS float*)A.mu)[1536 + (i - 192)];
            else { const int j = i - 448, c_ = h * 64 + (j & 63); const int w_ = j >> 6; const float* pp_ = (w_ == 0) ? A.w0 : (w_ == 1) ? A.a0 : (w_ == 2) ? A.k_k : (w_ == 3) ? A.k_a : A.r_k; v_ = ((const GAS float*)pp_)[c_]; }
            pt[i] = v_;
        }
        hprev = h;
        LDS_BAR();
    }
    const LAS float* PT = (const LAS float*)(lds + PTAB);
    bf16x8 fw[2], fa[2], fg[4];
    {
        const int cb = wave >> 1;
        const bf16* wu = A.WupT + (size_t)(h * 64 + 16 * cb + r) * 64 + 8 * g;
        const bf16* au = A.AupT + (size_t)(h * 64 + 16 * cb + r) * 64 + 8 * g;
        const bf16* gu = A.GupT + (size_t)(h * 64 + 16 * cb + r) * 128 + 8 * g;
#pragma unroll
        for (int s = 0; s < 2; ++s) { fw[s] = *(const GAS bf16x8*)(wu + 32 * s); fa[s] = *(const GAS bf16x8*)(au + 32 * s); }
#pragma unroll
        for (int s = 0; s < 4; ++s) fg[s] = *(const GAS bf16x8*)(gu + 32 * s);
    }
    {
        const bf16* cur = A.RW + (row0 + t) * NRW;
        const bf16* prv = (t > 0) ? (cur - NRW) : (A.SB + (size_t)(cidx - 1) * NRW);
        const bool hasprev = (t > 0) || (c_in_b > 0);
        float c8[8], p8[8];
#define MIXLOAD(COL, MUO, DST) do { unpack8(*(const GAS v4u*)(cur + (COL)), c8); if (hasprev) unpack8(*(const GAS v4u*)(prv + (COL)), p8); \
            _Pragma("unroll") for (int e = 0; e < 8; ++e) { const float pv_ = hasprev ? p8[e] : 0.f; DST[e] = c8[e] + (pv_ - c8[e]) * PT[(MUO) + e]; } } while (0)
        MIXLOAD(h * 64 + 8 * q, 8 * q, rp); MIXLOAD(512 + h * 64 + 8 * q, 64 + 8 * q, kp); MIXLOAD(1024 + h * 64 + 8 * q, 128 + 8 * q, vp);
#pragma unroll
        for (int e = 0; e < 8; ++e) *(LAS bf16*)(lds + VTT + (8 * q + e) * 144 + t * 2) = (bf16)f2bf(vp[e]);
        float x8[8];
        MIXLOAD(1536 + 8 * q, 192 + 8 * q, x8);
#pragma unroll
        for (int e = 0; e < 8; ++e) x8[e] = ftanh(x8[e]);
        *(LAS v4u*)(lds + ACTW + t * 144 + q * 16) = pack8(x8);
        MIXLOAD(1600 + 8 * q, 256 + 8 * q, x8);
        *(LAS v4u*)(lds + ACTA + t * 144 + q * 16) = pack8(x8);
        MIXLOAD(1664 + 16 * q, 320 + 16 * q, x8);
#pragma unroll
        for (int e = 0; e < 8; ++e) x8[e] = fsig(x8[e]);
        *(LAS v4u*)(lds + ACTG + t * 272 + q * 32) = pack8(x8);
        MIXLOAD(1664 + 16 * q + 8, 320 + 16 * q + 8, x8);
#pragma unroll
        for (int e = 0; e < 8; ++e) x8[e] = fsig(x8[e]);
        *(LAS v4u*)(lds + ACTG + t * 272 + q * 32 + 16) = pack8(x8);
#undef MIXLOAD
    }
    LDS_BAR();
    if (!dummy) *(GAS v4u*)(A.Vm + (row0 + t) * A.ldv + h * 64 + 8 * q) = pack8(vp);
    {
        const int cb = wave >> 1;
#pragma unroll
        for (int i = 0; i < 2; ++i) {
            const int tb = 2 * (wave & 1) + i;
            f32x4 cw = {0.f, 0.f, 0.f, 0.f}, ca = {0.f, 0.f, 0.f, 0.f}, cg = {0.f, 0.f, 0.f, 0.f};
#pragma unroll
            for (int s = 0; s < 2; ++s) { cw = mma(fw[s], ldf(lds + ACTW, 16 * tb + r, s, g), cw); ca = mma(fa[s], ldf(lds + ACTA, 16 * tb + r, s, g), ca); }
#pragma unroll
            for (int s = 0; s < 4; ++s) cg = mma(fg[s], *(const LAS bf16x8*)(lds + ACTG + (16 * tb + r) * 272 + s * 64 + g * 16), cg);
            *(LAS f32x4*)(lds + LWP + (16 * tb + r) * 272 + (16 * cb + 4 * g) * 4) = cw;
            *(LAS f32x4*)(lds + AIP + (16 * tb + r) * 272 + (16 * cb + 4 * g) * 4) = ca;
            if (!dummy) *(GAS v2u*)(A.Gf + (row0 + 16 * tb + r) * W + h * 64 + 16 * cb + 4 * g) = pack4(cg);
        }
    }
    LDS_BAR();
    {
        const f32x4 l0 = *(const LAS f32x4*)(lds + LWP + t * 272 + q * 32), l1 = *(const LAS f32x4*)(lds + LWP + t * 272 + q * 32 + 16);
        const f32x4 a0v = *(const LAS f32x4*)(lds + AIP + t * 272 + q * 32), a1v = *(const LAS f32x4*)(lds + AIP + t * 272 + q * 32 + 16);
        float ss = 0.f, bon = 0.f;
#pragma unroll
        for (int e = 0; e < 8; ++e) { const int hc = 8 * q + e;
            const float lp = (e < 4) ? l0[e & 3] : l1[e & 3], ap = (e < 4) ? a0v[e & 3] : a1v[e & 3];
            lwv[e] = -0.60653065971263342f * fsig(PT[448 + hc] + lp);
            av[e] = fsig(PT[512 + hc] + ap);
            kk[e] = kp[e] * PT[576 + hc]; ss += kk[e] * kk[e];
            kp[e] = kp[e] * (1.0f + (av[e] - 1.0f) * PT[640 + hc]);
            bon += rp[e] * kp[e] * PT[704 + hc]; }
        ss += __shfl_xor(ss, 1); ss += __shfl_xor(ss, 2); ss += __shfl_xor(ss, 4);
        bon += __shfl_xor(bon, 1); bon += __shfl_xor(bon, 2); bon += __shfl_xor(bon, 4);
        const float inv = 1.0f / fmaxf(sqrtf(ss), 1e-12f);
#pragma unroll
        for (int e = 0; e < 8; ++e) kk[e] *= inv;
        if (q == 0 && !dummy) ((GAS float*)A.bonus)[(row0 + t) * 8 + h] = bon;
        *(LAS f32x4*)(lds + LWP + t * 272 + q * 32) = (f32x4){lwv[0], lwv[1], lwv[2], lwv[3]};
        *(LAS f32x4*)(lds + LWP + t * 272 + q * 32 + 16) = (f32x4){lwv[4], lwv[5], lwv[6], lwv[7]};
    }
    LDS_BAR();
    {
        const int c = tid & 63, seg = tid >> 6; float x[8]; float run = 0.f;
#pragma unroll
        for (int i = 0; i < 8; ++i) { run += *(const LAS float*)(lds + LWP + (8 * seg + i) * 272 + c * 4); x[i] = run; }
        *(LAS float*)(lds + TOT + (seg * 64 + c) * 4) = run;
        LDS_BAR();
        float off = 0.f;
        for (int s2 = 0; s2 < seg; ++s2) off += *(const LAS float*)(lds + TOT + (s2 * 64 + c) * 4);
#pragma unroll
        for (int i = 0; i < 8; ++i) *(LAS float*)(lds + LGO + (8 * seg + i) * 272 + c * 4) = x[i] + off;
    }
    LDS_BAR();
    {
        const f32x4 g0 = *(const LAS f32x4*)(lds + LGO + t * 272 + q * 32), g1 = *(const LAS f32x4*)(lds + LGO + t * 272 + q * 32 + 16);
        const f32x4 e0 = *(const LAS f32x4*)(lds + LGO + 63 * 272 + q * 32), e1 = *(const LAS f32x4*)(lds + LGO + 63 * 272 + q * 32 + 16);
        float at[8], bt[8], kt[8], rt[8], bh[8], kh[8];
#pragma unroll
        for (int e = 0; e < 8; ++e) { const float lg = (e < 4) ? g0[e & 3] : g1[e & 3], lc = (e < 4) ? e0[e & 3] : e1[e & 3];
            const float gm1 = __expf(lg - lwv[e]), gi = __expf(-lg), gt = __expf(lg), gr = __expf(lc - lg);
            const float bb = kk[e] * av[e];
            at[e] = -kk[e] * gm1; bt[e] = bb * gi; kt[e] = kp[e] * gi; rt[e] = rp[e] * gt; bh[e] = bb * gr; kh[e] = kp[e] * gr;
            if (t == 63) *(LAS float*)(lds + GCV + (8 * q + e) * 4) = __expf(lc); }
        *(LAS v4u*)(lds + AT_ + t * 144 + q * 16) = pack8(at); *(LAS v4u*)(lds + BT_ + t * 144 + q * 16) = pack8(bt);
        *(LAS v4u*)(lds + KT_ + t * 144 + q * 16) = pack8(kt); *(LAS v4u*)(lds + RT_ + t * 144 + q * 16) = pack8(rt);
#pragma unroll
        for (int e = 0; e < 8; ++e) { const int o = (8 * q + e) * 144 + t * 2;
            *(LAS bf16*)(lds + ATT + o) = (bf16)f2bf(at[e]); *(LAS bf16*)(lds + BHT + o) = (bf16)f2bf(bh[e]); *(LAS bf16*)(lds + KHT + o) = (bf16)f2bf(kh[e]); }
    }
    LDS_BAR();
    {
        const int hv_tb[10] = {0, 1, 1, 2, 2, 2, 3, 3, 3, 3}, hv_jb[10] = {0, 0, 1, 0, 1, 2, 0, 1, 2, 3};
        const int z_tb[6] = {0, 0, 0, 1, 1, 2}, z_jb[6] = {1, 2, 3, 2, 3, 3};
#pragma unroll
        for (int pass = 0; pass < 2; ++pass) {
            const int hi = (pass == 0) ? wave : (wave < 2 ? 8 + wave : -1);
            if (hi >= 0) {
                int tb = 0, jb = 0;
#pragma unroll
                for (int k = 0; k < 10; ++k) if (k == hi) { tb = hv_tb[k]; jb = hv_jb[k]; }
                f32x4 cab = {0.f, 0.f, 0.f, 0.f}, cak = cab, crb = cab, crk = cab;
#pragma unroll
                for (int s = 0; s < 2; ++s) { const bf16x8 fb = ldf(lds + BT_, 16 * jb + r, s, g), fk = ldf(lds + KT_, 16 * jb + r, s, g), fa = ldf(lds + AT_, 16 * tb + r, s, g), fr = ldf(lds + RT_, 16 * tb + r, s, g);
                    cab = mma(fb, fa, cab); cak = mma(fk, fa, cak); crb = mma(fb, fr, crb); crk = mma(fk, fr, crk); }
                const int tt = 16 * tb + r;
#pragma unroll
                for (int e = 0; e < 4; ++e) { const int j = 16 * jb + 4 * g + e; if (!(j < tt)) { cab[e] = 0.f; cak[e] = 0.f; } if (!(j <= tt)) { crb[e] = 0.f; crk[e] = 0.f; } }
                const int o = tt * 144 + (16 * jb + 4 * g) * 2;
                *(LAS v2u*)(lds + AAB + o) = pack4(cab); *(LAS v2u*)(lds + AAK + o) = pack4(cak); *(LAS v2u*)(lds + ARB + o) = pack4(crb); *(LAS v2u*)(lds + ARK + o) = pack4(crk);
                if (tb == jb) *(LAS f32x4*)(lds + DG + ((tb * 16 + r) * 16 + 4 * g) * 4) = cab;
            }
        }
        if (wave >= 2) {
            int tb = 0, jb = 0;
#pragma unroll
            for (int k = 0; k < 6; ++k) if (k == wave - 2) { tb = z_tb[k]; jb = z_jb[k]; }
            const int o = (16 * tb + r) * 144 + (16 * jb + 4 * g) * 2; const v2u z = {0u, 0u};
            *(LAS v2u*)(lds + AAB + o) = z; *(LAS v2u*)(lds + AAK + o) = z; *(LAS v2u*)(lds + ARB + o) = z; *(LAS v2u*)(lds + ARK + o) = z;
        }
    }
    LDS_BAR();
    f32x4 Y[4];
    if (wave == 7) {
        const int blk = lane >> 4, col = lane & 15; float x[16];
#pragma unroll
        for (int tt = 0; tt < 16; ++tt) {
            float acc = (tt == col) ? 1.0f : 0.0f;
            const LAS float* nrow = (const LAS float*)(lds + DG + ((blk * 16 + tt) * 16) * 4);
#pragma unroll
            for (int j = 0; j < 16; ++j) if (j < tt) acc += nrow[j] * x[j];
            x[tt] = acc;
            *(LAS bf16*)(lds + TI + ((blk * 16 + tt) * 16 + col) * 2) = (bf16)f2bf(acc);
        }
    }
    if (wave < 4) {
#pragma unroll
        for (int i = 0; i < 4; ++i) { Y[i] = (f32x4){0.f, 0.f, 0.f, 0.f};
#pragma unroll
            for (int s = 0; s < 2; ++s) Y[i] = mma(ldf(lds + AAK, 16 * i + r, s, g), ldf(lds + VTT, 16 * wave + r, s, g), Y[i]); }
    } else {
#pragma unroll
        for (int i = 0; i < 4; ++i) Y[i] = unpack4(*(const LAS v2u*)(lds + ATT + (16 * (wave - 4) + r) * 144 + (16 * i + 4 * g) * 2));
    }
    LDS_BAR();
    {
        v2u Xb[4];
        const bf16x8 zf = {0, 0, 0, 0, 0, 0, 0, 0};
#pragma unroll
        for (int i = 0; i < 4; ++i) {
            if (i >= 1) {
                v4u bw; bw.x = Xb[0].x; bw.y = Xb[0].y; bw.z = (i >= 2) ? Xb[1].x : 0u; bw.w = (i >= 2) ? Xb[1].y : 0u;
                v4u aw; const v2u a0 = *(const LAS v2u*)(lds + AAB + (16 * i + r) * 144 + (4 * g) * 2), a1 = *(const LAS v2u*)(lds + AAB + (16 * i + r) * 144 + (16 + 4 * g) * 2);
                aw.x = a0.x; aw.y = a0.y; aw.z = a1.x; aw.w = a1.y;
                Y[i] = mma(__builtin_bit_cast(bf16x8, aw), __builtin_bit_cast(bf16x8, bw), Y[i]);
            }
            if (i >= 3) {
                v4u bw; bw.x = Xb[2].x; bw.y = Xb[2].y; bw.z = 0u; bw.w = 0u;
                v4u aw; const v2u a0 = *(const LAS v2u*)(lds + AAB + (16 * i + r) * 144 + (32 + 4 * g) * 2);
                aw.x = a0.x; aw.y = a0.y; aw.z = 0u; aw.w = 0u;
                Y[i] = mma(__builtin_bit_cast(bf16x8, aw), __builtin_bit_cast(bf16x8, bw), Y[i]);
            }
            v4u tw; const v2u t0 = *(const LAS v2u*)(lds + TI + ((i * 16 + r) * 16 + 4 * g) * 2); tw.x = t0.x; tw.y = t0.y; tw.z = 0u; tw.w = 0u;
            v4u yw; const v2u yp = pack4(Y[i]); yw.x = yp.x; yw.y = yp.y; yw.z = 0u; yw.w = 0u;
            const f32x4 X = mma(__builtin_bit_cast(bf16x8, tw), __builtin_bit_cast(bf16x8, yw), (f32x4){0.f, 0.f, 0.f, 0.f});
            Xb[i] = pack4(X);
            const int dst = (wave < 4) ? (U0T + (16 * wave + r) * 144) : (ATT + (16 * (wave - 4) + r) * 144);
            *(LAS v2u*)(lds + dst + (16 * i + 4 * g) * 2) = Xb[i];
        }
        (void)zf;
    }
    LDS_BAR();
    {
#pragma unroll
        for (int i = 0; i < 2; ++i) {
            const int qq = 2 * wave + i, rb = qq >> 2, cb = qq & 3;
            f32x4 crh = {0.f, 0.f, 0.f, 0.f}, co0 = crh, cp = crh, cq = crh;
#pragma unroll
            for (int s = 0; s < 2; ++s) {
                const bf16x8 fah = ldf(lds + ATT, 16 * rb + r, s, g), fu0 = ldf(lds + U0T, 16 * rb + r, s, g), fvt = ldf(lds + VTT, 16 * rb + r, s, g), fbh = ldf(lds + BHT, 16 * rb + r, s, g), fkh = ldf(lds + KHT, 16 * rb + r, s, g);
                const bf16x8 frb = ldf(lds + ARB, 16 * cb + r, s, g), frk = ldf(lds + ARK, 16 * cb + r, s, g), fbhc = ldf(lds + BHT, 16 * cb + r, s, g), fu0c = ldf(lds + U0T, 16 * cb + r, s, g), fvtc = ldf(lds + VTT, 16 * cb + r, s, g);
                crh = mma(fah, frb, crh);
                co0 = mma(fu0, frb, co0); co0 = mma(fvt, frk, co0);
                cp = mma(fah, fbhc, cp);
                cq = mma(fbh, fu0c, cq); cq = mma(fkh, fvtc, cq);
            }
            crh = crh + unpack4(*(const LAS v2u*)(lds + RT_ + (16 * cb + r) * 144 + (16 * rb + 4 * g) * 2));
            if (rb == cb) {
#pragma unroll
                for (int e = 0; e < 4; ++e) if (4 * g + e == r) cp[e] += *(const LAS float*)(lds + GCV + (16 * rb + 4 * g + e) * 4);
            }
            const size_t tok = row0 + 16 * cb + r;
            if (!dummy) {
            *(GAS v2u*)(A.Rh + tok * A.ldo + h * 64 + 16 * rb + 4 * g) = pack4(crh);
            *(GAS v2u*)(A.O0 + tok * A.ldo + h * 64 + 16 * rb + 4 * g) = pack4(co0);
            const size_t su = (size_t)(((cidx >> 7) * 8 + h) * 128 + c_in_b);
            *(GAS v2u*)(A.Pst + su * 4096 + (16 * cb + r) * 64 + 32 * (rb >> 1) + 8 * g + 4 * (rb & 1)) = pack4(cp);
            *(GAS v2u*)(A.Qst + su * 4096 + (16 * cb + r) * 64 + 16 * g + 4 * rb) = pack4(cq);
            }
        }
    }
    LDS_BAR();
}

struct PQ { v4u p[4][2]; v4u q[2]; };
constexpr int S2_NS = 8, S2_SLOTB = 2048, S2_FLAGS = 4 * S2_NS * S2_SLOTB;
__device__ __forceinline__ void s2_chain(LAS unsigned char* lds, const bf16* Pst, const bf16* Qst, const int bh, const int vb, const int lane) {
    const int r = lane & 15, g = lane >> 4;
    f32x4 S[4];
#pragma unroll
    for (int i = 0; i < 4; ++i) S[i] = (f32x4){0.f, 0.f, 0.f, 0.f};
    const size_t ustep = (size_t)4096;
    const bf16* Pp = Pst + ((size_t)bh * 128) * 4096 + r * 64 + 8 * g;
    const bf16* Qp = Qst + ((size_t)bh * 128) * 4096 + (16 * vb + r) * 64 + 16 * g;
    LAS unsigned char* ring = lds + vb * (S2_NS * S2_SLOTB) + r * 128 + g * 8;
    volatile LAS int* prod = (volatile LAS int*)(lds + S2_FLAGS + vb * 64);
    volatile LAS int* cons = (volatile LAS int*)(lds + S2_FLAGS + 256 + vb * 64);
#define S2_GLD(DST, PTR) asm volatile("global_load_dwordx4 %0, %1, off" : "=v"(DST) : "v"(PTR) : "memory")
#define S2_LOAD(B, C) do { const int c_ = (C) < 128 ? (C) : 127; const bf16* P_ = Pp + (size_t)c_ * ustep; const bf16* Q_ = Qp + (size_t)c_ * ustep; \
        _Pragma("unroll") for (int i = 0; i < 4; ++i) { S2_GLD(B.p[i][0], P_ + (16 * i) * 64); S2_GLD(B.p[i][1], P_ + (16 * i) * 64 + 32); } \
        S2_GLD(B.q[0], Q_); S2_GLD(B.q[1], Q_ + 8); } while (0)
#define S2_READY(B, N) asm volatile("s_waitcnt vmcnt(" #N ")" : "+v"(B.p[0][0]), "+v"(B.p[0][1]), "+v"(B.p[1][0]), "+v"(B.p[1][1]), "+v"(B.p[2][0]), "+v"(B.p[2][1]), "+v"(B.p[3][0]), "+v"(B.p[3][1]), "+v"(B.q[0]), "+v"(B.q[1]) :: "memory")
#define S2_STEP(B, C) do { v2u sb_[4]; \
        { unsigned sp_ = 0; while ((C) - *cons >= S2_NS && ++sp_ < (1u << 22)) __builtin_amdgcn_s_sleep(1); } asm volatile("" ::: "memory");   \
        _Pragma("unroll") for (int i = 0; i < 4; ++i) { sb_[i] = pack4(S[i]); *(LAS v2u*)(ring + ((C) & (S2_NS - 1)) * S2_SLOTB + 32 * i) = sb_[i]; } \
        asm volatile("s_waitcnt lgkmcnt(0)" ::: "memory"); if (lane == 0) *prod = (C) + 1; \
        _Pragma("unroll") for (int i = 0; i < 4; ++i) { v2u qi_; qi_.x = (i & 1) ? B.q[i >> 1].z : B.q[i >> 1].x; qi_.y = (i & 1) ? B.q[i >> 1].w : B.q[i >> 1].y; f32x4 n_ = unpack4(qi_); \
            _Pragma("unroll") for (int s_ = 0; s_ < 2; ++s_) { \
                v4u bw_; bw_.x = sb_[2 * s_].x; bw_.y = sb_[2 * s_].y; bw_.z = sb_[2 * s_ + 1].x; bw_.w = sb_[2 * s_ + 1].y; \
                n_ = mma(__builtin_bit_cast(bf16x8, B.p[i][s_]), __builtin_bit_cast(bf16x8, bw_), n_); } \
            S[i] = n_; } } while (0)
#define PIN() asm volatile("" ::: "memory")
    PQ B0, B1, B2, B3;
    asm volatile("s_waitcnt vmcnt(0)" ::: "memory");
    S2_LOAD(B0, 0); S2_LOAD(B1, 1); S2_LOAD(B2, 2);
    for (int c = 0; c < 128; c += 4) {
        S2_LOAD(B3, c + 3); S2_READY(B0, 30); S2_STEP(B0, c);
        S2_LOAD(B0, c + 4); S2_READY(B1, 30); S2_STEP(B1, c + 1);
        S2_LOAD(B1, c + 5); S2_READY(B2, 30); S2_STEP(B2, c + 2);
        S2_LOAD(B2, c + 6); S2_READY(B3, 30); S2_STEP(B3, c + 3);
    }
    asm volatile("s_waitcnt vmcnt(0)" : "+v"(B0.p[0][0]), "+v"(B0.p[0][1]), "+v"(B0.p[1][0]), "+v"(B0.p[1][1]), "+v"(B0.p[2][0]), "+v"(B0.p[2][1]), "+v"(B0.p[3][0]), "+v"(B0.p[3][1]), "+v"(B0.q[0]), "+v"(B0.q[1]),
                 "+v"(B1.p[0][0]), "+v"(B1.p[0][1]), "+v"(B1.p[1][0]), "+v"(B1.p[1][1]), "+v"(B1.p[2][0]), "+v"(B1.p[2][1]), "+v"(B1.p[3][0]), "+v"(B1.p[3][1]), "+v"(B1.q[0]), "+v"(B1.q[1]) :: "memory");
    asm volatile("" : "+v"(B2.p[0][0]), "+v"(B2.p[0][1]), "+v"(B2.p[1][0]), "+v"(B2.p[1][1]), "+v"(B2.p[2][0]), "+v"(B2.p[2][1]), "+v"(B2.p[3][0]), "+v"(B2.p[3][1]), "+v"(B2.q[0]), "+v"(B2.q[1]) :: "memory");
#undef S2_LOAD
#undef S2_STEP
}
__device__ __forceinline__ void s2_storer(LAS unsigned char* lds, bf16* Sst, const int bh, const int vb, const int lane) {
    volatile LAS int* prod = (volatile LAS int*)(lds + S2_FLAGS + vb * 64);
    volatile LAS int* cons = (volatile LAS int*)(lds + S2_FLAGS + 256 + vb * 64);
    const LAS unsigned char* ring = lds + vb * (S2_NS * S2_SLOTB) + lane * 32;
    bf16* Sp = Sst + ((size_t)bh * 128) * 4096 + (16 * vb) * 64 + lane * 16;
    for (int c = 0; c < 128; ++c) {
        { unsigned sp_ = 0; while (*prod <= c && ++sp_ < (1u << 22)) __builtin_amdgcn_s_sleep(1); }
        asm volatile("" ::: "memory");
        const v4u a_ = *(const LAS v4u*)(ring + (c & (S2_NS - 1)) * S2_SLOTB), b_ = *(const LAS v4u*)(ring + (c & (S2_NS - 1)) * S2_SLOTB + 16);
        asm volatile("s_waitcnt lgkmcnt(0)" ::: "memory");
        if (lane == 0) *cons = c + 1;
        *(GAS v4u*)(Sp + (size_t)c * 4096) = a_; *(GAS v4u*)(Sp + (size_t)c * 4096 + 8) = b_;
    }
}

struct S3Args { const bf16 *Rh, *O0; int ldo; const bf16* Vp; int ldv; const bf16 *Gf, *Sst; const float *bonus, *lnx_g, *lnx_b; bf16* Y; int ldy; };
__device__ __forceinline__ void s3_unit(const S3Args& A, const int unit, const int lane) {
    const int r = lane & 15, g = lane >> 4;
    const int h = unit & 7, cidx = unit >> 3;
    bf16x8 sf[4][2];
#pragma unroll
    for (int i = 0; i < 4; ++i)
#pragma unroll
        for (int s = 0; s < 2; ++s) sf[i][s] = *(const GAS bf16x8*)(A.Sst + (size_t)(((cidx >> 7) * 8 + h) * 128 + (cidx & 127)) * 4096 + (16 * i + r) * 64 + 32 * s + 8 * g);
#pragma unroll
    for (int tb = 0; tb < 4; ++tb) {
        const size_t tok = (size_t)cidx * 64 + 16 * tb + r;
        f32x4 o[4];
        bf16x8 fr[2];
#pragma unroll
        for (int s = 0; s < 2; ++s) fr[s] = *(const GAS bf16x8*)(A.Rh + tok * A.ldo + h * 64 + 32 * s + 8 * g);
#pragma unroll
        for (int i = 0; i < 4; ++i) {
            o[i] = unpack4(*(const GAS v2u*)(A.O0 + tok * A.ldo + h * 64 + 16 * i + 4 * g));
#pragma unroll
            for (int s = 0; s < 2; ++s) o[i] = mma(sf[i][s], fr[s], o[i]);
        }
        float sm = 0.f;
#pragma unroll
        for (int i = 0; i < 4; ++i) sm += (o[i][0] + o[i][1]) + (o[i][2] + o[i][3]);
        sm += __shfl_xor(sm, 16); sm += __shfl_xor(sm, 32);
        const float mean = sm * (1.0f / 64.0f); float sq = 0.f;
#pragma unroll
        for (int i = 0; i < 4; ++i) { o[i] = o[i] - mean; sq += (o[i][0] * o[i][0] + o[i][1] * o[i][1]) + (o[i][2] * o[i][2] + o[i][3] * o[i][3]); }
        sq += __shfl_xor(sq, 16); sq += __shfl_xor(sq, 32);
        const float rstd = 1.0f / sqrtf(sq * (1.0f / 64.0f) + 64e-5f);
        const float bon = ((const GAS float*)A.bonus)[tok * 8 + h];
#pragma unroll
        for (int i = 0; i < 4; ++i) {
            const int hv = h * 64 + 16 * i + 4 * g;
            const f32x4 lg = *(const GAS f32x4*)(A.lnx_g + hv), lb = *(const GAS f32x4*)(A.lnx_b + hv);
            const f32x4 vv = unpack4(*(const GAS v2u*)(A.Vp + tok * A.ldv + hv)), gg = unpack4(*(const GAS v2u*)(A.Gf + tok * W + hv));
            const f32x4 y = (o[i] * rstd * lg + lb + vv * bon) * gg;
            *(GAS v2u*)(A.Y + tok * A.ldy + hv) = pack4(y);
        }
    }
}
}
namespace moba {
typedef short bf16x8 __attribute__((ext_vector_type(8)));
constexpr int OSP = 132;
constexpr int OSLOT = 0, LSUM = OSLOT + 4 * 256 * OSP, KMF = LSUM + 4 * 256 * 4, CNT = KMF + 8192, OFFS = CNT + 128, FILL = OFFS + 128, QLIST = FILL + 128, QSLOT = QLIST + 1024, ITEMS = QSLOT + 1024, ICTR = ITEMS + 1024, NVQ = ICTR + 64  , MOBA_LDS = NVQ + 256;
static_assert(MOBA_LDS <= 153600 - 1024, "MoBA LDS map below the control words");
__device__ __forceinline__ f32x4 mma(bf16x8 a, bf16x8 b, f32x4 c) { return __builtin_amdgcn_mfma_f32_16x16x32_bf16(a, b, c, 0, 0, 0); }
struct Args { bf16* AT; const bf16* VT; const float* KM; const float *qg, *kg; };
struct KV { bf16x8 k[2][2]; bf16x8 v[4]; };
__device__ __forceinline__ void item(LAS unsigned char* lds, const Args& A, const int b, const int h, const int qb, const int kblk, const int off, const int cnt, const int nkc, const bool own, const int lane) {
    const int r = lane & 15, g = lane >> 4;
    const float slope2 = exp2f(-(float)(h + 1)) * 1.4426950408889634f;
    int ql[2]; float aq[2];
    bf16x8 qf[2][2];
#pragma unroll
    for (int qt = 0; qt < 2; ++qt) {
        const int li = qt * 16 + r;
        int qv = -1;
        if (own) qv = off + li; else if (li < cnt) qv = (int)*(const LAS unsigned char*)(lds + QLIST + off + li);
        ql[qt] = qv;
        const int qrow = (qv >= 0) ? qv : 0;
        aq[qt] = (qv >= 0) ? -slope2 * (float)(256 * (qb - kblk) + qrow) : -1e30f;
    }
    const bf16* kbase = A.AT + ((size_t)b * T + kblk * 256 + 8 * (r >> 2) + (r & 3)) * NAT + 512 + h * 64 + 8 * g;
    const bf16* vbase = A.VT + (((size_t)(b * NH + h) * (T / 32) + kblk * 8) * 64 + r) * 32 + 8 * g;
    f32x4 o[4][2]; float l[2] = {0.f, 0.f};
#pragma unroll
    for (int db = 0; db < 4; ++db) { o[db][0] = (f32x4){0.f, 0.f, 0.f, 0.f}; o[db][1] = (f32x4){0.f, 0.f, 0.f, 0.f}; }
#define GLD16(DST, PTR) asm volatile("global_load_dwordx4 %0, %1, off" : "=v"(DST) : "v"(PTR) : "memory")
#define MOBA_LOAD(B, KC) do { const int kc_ = (KC) < nkc ? (KC) : nkc - 1; \
        _Pragma("unroll") for (int kt = 0; kt < 2; ++kt) { const bf16* kp_ = kbase + (size_t)(kc_ * 32 + kt * 4) * NAT; GLD16(B.k[kt][0], kp_); GLD16(B.k[kt][1], kp_ + 32); } \
        _Pragma("unroll") for (int db = 0; db < 4; ++db) { const bf16* vp_ = vbase + (size_t)kc_ * (64 * 32) + (16 * db) * 32; GLD16(B.v[db], vp_); } } while (0)
#define MOBA_READY(B, N) asm volatile("s_waitcnt vmcnt(" #N ")" : "+v"(B.k[0][0]), "+v"(B.k[0][1]), "+v"(B.k[1][0]), "+v"(B.k[1][1]), "+v"(B.v[0]), "+v"(B.v[1]), "+v"(B.v[2]), "+v"(B.v[3]) :: "memory")
#define MOBA_COMPUTE(B, KC) do { v4u pb_[2]; const int kb_ = (KC) * 32 + 8 * g; const bool dg_ = own && ((KC) == nkc - 1); \
        _Pragma("unroll") for (int qt = 0; qt < 2; ++qt) { unsigned pw_[4]; const float bs_ = aq[qt] + slope2 * (float)kb_; const int dl_ = ql[qt] - kb_; \
            _Pragma("unroll") for (int kt = 0; kt < 2; ++kt) { f32x4 st_ = {0.f, 0.f, 0.f, 0.f}; \
                st_ = mma(B.k[kt][0], qf[qt][0], st_); st_ = mma(B.k[kt][1], qf[qt][1], st_); f32x4 p_; \
                if (dg_) { _Pragma("unroll") for (int e = 0; e < 4; ++e) { float x_ = (st_[e] + bs_) + cst[kt * 4 + e]; if (4 * kt + e > dl_) x_ = -1e30f; p_[e] = __builtin_amdgcn_exp2f(x_); } } \
                else { _Pragma("unroll") for (int e = 0; e < 4; ++e) p_[e] = __builtin_amdgcn_exp2f((st_[e] + bs_) + cst[kt * 4 + e]); } \
                l[qt] += (p_[0] + p_[1]) + (p_[2] + p_[3]); pw_[2 * kt] = pk2(p_[0], p_[1]); pw_[2 * kt + 1] = pk2(p_[2], p_[3]); } \
            pb_[qt].x = pw_[0]; pb_[qt].y = pw_[1]; pb_[qt].z = pw_[2]; pb_[qt].w = pw_[3]; } \
        _Pragma("unroll") for (int db = 0; db < 4; ++db) { _Pragma("unroll") for (int qt = 0; qt < 2; ++qt) o[db][qt] = mma(B.v[db], __builtin_bit_cast(bf16x8, pb_[qt]), o[db][qt]); } } while (0)
    float cst[8];
#pragma unroll
    for (int j = 0; j < 8; ++j) cst[j] = slope2 * (float)j;
    KV B0, B1, B2;
    MOBA_LOAD(B0, 0); MOBA_LOAD(B1, 1);
#pragma unroll
    for (int qt = 0; qt < 2; ++qt) { const int qrow = (ql[qt] >= 0) ? ql[qt] : 0; const bf16* qp = A.AT + ((size_t)b * T + qb * 256 + qrow) * NAT + h * 64 + 8 * g;
        qf[qt][0] = *(const GAS bf16x8*)qp; qf[qt][1] = *(const GAS bf16x8*)(qp + 32); }
    asm volatile("" :: "v"(qf[0][0]), "v"(qf[0][1]), "v"(qf[1][0]), "v"(qf[1][1]) : "memory");
    for (int kc = 0; kc < nkc; kc += 3) {
        MOBA_LOAD(B2, kc + 2); MOBA_READY(B0, 16); MOBA_COMPUTE(B0, kc);
        if (kc + 1 < nkc) { MOBA_LOAD(B0, kc + 3); MOBA_READY(B1, 16); MOBA_COMPUTE(B1, kc + 1); }
        if (kc + 2 < nkc) { MOBA_LOAD(B1, kc + 4); MOBA_READY(B2, 16); MOBA_COMPUTE(B2, kc + 2); }
    }
    asm volatile("s_waitcnt vmcnt(0)" : "+v"(B0.k[0][0]), "+v"(B0.k[0][1]), "+v"(B0.k[1][0]), "+v"(B0.k[1][1]), "+v"(B0.v[0]), "+v"(B0.v[1]), "+v"(B0.v[2]), "+v"(B0.v[3]),
                 "+v"(B1.k[0][0]), "+v"(B1.k[0][1]), "+v"(B1.k[1][0]), "+v"(B1.k[1][1]), "+v"(B1.v[0]), "+v"(B1.v[1]), "+v"(B1.v[2]), "+v"(B1.v[3]),
                 "+v"(B2.k[0][0]), "+v"(B2.k[0][1]), "+v"(B2.k[1][0]), "+v"(B2.k[1][1]), "+v"(B2.v[0]), "+v"(B2.v[1]), "+v"(B2.v[2]), "+v"(B2.v[3]) :: "memory");
#undef MOBA_LOAD
#undef MOBA_COMPUTE
#pragma unroll
    for (int qt = 0; qt < 2; ++qt) {
        float ls = l[qt]; ls += __shfl_xor(ls, 16); ls += __shfl_xor(ls, 32);
        if (ql[qt] >= 0) {
            const int slot = own ? 0 : (int)*(const LAS unsigned char*)(lds + QSLOT + off + qt * 16 + r);
            LAS unsigned char* op = lds + OSLOT + (slot * 256 + ql[qt]) * OSP + g * 8;
#pragma unroll
            for (int db = 0; db < 4; ++db) { *(LAS unsigned*)(op + db * 32) = pk2(o[db][qt][0], o[db][qt][1]); *(LAS unsigned*)(op + db * 32 + 4) = pk2(o[db][qt][2], o[db][qt][3]); }
            if (g == 0) *((LAS float*)(lds + LSUM) + slot * 256 + ql[qt]) = ls;
        }
    }
}
__device__ __forceinline__ void unit(LAS unsigned char* lds, const Args& A, const int b, const int h, const int qb, const int tid, const bool dummy = false) {
    const int lane = tid & 63;
    const int wave = __builtin_amdgcn_readfirstlane(tid >> 6);
    if (tid < 96) ((LAS int*)(lds + CNT))[tid] = 0;
    if (tid == 0) *(LAS int*)(lds + ICTR) = 0;
    if (tid < 64) {
        float mq = fabsf(((const GAS float*)A.qg)[lane]), mk = fabsf(((const GAS float*)A.kg)[lane]);
#pragma unroll
        for (int o_ = 1; o_ < 64; o_ <<= 1) { mq = fmaxf(mq, __shfl_xor(mq, o_)); mk = fmaxf(mk, __shfl_xor(mk, o_)); }
        const float B2 = 64.0f * (0.125f * 1.4426950408889634f) * mq * mk * 1.02f, sl2 = exp2f(-(float)(h + 1)) * 1.4426950408889634f;
        const float dmin = ((B2 + 152.0f) / sl2 - 1.0f) * (1.0f / 256.0f);
        if (lane == 0) *(LAS int*)(lds + ICTR + 8) = (int)floorf(dmin) + 2;
    }
    int s0 = -1, s1 = -1, s2 = -1, sl0 = 0, sl1 = 0, sl2q = 0, nv = 1;
    if (qb > 0) {
        const int r = lane & 15, g = lane >> 4;
        bf16x8 qf[2][2];
#pragma unroll
        for (int nt = 0; nt < 2; ++nt) { const bf16* qp = A.AT + ((size_t)b * T + qb * 256 + wave * 32 + nt * 16 + r) * NAT + h * 64 + 8 * g;
            qf[nt][0] = *(const GAS bf16x8*)qp; qf[nt][1] = *(const GAS bf16x8*)(qp + 32); }
        f32x4 ga[2][2];
#pragma unroll
        for (int mt = 0; mt < 2; ++mt) {
            ga[mt][0] = (f32x4){0.f, 0.f, 0.f, 0.f}; ga[mt][1] = (f32x4){0.f, 0.f, 0.f, 0.f};
            const float* kmp = A.KM + ((size_t)(b * NH + h) * NBLK + mt * 16 + r) * 64 + 8 * g;
#pragma unroll
            for (int ks = 0; ks < 2; ++ks) {
                const f32x4 x0 = *(const GAS f32x4*)(kmp + 32 * ks), x1 = *(const GAS f32x4*)(kmp + 32 * ks + 4);
                v4u wh, wl;
                wh.x = pk2(x0[0], x0[1]); wh.y = pk2(x0[2], x0[3]); wh.z = pk2(x1[0], x1[1]); wh.w = pk2(x1[2], x1[3]);
                wl.x = pk2(x0[0] - bflo(wh.x), x0[1] - bfhi(wh.x)); wl.y = pk2(x0[2] - bflo(wh.y), x0[3] - bfhi(wh.y));
                wl.z = pk2(x1[0] - bflo(wh.z), x1[1] - bfhi(wh.z)); wl.w = pk2(x1[2] - bflo(wh.w), x1[3] - bfhi(wh.w));
#pragma unroll
                for (int nt = 0; nt < 2; ++nt) { ga[mt][nt] = mma(__builtin_bit_cast(bf16x8, wh), qf[nt][ks], ga[mt][nt]); ga[mt][nt] = mma(__builtin_bit_cast(bf16x8, wl), qf[nt][ks], ga[mt][nt]); }
            }
        }
        float tg0[2], tg1[2], tg2[2]; int ts0[2], ts1[2], ts2[2];
#define MOBA_INS(V, I) do { const float v_ = (V); const int i_ = (I); \
            if (v_ > g0 || (v_ == g0 && i_ < t0)) { g2 = g1; t2 = t1; g1 = g0; t1 = t0; g0 = v_; t0 = i_; } \
            else if (v_ > g1 || (v_ == g1 && i_ < t1)) { g2 = g1; t2 = t1; g1 = v_; t1 = i_; } \
            else if (v_ > g2 || (v_ == g2 && i_ < t2)) { g2 = v_; t2 = i_; } } while (0)
#pragma unroll
        for (int nt = 0; nt < 2; ++nt) {
            float g0 = -3e38f, g1 = -3e38f, g2 = -3e38f; int t0 = -1, t1 = -1, t2 = -1;
#pragma unroll
            for (int mt = 0; mt < 2; ++mt) {
#pragma unroll
                for (int e = 0; e < 4; ++e) { const int n = 16 * mt + 4 * g + e; const float gt = (n < qb) ? ga[mt][nt][e] : -3e38f;
                    if (gt > g0) { g2 = g1; t2 = t1; g1 = g0; t1 = t0; g0 = gt; t0 = n; }
                    else if (gt > g1) { g2 = g1; t2 = t1; g1 = gt; t1 = n; }
                    else if (gt > g2) { g2 = gt; t2 = n; } }
            }
#pragma unroll
            for (int o_ = 16; o_ <= 32; o_ <<= 1) {
                const float b0 = __shfl_xor(g0, o_), b1 = __shfl_xor(g1, o_), b2 = __shfl_xor(g2, o_);
                const int j0 = __shfl_xor(t0, o_), j1 = __shfl_xor(t1, o_), j2 = __shfl_xor(t2, o_);
                MOBA_INS(b0, j0); MOBA_INS(b1, j1); MOBA_INS(b2, j2);
            }
            tg0[nt] = g0; tg1[nt] = g1; tg2[nt] = g2; ts0[nt] = t0; ts1[nt] = t1; ts2[nt] = t2;
        }
#undef MOBA_INS
        if (lane < 32) { s0 = g ? ts0[1] : ts0[0]; s1 = g ? ts1[1] : ts1[0]; s2 = g ? ts2[1] : ts2[0]; }
        (void)tg0; (void)tg1; (void)tg2;
    }
    const int qid = wave * 32 + lane;
    RW_BAR();
    if (lane < 32) {
        const int Dd = *(const LAS int*)(lds + ICTR + 8);
        if (s0 >= 0 && qb - s0 >= Dd) s0 = -1; if (s0 >= 0) sl0 = nv++;
        if (s1 >= 0 && qb - s1 >= Dd) s1 = -1; if (s1 >= 0) sl1 = nv++;
        if (s2 >= 0 && qb - s2 >= Dd) s2 = -1; if (s2 >= 0) sl2q = nv++;
        if (s0 >= 0) __hip_atomic_fetch_add((LAS int*)(lds + CNT) + s0, 1, __ATOMIC_RELAXED, __HIP_MEMORY_SCOPE_WORKGROUP);
        if (s1 >= 0) __hip_atomic_fetch_add((LAS int*)(lds + CNT) + s1, 1, __ATOMIC_RELAXED, __HIP_MEMORY_SCOPE_WORKGROUP);
        if (s2 >= 0) __hip_atomic_fetch_add((LAS int*)(lds + CNT) + s2, 1, __ATOMIC_RELAXED, __HIP_MEMORY_SCOPE_WORKGROUP);
        *(LAS unsigned char*)(lds + NVQ + qid) = (unsigned char)nv;
    }
    RW_BAR();
    if (tid < 64) {
        const int c = (lane < qb) ? ((LAS int*)(lds + CNT))[lane] : 0, nit = (c + 31) >> 5;
        int run = c, irun = nit;
#pragma unroll
        for (int o_ = 1; o_ < 32; o_ <<= 1) { const int t_ = __shfl_up(run, o_), u_ = __shfl_up(irun, o_); if (lane >= o_) { run += t_; irun += u_; } }
        const int tot = __shfl(irun, 31), off = run - c, ib = irun - nit;
        if (lane < qb) ((LAS int*)(lds + OFFS))[lane] = off;
        for (int k = 0; k < nit; ++k) { ((LAS int*)(lds + ITEMS))[2 * (ib + k)] = lane | ((c - 32 * k < 32 ? c - 32 * k : 32) << 8); ((LAS int*)(lds + ITEMS))[2 * (ib + k) + 1] = off + 32 * k; }
        if (lane >= 32 && lane < 40) { const int i = 39 - lane; ((LAS int*)(lds + ITEMS))[2 * (tot + lane - 32)] = qb | (32 << 8) | (1 << 16) | ((i + 1) << 20); ((LAS int*)(lds + ITEMS))[2 * (tot + lane - 32) + 1] = 32 * i; }
        if (lane == 0) *(LAS int*)(lds + ICTR + 4) = tot + 8;
    }
    RW_BAR();
    if (lane < 32) {
        if (s0 >= 0) { const int p = __hip_atomic_fetch_add((LAS int*)(lds + FILL) + s0, 1, __ATOMIC_RELAXED, __HIP_MEMORY_SCOPE_WORKGROUP); *(LAS unsigned char*)(lds + QLIST + ((LAS int*)(lds + OFFS))[s0] + p) = (unsigned char)qid; *(LAS unsigned char*)(lds + QSLOT + ((LAS int*)(lds + OFFS))[s0] + p) = (unsigned char)sl0; }
        if (s1 >= 0) { const int p = __hip_atomic_fetch_add((LAS int*)(lds + FILL) + s1, 1, __ATOMIC_RELAXED, __HIP_MEMORY_SCOPE_WORKGROUP); *(LAS unsigned char*)(lds + QLIST + ((LAS int*)(lds + OFFS))[s1] + p) = (unsigned char)qid; *(LAS unsigned char*)(lds + QSLOT + ((LAS int*)(lds + OFFS))[s1] + p) = (unsigned char)sl1; }
        if (s2 >= 0) { const int p = __hip_atomic_fetch_add((LAS int*)(lds + FILL) + s2, 1, __ATOMIC_RELAXED, __HIP_MEMORY_SCOPE_WORKGROUP); *(LAS unsigned char*)(lds + QLIST + ((LAS int*)(lds + OFFS))[s2] + p) = (unsigned char)qid; *(LAS unsigned char*)(lds + QSLOT + ((LAS int*)(lds + OFFS))[s2] + p) = (unsigned char)sl2q; }
    }
    RW_BAR();
    {
        const int ni = *(const LAS int*)(lds + ICTR + 4);
        for (;;) {
            int idx = 0; if (lane == 0) idx = __hip_atomic_fetch_add((LAS int*)(lds + ICTR), 1, __ATOMIC_RELAXED, __HIP_MEMORY_SCOPE_WORKGROUP);
            idx = __builtin_amdgcn_readfirstlane(idx);
            if (idx >= ni) break;
            const int w0 = __builtin_amdgcn_readfirstlane(((const LAS int*)(lds + ITEMS))[2 * idx]), w1 = __builtin_amdgcn_readfirstlane(((const LAS int*)(lds + ITEMS))[2 * idx + 1]);
            const bool own = (w0 >> 16) & 1;
            item(lds, A, b, h, qb, w0 & 255, w1, (w0 >> 8) & 255, own ? (w0 >> 20) : 8, own, lane);
        }
    }
    RW_BAR();
    if (!dummy) {
        const int qloc = tid >> 1, half = tid & 1;
        const int nslot = (int)*(const LAS unsigned char*)(lds + NVQ + qloc);
        float acc[32]; float lt = 0.f;
#pragma unroll
        for (int d = 0; d < 32; ++d) acc[d] = 0.f;
        for (int sl = 0; sl < nslot; ++sl) {
            const LAS unsigned* op = (const LAS unsigned*)(lds + OSLOT + (sl * 256 + qloc) * OSP + half * 64);
#pragma unroll
            for (int d = 0; d < 16; ++d) { const unsigned w = op[d]; acc[2 * d] += bflo(w); acc[2 * d + 1] += bfhi(w); }
            lt += *((const LAS float*)(lds + LSUM) + sl * 256 + qloc);
        }
        const float inv = 1.0f / lt;
        bf16* yp = A.AT + ((size_t)b * T + qb * 256 + qloc) * NAT + h * 64 + half * 32;
#pragma unroll
        for (int c = 0; c < 4; ++c) { v4u w; w.x = pk2(acc[8*c] * inv, acc[8*c+1] * inv); w.y = pk2(acc[8*c+2] * inv, acc[8*c+3] * inv); w.z = pk2(acc[8*c+4] * inv, acc[8*c+5] * inv); w.w = pk2(acc[8*c+6] * inv, acc[8*c+7] * inv); *(GAS v4u*)(yp + 8 * c) = w; }
    }
    RW_BAR();
}
}

__global__ void __launch_bounds__(NWAVES * 64, 2) mk_fwd(Args args) {
    extern __shared__ __attribute__((aligned(16))) unsigned char lds_raw[];
    LAS unsigned char* lds = (LAS unsigned char*)lds_raw;
    const int tid0 = threadIdx.x;
    const int wv0 = __builtin_amdgcn_readfirstlane(tid0 >> 6);
    const int G = gridDim.x;
    unsigned char* ws0 = args.ws;
    const int lo = args.ph_lo, hi = args.ph_hi;
    const int NGW = G * NWAVES;
    const bool fused = args.fused != 0;
    volatile LAS unsigned* MISC = (volatile LAS unsigned*)(lds + MISC_OFF);
    for (int u = tid0; u < (LDS_BYTES - LDSCTL_OFF) / 4; u += NWAVES * 64) ((LAS unsigned*)(lds + LDSCTL_OFF))[u] = 0u;
    __syncthreads();
    XcdBarrier bar; bar.bar = (unsigned*)(ws0 + WS_CTL) + CW_BAR; bar.x = 0; bar.st = nullptr;
    if (fused) bar = xcd_barrier_post((unsigned*)(ws0 + WS_CTL) + CW_BAR, MISC + 8);
#define IN(k) (lo <= (k) && (k) < hi && (rep == 1 || (k) <= args.probe_upto || (k) == args.probe_dup))
#define SEAM(k) do { if (fused && !((k) == PH_FF2 && L == args.l_hi - 1)) xcd_barrier(bar, tidL == 0); } while (0)

    for (int L = args.l_lo; L < args.l_hi; ++L)
    for (int rep = (args.probe_upto >= 0 || args.probe_dup >= 0) ? 0 : 1; rep < 2; ++rep) {
    const float* xsrc = (L == 0) ? args.in[I_X] : args.out;
    int tidL; asm volatile("v_mbcnt_lo_u32_b32 %0, -1, 0\n\tv_mbcnt_hi_u32_b32 %0, -1, %0\n\tv_lshl_add_u32 %0, %1, 6, %0" : "=&v"(tidL) : "s"(wv0));
    const int tid = tidL, lane = tid & 63, wave = __builtin_amdgcn_readfirstlane(tid >> 6), gw = blockIdx.x * NWAVES + wave;
    if (IN(PH_CONV)) {
        unsigned char* ws = args.ws; asm volatile("" : "+s"(ws));
        LAS float* scr = (LAS float*)(lds + RING_OFF + wave * 16384);
        const float* w_in = args.in[I_WIN] + (size_t)L * D * NIN;
        const float* w_br = args.in[I_WBR] + (size_t)L * 3 * W * D;
        const float* w_out = args.in[I_WOUT] + (size_t)L * D * D;
        const float* w_f1 = args.in[I_FF1] + (size_t)L * D * FF;
        const float* w_f2 = args.in[I_FF2] + (size_t)L * FF * D;
        constexpr int I_IN = (D / 64) * (NIN / 32), I_B = (W / 64) * (D / 32), I_O = (D / 64) * (D / 32), I_1 = (D / 64) * (FF / 32), I_2 = (FF / 64) * (D / 32);
        constexpr int I_LU = 16, I_LG = 32;
        constexpr int NITEMS = I_IN + 2 * I_B + I_O + I_1 + I_2 + 2 * I_LU + I_LG;
        bf16* WupT = (bf16*)(ws + WS_LORA); bf16* AupT = WupT + 512 * 64; bf16* GupT = AupT + 512 * 64;
        for (int it = gw; it < NITEMS; it += NGW) {
            int r = it;
            if (r < I_IN) { p0_transpose_item(w_in, D, NIN, ((bf16*)(ws + WS_WIN)), scr, r, lane); continue; } r -= I_IN;
            if (r < I_B) { p0_transpose_item(w_br, W, D, ((bf16*)(ws + WS_WB)), scr, r, lane); continue; } r -= I_B;
            if (r < I_B) { p0_transpose_item(w_br + (size_t)W * D, W, D, ((bf16*)(ws + WS_WB)) + (size_t)D * W, scr, r, lane); continue; } r -= I_B;
            if (r < I_O) { p0_transpose_item(w_out, D, D, ((bf16*)(ws + WS_WO)), scr, r, lane); continue; } r -= I_O;
            if (r < I_1) { p0_transpose_item(w_f1, D, FF, ((bf16*)(ws + WS_W1)), scr, r, lane); continue; } r -= I_1;
            if (r < I_2) { p0_transpose_item(w_f2, FF, D, ((bf16*)(ws + WS_W2)), scr, r, lane); continue; } r -= I_2;
            if (r < I_LU) { p0_transpose_item(args.in[I_WUP] + (size_t)L * 64 * W, 64, W, WupT, scr, r, lane); continue; } r -= I_LU;
            if (r < I_LU) { p0_transpose_item(args.in[I_AUP] + (size_t)L * 64 * W, 64, W, AupT, scr, r, lane); continue; } r -= I_LU;
            p0_transpose_item(args.in[I_GUP] + (size_t)L * 128 * W, 128, W, GupT, scr, r, lane);
        }
        const float* pw = args.in[I_POOLW] + (size_t)L * 4 * 128 * 128; const float* ps = args.in[I_POOLS] + (size_t)L * W; const float* wb2 = w_br + (size_t)2 * W * D;
        bf16* WeT = ((bf16*)(ws + WS_WB)) + (size_t)2 * D * W;
        for (int idx = blockIdx.x * (NWAVES * 64) + tid; idx < W * D; idx += G * NWAVES * 64) {
            const int gc = idx / D, dout = idx % D, g = gc >> 7;
            const GAS float* pwr = (const GAS float*)pw + (size_t)gc * 128; float acc = 0.f;
            for (int dp = 0; dp < 128; ++dp) acc += pwr[dp] * ((const GAS float*)ps)[g * 128 + dp] * ((const GAS float*)wb2)[(size_t)(g * 128 + dp) * D + dout];
            ((GAS bf16*)WeT)[(size_t)dout * W + gc] = (bf16)f2bf(acc);
        }
        rms_rows(xsrc, args.in[I_N1G] + (size_t)L * D, ((bf16*)(ws + WS_H)), gw, NGW, lane);
        SEAM(PH_CONV);
    }
    if (IN(PH_GEMMA)) {
        unsigned char* ws = args.ws; asm volatile("" : "+s"(ws));
        pg8::Gemm g{((bf16*)(ws + WS_H)), ((bf16*)(ws + WS_WIN)), M, NA, D, D, D}; pg8::StaticOrder S; S.init(M, NA, G, (int)blockIdx.x);
        pg8::EpiA E{(bf16*)(ws + WS_RW), (bf16*)(ws + WS_AT), (bf16*)(ws + WS_PL), (bf16*)(ws + WS_SB), (bf16*)(ws + WS_HB)};
        pg8::gemm_phase<pg8::EpiA, pg8::StaticOrder, true, true>(lds + RING_OFF, g, S, E, tidL);
        SEAM(PH_GEMMA);
    }
    if (IN(PH_MIX1)) {
        unsigned char* ws = args.ws; asm volatile("" : "+s"(ws));
        ph_attn_prep(lds, (bf16*)(ws + WS_AT), (bf16*)(ws + WS_VT), args.in[I_QNG] + L * 64, args.in[I_KNG] + L * 64, (float*)(ws + WS_KM), G, tidL);
        ph_pool((bf16*)(ws + WS_PL), (const bf16*)(ws + WS_HB), G, tidL);
        __syncthreads();
        rw::S1Args A1; A1.RW = (bf16*)(ws + WS_RW); A1.SB = (const bf16*)(ws + WS_SB);
        A1.mu = args.in[I_MU] + L * NRW; A1.w0 = args.in[I_W0] + L * W; A1.a0 = args.in[I_A0] + L * W; A1.k_k = args.in[I_KK] + L * W; A1.k_a = args.in[I_KA] + L * W; A1.r_k = args.in[I_RK] + L * W;
        A1.WupT = (const bf16*)(ws + WS_LORA); A1.AupT = A1.WupT + 512 * 64; A1.GupT = A1.AupT + 512 * 64;
        A1.Gf = (bf16*)(ws + WS_GF); A1.Pst = (bf16*)(ws + WS_PST); A1.Qst = (bf16*)(ws + WS_QST); A1.bonus = (float*)(ws + WS_BON);
        A1.Rh = (bf16*)(ws + WS_RW); A1.O0 = (bf16*)(ws + WS_RW) + 512; A1.ldo = NRW; A1.Vm = (bf16*)(ws + WS_RW) + 1024; A1.ldv = NRW;
        int hprev = -1;
        for (int unit = blockIdx.x; unit < NB * 128 * NH; unit += G) rw::s1_unit(lds, A1, unit, tidL, hprev);
        SEAM(PH_MIX1);
    }
    if (IN(PH_MIX2)) {
        unsigned char* ws = args.ws; asm volatile("" : "+s"(ws));
#define S3_PUBLISH(BH) do { asm volatile("s_waitcnt vmcnt(0)" ::: "memory"); __syncthreads(); \
            if (tid == 0) { __builtin_amdgcn_fence(__ATOMIC_RELEASE, "agent"); asm volatile("s_waitcnt vmcnt(0)" ::: "memory"); \
                __hip_atomic_store((unsigned*)(ws + WS_CTL) + CW_S3F + L * 64 + (BH), 1u, __ATOMIC_RELAXED, __HIP_MEMORY_SCOPE_AGENT); } } while (0)
        { moba::Args MA; MA.AT = (bf16*)(ws + WS_AT); MA.VT = (const bf16*)(ws + WS_VT); MA.KM = (const float*)(ws + WS_KM); MA.qg = args.in[I_QNG] + L * 64; MA.kg = args.in[I_KNG] + L * 64;
          if (G == 256) {
              const int xcd = blockIdx.x & 7, slot = blockIdx.x >> 3;
              if (slot < 4) {
                  if (tid < 8) *(volatile LAS int*)(lds + rw::S2_FLAGS + tid * 64) = 0;
                  __syncthreads();
                  if (wave < 4) rw::s2_chain(lds, (const bf16*)(ws + WS_PST), (const bf16*)(ws + WS_QST), slot * 8 + xcd, wave, lane);
                  else rw::s2_storer(lds, (bf16*)(ws + WS_SST), slot * 8 + xcd, wave - 4, lane);
                  S3_PUBLISH(slot * 8 + xcd);
              }
              volatile LAS int* qslot = (volatile LAS int*)(lds + LDSCTL_OFF + 64);
              for (int qx = 0; qx < 8; ++qx) {
                  const int x = (xcd + qx) & 7;
                  gu32* qw = (gu32*)(ws + WS_CTL) + CW_Q + (L * 8 + x) * 64;
                  for (;;) {
                      __syncthreads();
                      if (tid == 0) *qslot = (int)__hip_atomic_fetch_add(qw, 1u, RLX_AGENT);
                      __syncthreads();
                      const int u = *qslot;
                      if (u >= 128) break;
                      const int pb_ = u >> 5, ph_ = (pb_ & 1) ? 7 - x : x;
                      int tq = tidL; asm volatile("" : "+v"(tq));
#ifdef PROBE_MOBA2
                      moba::unit(lds, MA, pb_, ph_, 31 - (u & 31), tq, true);
#endif
                      moba::unit(lds, MA, pb_, ph_, 31 - (u & 31), tq);
                  }
              }
          } else {
              for (int bh = blockIdx.x; bh < NB * NH; bh += G) {
                  __syncthreads();
                  if (tid < 8) *(volatile LAS int*)(lds + rw::S2_FLAGS + tid * 64) = 0;
                  __syncthreads();
                  if (wave < 4) rw::s2_chain(lds, (const bf16*)(ws + WS_PST), (const bf16*)(ws + WS_QST), bh, wave, lane);
                  else rw::s2_storer(lds, (bf16*)(ws + WS_SST), bh, wave - 4, lane);
                  S3_PUBLISH(bh);
              }
              __syncthreads();
              for (int u = blockIdx.x; u < NB * NH * NBLK; u += G) { int tq = tidL; asm volatile("" : "+v"(tq)); moba::unit(lds, MA, u >> 8, (u >> 5) & 7, u & 31, tq); } } }
#undef S3_PUBLISH
        {
            if (tid < NB * NH) { unsigned sp_ = 0; while (__hip_atomic_load((unsigned*)(ws + WS_CTL) + CW_S3F + L * 64 + tid, __ATOMIC_RELAXED, __HIP_MEMORY_SCOPE_AGENT) == 0u && ++sp_ < (1u << 24)) __builtin_amdgcn_s_sleep(2); }
            if (tid < 64) { __builtin_amdgcn_fence(__ATOMIC_ACQUIRE, "agent"); asm volatile("s_waitcnt vmcnt(0)" ::: "memory"); }
            __syncthreads();
            rw::S3Args A3; A3.Rh = (const bf16*)(ws + WS_RW); A3.O0 = A3.Rh + 512; A3.ldo = NRW; A3.Vp = A3.Rh + 1024; A3.ldv = NRW; A3.Gf = (const bf16*)(ws + WS_GF); A3.Sst = (const bf16*)(ws + WS_SST);
            A3.bonus = (const float*)(ws + WS_BON); A3.lnx_g = args.in[I_LNG] + L * W; A3.lnx_b = args.in[I_LNB] + L * W; A3.Y = (bf16*)(ws + WS_RW); A3.ldy = NRW;
            gu32* s3q = (gu32*)(ws + WS_CTL) + CW_S3Q + L * 64;
            int cur = 0; if (lane == 0) cur = (int)__hip_atomic_fetch_add(s3q, 1u, RLX_AGENT);
            cur = __builtin_amdgcn_readfirstlane(cur);
            while (cur < NB * 128 * NH) {
                int nxt = 0; if (lane == 0) nxt = (int)__hip_atomic_fetch_add(s3q, 1u, RLX_AGENT);
                rw::s3_unit(A3, cur, lane);
                cur = __builtin_amdgcn_readfirstlane(nxt);
            }
        }
        SEAM(PH_MIX2);
    }
    if (IN(PH_GB)) {
        unsigned char* ws = args.ws; asm volatile("" : "+s"(ws));
        bf16* GBp = (bf16*)(ws + WS_GB); bf16* MBp = (bf16*)(ws + WS_MB);
        pg8::StaticOrder S; S.init(M, D, G, (int)blockIdx.x);
#pragma unroll
        for (int b = 0; b < 3; ++b) {
            { int tv = tidL; asm volatile("" : "+v"(tv)); pg8::Gemm g{((bf16*)(ws + WS_H)), ((bf16*)(ws + WS_WIN)) + (size_t)(NA + b * D) * D, M, D, D, D, D}; pg8::EpiAct<1> E{GBp, D};
              pg8::gemm_phase<pg8::EpiAct<1>, pg8::StaticOrder, true, true>(lds + RING_OFF, g, S, E, tv); }
            __syncthreads();
            { int tv = tidL; asm volatile("" : "+v"(tv)); const bf16* Ysrc = (b == 0) ? (const bf16*)(ws + WS_RW) : (b == 1 ? (const bf16*)(ws + WS_AT) : (const bf16*)(ws + WS_PL));
              pg8::Gemm g{Ysrc, ((bf16*)(ws + WS_WB)) + (size_t)b * D * W, M, D, W, (b == 0) ? NRW : (b == 1 ? NAT : NPL), W};
              if (b == 0) { pg8::EpiBr<true> E{GBp, MBp}; pg8::gemm_phase<pg8::EpiBr<true>, pg8::StaticOrder, true, true>(lds + RING_OFF, g, S, E, tv); }
              else { pg8::EpiBr<false> E{GBp, MBp}; pg8::gemm_phase<pg8::EpiBr<false>, pg8::StaticOrder, true, true>(lds + RING_OFF, g, S, E, tv); } }
            __syncthreads();
        }
        SEAM(PH_GB);
    }
    if (IN(PH_GO)) {
        unsigned char* ws = args.ws; asm volatile("" : "+s"(ws));
        pg8::Gemm g{(const bf16*)(ws + WS_MB), ((bf16*)(ws + WS_WO)), M, D, D, D, D}; pg8::StaticOrder S; S.init(M, D, G, (int)blockIdx.x);
        pg8::EpiRes E{xsrc, args.out};
        pg8::gemm_phase<pg8::EpiRes, pg8::StaticOrder, true, true>(lds + RING_OFF, g, S, E, tidL);
        SEAM(PH_GO);
    }
    if (IN(PH_NORM2)) { unsigned char* ws = args.ws; asm volatile("" : "+s"(ws)); rms_rows(args.out, args.in[I_N2G] + (size_t)L * D, ((bf16*)(ws + WS_H)), gw, NGW, lane); SEAM(PH_NORM2); }
        unsigned char* ws = args.ws; asm volatile("" : "+s"(ws));
    if (IN(PH_FF1)) {
        unsigned char* ws = args.ws; asm volatile("" : "+s"(ws));
        pg8::Gemm g{((bf16*)(ws + WS_H)), ((bf16*)(ws + WS_W1)), M, FF, D, D, D}; pg8::StaticOrder S; S.init(M, FF, G, (int)blockIdx.x);
        pg8::EpiAct<2> E{(bf16*)(ws + WS_HID), FF};
        pg8::gemm_phase<pg8::EpiAct<2>, pg8::StaticOrder, true, true>(lds + RING_OFF, g, S, E, tidL);
        SEAM(PH_FF1);
    }
    if (IN(PH_FF2)) {
        unsigned char* ws = args.ws; asm volatile("" : "+s"(ws));
        pg8::Gemm g{(const bf16*)(ws + WS_HID), ((bf16*)(ws + WS_W2)), M, D, FF, FF, FF}; pg8::StaticOrder S; S.init(M, D, G, (int)blockIdx.x);
        pg8::EpiRes E{args.out, args.out};
        pg8::gemm_phase<pg8::EpiRes, pg8::StaticOrder, true, true>(lds + RING_OFF, g, S, E, tidL);
        SEAM(PH_FF2);
    }
    }
#undef IN
#undef SEAM
}

#ifndef MK_MULTI
#define MK_MULTI 0
#endif
#ifndef PROBE_UPTO
#define PROBE_UPTO (-1)
#endif
#ifndef PROBE_DUP
#define PROBE_DUP (-1)
#endif
extern "C" void kernel_launch(void* const* d_in, const int* in_sizes, int n_in, void* d_out, int out_size, void* d_ws, size_t ws_size, hipStream_t stream) {
    static int grid = 0;
    if (grid == 0) {
        if (n_in != 23 || in_sizes[0] != M * D || out_size != M * D || ws_size < WS_END) { fprintf(stderr, "kernel_launch: unexpected shapes (n_in %d, in0 %d, out %d, ws %zu)\n", n_in, n_in > 0 ? in_sizes[0] : -1, out_size, ws_size); grid = -1; return; }
        int dev = 0, cus = 0;
        if (hipGetDevice(&dev) != hipSuccess || hipDeviceGetAttribute(&cus, hipDeviceAttributeMultiprocessorCount, dev) != hipSuccess) { grid = -1; return; }
        if (hipFuncSetAttribute((const void*)mk_fwd, hipFuncAttributeMaxDynamicSharedMemorySize, LDS_BYTES) != hipSuccess) { fprintf(stderr, "kernel_launch: hipFuncSetAttribute failed\n"); grid = -1; return; }
        int per_cu = 0;
        if (hipOccupancyMaxActiveBlocksPerMultiprocessor(&per_cu, (const void*)mk_fwd, NWAVES * 64, LDS_BYTES) != hipSuccess || per_cu < 1) fprintf(stderr, "kernel_launch: occupancy query reports %d\n", per_cu);
        (void)hipGetLastError();
        grid = cus;
    }
    if (grid < 0) return;
    unsigned char* ws = (unsigned char*)d_ws;
    (void)hipMemsetAsync(ws + WS_CTL, 0, CTL_ZERO_BYTES, stream);
    Args a{};
    for (int i = 0; i < 23; ++i) a.in[i] = (const float*)d_in[i];
    a.out = (float*)d_out; a.ws = ws;
#if MK_MULTI
    for (int L = 0; L < 2; ++L) for (int p = 0; p < PH_N; ++p) { a.ph_lo = p; a.ph_hi = p + 1; a.l_lo = L; a.l_hi = L + 1; a.fused = 0; a.probe_upto = -1; a.probe_dup = -1; hipLaunchKernelGGL(mk_fwd, dim3(grid), dim3(NWAVES * 64), LDS_BYTES, stream, a); }
#else
    a.ph_lo = 0; a.ph_hi = PH_N; a.l_lo = 0; a.l_hi = 2; a.fused = 1; a.probe_upto = PROBE_UPTO; a.probe_dup = PROBE_DUP;
    hipLaunchKernelGGL(mk_fwd, dim3(grid), dim3(NWAVES * 64), LDS_BYTES, stream, a);
#endif
}
```

```cpp
#include <hip/hip_runtime.h>
#include <cstdio>
#include <cstdint>
#define GAS __attribute__((address_space(1)))
namespace pg8 {
#define PG8_LAS __attribute__((address_space(3)))
typedef unsigned short bf16_t;
typedef short bf16x8 __attribute__((ext_vector_type(8)));
typedef float f32x4 __attribute__((ext_vector_type(4)));
typedef unsigned u32x4 __attribute__((ext_vector_type(4)));
constexpr int BM = 256, BK = 64, HALF = 128, HTB = HALF * BK * 2  , STAGE_BYTES = 8 * HTB, NXCD = 8, WGM = 8;

__host__ __device__ __forceinline__ int lds_byte(int r, int c) { const int st = (r >> 4) * 2 + (c >> 5), rr = r & 15, cc = c & 31, ob = rr * 64 + cc * 2; return st * 1024 + (ob ^ (((ob >> 9) & 1) << 5)); }
__host__ __device__ __forceinline__ void stage_rc(int b, int& R, int& C) { const int st = b / 1024, sb = b % 1024, swz = sb ^ (((sb >> 9) & 1) << 5); R = (st >> 1) * 16 + swz / 64; C = (st & 1) * 32 + (swz % 64) / 2; }
__host__ __device__ __forceinline__ int perm32(int rho) { const int n = rho >> 4, i = rho & 15; return 8 * (i >> 2) + 4 * n + (i & 3); }

struct Unit { int pm, pn; };
struct Gemm { const bf16_t* A; const bf16_t* Bt; int M, N, K, lda, ldb; };

struct StaticOrder {
    int nM, nN, nwg, G, c;
    __host__ __device__ void init(int M, int N, int G_, int c_) { nM = M / BM; nN = N / BM; nwg = nM * nN; G = G_; c = c_; }
    __host__ __device__ bool next(int i, Unit& u) const {
        const long L = (long)i * G + c; if (L >= nwg) return false;
        int wgid = (int)L; { const int q = nwg / NXCD, r = nwg % NXCD, xcd = wgid % NXCD, off = wgid / NXCD; wgid = (xcd < r ? xcd * (q + 1) : r * (q + 1) + (xcd - r) * q) + off; }
        const int nig = WGM * nN, gid = wgid / nig, fm = gid * WGM, gsz = (nM - fm) < WGM ? (nM - fm) : WGM;
        u.pm = fm + ((wgid % nig) % gsz); u.pn = (wgid % nig) / gsz; return true;
    }
    __device__ __forceinline__ void a_ready(const Unit&) const {}
    __device__ __forceinline__ void done(const Unit&) const {}
};

__device__ __forceinline__ unsigned cvt_pk_bf16(float lo, float hi) { unsigned r; asm volatile("v_cvt_pk_bf16_f32 %0, %1, %2" : "=v"(r) : "v"(lo), "v"(hi)); return r; }
__device__ __forceinline__ float sigm(float x) { return 1.0f / (1.0f + __expf(-x)); }
__device__ __forceinline__ float bf_lo(unsigned w) { return __builtin_bit_cast(float, w << 16); }
__device__ __forceinline__ float bf_hi(unsigned w) { return __builtin_bit_cast(float, w & 0xffff0000u); }
struct EpiA {
    static constexpr bool PERM = true, AFTER_DRAIN = false;
    bf16_t *RW, *AT, *PL, *SB, *HB;
    __device__ __forceinline__ void operator()(const f32x4 (&acc)[2][2][4][2], const Unit& u, int wr, int wc, int fr, int fq) const {
        bf16_t* base; int ldc, colt;
        if (u.pn < 7) { base = RW; ldc = 1792; colt = u.pn * 256; } else if (u.pn < 13) { base = AT; ldc = 1536; colt = (u.pn - 7) * 256; } else { base = PL; ldc = 512; colt = (u.pn - 13) * 256; }
        const int row0 = u.pm * BM + wr * 64 + fr, col0 = colt + wc * 32 + 8 * fq;
#pragma unroll
        for (int ai = 0; ai < 2; ++ai)
#pragma unroll
            for (int m = 0; m < 4; ++m) { bf16_t* rowp = base + (size_t)(row0 + ai * HALF + m * 16) * ldc + col0;
#pragma unroll
                for (int bj = 0; bj < 2; ++bj) { const f32x4 v0 = acc[ai][bj][m][0], v1 = acc[ai][bj][m][1];
                    u32x4 w; w.x = cvt_pk_bf16(v0[0], v0[1]); w.y = cvt_pk_bf16(v0[2], v0[3]); w.z = cvt_pk_bf16(v1[0], v1[1]); w.w = cvt_pk_bf16(v1[2], v1[3]);
                    *(GAS u32x4*)(rowp + bj * HALF) = w;
                    if (u.pn < 7 && m == 3 && fr == 15) *(GAS u32x4*)(SB + (size_t)((row0 + ai * HALF + 48) >> 6) * 1792 + col0 + bj * HALF) = w;
                    if (u.pn >= 13 && m == 3 && wr == 1 && fr >= 1) *(GAS u32x4*)(HB + ((size_t)((row0 + ai * HALF + 48) >> 7) * 15 + (fr - 1)) * 512 + col0 + bj * HALF) = w; } }
    }
};
template <int MODE> struct EpiAct {
    static constexpr bool PERM = true, AFTER_DRAIN = false;
    bf16_t* O; int ldc;
    __device__ __forceinline__ void operator()(const f32x4 (&acc)[2][2][4][2], const Unit& u, int wr, int wc, int fr, int fq) const {
        const int row0 = u.pm * BM + wr * 64 + fr, col0 = u.pn * BM + wc * 32 + 8 * fq;
#pragma unroll
        for (int ai = 0; ai < 2; ++ai)
#pragma unroll
            for (int m = 0; m < 4; ++m) { bf16_t* rowp = O + (size_t)(row0 + ai * HALF + m * 16) * ldc + col0;
#pragma unroll
                for (int bj = 0; bj < 2; ++bj) { f32x4 v0 = acc[ai][bj][m][0], v1 = acc[ai][bj][m][1];
#pragma unroll
                    for (int e = 0; e < 4; ++e) {
                        if (MODE == 1) { v0[e] = sigm(v0[e]); v1[e] = sigm(v1[e]); }
                        if (MODE == 2) { const float a = fmaxf(v0[e], 0.f), b = fmaxf(v1[e], 0.f); v0[e] = a * a; v1[e] = b * b; } }
                    u32x4 w; w.x = cvt_pk_bf16(v0[0], v0[1]); w.y = cvt_pk_bf16(v0[2], v0[3]); w.z = cvt_pk_bf16(v1[0], v1[1]); w.w = cvt_pk_bf16(v1[2], v1[3]);
                    *(GAS u32x4*)(rowp + bj * HALF) = w; } }
    }
};
template <bool FIRST> struct EpiBr {
    static constexpr bool PERM = true, AFTER_DRAIN = false;
    const bf16_t* GB; bf16_t* MBuf;
    __device__ __forceinline__ void operator()(const f32x4 (&acc)[2][2][4][2], const Unit& u, int wr, int wc, int fr, int fq) const {
        const int row0 = u.pm * BM + wr * 64 + fr, col0 = u.pn * BM + wc * 32 + 8 * fq;
#pragma unroll
        for (int ai = 0; ai < 2; ++ai) {
            u32x4 gw[4][2], mw[4][2];
#pragma unroll
            for (int m = 0; m < 4; ++m) { const size_t off = (size_t)(row0 + ai * HALF + m * 16) * 1024 + col0;
#pragma unroll
                for (int bj = 0; bj < 2; ++bj) { gw[m][bj] = *(const GAS u32x4*)(GB + off + bj * HALF); if (!FIRST) mw[m][bj] = *(const GAS u32x4*)(MBuf + off + bj * HALF); } }
#pragma unroll
            for (int m = 0; m < 4; ++m) { const size_t off = (size_t)(row0 + ai * HALF + m * 16) * 1024 + col0;
#pragma unroll
                for (int bj = 0; bj < 2; ++bj) { const f32x4 v0 = acc[ai][bj][m][0], v1 = acc[ai][bj][m][1]; const u32x4 g_ = gw[m][bj];
                    float o[8] = {bf_lo(g_.x) * v0[0], bf_hi(g_.x) * v0[1], bf_lo(g_.y) * v0[2], bf_hi(g_.y) * v0[3], bf_lo(g_.z) * v1[0], bf_hi(g_.z) * v1[1], bf_lo(g_.w) * v1[2], bf_hi(g_.w) * v1[3]};
                    if (!FIRST) { const u32x4 m_ = mw[m][bj];
                        o[0] += bf_lo(m_.x); o[1] += bf_hi(m_.x); o[2] += bf_lo(m_.y); o[3] += bf_hi(m_.y); o[4] += bf_lo(m_.z); o[5] += bf_hi(m_.z); o[6] += bf_lo(m_.w); o[7] += bf_hi(m_.w); }
                    u32x4 w; w.x = cvt_pk_bf16(o[0], o[1]); w.y = cvt_pk_bf16(o[2], o[3]); w.z = cvt_pk_bf16(o[4], o[5]); w.w = cvt_pk_bf16(o[6], o[7]);
                    *(GAS u32x4*)(MBuf + off + bj * HALF) = w; } }
        }
    }
};
struct EpiRes {
    static constexpr bool PERM = false, AFTER_DRAIN = false;
    const float* base; float* out;
    __device__ __forceinline__ void operator()(const f32x4 (&acc)[2][2][4][2], const Unit& u, int wr, int wc, int fr, int fq) const {
        const int row0 = u.pm * BM + wr * 64 + fr, col0 = u.pn * BM + wc * 32 + 4 * fq;
#pragma unroll
        for (int ai = 0; ai < 2; ++ai) {
            f32x4 bs[4][2][2];
#pragma unroll
            for (int m = 0; m < 4; ++m) { const size_t off = (size_t)(row0 + ai * HALF + m * 16) * 1024 + col0;
#pragma unroll
                for (int bj = 0; bj < 2; ++bj)
#pragma unroll
                    for (int n = 0; n < 2; ++n) bs[m][bj][n] = *(const GAS f32x4*)(base + off + bj * HALF + n * 16); }
#pragma unroll
            for (int m = 0; m < 4; ++m) { const size_t off = (size_t)(row0 + ai * HALF + m * 16) * 1024 + col0;
#pragma unroll
                for (int bj = 0; bj < 2; ++bj)
#pragma unroll
                    for (int n = 0; n < 2; ++n) *(GAS f32x4*)(out + off + bj * HALF + n * 16) = bs[m][bj][n] + acc[ai][bj][m][n]; }
        }
    }
};
template <class Epi, class Sched, bool ALIGN_EPI = false, bool SP2 = false>
__device__ __forceinline__ void gemm_phase(PG8_LAS unsigned char* lds, const Gemm g, const Sched& S, const Epi& E, const int tid) {
    const int wid = __builtin_amdgcn_readfirstlane(tid >> 6), lane = tid & 63, wr = wid >> 2, wc = wid & 3, fr = lane & 15, fq = lane >> 4;
    const int K = g.K, nt = K / BK;
    unsigned voffA[2], voffB[2];
#pragma unroll
    for (int i = 0; i < 2; ++i) { int R, C; stage_rc(tid * 16 + i * 8192, R, C); const int Rb = Epi::PERM ? ((R & ~31) + perm32(R & 31)) : R;
        voffA[i] = (unsigned)(R * g.lda + C) * 2u; voffB[i] = (unsigned)(Rb * g.ldb + C) * 2u; }
    const size_t kstep = (size_t)(BK * 2);
    const size_t hstepA = (size_t)HALF * g.lda * 2, hstepB = (size_t)HALF * g.ldb * 2;
    const size_t tstepA = 2 * hstepA, tstepB = 2 * hstepB;
    const unsigned ldsw = (unsigned)wid * 1024u;
    const int aoff = lds_byte(wr * 64 + fr, fq * 8), boff = lds_byte(wc * 32 + fr, fq * 8);
#define PG8_SA(b, h) (((b) * 2 + (h)) * HTB)
#define PG8_SB(b, h) ((4 + (b) * 2 + (h)) * HTB)
#define PG8_STAGE(bufoff, gbase, voff) do { _Pragma("unroll") for (int _i = 0; _i < 2; ++_i) \
        __builtin_amdgcn_global_load_lds((const unsigned*)((const char*)(gbase) + (voff)[_i]), (PG8_LAS unsigned*)(lds + (bufoff) + ldsw + _i * 8192), 16, 0, 0); } while (0)
#define PG8_LDA(dst, b, h) do { _Pragma("unroll") for (int m = 0; m < 4; ++m) _Pragma("unroll") for (int k = 0; k < 2; ++k) dst[m][k] = *(const PG8_LAS bf16x8*)(lds + PG8_SA(b, h) + aoff + m * 2048 + k * 1024); } while (0)
#define PG8_LDB(dst, b, h) do { _Pragma("unroll") for (int n = 0; n < 2; ++n) _Pragma("unroll") for (int k = 0; k < 2; ++k) dst[n][k] = *(const PG8_LAS bf16x8*)(lds + PG8_SB(b, h) + boff + n * 2048 + k * 1024); } while (0)
#define PG8_MMA(ai, bj, At, Bt) do { __builtin_amdgcn_s_setprio(1); _Pragma("unroll") for (int m = 0; m < 4; ++m) _Pragma("unroll") for (int n = 0; n < 2; ++n) _Pragma("unroll") for (int k = 0; k < 2; ++k) \
        acc[ai][bj][m][n] = __builtin_amdgcn_mfma_f32_16x16x32_bf16(Bt[n][k], At[m][k], acc[ai][bj][m][n], 0, 0, 0); __builtin_amdgcn_s_setprio(0); } while (0)
#define PG8_WAIT_V(n) asm volatile("s_waitcnt vmcnt(" #n ")" ::: "memory")
#define PG8_WAIT_L(n) asm volatile("s_waitcnt lgkmcnt(" #n ")" ::: "memory")
#define PG8_BAR __builtin_amdgcn_s_barrier()
#define PG8_SCHED __builtin_amdgcn_sched_barrier(0)
    Unit cur, nxt; int ui = 0;
    if (!S.next(0, cur)) return;
    f32x4 acc[2][2][4][2];
#pragma unroll
    for (int a = 0; a < 2; ++a)
#pragma unroll
        for (int b = 0; b < 2; ++b)
#pragma unroll
            for (int m = 0; m < 4; ++m)
#pragma unroll
                for (int n = 0; n < 2; ++n) acc[a][b][m][n] = (f32x4){0.f, 0.f, 0.f, 0.f};
    bf16x8 At[4][2], B0[2][2], B1[2][2];
    const char* cA = (const char*)g.A + (size_t)cur.pm * tstepA; const char* cB = (const char*)g.Bt + (size_t)cur.pn * tstepB;
    S.a_ready(cur);
    if constexpr (SP2) {
        PG8_STAGE(PG8_SB(0, 0), cB, voffB); PG8_STAGE(PG8_SB(0, 1), cB + hstepB, voffB); PG8_STAGE(PG8_SA(0, 0), cA, voffA); PG8_STAGE(PG8_SA(0, 1), cA + hstepA, voffA);
        if (wr == 1) PG8_BAR;
        PG8_WAIT_V(2); PG8_BAR;
        PG8_STAGE(PG8_SB(1, 0), cB + kstep, voffB); PG8_STAGE(PG8_SA(1, 0), cA + kstep, voffA); PG8_STAGE(PG8_SB(1, 1), cB + hstepB + kstep, voffB);
        PG8_WAIT_V(6); PG8_BAR;
    } else {
        PG8_STAGE(PG8_SB(0, 0), cB, voffB); PG8_STAGE(PG8_SA(0, 0), cA, voffA); PG8_STAGE(PG8_SB(0, 1), cB + hstepB, voffB); PG8_STAGE(PG8_SA(0, 1), cA + hstepA, voffA);
        if (wr == 1) PG8_BAR;
        PG8_WAIT_V(4); PG8_BAR;
        PG8_STAGE(PG8_SB(1, 0), cB + kstep, voffB); PG8_STAGE(PG8_SA(1, 0), cA + kstep, voffA); PG8_STAGE(PG8_SB(1, 1), cB + hstepB + kstep, voffB);
        PG8_WAIT_V(6); PG8_BAR;
    }
    for (;;) {
        const bool has_next = S.next(ui + 1, nxt);
        const char* nA = has_next ? (const char*)g.A + (size_t)nxt.pm * tstepA : cA; const char* nB = has_next ? (const char*)g.Bt + (size_t)nxt.pn * tstepB : cB;
        for (int t = 0; t < nt; t += 2) {
            const bool last = (t == nt - 2);
            const char* a1 = cA + (size_t)(t + 1) * kstep;
            const char* a2 = last ? nA : cA + (size_t)(t + 2) * kstep; const char* b2 = last ? nB : cB + (size_t)(t + 2) * kstep;
            const char* a3 = a2 + kstep; const char* b3 = b2 + kstep;
            if (last && has_next) S.a_ready(nxt);
            if constexpr (SP2) {
            PG8_LDB(B0, 0, 0); PG8_LDB(B1, 0, 1); PG8_SCHED; PG8_LDA(At, 0, 0); PG8_STAGE(PG8_SA(1, 1), a1 + hstepA, voffA);
            PG8_WAIT_V(8); PG8_WAIT_L(0); PG8_BAR; PG8_MMA(0, 0, At, B0); PG8_MMA(0, 1, At, B1); PG8_BAR; PG8_SCHED;
            PG8_LDA(At, 0, 1); PG8_STAGE(PG8_SB(0, 0), b2, voffB); PG8_STAGE(PG8_SB(0, 1), b2 + hstepB, voffB); PG8_STAGE(PG8_SA(0, 0), a2, voffA);
            PG8_WAIT_V(8); PG8_WAIT_L(0); PG8_BAR; PG8_MMA(1, 0, At, B0); PG8_MMA(1, 1, At, B1); PG8_BAR; PG8_SCHED;
            PG8_LDB(B0, 1, 0); PG8_LDB(B1, 1, 1); PG8_SCHED; PG8_LDA(At, 1, 0); PG8_STAGE(PG8_SA(0, 1), a2 + hstepA, voffA);
            PG8_WAIT_V(8); PG8_WAIT_L(0); PG8_BAR; PG8_MMA(0, 0, At, B0); PG8_MMA(0, 1, At, B1); PG8_BAR; PG8_SCHED;
            PG8_LDA(At, 1, 1); PG8_STAGE(PG8_SB(1, 0), b3, voffB); PG8_STAGE(PG8_SB(1, 1), b3 + hstepB, voffB); PG8_STAGE(PG8_SA(1, 0), a3, voffA);
            PG8_WAIT_V(8); PG8_WAIT_L(0); PG8_BAR; PG8_MMA(1, 0, At, B0); PG8_MMA(1, 1, At, B1); PG8_BAR; PG8_SCHED;
            } else {
            PG8_LDB(B0, 0, 0); PG8_SCHED; PG8_LDA(At, 0, 0); PG8_STAGE(PG8_SA(1, 1), a1 + hstepA, voffA);
            PG8_WAIT_L(8); PG8_BAR; PG8_WAIT_L(0); PG8_MMA(0, 0, At, B0); PG8_BAR; PG8_SCHED;
            PG8_LDB(B1, 0, 1); PG8_STAGE(PG8_SB(0, 0), b2, voffB);
            PG8_BAR; PG8_WAIT_L(0); PG8_MMA(0, 1, At, B1); PG8_BAR;
            PG8_LDA(At, 0, 1); PG8_STAGE(PG8_SA(0, 0), a2, voffA);
            PG8_BAR; PG8_WAIT_L(0); PG8_MMA(1, 0, At, B0); PG8_BAR; PG8_SCHED;
            PG8_STAGE(PG8_SB(0, 1), b2 + hstepB, voffB);
            PG8_WAIT_V(6); PG8_BAR; PG8_MMA(1, 1, At, B1); PG8_BAR;
            PG8_LDB(B0, 1, 0); PG8_SCHED; PG8_LDA(At, 1, 0); PG8_STAGE(PG8_SA(0, 1), a2 + hstepA, voffA);
            PG8_WAIT_L(8); PG8_BAR; PG8_WAIT_L(0); PG8_MMA(0, 0, At, B0); PG8_BAR; PG8_SCHED;
            PG8_LDB(B1, 1, 1); PG8_STAGE(PG8_SB(1, 0), b3, voffB);
            PG8_BAR; PG8_WAIT_L(0); PG8_MMA(0, 1, At, B1); PG8_BAR;
            PG8_LDA(At, 1, 1); PG8_STAGE(PG8_SA(1, 0), a3, voffA);
            PG8_BAR; PG8_WAIT_L(0); PG8_MMA(1, 0, At, B0); PG8_BAR; PG8_SCHED;
            PG8_STAGE(PG8_SB(1, 1), b3 + hstepB, voffB);
            PG8_WAIT_V(6); PG8_BAR; PG8_MMA(1, 1, At, B1); PG8_BAR;
            }
        }
        if constexpr (ALIGN_EPI) { if (wr == 0) PG8_BAR; }
        if constexpr (!Epi::AFTER_DRAIN) { E(acc, cur, wr, wc, fr, fq); S.done(cur); }
        if (!has_next) break;
#pragma unroll
        for (int a = 0; a < 2; ++a)
#pragma unroll
            for (int b = 0; b < 2; ++b)
#pragma unroll
                for (int m = 0; m < 4; ++m)
#pragma unroll
                    for (int n = 0; n < 2; ++n) acc[a][b][m][n] = (f32x4){0.f, 0.f, 0.f, 0.f};
        cur = nxt; cA = nA; cB = nB; ++ui;
        if constexpr (ALIGN_EPI) { if (wr == 1) PG8_BAR; }
    }
    PG8_WAIT_V(0);
    if constexpr (!ALIGN_EPI) { if (wr == 0) PG8_BAR; }
    PG8_BAR;
    if constexpr (Epi::AFTER_DRAIN) { E.fused(acc, cur, wr, wc, fr, fq, lds, wid, lane); S.done(cur); }
#undef PG8_SA
#undef PG8_SB
#undef PG8_STAGE
#undef PG8_LDA
#undef PG8_LDB
#undef PG8_MMA
#undef PG8_WAIT_V
#undef PG8_WAIT_L
#undef PG8_BAR
#undef PG8_SCHED
}
}
constexpr int NB = 4, T = 8192, D = 1024, M = NB * T, FF = 4096;
constexpr int NRW = 1792, NAT = 1536, NPL = 512, NA = NRW + NAT + NPL  , NG = 3072, NIN = NA + NG  , W = 512;
constexpr int NH = 8, HD = 64, MB_BLK = 256, NBLK = T / MB_BLK  ;
constexpr int NWAVES = 8;
typedef unsigned short bf16;
typedef unsigned v4u __attribute__((ext_vector_type(4)));
typedef unsigned v2u __attribute__((ext_vector_type(2)));
typedef float f32x4 __attribute__((ext_vector_type(4)));
#define LAS __attribute__((address_space(3)))
typedef GAS unsigned gu32;
#define RLX_AGENT __ATOMIC_RELAXED, __HIP_MEMORY_SCOPE_AGENT
#define LDS_WAIT() asm volatile("s_waitcnt lgkmcnt(0)" ::: "memory")
#define VM_WAIT() asm volatile("s_waitcnt vmcnt(0)" ::: "memory")
__device__ __forceinline__ unsigned f2bf(float f) { unsigned u = __builtin_bit_cast(unsigned, f); return (u + 0x7fffu + ((u >> 16) & 1u)) >> 16; }
typedef float f32x2_t __attribute__((ext_vector_type(2)));
typedef __bf16 bf16x2_t __attribute__((ext_vector_type(2)));
__device__ __forceinline__ unsigned pk2(float lo, float hi) { f32x2_t v = {lo, hi}; bf16x2_t b = __builtin_convertvector(v, bf16x2_t); return __builtin_bit_cast(unsigned, b); }
__device__ __forceinline__ float bf2f(unsigned b) { return __builtin_bit_cast(float, b << 16); }
__device__ __forceinline__ float bflo(unsigned w) { return __builtin_bit_cast(float, w << 16); }
__device__ __forceinline__ float bfhi(unsigned w) { return __builtin_bit_cast(float, w & 0xffff0000u); }
__device__ __forceinline__ float sigmoidf_(float x) { return 1.0f / (1.0f + __expf(-x)); }
__device__ __forceinline__ float fsig(float x) { return __builtin_amdgcn_rcpf(1.0f + __builtin_amdgcn_exp2f(-1.4426950408889634f * x)); }
__device__ __forceinline__ float ftanh(float x) { return 2.0f * fsig(2.0f * x) - 1.0f; }
__device__ __forceinline__ float wave_sum(float v) {
#pragma unroll
    for (int o = 1; o < 64; o <<= 1) v += __shfl_xor(v, o);
    return v;
}

constexpr size_t MiB = 1u << 20;
constexpr size_t WS_CTL = 0, CTL_ZERO_BYTES = 1 * MiB;
constexpr size_t WS_WIN = 1 * MiB, WS_WB = 15 * MiB, WS_WO = 18 * MiB, WS_W1 = 20 * MiB, WS_W2 = 28 * MiB, WS_KM = 36 * MiB, WS_LORA = 37 * MiB;
constexpr size_t WS_H = 40 * MiB, WS_RW = 104 * MiB, WS_AT = 216 * MiB, WS_PL = 312 * MiB  , WS_VT = 344 * MiB  ;
constexpr size_t WS_GF = 376 * MiB, WS_PST = 408 * MiB, WS_QST = 440 * MiB, WS_SST = 472 * MiB, WS_BON = 504 * MiB, WS_SB = 505 * MiB, WS_HB = 507 * MiB, WS_END = 511 * MiB;
constexpr size_t WS_GB = 376 * MiB, WS_MB = 440 * MiB, WS_HID = 104 * MiB;
constexpr int CW_BAR = 4096, CW_Q = 8192, CW_S3F = 10240  , CW_S3Q = 11264  ;
constexpr int RING_OFF = 0, RING_BYTES = 131072;
constexpr int LDS_BYTES = 153600, LDSCTL_OFF = LDS_BYTES - 1024, MISC_OFF = LDSCTL_OFF + 320;
#define XB_TMO      128
#define XB_XCNT(j)  (256  + 64 * (j))
#define XB_XSUB(j)  (1280 + 64 * (j))
#define XB_XGEN(j)  (2304 + 64 * (j))
#define XB_TOP      3328
#define XB_TOPGEN   3392
#define XCD_BAR_WORDS 3456
#define XB_SPIN_CAP (1u << 18)
__device__ __forceinline__ unsigned xb_ld(unsigned* p)              { return __hip_atomic_load(p, __ATOMIC_RELAXED, __HIP_MEMORY_SCOPE_AGENT); }
__device__ __forceinline__ unsigned xb_add(unsigned* p, unsigned v) { return __hip_atomic_fetch_add(p, v, __ATOMIC_RELAXED, __HIP_MEMORY_SCOPE_AGENT); }
__device__ __forceinline__ unsigned xb_xcc_id() { return (unsigned)__builtin_amdgcn_s_getreg((3 << 11) | 20) & 0xFu; }
#define XB_SPIN(cond, bar) do { unsigned _sp = 0; while (cond) { __builtin_amdgcn_s_sleep(1); \
    if ((++_sp & 255u) == 0u) { if (xb_ld(&(bar)[XB_TMO])) break; if (_sp > XB_SPIN_CAP) { atomicAdd(&(bar)[XB_TMO], 1u); break; } } } } while (0)
struct XcdBarrier { unsigned* bar; unsigned x; volatile LAS unsigned* st; };
__device__ __forceinline__ XcdBarrier xcd_barrier_post(unsigned* bar, volatile LAS unsigned* st) {
    XcdBarrier b; b.bar = bar; b.x = xb_xcc_id(); b.st = st;
    if (threadIdx.x == 0) (void)xb_add(&bar[XB_XCNT(b.x)], 1u);
    return b;
}
__device__ __forceinline__ void xcd_barrier_complete(unsigned* bar, unsigned x, unsigned& nloc, unsigned& nx) {
    const unsigned G = gridDim.x * gridDim.y * gridDim.z;
    unsigned sum, cnt, mine, sp = 0u;
    for (;;) {
        sum = 0u; cnt = 0u; mine = 0u;
#pragma unroll
        for (unsigned j = 0; j < 16; ++j) { const unsigned c = xb_ld(&bar[XB_XCNT(j)]); sum += c; cnt += (c > 0u) ? 1u : 0u; mine = (j == x) ? c : mine; }
        if (sum == G) break;
        __builtin_amdgcn_s_sleep(1);
        if ((++sp & 255u) == 0u) { if (xb_ld(&bar[XB_TMO])) break; if (sp > XB_SPIN_CAP) { atomicAdd(&bar[XB_TMO], 1u); break; } }
    }
    nloc = mine > 0u ? mine : 1u; nx = cnt > 0u ? cnt : 1u;
}
__device__ __forceinline__ void xcd_barrier(const XcdBarrier& b, const bool t0) {
    asm volatile("s_waitcnt vmcnt(0)" ::: "memory");
    __syncthreads();
    if (t0) {
        unsigned* bar = b.bar;
        __builtin_amdgcn_s_waitcnt(0);
        unsigned nloc = b.st[0], nx = b.st[1];
        if (nloc == 0u) { xcd_barrier_complete(bar, b.x, nloc, nx); b.st[0] = nloc; b.st[1] = nx; }
        const unsigned old = xb_add(&bar[XB_XSUB(b.x)], 1u);
        const unsigned gen = old / nloc;
        if (old + 1u == (gen + 1u) * nloc) {
            __builtin_amdgcn_fence(__ATOMIC_RELEASE, "agent");
            asm volatile("s_waitcnt vmcnt(0)" ::: "memory");
            const unsigned og = xb_add(&bar[XB_TOP], 1u);
            const unsigned tg = og / nx;
            if (og + 1u == (tg + 1u) * nx) xb_add(&bar[XB_TOPGEN], 1u);
            else XB_SPIN(xb_ld(&bar[XB_TOPGEN]) == tg, bar);
            __builtin_amdgcn_fence(__ATOMIC_ACQUIRE, "agent");
            xb_add(&bar[XB_XGEN(b.x)], 1u);
            asm volatile("s_waitcnt vmcnt(0)" ::: "memory");
        } else {
            XB_SPIN(xb_ld(&bar[XB_XGEN(b.x)]) == gen, bar);
            __builtin_amdgcn_fence(__ATOMIC_ACQUIRE, "agent");
            asm volatile("s_waitcnt vmcnt(0)" ::: "memory");
        }
    }
    __syncthreads();
}

struct Args { const float* in[23]; float* out; unsigned char* ws; int ph_lo, ph_hi, l_lo, l_hi, fused, probe_upto, probe_dup, pad; };
enum Phase { PH_CONV = 0, PH_GEMMA, PH_MIX1, PH_MIX2, PH_S3, PH_GB, PH_GO, PH_NORM2, PH_FF1, PH_FF2, PH_N };
enum In { I_X = 0, I_N1G, I_WIN, I_MU, I_W0, I_WUP, I_A0, I_AUP, I_GUP, I_KK, I_KA, I_RK, I_LNG, I_LNB, I_QNG, I_KNG, I_POOLW, I_POOLS, I_WBR, I_WOUT, I_N2G, I_FF1, I_FF2 };

__device__ __forceinline__ void p0_transpose_item(const float* Wm, int K, int N, bf16* WT, LAS float* scr, int item, int lane) {
    const int nblk = N / 32, kb = item / nblk, nb = item % nblk, k0 = 64 * kb, n0 = 32 * nb;
#pragma unroll 8
    for (int i = 0; i < 32; ++i) { const int kk = 2 * i + (lane >> 5); scr[kk * 33 + (lane & 31)] = ((const GAS float*)Wm)[(size_t)(k0 + kk) * N + n0 + (lane & 31)]; }
    LDS_WAIT(); asm volatile("" ::: "memory");
    const int c = lane & 7;
#pragma unroll
    for (int j = 0; j < 4; ++j) { const int n = (lane >> 3) + 8 * j; const LAS float* s = scr + (8 * c) * 33 + n;
        v4u o; o.x = pk2(s[0 * 33], s[1 * 33]); o.y = pk2(s[2 * 33], s[3 * 33]); o.z = pk2(s[4 * 33], s[5 * 33]); o.w = pk2(s[6 * 33], s[7 * 33]);
        *(GAS v4u*)(WT + (size_t)(n0 + n) * K + k0 + 8 * c) = o; }
    LDS_WAIT(); asm volatile("" ::: "memory");
}
__device__ __forceinline__ void rms_rows(const float* x, const float* g, bf16* out, int gw, int NGW, int lane) {
    f32x4 gv[4];
#pragma unroll
    for (int j = 0; j < 4; ++j) gv[j] = ((const GAS f32x4*)g)[lane + 64 * j];
    for (int m0 = gw; m0 < M; m0 += 4 * NGW) {
        f32x4 v[4][4];
#pragma unroll
        for (int rr = 0; rr < 4; ++rr) { const int m = m0 + rr * NGW; if (m < M) { const GAS f32x4* xr = (const GAS f32x4*)(x + (size_t)m * D) + lane;
#pragma unroll
            for (int j = 0; j < 4; ++j) v[rr][j] = xr[64 * j]; } }
#pragma unroll
        for (int rr = 0; rr < 4; ++rr) { const int m = m0 + rr * NGW; if (m < M) {
            float s_ = 0.f;
#pragma unroll
            for (int j = 0; j < 4; ++j) s_ += (v[rr][j].x * v[rr][j].x + v[rr][j].y * v[rr][j].y) + (v[rr][j].z * v[rr][j].z + v[rr][j].w * v[rr][j].w);
            const float rstd = 1.0f / sqrtf(wave_sum(s_) * (1.0f / D) + 1e-6f);
            GAS unsigned long long* o8 = (GAS unsigned long long*)(out + (size_t)m * D) + lane;
#pragma unroll
            for (int j = 0; j < 4; ++j) { const f32x4 y = v[rr][j] * rstd * gv[j]; o8[64 * j] = (unsigned long long)pk2(y.x, y.y) | ((unsigned long long)pk2(y.z, y.w) << 32); } } }
    }
}

__device__ __forceinline__ void ph_attn_prep(LAS unsigned char* lds, bf16* AT, bf16* VT, const float* qg, const float* kg, float* KM, int G, const int tid) {
    LAS float* red = (LAS float*)lds;
    LAS unsigned char* vt = lds + 2048;
    const int lane = tid & 63, wave = tid >> 6, tsub = lane >> 3, dq = lane & 7;
    float gq[8], gk[8];
#pragma unroll
    for (int e = 0; e < 8; ++e) { gq[e] = ((const GAS float*)qg)[dq * 8 + e] * (0.125f * 1.4426950408889634f); gk[e] = ((const GAS float*)kg)[dq * 8 + e]; }
    for (int bid = blockIdx.x; bid < NB * NBLK * NH; bid += G) {
        const int h = bid & 7, n = (bid >> 3) & 31, b = bid >> 8;
        v4u qv[4], kv[4], vv[4];
#pragma unroll
        for (int j = 0; j < 4; ++j) { const size_t row = (size_t)b * T + n * 256 + wave * 32 + 8 * j + tsub; const bf16* qp = AT + row * NAT + h * 64 + dq * 8;
            qv[j] = *(const GAS v4u*)qp; kv[j] = *(const GAS v4u*)(qp + 512); vv[j] = *(const GAS v4u*)(qp + 1024); }
        float ksum[8];
#pragma unroll
        for (int e = 0; e < 8; ++e) ksum[e] = 0.f;
#pragma unroll
        for (int j = 0; j < 4; ++j) {
            const int tok = wave * 32 + 8 * j + tsub; const size_t row = (size_t)b * T + n * 256 + tok; bf16* qp = AT + row * NAT + h * 64 + dq * 8;
            float q[8], k[8];
            q[0] = bflo(qv[j].x); q[1] = bfhi(qv[j].x); q[2] = bflo(qv[j].y); q[3] = bfhi(qv[j].y); q[4] = bflo(qv[j].z); q[5] = bfhi(qv[j].z); q[6] = bflo(qv[j].w); q[7] = bfhi(qv[j].w);
            k[0] = bflo(kv[j].x); k[1] = bfhi(kv[j].x); k[2] = bflo(kv[j].y); k[3] = bfhi(kv[j].y); k[4] = bflo(kv[j].z); k[5] = bfhi(kv[j].z); k[6] = bflo(kv[j].w); k[7] = bfhi(kv[j].w);
            float qs = 0.f, ks = 0.f;
#pragma unroll
            for (int e = 0; e < 8; ++e) { qs += q[e] * q[e]; ks += k[e] * k[e]; }
            qs += __shfl_xor(qs, 1); qs += __shfl_xor(qs, 2); qs += __shfl_xor(qs, 4);
            ks += __shfl_xor(ks, 1); ks += __shfl_xor(ks, 2); ks += __shfl_xor(ks, 4);
            const float rq = 1.0f / sqrtf(qs * (1.0f / 64.0f) + 1e-6f), rk = 1.0f / sqrtf(ks * (1.0f / 64.0f) + 1e-6f);
#pragma unroll
            for (int e = 0; e < 8; ++e) { q[e] = q[e] * rq * gq[e]; k[e] = k[e] * rk * gk[e]; ksum[e] += k[e]; }
            v4u w; w.x = pk2(q[0], q[1]); w.y = pk2(q[2], q[3]); w.z = pk2(q[4], q[5]); w.w = pk2(q[6], q[7]); *(GAS v4u*)qp = w;
            w.x = pk2(k[0], k[1]); w.y = pk2(k[2], k[3]); w.z = pk2(k[4], k[5]); w.w = pk2(k[6], k[7]); *(GAS v4u*)(qp + 512) = w;
            const unsigned vw[4] = {vv[j].x, vv[j].y, vv[j].z, vv[j].w};
#pragma unroll
            for (int e = 0; e < 8; ++e) *(LAS bf16*)(vt + (dq * 8 + e) * 520 + tok * 2) = (bf16)((e & 1) ? (vw[e >> 1] >> 16) : (vw[e >> 1] & 0xffffu));
        }
#pragma unroll
        for (int e = 0; e < 8; ++e) { float s_ = ksum[e]; s_ += __shfl_xor(s_, 8); s_ += __shfl_xor(s_, 16); s_ += __shfl_xor(s_, 32); if (tsub == 0) red[wave * 64 + dq * 8 + e] = s_; }
        __syncthreads();
        if (wave == 0) { float s_ = 0.f; for (int w = 0; w < 8; ++w) s_ += red[w * 64 + lane]; ((GAS float*)KM)[(((size_t)b * NH + h) * NBLK + n) * 64 + lane] = s_ * (1.0f / 256.0f); }
#pragma unroll
        for (int j = 0; j < 4; ++j) { const int c = tid + 512 * j, dim = c >> 5, part = c & 31;
            const v2u lo = *(const LAS v2u*)(vt + dim * 520 + part * 16), hi = *(const LAS v2u*)(vt + dim * 520 + part * 16 + 8);
            v4u w; w.x = lo.x; w.y = lo.y; w.z = hi.x; w.w = hi.y;
            *(GAS v4u*)(VT + (((size_t)(b * NH + h) * (T / 32) + n * 8 + (part >> 2)) * 64 + dim) * 32 + (part & 3) * 8) = w; }
        __syncthreads();
    }
}
__device__ __forceinline__ void ph_pool(bf16* PL_, const bf16* HB_, int G, const int tid) {
    GAS bf16* PL = (GAS bf16*)PL_; const GAS bf16* HB = (const GAS bf16*)HB_;
    const int ch = tid, wdw = 2 << (ch >> 7);
    for (int u = blockIdx.x; u < M / 128; u += G) {
        float ring[16];
        const int tb0 = (u * 128) & (T - 1);
#pragma unroll
        for (int k = 0; k < 16; ++k) ring[k] = 0.f;
        unsigned short hv[15], cu[16], nx[16];
        if (tb0 > 0) {
#pragma unroll
            for (int j = 0; j < 15; ++j) hv[j] = HB[((size_t)(u - 1) * 15 + j) * 512 + ch];
        }
#pragma unroll
        for (int tt = 0; tt < 16; ++tt) cu[tt] = PL[((size_t)u * 128 + tt) * NPL + ch];
        if (tb0 > 0) {
#pragma unroll
            for (int j = 0; j < 15; ++j) ring[1 + j] = bf2f(hv[j]);
        }
#pragma unroll
        for (int t0 = 0; t0 < 128; t0 += 16) {
            if (t0 + 16 < 128) {
#pragma unroll
                for (int tt = 0; tt < 16; ++tt) nx[tt] = PL[((size_t)u * 128 + t0 + 16 + tt) * NPL + ch];
            }
#pragma unroll
            for (int tt = 0; tt < 16; ++tt) {
                const float cur = bf2f(cu[tt]);
                ring[tt] = cur;
                float sm = 0.f;
#pragma unroll
                for (int i = 0; i < 16; ++i) sm += (i < wdw) ? ring[(tt - i) & 15] : 0.f;
                const int tpos = tb0 + t0 + tt; const int cnt = (tpos + 1 < wdw) ? (tpos + 1) : wdw;
                PL[((size_t)u * 128 + t0 + tt) * NPL + ch] = (bf16)f2bf(sm / (float)cnt - cur);
            }
#pragma unroll
            for (int tt = 0; tt < 16; ++tt) cu[tt] = nx[tt];
        }
    }
}
namespace rw {
typedef short bf16x8 __attribute__((ext_vector_type(8)));
constexpr int MATB = 64 * 144;
constexpr int FPB = 64 * 272;
constexpr int X0 = 0, ACTW = X0, ACTA = X0 + MATB, ACTG = X0 + 2 * MATB  , AAB = X0, AAK = X0 + MATB, ARB = X0 + 2 * MATB, ARK = X0 + 3 * MATB;
constexpr int Y0 = 4 * MATB, LWP = Y0, AIP = Y0 + FPB, LGO = AIP, TOT = Y0 + 2 * FPB  , GCV = TOT + 2048  , DG = Y0  , TI = Y0 + 4096  , U0T = Y0 + 8192;
constexpr int PTAB = GCV + 256  ;
constexpr int Z0 = Y0 + 2 * FPB + 2048 + 256 + 3072, AT_ = Z0, BT_ = Z0 + MATB, KT_ = Z0 + 2 * MATB, RT_ = Z0 + 3 * MATB, ATT = Z0 + 4 * MATB, BHT = Z0 + 5 * MATB, KHT = Z0 + 6 * MATB, VTT = Z0 + 7 * MATB;
constexpr int S1_LDS = Z0 + 8 * MATB;
static_assert(S1_LDS <= 153600 - 1024, "S1 LDS map below the control words");
static_assert(U0T + MATB <= TOT, "U0T inside the dead f32 region");
__device__ __forceinline__ f32x4 mma(bf16x8 a, bf16x8 b, f32x4 c) { return __builtin_amdgcn_mfma_f32_16x16x32_bf16(a, b, c, 0, 0, 0); }
__device__ __forceinline__ bf16x8 ldf(const LAS unsigned char* mat, int row, int s, int g) { return *(const LAS bf16x8*)(mat + row * 144 + s * 64 + g * 16); }
__device__ __forceinline__ v2u pack4(f32x4 v) { v2u w; w.x = pk2(v[0], v[1]); w.y = pk2(v[2], v[3]); return w; }
__device__ __forceinline__ f32x4 unpack4(v2u w) { return (f32x4){bflo(w.x), bfhi(w.x), bflo(w.y), bfhi(w.y)}; }
__device__ __forceinline__ void unpack8(v4u w, float* o) { o[0] = bflo(w.x); o[1] = bfhi(w.x); o[2] = bflo(w.y); o[3] = bfhi(w.y); o[4] = bflo(w.z); o[5] = bfhi(w.z); o[6] = bflo(w.w); o[7] = bfhi(w.w); }
__device__ __forceinline__ v4u pack8(const float* o) { v4u w; w.x = pk2(o[0], o[1]); w.y = pk2(o[2], o[3]); w.z = pk2(o[4], o[5]); w.w = pk2(o[6], o[7]); return w; }
#define LDS_BAR() do { asm volatile("s_waitcnt lgkmcnt(0)" ::: "memory"); __builtin_amdgcn_s_barrier(); asm volatile("" ::: "memory"); } while (0)
#define RW_BAR() do { asm volatile("s_waitcnt vmcnt(0) lgkmcnt(0)" ::: "memory"); __builtin_amdgcn_s_barrier(); asm volatile("" ::: "memory"); } while (0)

struct S1Args {
    bf16* RW; const bf16* SB;
    const float *mu, *w0, *a0, *k_k, *k_a, *r_k;
    const bf16 *WupT, *AupT, *GupT;
    bf16 *Gf, *Pst, *Qst; float* bonus;
    bf16 *Rh, *O0; int ldo;
    bf16* Vm; int ldv;
};
__device__ __forceinline__ void s1_unit(LAS unsigned char* lds, const S1Args& A, const int unit, const int tid, int& hprev, const bool dummy = false) {
    const int lane = tid & 63, wave = __builtin_amdgcn_readfirstlane(tid >> 6), r = lane & 15, g = lane >> 4;
    const int h = unit & 7, cidx = unit >> 3  , c_in_b = cidx & 127;
    const size_t row0 = (size_t)cidx * 64;
    const int t = tid >> 3, q = tid & 7;
    float rp[8], kp[8], lwv[8], av[8], kk[8], vp[8];
    if (h != hprev) {
        LAS float* pt = (LAS float*)(lds + PTAB);
        for (int i = tid; i < 768; i += 512) {
            float v_;
            if (i < 192) v_ = ((const GAS float*)A.mu)[(i >> 6) * 512 + h * 64 + (i & 63)];
            else if (i < 448) v_ = ((const GAS float*)A.mu)[1536 + (i - 192)];
            else { const int j = i - 448, c_ = h * 64 + (j & 63); const int w_ = j >> 6; const float* pp_ = (w_ == 0) ? A.w0 : (w_ == 1) ? A.a0 : (w_ == 2) ? A.k_k : (w_ == 3) ? A.k_a : A.r_k; v_ = ((const GAS float*)pp_)[c_]; }
            pt[i] = v_;
        }
        hprev = h;
        LDS_BAR();
    }
    const LAS float* PT = (const LAS float*)(lds + PTAB);
    bf16x8 fw[2], fa[2], fg[4];
    {
        const int cb = wave >> 1;
        const bf16* wu = A.WupT + (size_t)(h * 64 + 16 * cb + r) * 64 + 8 * g;
        const bf16* au = A.AupT + (size_t)(h * 64 + 16 * cb + r) * 64 + 8 * g;
        const bf16* gu = A.GupT + (size_t)(h * 64 + 16 * cb + r) * 128 + 8 * g;
#pragma unroll
        for (int s = 0; s < 2; ++s) { fw[s] = *(const GAS bf16x8*)(wu + 32 * s); fa[s] = *(const GAS bf16x8*)(au + 32 * s); }
#pragma unroll
        for (int s = 0; s < 4; ++s) fg[s] = *(const GAS bf16x8*)(gu + 32 * s);
    }
    {
        const bf16* cur = A.RW + (row0 + t) * NRW;
        const bf16* prv = (t > 0) ? (cur - NRW) : (A.SB + (size_t)(cidx - 1) * NRW);
        const bool hasprev = (t > 0) || (c_in_b > 0);
        float c8[8], p8[8];
#define MIXLOAD(COL, MUO, DST) do { unpack8(*(const GAS v4u*)(cur + (COL)), c8); if (hasprev) unpack8(*(const GAS v4u*)(prv + (COL)), p8); \
            _Pragma("unroll") for (int e = 0; e < 8; ++e) { const float pv_ = hasprev ? p8[e] : 0.f; DST[e] = c8[e] + (pv_ - c8[e]) * PT[(MUO) + e]; } } while (0)
        MIXLOAD(h * 64 + 8 * q, 8 * q, rp); MIXLOAD(512 + h * 64 + 8 * q, 64 + 8 * q, kp); MIXLOAD(1024 + h * 64 + 8 * q, 128 + 8 * q, vp);
#pragma unroll
        for (int e = 0; e < 8; ++e) *(LAS bf16*)(lds + VTT + (8 * q + e) * 144 + t * 2) = (bf16)f2bf(vp[e]);
        float x8[8];
        MIXLOAD(1536 + 8 * q, 192 + 8 * q, x8);
#pragma unroll
        for (int e = 0; e < 8; ++e) x8[e] = ftanh(x8[e]);
        *(LAS v4u*)(lds + ACTW + t * 144 + q * 16) = pack8(x8);
        MIXLOAD(1600 + 8 * q, 256 + 8 * q, x8);
        *(LAS v4u*)(lds + ACTA + t * 144 + q * 16) = pack8(x8);
        MIXLOAD(1664 + 16 * q, 320 + 16 * q, x8);
#pragma unroll
        for (int e = 0; e < 8; ++e) x8[e] = fsig(x8[e]);
        *(LAS v4u*)(lds + ACTG + t * 272 + q * 32) = pack8(x8);
        MIXLOAD(1664 + 16 * q + 8, 320 + 16 * q + 8, x8);
#pragma unroll
        for (int e = 0; e < 8; ++e) x8[e] = fsig(x8[e]);
        *(LAS v4u*)(lds + ACTG + t * 272 + q * 32 + 16) = pack8(x8);
#undef MIXLOAD
    }
    LDS_BAR();
    if (!dummy) *(GAS v4u*)(A.Vm + (row0 + t) * A.ldv + h * 64 + 8 * q) = pack8(vp);
    {
        const int cb = wave >> 1;
#pragma unroll
        for (int i = 0; i < 2; ++i) {
            const int tb = 2 * (wave & 1) + i;
            f32x4 cw = {0.f, 0.f, 0.f, 0.f}, ca = {0.f, 0.f, 0.f, 0.f}, cg = {0.f, 0.f, 0.f, 0.f};
#pragma unroll
            for (int s = 0; s < 2; ++s) { cw = mma(fw[s], ldf(lds + ACTW, 16 * tb + r, s, g), cw); ca = mma(fa[s], ldf(lds + ACTA, 16 * tb + r, s, g), ca); }
#pragma unroll
            for (int s = 0; s < 4; ++s) cg = mma(fg[s], *(const LAS bf16x8*)(lds + ACTG + (16 * tb + r) * 272 + s * 64 + g * 16), cg);
            *(LAS f32x4*)(lds + LWP + (16 * tb + r) * 272 + (16 * cb + 4 * g) * 4) = cw;
            *(LAS f32x4*)(lds + AIP + (16 * tb + r) * 272 + (16 * cb + 4 * g) * 4) = ca;
            if (!dummy) *(GAS v2u*)(A.Gf + (row0 + 16 * tb + r) * W + h * 64 + 16 * cb + 4 * g) = pack4(cg);
        }
    }
    LDS_BAR();
    {
        const f32x4 l0 = *(const LAS f32x4*)(lds + LWP + t * 272 + q * 32), l1 = *(const LAS f32x4*)(lds + LWP + t * 272 + q * 32 + 16);
        const f32x4 a0v = *(const LAS f32x4*)(lds + AIP + t * 272 + q * 32), a1v = *(const LAS f32x4*)(lds + AIP + t * 272 + q * 32 + 16);
        float ss = 0.f, bon = 0.f;
#pragma unroll
        for (int e = 0; e < 8; ++e) { const int hc = 8 * q + e;
            const float lp = (e < 4) ? l0[e & 3] : l1[e & 3], ap = (e < 4) ? a0v[e & 3] : a1v[e & 3];
            lwv[e] = -0.60653065971263342f * fsig(PT[448 + hc] + lp);
            av[e] = fsig(PT[512 + hc] + ap);
            kk[e] = kp[e] * PT[576 + hc]; ss += kk[e] * kk[e];
            kp[e] = kp[e] * (1.0f + (av[e] - 1.0f) * PT[640 + hc]);
            bon += rp[e] * kp[e] * PT[704 + hc]; }
        ss += __shfl_xor(ss, 1); ss += __shfl_xor(ss, 2); ss += __shfl_xor(ss, 4);
        bon += __shfl_xor(bon, 1); bon += __shfl_xor(bon, 2); bon += __shfl_xor(bon, 4);
        const float inv = 1.0f / fmaxf(sqrtf(ss), 1e-12f);
#pragma unroll
        for (int e = 0; e < 8; ++e) kk[e] *= inv;
        if (q == 0 && !dummy) ((GAS float*)A.bonus)[(row0 + t) * 8 + h] = bon;
        *(LAS f32x4*)(lds + LWP + t * 272 + q * 32) = (f32x4){lwv[0], lwv[1], lwv[2], lwv[3]};
        *(LAS f32x4*)(lds + LWP + t * 272 + q * 32 + 16) = (f32x4){lwv[4], lwv[5], lwv[6], lwv[7]};
    }
    LDS_BAR();
    {
        const int c = tid & 63, seg = tid >> 6; float x[8]; float run = 0.f;
#pragma unroll
        for (int i = 0; i < 8; ++i) { run += *(const LAS float*)(lds + LWP + (8 * seg + i) * 272 + c * 4); x[i] = run; }
        *(LAS float*)(lds + TOT + (seg * 64 + c) * 4) = run;
        LDS_BAR();
        float off = 0.f;
        for (int s2 = 0; s2 < seg; ++s2) off += *(const LAS float*)(lds + TOT + (s2 * 64 + c) * 4);
#pragma unroll
        for (int i = 0; i < 8; ++i) *(LAS float*)(lds + LGO + (8 * seg + i) * 272 + c * 4) = x[i] + off;
    }
    LDS_BAR();
    {
        const f32x4 g0 = *(const LAS f32x4*)(lds + LGO + t * 272 + q * 32), g1 = *(const LAS f32x4*)(lds + LGO + t * 272 + q * 32 + 16);
        const f32x4 e0 = *(const LAS f32x4*)(lds + LGO + 63 * 272 + q * 32), e1 = *(const LAS f32x4*)(lds + LGO + 63 * 272 + q * 32 + 16);
        float at[8], bt[8], kt[8], rt[8], bh[8], kh[8];
#pragma unroll
        for (int e = 0; e < 8; ++e) { const float lg = (e < 4) ? g0[e & 3] : g1[e & 3], lc = (e < 4) ? e0[e & 3] : e1[e & 3];
            const float gm1 = __expf(lg - lwv[e]), gi = __expf(-lg), gt = __expf(lg), gr = __expf(lc - lg);
            const float bb = kk[e] * av[e];
            at[e] = -kk[e] * gm1; bt[e] = bb * gi; kt[e] = kp[e] * gi; rt[e] = rp[e] * gt; bh[e] = bb * gr; kh[e] = kp[e] * gr;
            if (t == 63) *(LAS float*)(lds + GCV + (8 * q + e) * 4) = __expf(lc); }
        *(LAS v4u*)(lds + AT_ + t * 144 + q * 16) = pack8(at); *(LAS v4u*)(lds + BT_ + t * 144 + q * 16) = pack8(bt);
        *(LAS v4u*)(lds + KT_ + t * 144 + q * 16) = pack8(kt); *(LAS v4u*)(lds + RT_ + t * 144 + q * 16) = pack8(rt);
#pragma unroll
        for (int e = 0; e < 8; ++e) { const int o = (8 * q + e) * 144 + t * 2;
            *(LAS bf16*)(lds + ATT + o) = (bf16)f2bf(at[e]); *(LAS bf16*)(lds + BHT + o) = (bf16)f2bf(bh[e]); *(LAS bf16*)(lds + KHT + o) = (bf16)f2bf(kh[e]); }
    }
    LDS_BAR();
    {
        const int hv_tb[10] = {0, 1, 1, 2, 2, 2, 3, 3, 3, 3}, hv_jb[10] = {0, 0, 1, 0, 1, 2, 0, 1, 2, 3};
        const int z_tb[6] = {0, 0, 0, 1, 1, 2}, z_jb[6] = {1, 2, 3, 2, 3, 3};
#pragma unroll
        for (int pass = 0; pass < 2; ++pass) {
            const int hi = (pass == 0) ? wave : (wave < 2 ? 8 + wave : -1);
            if (hi >= 0) {
                int tb = 0, jb = 0;
#pragma unroll
                for (int k = 0; k < 10; ++k) if (k == hi) { tb = hv_tb[k]; jb = hv_jb[k]; }
                f32x4 cab = {0.f, 0.f, 0.f, 0.f}, cak = cab, crb = cab, crk = cab;
#pragma unroll
                for (int s = 0; s < 2; ++s) { const bf16x8 fb = ldf(lds + BT_, 16 * jb + r, s, g), fk = ldf(lds + KT_, 16 * jb + r, s, g), fa = ldf(lds + AT_, 16 * tb + r, s, g), fr = ldf(lds + RT_, 16 * tb + r, s, g);
                    cab = mma(fb, fa, cab); cak = mma(fk, fa, cak); crb = mma(fb, fr, crb); crk = mma(fk, fr, crk); }
                const int tt = 16 * tb + r;
#pragma unroll
                for (int e = 0; e < 4; ++e) { const int j = 16 * jb + 4 * g + e; if (!(j < tt)) { cab[e] = 0.f; cak[e] = 0.f; } if (!(j <= tt)) { crb[e] = 0.f; crk[e] = 0.f; } }
                const int o = tt * 144 + (16 * jb + 4 * g) * 2;
                *(LAS v2u*)(lds + AAB + o) = pack4(cab); *(LAS v2u*)(lds + AAK + o) = pack4(cak); *(LAS v2u*)(lds + ARB + o) = pack4(crb); *(LAS v2u*)(lds + ARK + o) = pack4(crk);
                if (tb == jb) *(LAS f32x4*)(lds + DG + ((tb * 16 + r) * 16 + 4 * g) * 4) = cab;
            }
        }
        if (wave >= 2) {
            int tb = 0, jb = 0;
#pragma unroll
            for (int k = 0; k < 6; ++k) if (k == wave - 2) { tb = z_tb[k]; jb = z_jb[k]; }
            const int o = (16 * tb + r) * 144 + (16 * jb + 4 * g) * 2; const v2u z = {0u, 0u};
            *(LAS v2u*)(lds + AAB + o) = z; *(LAS v2u*)(lds + AAK + o) = z; *(LAS v2u*)(lds + ARB + o) = z; *(LAS v2u*)(lds + ARK + o) = z;
        }
    }
    LDS_BAR();
    f32x4 Y[4];
    if (wave == 7) {
        const int blk = lane >> 4, col = lane & 15; float x[16];
#pragma unroll
        for (int tt = 0; tt < 16; ++tt) {
            float acc = (tt == col) ? 1.0f : 0.0f;
            const LAS float* nrow = (const LAS float*)(lds + DG + ((blk * 16 + tt) * 16) * 4);
#pragma unroll
            for (int j = 0; j < 16; ++j) if (j < tt) acc += nrow[j] * x[j];
            x[tt] = acc;
            *(LAS bf16*)(lds + TI + ((blk * 16 + tt) * 16 + col) * 2) = (bf16)f2bf(acc);
        }
    }
    if (wave < 4) {
#pragma unroll
        for (int i = 0; i < 4; ++i) { Y[i] = (f32x4){0.f, 0.f, 0.f, 0.f};
#pragma unroll
            for (int s = 0; s < 2; ++s) Y[i] = mma(ldf(lds + AAK, 16 * i + r, s, g), ldf(lds + VTT, 16 * wave + r, s, g), Y[i]); }
    } else {
#pragma unroll
        for (int i = 0; i < 4; ++i) Y[i] = unpack4(*(const LAS v2u*)(lds + ATT + (16 * (wave - 4) + r) * 144 + (16 * i + 4 * g) * 2));
    }
    LDS_BAR();
    {
        v2u Xb[4];
        const bf16x8 zf = {0, 0, 0, 0, 0, 0, 0, 0};
#pragma unroll
        for (int i = 0; i < 4; ++i) {
            if (i >= 1) {
                v4u bw; bw.x = Xb[0].x; bw.y = Xb[0].y; bw.z = (i >= 2) ? Xb[1].x : 0u; bw.w = (i >= 2) ? Xb[1].y : 0u;
                v4u aw; const v2u a0 = *(const LAS v2u*)(lds + AAB + (16 * i + r) * 144 + (4 * g) * 2), a1 = *(const LAS v2u*)(lds + AAB + (16 * i + r) * 144 + (16 + 4 * g) * 2);
                aw.x = a0.x; aw.y = a0.y; aw.z = a1.x; aw.w = a1.y;
                Y[i] = mma(__builtin_bit_cast(bf16x8, aw), __builtin_bit_cast(bf16x8, bw), Y[i]);
            }
            if (i >= 3) {
                v4u bw; bw.x = Xb[2].x; bw.y = Xb[2].y; bw.z = 0u; bw.w = 0u;
                v4u aw; const v2u a0 = *(const LAS v2u*)(lds + AAB + (16 * i + r) * 144 + (32 + 4 * g) * 2);
                aw.x = a0.x; aw.y = a0.y; aw.z = 0u; aw.w = 0u;
                Y[i] = mma(__builtin_bit_cast(bf16x8, aw), __builtin_bit_cast(bf16x8, bw), Y[i]);
            }
            v4u tw; const v2u t0 = *(const LAS v2u*)(lds + TI + ((i * 16 + r) * 16 + 4 * g) * 2); tw.x = t0.x; tw.y = t0.y; tw.z = 0u; tw.w = 0u;
            v4u yw; const v2u yp = pack4(Y[i]); yw.x = yp.x; yw.y = yp.y; yw.z = 0u; yw.w = 0u;
            const f32x4 X = mma(__builtin_bit_cast(bf16x8, tw), __builtin_bit_cast(bf16x8, yw), (f32x4){0.f, 0.f, 0.f, 0.f});
            Xb[i] = pack4(X);
            const int dst = (wave < 4) ? (U0T + (16 * wave + r) * 144) : (ATT + (16 * (wave - 4) + r) * 144);
            *(LAS v2u*)(lds + dst + (16 * i + 4 * g) * 2) = Xb[i];
        }
        (void)zf;
    }
    LDS_BAR();
    {
#pragma unroll
        for (int i = 0; i < 2; ++i) {
            const int qq = 2 * wave + i, rb = qq >> 2, cb = qq & 3;
            f32x4 crh = {0.f, 0.f, 0.f, 0.f}, co0 = crh, cp = crh, cq = crh;
#pragma unroll
            for (int s = 0; s < 2; ++s) {
                const bf16x8 fah = ldf(lds + ATT, 16 * rb + r, s, g), fu0 = ldf(lds + U0T, 16 * rb + r, s, g), fvt = ldf(lds + VTT, 16 * rb + r, s, g), fbh = ldf(lds + BHT, 16 * rb + r, s, g), fkh = ldf(lds + KHT, 16 * rb + r, s, g);
                const bf16x8 frb = ldf(lds + ARB, 16 * cb + r, s, g), frk = ldf(lds + ARK, 16 * cb + r, s, g), fbhc = ldf(lds + BHT, 16 * cb + r, s, g), fu0c = ldf(lds + U0T, 16 * cb + r, s, g), fvtc = ldf(lds + VTT, 16 * cb + r, s, g);
                crh = mma(fah, frb, crh);
                co0 = mma(fu0, frb, co0); co0 = mma(fvt, frk, co0);
                cp = mma(fah, fbhc, cp);
                cq = mma(fbh, fu0c, cq); cq = mma(fkh, fvtc, cq);
            }
            crh = crh + unpack4(*(const LAS v2u*)(lds + RT_ + (16 * cb + r) * 144 + (16 * rb + 4 * g) * 2));
            if (rb == cb) {
#pragma unroll
                for (int e = 0; e < 4; ++e) if (4 * g + e == r) cp[e] += *(const LAS float*)(lds + GCV + (16 * rb + 4 * g + e) * 4);
            }
            const size_t tok = row0 + 16 * cb + r;
            if (!dummy) {
            *(GAS v2u*)(A.Rh + tok * A.ldo + h * 64 + 16 * rb + 4 * g) = pack4(crh);
            *(GAS v2u*)(A.O0 + tok * A.ldo + h * 64 + 16 * rb + 4 * g) = pack4(co0);
            const size_t su = (size_t)(((cidx >> 7) * 8 + h) * 128 + c_in_b);
            *(GAS v2u*)(A.Pst + su * 4096 + (16 * cb + r) * 64 + 32 * (rb >> 1) + 8 * g + 4 * (rb & 1)) = pack4(cp);
            *(GAS v2u*)(A.Qst + su * 4096 + (16 * cb + r) * 64 + 16 * g + 4 * rb) = pack4(cq);
            }
        }
    }
    LDS_BAR();
}

struct PQ { v4u p[4][2]; v4u q[2]; };
constexpr int S2_NS = 8, S2_SLOTB = 2048, S2_FLAGS = 4 * S2_NS * S2_SLOTB;
__device__ __forceinline__ void s2_chain(LAS unsigned char* lds, const bf16* Pst, const bf16* Qst, const int bh, const int vb, const int lane) {
    const int r = lane & 15, g = lane >> 4;
    f32x4 S[4];
#pragma unroll
    for (int i = 0; i < 4; ++i) S[i] = (f32x4){0.f, 0.f, 0.f, 0.f};
    const size_t ustep = (size_t)4096;
    const bf16* Pp = Pst + ((size_t)bh * 128) * 4096 + r * 64 + 8 * g;
    const bf16* Qp = Qst + ((size_t)bh * 128) * 4096 + (16 * vb + r) * 64 + 16 * g;
    LAS unsigned char* ring = lds + vb * (S2_NS * S2_SLOTB) + r * 128 + g * 8;
    volatile LAS int* prod = (volatile LAS int*)(lds + S2_FLAGS + vb * 64);
    volatile LAS int* cons = (volatile LAS int*)(lds + S2_FLAGS + 256 + vb * 64);
#define S2_GLD(DST, PTR) asm volatile("global_load_dwordx4 %0, %1, off" : "=v"(DST) : "v"(PTR) : "memory")
#define S2_LOAD(B, C) do { const int c_ = (C) < 128 ? (C) : 127; const bf16* P_ = Pp + (size_t)c_ * ustep; const bf16* Q_ = Qp + (size_t)c_ * ustep; \
        _Pragma("unroll") for (int i = 0; i < 4; ++i) { S2_GLD(B.p[i][0], P_ + (16 * i) * 64); S2_GLD(B.p[i][1], P_ + (16 * i) * 64 + 32); } \
        S2_GLD(B.q[0], Q_); S2_GLD(B.q[1], Q_ + 8); } while (0)
#define S2_READY(B, N) asm volatile("s_waitcnt vmcnt(" #N ")" : "+v"(B.p[0][0]), "+v"(B.p[0][1]), "+v"(B.p[1][0]), "+v"(B.p[1][1]), "+v"(B.p[2][0]), "+v"(B.p[2][1]), "+v"(B.p[3][0]), "+v"(B.p[3][1]), "+v"(B.q[0]), "+v"(B.q[1]) :: "memory")
#define S2_STEP(B, C) do { v2u sb_[4]; \
        { unsigned sp_ = 0; while ((C) - *cons >= S2_NS && ++sp_ < (1u << 22)) __builtin_amdgcn_s_sleep(1); } asm volatile("" ::: "memory");   \
        _Pragma("unroll") for (int i = 0; i < 4; ++i) { sb_[i] = pack4(S[i]); *(LAS v2u*)(ring + ((C) & (S2_NS - 1)) * S2_SLOTB + 32 * i) = sb_[i]; } \
        asm volatile("s_waitcnt lgkmcnt(0)" ::: "memory"); if (lane == 0) *prod = (C) + 1; \
        _Pragma("unroll") for (int i = 0; i < 4; ++i) { v2u qi_; qi_.x = (i & 1) ? B.q[i >> 1].z : B.q[i >> 1].x; qi_.y = (i & 1) ? B.q[i >> 1].w : B.q[i >> 1].y; f32x4 n_ = unpack4(qi_); \
            _Pragma("unroll") for (int s_ = 0; s_ < 2; ++s_) { \
                v4u bw_; bw_.x = sb_[2 * s_].x; bw_.y = sb_[2 * s_].y; bw_.z = sb_[2 * s_ + 1].x; bw_.w = sb_[2 * s_ + 1].y; \
                n_ = mma(__builtin_bit_cast(bf16x8, B.p[i][s_]), __builtin_bit_cast(bf16x8, bw_), n_); } \
            S[i] = n_; } } while (0)
#define PIN() asm volatile("" ::: "memory")
    PQ B0, B1, B2, B3;
    asm volatile("s_waitcnt vmcnt(0)" ::: "memory");
    S2_LOAD(B0, 0); S2_LOAD(B1, 1); S2_LOAD(B2, 2);
    for (int c = 0; c < 128; c += 4) {
        S2_LOAD(B3, c + 3); S2_READY(B0, 30); S2_STEP(B0, c);
        S2_LOAD(B0, c + 4); S2_READY(B1, 30); S2_STEP(B1, c + 1);
        S2_LOAD(B1, c + 5); S2_READY(B2, 30); S2_STEP(B2, c + 2);
        S2_LOAD(B2, c + 6); S2_READY(B3, 30); S2_STEP(B3, c + 3);
    }
    asm volatile("s_waitcnt vmcnt(0)" : "+v"(B0.p[0][0]), "+v"(B0.p[0][1]), "+v"(B0.p[1][0]), "+v"(B0.p[1][1]), "+v"(B0.p[2][0]), "+v"(B0.p[2][1]), "+v"(B0.p[3][0]), "+v"(B0.p[3][1]), "+v"(B0.q[0]), "+v"(B0.q[1]),
                 "+v"(B1.p[0][0]), "+v"(B1.p[0][1]), "+v"(B1.p[1][0]), "+v"(B1.p[1][1]), "+v"(B1.p[2][0]), "+v"(B1.p[2][1]), "+v"(B1.p[3][0]), "+v"(B1.p[3][1]), "+v"(B1.q[0]), "+v"(B1.q[1]) :: "memory");
    asm volatile("" : "+v"(B2.p[0][0]), "+v"(B2.p[0][1]), "+v"(B2.p[1][0]), "+v"(B2.p[1][1]), "+v"(B2.p[2][0]), "+v"(B2.p[2][1]), "+v"(B2.p[3][0]), "+v"(B2.p[3][1]), "+v"(B2.q[0]), "+v"(B2.q[1]) :: "memory");
#undef S2_LOAD
#undef S2_STEP
}
__device__ __forceinline__ void s2_storer(LAS unsigned char* lds, bf16* Sst, const int bh, const int vb, const int lane) {
    volatile LAS int* prod = (volatile LAS int*)(lds + S2_FLAGS + vb * 64);
    volatile LAS int* cons = (volatile LAS int*)(lds + S2_FLAGS + 256 + vb * 64);
    const LAS unsigned char* ring = lds + vb * (S2_NS * S2_SLOTB) + lane * 32;
    bf16* Sp = Sst + ((size_t)bh * 128) * 4096 + (16 * vb) * 64 + lane * 16;
    for (int c = 0; c < 128; ++c) {
        { unsigned sp_ = 0; while (*prod <= c && ++sp_ < (1u << 22)) __builtin_amdgcn_s_sleep(1); }
        asm volatile("" ::: "memory");
        const v4u a_ = *(const LAS v4u*)(ring + (c & (S2_NS - 1)) * S2_SLOTB), b_ = *(const LAS v4u*)(ring + (c & (S2_NS - 1)) * S2_SLOTB + 16);
        asm volatile("s_waitcnt lgkmcnt(0)" ::: "memory");
        if (lane == 0) *cons = c + 1;
        *(GAS v4u*)(Sp + (size_t)c * 4096) = a_; *(GAS v4u*)(Sp + (size_t)c * 4096 + 8) = b_;
    }
}

struct S3Args { const bf16 *Rh, *O0; int ldo; const bf16* Vp; int ldv; const bf16 *Gf, *Sst; const float *bonus, *lnx_g, *lnx_b; bf16* Y; int ldy; };
__device__ __forceinline__ void s3_unit(const S3Args& A, const int unit, const int lane) {
    const int r = lane & 15, g = lane >> 4;
    const int h = unit & 7, cidx = unit >> 3;
    bf16x8 sf[4][2];
#pragma unroll
    for (int i = 0; i < 4; ++i)
#pragma unroll
        for (int s = 0; s < 2; ++s) sf[i][s] = *(const GAS bf16x8*)(A.Sst + (size_t)(((cidx >> 7) * 8 + h) * 128 + (cidx & 127)) * 4096 + (16 * i + r) * 64 + 32 * s + 8 * g);
    struct TB { bf16x8 fr[2]; v2u o0[4], vv[4], gg[4]; float bon; };
#define S3_LOAD(B_, TB_) do { const size_t tok_ = (size_t)cidx * 64 + 16 * (TB_) + r; \
        _Pragma("unroll") for (int s_ = 0; s_ < 2; ++s_) B_.fr[s_] = *(const GAS bf16x8*)(A.Rh + tok_ * A.ldo + h * 64 + 32 * s_ + 8 * g); \
        _Pragma("unroll") for (int i_ = 0; i_ < 4; ++i_) { const int hv_ = h * 64 + 16 * i_ + 4 * g; B_.o0[i_] = *(const GAS v2u*)(A.O0 + tok_ * A.ldo + hv_); \
            B_.vv[i_] = *(const GAS v2u*)(A.Vp + tok_ * A.ldv + hv_); B_.gg[i_] = *(const GAS v2u*)(A.Gf + tok_ * W + hv_); } \
        B_.bon = ((const GAS float*)A.bonus)[tok_ * 8 + h]; } while (0)
#define S3_COMP(B_, TB_) do { const size_t tok_ = (size_t)cidx * 64 + 16 * (TB_) + r; f32x4 o[4]; \
        _Pragma("unroll") for (int i_ = 0; i_ < 4; ++i_) { o[i_] = unpack4(B_.o0[i_]); _Pragma("unroll") for (int s_ = 0; s_ < 2; ++s_) o[i_] = mma(sf[i_][s_], B_.fr[s_], o[i_]); } \
        float sm = 0.f; \
        _Pragma("unroll") for (int i_ = 0; i_ < 4; ++i_) sm += (o[i_][0] + o[i_][1]) + (o[i_][2] + o[i_][3]); \
        sm += __shfl_xor(sm, 16); sm += __shfl_xor(sm, 32); \
        const float mean = sm * (1.0f / 64.0f); float sq = 0.f; \
        _Pragma("unroll") for (int i_ = 0; i_ < 4; ++i_) { o[i_] = o[i_] - mean; sq += (o[i_][0] * o[i_][0] + o[i_][1] * o[i_][1]) + (o[i_][2] * o[i_][2] + o[i_][3] * o[i_][3]); } \
        sq += __shfl_xor(sq, 16); sq += __shfl_xor(sq, 32); \
        const float rstd = 1.0f / sqrtf(sq * (1.0f / 64.0f) + 64e-5f); \
        _Pragma("unroll") for (int i_ = 0; i_ < 4; ++i_) { const int hv_ = h * 64 + 16 * i_ + 4 * g; \
            const f32x4 y = (o[i_] * rstd * lg[i_] + lb[i_] + unpack4(B_.vv[i_]) * B_.bon) * unpack4(B_.gg[i_]); \
            *(GAS v2u*)(A.Y + tok_ * A.ldy + hv_) = pack4(y); } } while (0)
    TB t0, t1, t2;
    S3_LOAD(t0, 0); S3_LOAD(t1, 1);
    f32x4 lg[4], lb[4];
#pragma unroll
    for (int i = 0; i < 4; ++i) { const int hv = h * 64 + 16 * i + 4 * g; lg[i] = *(const GAS f32x4*)(A.lnx_g + hv); lb[i] = *(const GAS f32x4*)(A.lnx_b + hv); }
    S3_LOAD(t2, 2); S3_COMP(t0, 0);
    S3_LOAD(t0, 3); S3_COMP(t1, 1);
    S3_COMP(t2, 2); S3_COMP(t0, 3);
#undef S3_LOAD
#undef S3_COMP
}
}
namespace moba {
typedef short bf16x8 __attribute__((ext_vector_type(8)));
constexpr int OSP = 132;
constexpr int OSLOT = 0, LSUM = OSLOT + 4 * 256 * OSP, KMF = LSUM + 4 * 256 * 4, CNT = KMF + 8192, OFFS = CNT + 128, FILL = OFFS + 128, QLIST = FILL + 128, QSLOT = QLIST + 1024, ITEMS = QSLOT + 1024, ICTR = ITEMS + 1024, NVQ = ICTR + 64  , MOBA_LDS = NVQ + 256;
static_assert(MOBA_LDS <= 153600 - 1024, "MoBA LDS map below the control words");
__device__ __forceinline__ f32x4 mma(bf16x8 a, bf16x8 b, f32x4 c) { return __builtin_amdgcn_mfma_f32_16x16x32_bf16(a, b, c, 0, 0, 0); }
struct Args { bf16* AT; const bf16* VT; const float* KM; const float *qg, *kg; };
struct KV { bf16x8 k[2][2]; bf16x8 v[4]; };
__device__ __forceinline__ void item(LAS unsigned char* lds, const Args& A, const int b, const int h, const int qb, const int kblk, const int off, const int cnt, const int nkc, const bool own, const int lane) {
    const int r = lane & 15, g = lane >> 4;
    const float slope2 = exp2f(-(float)(h + 1)) * 1.4426950408889634f;
    int ql[2]; float aq[2];
    bf16x8 qf[2][2];
#pragma unroll
    for (int qt = 0; qt < 2; ++qt) {
        const int li = qt * 16 + r;
        int qv = -1;
        if (own) qv = off + li; else if (li < cnt) qv = (int)*(const LAS unsigned char*)(lds + QLIST + off + li);
        ql[qt] = qv;
        const int qrow = (qv >= 0) ? qv : 0;
        aq[qt] = (qv >= 0) ? -slope2 * (float)(256 * (qb - kblk) + qrow) : -1e30f;
    }
    const bf16* kbase = A.AT + ((size_t)b * T + kblk * 256 + 8 * (r >> 2) + (r & 3)) * NAT + 512 + h * 64 + 8 * g;
    const bf16* vbase = A.VT + (((size_t)(b * NH + h) * (T / 32) + kblk * 8) * 64 + r) * 32 + 8 * g;
    f32x4 o[4][2]; float l[2] = {0.f, 0.f};
#pragma unroll
    for (int db = 0; db < 4; ++db) { o[db][0] = (f32x4){0.f, 0.f, 0.f, 0.f}; o[db][1] = (f32x4){0.f, 0.f, 0.f, 0.f}; }
#define GLD16(DST, PTR) asm volatile("global_load_dwordx4 %0, %1, off" : "=v"(DST) : "v"(PTR) : "memory")
#define MOBA_LOAD(B, KC) do { const int kc_ = (KC) < nkc ? (KC) : nkc - 1; \
        _Pragma("unroll") for (int kt = 0; kt < 2; ++kt) { const bf16* kp_ = kbase + (size_t)(kc_ * 32 + kt * 4) * NAT; GLD16(B.k[kt][0], kp_); GLD16(B.k[kt][1], kp_ + 32); } \
        _Pragma("unroll") for (int db = 0; db < 4; ++db) { const bf16* vp_ = vbase + (size_t)kc_ * (64 * 32) + (16 * db) * 32; GLD16(B.v[db], vp_); } } while (0)
#define MOBA_READY(B, N) asm volatile("s_waitcnt vmcnt(" #N ")" : "+v"(B.k[0][0]), "+v"(B.k[0][1]), "+v"(B.k[1][0]), "+v"(B.k[1][1]), "+v"(B.v[0]), "+v"(B.v[1]), "+v"(B.v[2]), "+v"(B.v[3]) :: "memory")
#define MOBA_COMPUTE(B, KC) do { v4u pb_[2]; const int kb_ = (KC) * 32 + 8 * g; const bool dg_ = own && ((KC) == nkc - 1); \
        _Pragma("unroll") for (int qt = 0; qt < 2; ++qt) { unsigned pw_[4]; const float bs_ = aq[qt] + slope2 * (float)kb_; const int dl_ = ql[qt] - kb_; \
            _Pragma("unroll") for (int kt = 0; kt < 2; ++kt) { f32x4 st_ = {0.f, 0.f, 0.f, 0.f}; \
                st_ = mma(B.k[kt][0], qf[qt][0], st_); st_ = mma(B.k[kt][1], qf[qt][1], st_); f32x4 p_; \
                if (dg_) { _Pragma("unroll") for (int e = 0; e < 4; ++e) { float x_ = (st_[e] + bs_) + cst[kt * 4 + e]; if (4 * kt + e > dl_) x_ = -1e30f; p_[e] = __builtin_amdgcn_exp2f(x_); } } \
                else { _Pragma("unroll") for (int e = 0; e < 4; ++e) p_[e] = __builtin_amdgcn_exp2f((st_[e] + bs_) + cst[kt * 4 + e]); } \
                l[qt] += (p_[0] + p_[1]) + (p_[2] + p_[3]); pw_[2 * kt] = pk2(p_[0], p_[1]); pw_[2 * kt + 1] = pk2(p_[2], p_[3]); } \
            pb_[qt].x = pw_[0]; pb_[qt].y = pw_[1]; pb_[qt].z = pw_[2]; pb_[qt].w = pw_[3]; } \
        _Pragma("unroll") for (int db = 0; db < 4; ++db) { _Pragma("unroll") for (int qt = 0; qt < 2; ++qt) o[db][qt] = mma(B.v[db], __builtin_bit_cast(bf16x8, pb_[qt]), o[db][qt]); } } while (0)
    float cst[8];
#pragma unroll
    for (int j = 0; j < 8; ++j) cst[j] = slope2 * (float)j;
    KV B0, B1, B2;
    MOBA_LOAD(B0, 0); MOBA_LOAD(B1, 1);
#pragma unroll
    for (int qt = 0; qt < 2; ++qt) { const int qrow = (ql[qt] >= 0) ? ql[qt] : 0; const bf16* qp = A.AT + ((size_t)b * T + qb * 256 + qrow) * NAT + h * 64 + 8 * g;
        qf[qt][0] = *(const GAS bf16x8*)qp; qf[qt][1] = *(const GAS bf16x8*)(qp + 32); }
    asm volatile("" :: "v"(qf[0][0]), "v"(qf[0][1]), "v"(qf[1][0]), "v"(qf[1][1]) : "memory");
    for (int kc = 0; kc < nkc; kc += 3) {
        MOBA_LOAD(B2, kc + 2); MOBA_READY(B0, 16); MOBA_COMPUTE(B0, kc);
        if (kc + 1 < nkc) { MOBA_LOAD(B0, kc + 3); MOBA_READY(B1, 16); MOBA_COMPUTE(B1, kc + 1); }
        if (kc + 2 < nkc) { MOBA_LOAD(B1, kc + 4); MOBA_READY(B2, 16); MOBA_COMPUTE(B2, kc + 2); }
    }
    asm volatile("s_waitcnt vmcnt(0)" : "+v"(B0.k[0][0]), "+v"(B0.k[0][1]), "+v"(B0.k[1][0]), "+v"(B0.k[1][1]), "+v"(B0.v[0]), "+v"(B0.v[1]), "+v"(B0.v[2]), "+v"(B0.v[3]),
                 "+v"(B1.k[0][0]), "+v"(B1.k[0][1]), "+v"(B1.k[1][0]), "+v"(B1.k[1][1]), "+v"(B1.v[0]), "+v"(B1.v[1]), "+v"(B1.v[2]), "+v"(B1.v[3]),
                 "+v"(B2.k[0][0]), "+v"(B2.k[0][1]), "+v"(B2.k[1][0]), "+v"(B2.k[1][1]), "+v"(B2.v[0]), "+v"(B2.v[1]), "+v"(B2.v[2]), "+v"(B2.v[3]) :: "memory");
#undef MOBA_LOAD
#undef MOBA_COMPUTE
#pragma unroll
    for (int qt = 0; qt < 2; ++qt) {
        float ls = l[qt]; ls += __shfl_xor(ls, 16); ls += __shfl_xor(ls, 32);
        if (ql[qt] >= 0) {
            const int slot = own ? 0 : (int)*(const LAS unsigned char*)(lds + QSLOT + off + qt * 16 + r);
            LAS unsigned char* op = lds + OSLOT + (slot * 256 + ql[qt]) * OSP + g * 8;
#pragma unroll
            for (int db = 0; db < 4; ++db) { *(LAS unsigned*)(op + db * 32) = pk2(o[db][qt][0], o[db][qt][1]); *(LAS unsigned*)(op + db * 32 + 4) = pk2(o[db][qt][2], o[db][qt][3]); }
            if (g == 0) *((LAS float*)(lds + LSUM) + slot * 256 + ql[qt]) = ls;
        }
    }
}
__device__ __forceinline__ void unit(LAS unsigned char* lds, const Args& A, const int b, const int h, const int qb, const int tid, const bool dummy = false) {
    const int lane = tid & 63;
    const int wave = __builtin_amdgcn_readfirstlane(tid >> 6);
    if (tid < 96) ((LAS int*)(lds + CNT))[tid] = 0;
    if (tid == 0) *(LAS int*)(lds + ICTR) = 0;
    if (tid < 64) {
        float mq = fabsf(((const GAS float*)A.qg)[lane]), mk = fabsf(((const GAS float*)A.kg)[lane]);
#pragma unroll
        for (int o_ = 1; o_ < 64; o_ <<= 1) { mq = fmaxf(mq, __shfl_xor(mq, o_)); mk = fmaxf(mk, __shfl_xor(mk, o_)); }
        const float B2 = 64.0f * (0.125f * 1.4426950408889634f) * mq * mk * 1.02f, sl2 = exp2f(-(float)(h + 1)) * 1.4426950408889634f;
        const float dmin = ((B2 + 152.0f) / sl2 - 1.0f) * (1.0f / 256.0f);
        if (lane == 0) *(LAS int*)(lds + ICTR + 8) = (int)floorf(dmin) + 2;
    }
    int s0 = -1, s1 = -1, s2 = -1, sl0 = 0, sl1 = 0, sl2q = 0, nv = 1;
    if (qb > 0) {
        const int r = lane & 15, g = lane >> 4;
        bf16x8 qf[2][2];
#pragma unroll
        for (int nt = 0; nt < 2; ++nt) { const bf16* qp = A.AT + ((size_t)b * T + qb * 256 + wave * 32 + nt * 16 + r) * NAT + h * 64 + 8 * g;
            qf[nt][0] = *(const GAS bf16x8*)qp; qf[nt][1] = *(const GAS bf16x8*)(qp + 32); }
        f32x4 ga[2][2];
#pragma unroll
        for (int mt = 0; mt < 2; ++mt) {
            ga[mt][0] = (f32x4){0.f, 0.f, 0.f, 0.f}; ga[mt][1] = (f32x4){0.f, 0.f, 0.f, 0.f};
            const float* kmp = A.KM + ((size_t)(b * NH + h) * NBLK + mt * 16 + r) * 64 + 8 * g;
#pragma unroll
            for (int ks = 0; ks < 2; ++ks) {
                const f32x4 x0 = *(const GAS f32x4*)(kmp + 32 * ks), x1 = *(const GAS f32x4*)(kmp + 32 * ks + 4);
                v4u wh, wl;
                wh.x = pk2(x0[0], x0[1]); wh.y = pk2(x0[2], x0[3]); wh.z = pk2(x1[0], x1[1]); wh.w = pk2(x1[2], x1[3]);
                wl.x = pk2(x0[0] - bflo(wh.x), x0[1] - bfhi(wh.x)); wl.y = pk2(x0[2] - bflo(wh.y), x0[3] - bfhi(wh.y));
                wl.z = pk2(x1[0] - bflo(wh.z), x1[1] - bfhi(wh.z)); wl.w = pk2(x1[2] - bflo(wh.w), x1[3] - bfhi(wh.w));
#pragma unroll
                for (int nt = 0; nt < 2; ++nt) { ga[mt][nt] = mma(__builtin_bit_cast(bf16x8, wh), qf[nt][ks], ga[mt][nt]); ga[mt][nt] = mma(__builtin_bit_cast(bf16x8, wl), qf[nt][ks], ga[mt][nt]); }
            }
        }
        float tg0[2], tg1[2], tg2[2]; int ts0[2], ts1[2], ts2[2];
#define MOBA_INS(V, I) do { const float v_ = (V); const int i_ = (I); \
            if (v_ > g0 || (v_ == g0 && i_ < t0)) { g2 = g1; t2 = t1; g1 = g0; t1 = t0; g0 = v_; t0 = i_; } \
            else if (v_ > g1 || (v_ == g1 && i_ < t1)) { g2 = g1; t2 = t1; g1 = v_; t1 = i_; } \
            else if (v_ > g2 || (v_ == g2 && i_ < t2)) { g2 = v_; t2 = i_; } } while (0)
#pragma unroll
        for (int nt = 0; nt < 2; ++nt) {
            float g0 = -3e38f, g1 = -3e38f, g2 = -3e38f; int t0 = -1, t1 = -1, t2 = -1;
#pragma unroll
            for (int mt = 0; mt < 2; ++mt) {
#pragma unroll
                for (int e = 0; e < 4; ++e) { const int n = 16 * mt + 4 * g + e; const float gt = (n < qb) ? ga[mt][nt][e] : -3e38f;
                    if (gt > g0) { g2 = g1; t2 = t1; g1 = g0; t1 = t0; g0 = gt; t0 = n; }
                    else if (gt > g1) { g2 = g1; t2 = t1; g1 = gt; t1 = n; }
                    else if (gt > g2) { g2 = gt; t2 = n; } }
            }
#pragma unroll
            for (int o_ = 16; o_ <= 32; o_ <<= 1) {
                const float b0 = __shfl_xor(g0, o_), b1 = __shfl_xor(g1, o_), b2 = __shfl_xor(g2, o_);
                const int j0 = __shfl_xor(t0, o_), j1 = __shfl_xor(t1, o_), j2 = __shfl_xor(t2, o_);
                MOBA_INS(b0, j0); MOBA_INS(b1, j1); MOBA_INS(b2, j2);
            }
            tg0[nt] = g0; tg1[nt] = g1; tg2[nt] = g2; ts0[nt] = t0; ts1[nt] = t1; ts2[nt] = t2;
        }
#undef MOBA_INS
        if (lane < 32) { s0 = g ? ts0[1] : ts0[0]; s1 = g ? ts1[1] : ts1[0]; s2 = g ? ts2[1] : ts2[0]; }
        (void)tg0; (void)tg1; (void)tg2;
    }
    const int qid = wave * 32 + lane;
    RW_BAR();
    if (lane < 32) {
        const int Dd = *(const LAS int*)(lds + ICTR + 8);
        if (s0 >= 0 && qb - s0 >= Dd) s0 = -1; if (s0 >= 0) sl0 = nv++;
        if (s1 >= 0 && qb - s1 >= Dd) s1 = -1; if (s1 >= 0) sl1 = nv++;
        if (s2 >= 0 && qb - s2 >= Dd) s2 = -1; if (s2 >= 0) sl2q = nv++;
        if (s0 >= 0) __hip_atomic_fetch_add((LAS int*)(lds + CNT) + s0, 1, __ATOMIC_RELAXED, __HIP_MEMORY_SCOPE_WORKGROUP);
        if (s1 >= 0) __hip_atomic_fetch_add((LAS int*)(lds + CNT) + s1, 1, __ATOMIC_RELAXED, __HIP_MEMORY_SCOPE_WORKGROUP);
        if (s2 >= 0) __hip_atomic_fetch_add((LAS int*)(lds + CNT) + s2, 1, __ATOMIC_RELAXED, __HIP_MEMORY_SCOPE_WORKGROUP);
        *(LAS unsigned char*)(lds + NVQ + qid) = (unsigned char)nv;
    }
    RW_BAR();
    if (tid < 64) {
        const int c = (lane < qb) ? ((LAS int*)(lds + CNT))[lane] : 0, nit = (c + 31) >> 5;
        int run = c, irun = nit;
#pragma unroll
        for (int o_ = 1; o_ < 32; o_ <<= 1) { const int t_ = __shfl_up(run, o_), u_ = __shfl_up(irun, o_); if (lane >= o_) { run += t_; irun += u_; } }
        const int tot = __shfl(irun, 31), off = run - c, ib = irun - nit;
        if (lane < qb) ((LAS int*)(lds + OFFS))[lane] = off;
        for (int k = 0; k < nit; ++k) { ((LAS int*)(lds + ITEMS))[2 * (ib + k)] = lane | ((c - 32 * k < 32 ? c - 32 * k : 32) << 8); ((LAS int*)(lds + ITEMS))[2 * (ib + k) + 1] = off + 32 * k; }
        if (lane >= 32 && lane < 40) { const int i = 39 - lane; ((LAS int*)(lds + ITEMS))[2 * (tot + lane - 32)] = qb | (32 << 8) | (1 << 16) | ((i + 1) << 20); ((LAS int*)(lds + ITEMS))[2 * (tot + lane - 32) + 1] = 32 * i; }
        if (lane == 0) *(LAS int*)(lds + ICTR + 4) = tot + 8;
    }
    RW_BAR();
    if (lane < 32) {
        if (s0 >= 0) { const int p = __hip_atomic_fetch_add((LAS int*)(lds + FILL) + s0, 1, __ATOMIC_RELAXED, __HIP_MEMORY_SCOPE_WORKGROUP); *(LAS unsigned char*)(lds + QLIST + ((LAS int*)(lds + OFFS))[s0] + p) = (unsigned char)qid; *(LAS unsigned char*)(lds + QSLOT + ((LAS int*)(lds + OFFS))[s0] + p) = (unsigned char)sl0; }
        if (s1 >= 0) { const int p = __hip_atomic_fetch_add((LAS int*)(lds + FILL) + s1, 1, __ATOMIC_RELAXED, __HIP_MEMORY_SCOPE_WORKGROUP); *(LAS unsigned char*)(lds + QLIST + ((LAS int*)(lds + OFFS))[s1] + p) = (unsigned char)qid; *(LAS unsigned char*)(lds + QSLOT + ((LAS int*)(lds + OFFS))[s1] + p) = (unsigned char)sl1; }
        if (s2 >= 0) { const int p = __hip_atomic_fetch_add((LAS int*)(lds + FILL) + s2, 1, __ATOMIC_RELAXED, __HIP_MEMORY_SCOPE_WORKGROUP); *(LAS unsigned char*)(lds + QLIST + ((LAS int*)(lds + OFFS))[s2] + p) = (unsigned char)qid; *(LAS unsigned char*)(lds + QSLOT + ((LAS int*)(lds + OFFS))[s2] + p) = (unsigned char)sl2q; }
    }
    RW_BAR();
    {
        const int ni = *(const LAS int*)(lds + ICTR + 4);
        for (;;) {
            int idx = 0; if (lane == 0) idx = __hip_atomic_fetch_add((LAS int*)(lds + ICTR), 1, __ATOMIC_RELAXED, __HIP_MEMORY_SCOPE_WORKGROUP);
            idx = __builtin_amdgcn_readfirstlane(idx);
            if (idx >= ni) break;
            const int w0 = __builtin_amdgcn_readfirstlane(((const LAS int*)(lds + ITEMS))[2 * idx]), w1 = __builtin_amdgcn_readfirstlane(((const LAS int*)(lds + ITEMS))[2 * idx + 1]);
            const bool own = (w0 >> 16) & 1;
            item(lds, A, b, h, qb, w0 & 255, w1, (w0 >> 8) & 255, own ? (w0 >> 20) : 8, own, lane);
        }
    }
    RW_BAR();
    if (!dummy) {
        const int qloc = tid >> 1, half = tid & 1;
        const int nslot = (int)*(const LAS unsigned char*)(lds + NVQ + qloc);
        float acc[32]; float lt = 0.f;
#pragma unroll
        for (int d = 0; d < 32; ++d) acc[d] = 0.f;
        for (int sl = 0; sl < nslot; ++sl) {
            const LAS unsigned* op = (const LAS unsigned*)(lds + OSLOT + (sl * 256 + qloc) * OSP + half * 64);
#pragma unroll
            for (int d = 0; d < 16; ++d) { const unsigned w = op[d]; acc[2 * d] += bflo(w); acc[2 * d + 1] += bfhi(w); }
            lt += *((const LAS float*)(lds + LSUM) + sl * 256 + qloc);
        }
        const float inv = 1.0f / lt;
        bf16* yp = A.AT + ((size_t)b * T + qb * 256 + qloc) * NAT + h * 64 + half * 32;
#pragma unroll
        for (int c = 0; c < 4; ++c) { v4u w; w.x = pk2(acc[8*c] * inv, acc[8*c+1] * inv); w.y = pk2(acc[8*c+2] * inv, acc[8*c+3] * inv); w.z = pk2(acc[8*c+4] * inv, acc[8*c+5] * inv); w.w = pk2(acc[8*c+6] * inv, acc[8*c+7] * inv); *(GAS v4u*)(yp + 8 * c) = w; }
    }
    RW_BAR();
}
}

__global__ void __launch_bounds__(NWAVES * 64, 2) mk_fwd(Args args) {
    extern __shared__ __attribute__((aligned(16))) unsigned char lds_raw[];
    LAS unsigned char* lds = (LAS unsigned char*)lds_raw;
    const int tid0 = threadIdx.x;
    const int wv0 = __builtin_amdgcn_readfirstlane(tid0 >> 6);
    const int G = gridDim.x;
    unsigned char* ws0 = args.ws;
    const int lo = args.ph_lo, hi = args.ph_hi;
    const int NGW = G * NWAVES;
    const bool fused = args.fused != 0;
    volatile LAS unsigned* MISC = (volatile LAS unsigned*)(lds + MISC_OFF);
    for (int u = tid0; u < (LDS_BYTES - LDSCTL_OFF) / 4; u += NWAVES * 64) ((LAS unsigned*)(lds + LDSCTL_OFF))[u] = 0u;
    __syncthreads();
    XcdBarrier bar; bar.bar = (unsigned*)(ws0 + WS_CTL) + CW_BAR; bar.x = 0; bar.st = nullptr;
    if (fused) bar = xcd_barrier_post((unsigned*)(ws0 + WS_CTL) + CW_BAR, MISC + 8);
#define IN(k) (lo <= (k) && (k) < hi && (rep == 1 || (k) <= args.probe_upto || (k) == args.probe_dup))
#define SEAM(k) do { if (fused && !((k) == PH_FF2 && L == args.l_hi - 1)) xcd_barrier(bar, tidL == 0); } while (0)

    for (int L = args.l_lo; L < args.l_hi; ++L)
    for (int rep = (args.probe_upto >= 0 || args.probe_dup >= 0) ? 0 : 1; rep < 2; ++rep) {
    const float* xsrc = (L == 0) ? args.in[I_X] : args.out;
    int tidL; asm volatile("v_mbcnt_lo_u32_b32 %0, -1, 0\n\tv_mbcnt_hi_u32_b32 %0, -1, %0\n\tv_lshl_add_u32 %0, %1, 6, %0" : "=&v"(tidL) : "s"(wv0));
    const int tid = tidL, lane = tid & 63, wave = __builtin_amdgcn_readfirstlane(tid >> 6), gw = blockIdx.x * NWAVES + wave;
    if (IN(PH_CONV)) {
        unsigned char* ws = args.ws; asm volatile("" : "+s"(ws));
        LAS float* scr = (LAS float*)(lds + RING_OFF + wave * 16384);
        const float* w_in = args.in[I_WIN] + (size_t)L * D * NIN;
        const float* w_br = args.in[I_WBR] + (size_t)L * 3 * W * D;
        const float* w_out = args.in[I_WOUT] + (size_t)L * D * D;
        const float* w_f1 = args.in[I_FF1] + (size_t)L * D * FF;
        const float* w_f2 = args.in[I_FF2] + (size_t)L * FF * D;
        constexpr int I_IN = (D / 64) * (NIN / 32), I_B = (W / 64) * (D / 32), I_O = (D / 64) * (D / 32), I_1 = (D / 64) * (FF / 32), I_2 = (FF / 64) * (D / 32);
        constexpr int I_LU = 16, I_LG = 32;
        constexpr int NITEMS = I_IN + 2 * I_B + I_O + I_1 + I_2 + 2 * I_LU + I_LG;
        bf16* WupT = (bf16*)(ws + WS_LORA); bf16* AupT = WupT + 512 * 64; bf16* GupT = AupT + 512 * 64;
        for (int it = gw; it < NITEMS; it += NGW) {
            int r = it;
            if (r < I_IN) { p0_transpose_item(w_in, D, NIN, ((bf16*)(ws + WS_WIN)), scr, r, lane); continue; } r -= I_IN;
            if (r < I_B) { p0_transpose_item(w_br, W, D, ((bf16*)(ws + WS_WB)), scr, r, lane); continue; } r -= I_B;
            if (r < I_B) { p0_transpose_item(w_br + (size_t)W * D, W, D, ((bf16*)(ws + WS_WB)) + (size_t)D * W, scr, r, lane); continue; } r -= I_B;
            if (r < I_O) { p0_transpose_item(w_out, D, D, ((bf16*)(ws + WS_WO)), scr, r, lane); continue; } r -= I_O;
            if (r < I_1) { p0_transpose_item(w_f1, D, FF, ((bf16*)(ws + WS_W1)), scr, r, lane); continue; } r -= I_1;
            if (r < I_2) { p0_transpose_item(w_f2, FF, D, ((bf16*)(ws + WS_W2)), scr, r, lane); continue; } r -= I_2;
            if (r < I_LU) { p0_transpose_item(args.in[I_WUP] + (size_t)L * 64 * W, 64, W, WupT, scr, r, lane); continue; } r -= I_LU;
            if (r < I_LU) { p0_transpose_item(args.in[I_AUP] + (size_t)L * 64 * W, 64, W, AupT, scr, r, lane); continue; } r -= I_LU;
            p0_transpose_item(args.in[I_GUP] + (size_t)L * 128 * W, 128, W, GupT, scr, r, lane);
        }
        const float* pw = args.in[I_POOLW] + (size_t)L * 4 * 128 * 128; const float* ps = args.in[I_POOLS] + (size_t)L * W; const float* wb2 = w_br + (size_t)2 * W * D;
        bf16* WeT = ((bf16*)(ws + WS_WB)) + (size_t)2 * D * W;
        for (int idx = blockIdx.x * (NWAVES * 64) + tid; idx < W * D; idx += G * NWAVES * 64) {
            const int gc = idx / D, dout = idx % D, g = gc >> 7;
            const GAS float* pwr = (const GAS float*)pw + (size_t)gc * 128; float acc = 0.f;
            for (int dp = 0; dp < 128; ++dp) acc += pwr[dp] * ((const GAS float*)ps)[g * 128 + dp] * ((const GAS float*)wb2)[(size_t)(g * 128 + dp) * D + dout];
            ((GAS bf16*)WeT)[(size_t)dout * W + gc] = (bf16)f2bf(acc);
        }
        rms_rows(xsrc, args.in[I_N1G] + (size_t)L * D, ((bf16*)(ws + WS_H)), gw, NGW, lane);
        SEAM(PH_CONV);
    }
    if (IN(PH_GEMMA)) {
        unsigned char* ws = args.ws; asm volatile("" : "+s"(ws));
        pg8::Gemm g{((bf16*)(ws + WS_H)), ((bf16*)(ws + WS_WIN)), M, NA, D, D, D}; pg8::StaticOrder S; S.init(M, NA, G, (int)blockIdx.x);
        pg8::EpiA E{(bf16*)(ws + WS_RW), (bf16*)(ws + WS_AT), (bf16*)(ws + WS_PL), (bf16*)(ws + WS_SB), (bf16*)(ws + WS_HB)};
        pg8::gemm_phase<pg8::EpiA, pg8::StaticOrder, true, true>(lds + RING_OFF, g, S, E, tidL);
        SEAM(PH_GEMMA);
    }
    if (IN(PH_MIX1)) {
        unsigned char* ws = args.ws; asm volatile("" : "+s"(ws));
        ph_attn_prep(lds, (bf16*)(ws + WS_AT), (bf16*)(ws + WS_VT), args.in[I_QNG] + L * 64, args.in[I_KNG] + L * 64, (float*)(ws + WS_KM), G, tidL);
        ph_pool((bf16*)(ws + WS_PL), (const bf16*)(ws + WS_HB), G, tidL);
        __syncthreads();
        rw::S1Args A1; A1.RW = (bf16*)(ws + WS_RW); A1.SB = (const bf16*)(ws + WS_SB);
        A1.mu = args.in[I_MU] + L * NRW; A1.w0 = args.in[I_W0] + L * W; A1.a0 = args.in[I_A0] + L * W; A1.k_k = args.in[I_KK] + L * W; A1.k_a = args.in[I_KA] + L * W; A1.r_k = args.in[I_RK] + L * W;
        A1.WupT = (const bf16*)(ws + WS_LORA); A1.AupT = A1.WupT + 512 * 64; A1.GupT = A1.AupT + 512 * 64;
        A1.Gf = (bf16*)(ws + WS_GF); A1.Pst = (bf16*)(ws + WS_PST); A1.Qst = (bf16*)(ws + WS_QST); A1.bonus = (float*)(ws + WS_BON);
        A1.Rh = (bf16*)(ws + WS_RW); A1.O0 = (bf16*)(ws + WS_RW) + 512; A1.ldo = NRW; A1.Vm = (bf16*)(ws + WS_RW) + 1024; A1.ldv = NRW;
        int hprev = -1;
        for (int unit = blockIdx.x; unit < NB * 128 * NH; unit += G) rw::s1_unit(lds, A1, unit, tidL, hprev);
        SEAM(PH_MIX1);
    }
    if (IN(PH_MIX2)) {
        unsigned char* ws = args.ws; asm volatile("" : "+s"(ws));
#define S3_PUBLISH(BH) do { asm volatile("s_waitcnt vmcnt(0)" ::: "memory"); __syncthreads(); \
            if (tid == 0) { __builtin_amdgcn_fence(__ATOMIC_RELEASE, "agent"); asm volatile("s_waitcnt vmcnt(0)" ::: "memory"); \
                __hip_atomic_store((unsigned*)(ws + WS_CTL) + CW_S3F + L * 64 + (BH), 1u, __ATOMIC_RELAXED, __HIP_MEMORY_SCOPE_AGENT); } } while (0)
        { moba::Args MA; MA.AT = (bf16*)(ws + WS_AT); MA.VT = (const bf16*)(ws + WS_VT); MA.KM = (const float*)(ws + WS_KM); MA.qg = args.in[I_QNG] + L * 64; MA.kg = args.in[I_KNG] + L * 64;
          if (G == 256) {
              const int xcd = blockIdx.x & 7, slot = blockIdx.x >> 3;
              if (slot < 4) {
                  if (tid < 8) *(volatile LAS int*)(lds + rw::S2_FLAGS + tid * 64) = 0;
                  __syncthreads();
                  if (wave < 4) rw::s2_chain(lds, (const bf16*)(ws + WS_PST), (const bf16*)(ws + WS_QST), slot * 8 + xcd, wave, lane);
                  else rw::s2_storer(lds, (bf16*)(ws + WS_SST), slot * 8 + xcd, wave - 4, lane);
                  S3_PUBLISH(slot * 8 + xcd);
              }
              volatile LAS int* qslot = (volatile LAS int*)(lds + LDSCTL_OFF + 64);
              for (int qx = 0; qx < 8; ++qx) {
                  const int x = (xcd + qx) & 7;
                  gu32* qw = (gu32*)(ws + WS_CTL) + CW_Q + (L * 8 + x) * 64;
                  for (;;) {
                      __syncthreads();
                      if (tid == 0) *qslot = (int)__hip_atomic_fetch_add(qw, 1u, RLX_AGENT);
                      __syncthreads();
                      const int u = *qslot;
                      if (u >= 128) break;
                      const int pb_ = u >> 5, ph_ = (pb_ & 1) ? 7 - x : x;
                      int tq = tidL; asm volatile("" : "+v"(tq));
#ifdef PROBE_MOBA2
                      moba::unit(lds, MA, pb_, ph_, 31 - (u & 31), tq, true);
#endif
                      moba::unit(lds, MA, pb_, ph_, 31 - (u & 31), tq);
                  }
              }
          } else {
              for (int bh = blockIdx.x; bh < NB * NH; bh += G) {
                  __syncthreads();
                  if (tid < 8) *(volatile LAS int*)(lds + rw::S2_FLAGS + tid * 64) = 0;
                  __syncthreads();
                  if (wave < 4) rw::s2_chain(lds, (const bf16*)(ws + WS_PST), (const bf16*)(ws + WS_QST), bh, wave, lane);
                  else rw::s2_storer(lds, (bf16*)(ws + WS_SST), bh, wave - 4, lane);
                  S3_PUBLISH(bh);
              }
              __syncthreads();
              for (int u = blockIdx.x; u < NB * NH * NBLK; u += G) { int tq = tidL; asm volatile("" : "+v"(tq)); moba::unit(lds, MA, u >> 8, (u >> 5) & 7, u & 31, tq); } } }
#undef S3_PUBLISH
        {
            if (tid < NB * NH) { unsigned sp_ = 0; while (__hip_atomic_load((unsigned*)(ws + WS_CTL) + CW_S3F + L * 64 + tid, __ATOMIC_RELAXED, __HIP_MEMORY_SCOPE_AGENT) == 0u && ++sp_ < (1u << 24)) __builtin_amdgcn_s_sleep(2); }
            if (tid < 64) { __builtin_amdgcn_fence(__ATOMIC_ACQUIRE, "agent"); asm volatile("s_waitcnt vmcnt(0)" ::: "memory"); }
            __syncthreads();
            rw::S3Args A3; A3.Rh = (const bf16*)(ws + WS_RW); A3.O0 = A3.Rh + 512; A3.ldo = NRW; A3.Vp = A3.Rh + 1024; A3.ldv = NRW; A3.Gf = (const bf16*)(ws + WS_GF); A3.Sst = (const bf16*)(ws + WS_SST);
            A3.bonus = (const float*)(ws + WS_BON); A3.lnx_g = args.in[I_LNG] + L * W; A3.lnx_b = args.in[I_LNB] + L * W; A3.Y = (bf16*)(ws + WS_RW); A3.ldy = NRW;
            gu32* s3q = (gu32*)(ws + WS_CTL) + CW_S3Q + L * 64;
            int cur = 0; if (lane == 0) cur = (int)__hip_atomic_fetch_add(s3q, 1u, RLX_AGENT);
            cur = __builtin_amdgcn_readfirstlane(cur);
            while (cur < NB * 128 * NH) {
                int nxt = 0;
                if (lane == 0) asm volatile("global_atomic_add %0, %1, %2, %3 sc0" : "=v"(nxt) : "v"(0), "v"(1), "s"(s3q) : "memory");
                rw::s3_unit(A3, cur, lane);
                asm volatile("s_waitcnt vmcnt(0)" : "+v"(nxt) :: "memory");
                cur = __builtin_amdgcn_readfirstlane(nxt);
            }
        }
        SEAM(PH_MIX2);
    }
    if (IN(PH_GB)) {
        unsigned char* ws = args.ws; asm volatile("" : "+s"(ws));
        bf16* GBp = (bf16*)(ws + WS_GB); bf16* MBp = (bf16*)(ws + WS_MB);
        pg8::StaticOrder S; S.init(M, D, G, (int)blockIdx.x);
#pragma unroll
        for (int b = 0; b < 3; ++b) {
            { int tv = tidL; asm volatile("" : "+v"(tv)); pg8::Gemm g{((bf16*)(ws + WS_H)), ((bf16*)(ws + WS_WIN)) + (size_t)(NA + b * D) * D, M, D, D, D, D}; pg8::EpiAct<1> E{GBp, D};
              pg8::gemm_phase<pg8::EpiAct<1>, pg8::StaticOrder, true, true>(lds + RING_OFF, g, S, E, tv); }
            __syncthreads();
            { int tv = tidL; asm volatile("" : "+v"(tv)); const bf16* Ysrc = (b == 0) ? (const bf16*)(ws + WS_RW) : (b == 1 ? (const bf16*)(ws + WS_AT) : (const bf16*)(ws + WS_PL));
              pg8::Gemm g{Ysrc, ((bf16*)(ws + WS_WB)) + (size_t)b * D * W, M, D, W, (b == 0) ? NRW : (b == 1 ? NAT : NPL), W};
              if (b == 0) { pg8::EpiBr<true> E{GBp, MBp}; pg8::gemm_phase<pg8::EpiBr<true>, pg8::StaticOrder, true, true>(lds + RING_OFF, g, S, E, tv); }
              else { pg8::EpiBr<false> E{GBp, MBp}; pg8::gemm_phase<pg8::EpiBr<false>, pg8::StaticOrder, true, true>(lds + RING_OFF, g, S, E, tv); } }
            __syncthreads();
        }
        SEAM(PH_GB);
    }
    if (IN(PH_GO)) {
        unsigned char* ws = args.ws; asm volatile("" : "+s"(ws));
        pg8::Gemm g{(const bf16*)(ws + WS_MB), ((bf16*)(ws + WS_WO)), M, D, D, D, D}; pg8::StaticOrder S; S.init(M, D, G, (int)blockIdx.x);
        pg8::EpiRes E{xsrc, args.out};
        pg8::gemm_phase<pg8::EpiRes, pg8::StaticOrder, true, true>(lds + RING_OFF, g, S, E, tidL);
        SEAM(PH_GO);
    }
    if (IN(PH_NORM2)) { unsigned char* ws = args.ws; asm volatile("" : "+s"(ws)); rms_rows(args.out, args.in[I_N2G] + (size_t)L * D, ((bf16*)(ws + WS_H)), gw, NGW, lane); SEAM(PH_NORM2); }
        unsigned char* ws = args.ws; asm volatile("" : "+s"(ws));
    if (IN(PH_FF1)) {
        unsigned char* ws = args.ws; asm volatile("" : "+s"(ws));
        pg8::Gemm g{((bf16*)(ws + WS_H)), ((bf16*)(ws + WS_W1)), M, FF, D, D, D}; pg8::StaticOrder S; S.init(M, FF, G, (int)blockIdx.x);
        pg8::EpiAct<2> E{(bf16*)(ws + WS_HID), FF};
        pg8::gemm_phase<pg8::EpiAct<2>, pg8::StaticOrder, true, true>(lds + RING_OFF, g, S, E, tidL);
        SEAM(PH_FF1);
    }
    if (IN(PH_FF2)) {
        unsigned char* ws = args.ws; asm volatile("" : "+s"(ws));
        pg8::Gemm g{(const bf16*)(ws + WS_HID), ((bf16*)(ws + WS_W2)), M, D, FF, FF, FF}; pg8::StaticOrder S; S.init(M, D, G, (int)blockIdx.x);
        pg8::EpiRes E{args.out, args.out};
        pg8::gemm_phase<pg8::EpiRes, pg8::StaticOrder, true, true>(lds + RING_OFF, g, S, E, tidL);
        SEAM(PH_FF2);
    }
    }
#undef IN
#undef SEAM
}

#ifndef MK_MULTI
#define MK_MULTI 0
#endif
#ifndef PROBE_UPTO
#define PROBE_UPTO (-1)
#endif
#ifndef PROBE_DUP
#define PROBE_DUP (-1)
#endif
extern "C" void kernel_launch(void* const* d_in, const int* in_sizes, int n_in, void* d_out, int out_size, void* d_ws, size_t ws_size, hipStream_t stream) {
    static int grid = 0;
    if (grid == 0) {
        if (n_in != 23 || in_sizes[0] != M * D || out_size != M * D || ws_size < WS_END) { fprintf(stderr, "kernel_launch: unexpected shapes (n_in %d, in0 %d, out %d, ws %zu)\n", n_in, n_in > 0 ? in_sizes[0] : -1, out_size, ws_size); grid = -1; return; }
        int dev = 0, cus = 0;
        if (hipGetDevice(&dev) != hipSuccess || hipDeviceGetAttribute(&cus, hipDeviceAttributeMultiprocessorCount, dev) != hipSuccess) { grid = -1; return; }
        if (hipFuncSetAttribute((const void*)mk_fwd, hipFuncAttributeMaxDynamicSharedMemorySize, LDS_BYTES) != hipSuccess) { fprintf(stderr, "kernel_launch: hipFuncSetAttribute failed\n"); grid = -1; return; }
        int per_cu = 0;
        if (hipOccupancyMaxActiveBlocksPerMultiprocessor(&per_cu, (const void*)mk_fwd, NWAVES * 64, LDS_BYTES) != hipSuccess || per_cu < 1) fprintf(stderr, "kernel_launch: occupancy query reports %d\n", per_cu);
        (void)hipGetLastError();
        grid = cus;
    }
    if (grid < 0) return;
    unsigned char* ws = (unsigned char*)d_ws;
    (void)hipMemsetAsync(ws + WS_CTL, 0, CTL_ZERO_BYTES, stream);
    Args a{};
    for (int i = 0; i < 23; ++i) a.in[i] = (const float*)d_in[i];
    a.out = (float*)d_out; a.ws = ws;
#if MK_MULTI
    for (int L = 0; L < 2; ++L) for (int p = 0; p < PH_N; ++p) { a.ph_lo = p; a.ph_hi = p + 1; a.l_lo = L; a.l_hi = L + 1; a.fused = 0; a.probe_upto = -1; a.probe_dup = -1; hipLaunchKernelGGL(mk_fwd, dim3(grid), dim3(NWAVES * 64), LDS_BYTES, stream, a); }
#else
    a.ph_lo = 0; a.ph_hi = PH_N; a.l_lo = 0; a.l_hi = 2; a.fused = 1; a.probe_upto = PROBE_UPTO; a.probe_dup = PROBE_DUP;
    hipLaunchKernelGGL(mk_fwd, dim3(grid), dim3(NWAVES * 64), LDS_BYTES, stream, a);
#endif
}
```

```cpp
#include <hip/hip_runtime.h>
#include <cstdio>
#include <cstdint>
#define GAS __attribute__((address_space(1)))
namespace pg8 {
#define PG8_LAS __attribute__((address_space(3)))
typedef unsigned short bf16_t;
typedef short bf16x8 __attribute__((ext_vector_type(8)));
typedef float f32x4 __attribute__((ext_vector_type(4)));
typedef unsigned u32x4 __attribute__((ext_vector_type(4)));
constexpr int BM = 256, BK = 64, HALF = 128, HTB = HALF * BK * 2  , STAGE_BYTES = 8 * HTB, NXCD = 8, WGM = 8;

__host__ __device__ __forceinline__ int lds_byte(int r, int c) { const int st = (r >> 4) * 2 + (c >> 5), rr = r & 15, cc = c & 31, ob = rr * 64 + cc * 2; return st * 1024 + (ob ^ (((ob >> 9) & 1) << 5)); }
__host__ __device__ __forceinline__ void stage_rc(int b, int& R, int& C) { const int st = b / 1024, sb = b % 1024, swz = sb ^ (((sb >> 9) & 1) << 5); R = (st >> 1) * 16 + swz / 64; C = (st & 1) * 32 + (swz % 64) / 2; }
__host__ __device__ __forceinline__ int perm32(int rho) { const int n = rho >> 4, i = rho & 15; return 8 * (i >> 2) + 4 * n + (i & 3); }

struct Unit { int pm, pn; };
struct Gemm { const bf16_t* A; const bf16_t* Bt; int M, N, K, lda, ldb; };

struct StaticOrder {
    int nM, nN, nwg, G, c;
    __host__ __device__ void init(int M, int N, int G_, int c_) { nM = M / BM; nN = N / BM; nwg = nM * nN; G = G_; c = c_; }
    __host__ __device__ bool next(int i, Unit& u) const {
        const long L = (long)i * G + c; if (L >= nwg) return false;
        int wgid = (int)L; { const int q = nwg / NXCD, r = nwg % NXCD, xcd = wgid % NXCD, off = wgid / NXCD; wgid = (xcd < r ? xcd * (q + 1) : r * (q + 1) + (xcd - r) * q) + off; }
        const int nig = WGM * nN, gid = wgid / nig, fm = gid * WGM, gsz = (nM - fm) < WGM ? (nM - fm) : WGM;
        u.pm = fm + ((wgid % nig) % gsz); u.pn = (wgid % nig) / gsz; return true;
    }
    __device__ __forceinline__ void a_ready(const Unit&) const {}
    __device__ __forceinline__ void done(const Unit&) const {}
};

__device__ __forceinline__ unsigned cvt_pk_bf16(float lo, float hi) { unsigned r; asm volatile("v_cvt_pk_bf16_f32 %0, %1, %2" : "=v"(r) : "v"(lo), "v"(hi)); return r; }
__device__ __forceinline__ float sigm(float x) { return 1.0f / (1.0f + __expf(-x)); }
__device__ __forceinline__ float bf_lo(unsigned w) { return __builtin_bit_cast(float, w << 16); }
__device__ __forceinline__ float bf_hi(unsigned w) { return __builtin_bit_cast(float, w & 0xffff0000u); }
struct EpiA {
    static constexpr bool PERM = true, AFTER_DRAIN = false;
    bf16_t *RW, *AT, *PL, *SB, *HB;
    __device__ __forceinline__ void operator()(const f32x4 (&acc)[2][2][4][2], const Unit& u, int wr, int wc, int fr, int fq) const {
        bf16_t* base; int ldc, colt;
        if (u.pn < 7) { base = RW; ldc = 1792; colt = u.pn * 256; } else if (u.pn < 13) { base = AT; ldc = 1536; colt = (u.pn - 7) * 256; } else { base = PL; ldc = 512; colt = (u.pn - 13) * 256; }
        const int row0 = u.pm * BM + wr * 64 + fr, col0 = colt + wc * 32 + 8 * fq;
#pragma unroll
        for (int ai = 0; ai < 2; ++ai)
#pragma unroll
            for (int m = 0; m < 4; ++m) { bf16_t* rowp = base + (size_t)(row0 + ai * HALF + m * 16) * ldc + col0;
#pragma unroll
                for (int bj = 0; bj < 2; ++bj) { const f32x4 v0 = acc[ai][bj][m][0], v1 = acc[ai][bj][m][1];
                    u32x4 w; w.x = cvt_pk_bf16(v0[0], v0[1]); w.y = cvt_pk_bf16(v0[2], v0[3]); w.z = cvt_pk_bf16(v1[0], v1[1]); w.w = cvt_pk_bf16(v1[2], v1[3]);
                    *(GAS u32x4*)(rowp + bj * HALF) = w;
                    if (u.pn < 7 && m == 3 && fr == 15) *(GAS u32x4*)(SB + (size_t)((row0 + ai * HALF + 48) >> 6) * 1792 + col0 + bj * HALF) = w;
                    if (u.pn >= 13 && m == 3 && wr == 1 && fr >= 1) *(GAS u32x4*)(HB + ((size_t)((row0 + ai * HALF + 48) >> 7) * 15 + (fr - 1)) * 512 + col0 + bj * HALF) = w; } }
    }
};
template <int MODE> struct EpiAct {
    static constexpr bool PERM = true, AFTER_DRAIN = false;
    bf16_t* O; int ldc;
    __device__ __forceinline__ void operator()(const f32x4 (&acc)[2][2][4][2], const Unit& u, int wr, int wc, int fr, int fq) const {
        const int row0 = u.pm * BM + wr * 64 + fr, col0 = u.pn * BM + wc * 32 + 8 * fq;
#pragma unroll
        for (int ai = 0; ai < 2; ++ai)
#pragma unroll
            for (int m = 0; m < 4; ++m) { bf16_t* rowp = O + (size_t)(row0 + ai * HALF + m * 16) * ldc + col0;
#pragma unroll
                for (int bj = 0; bj < 2; ++bj) { f32x4 v0 = acc[ai][bj][m][0], v1 = acc[ai][bj][m][1];
#pragma unroll
                    for (int e = 0; e < 4; ++e) {
                        if (MODE == 1) { v0[e] = sigm(v0[e]); v1[e] = sigm(v1[e]); }
                        if (MODE == 2) { const float a = fmaxf(v0[e], 0.f), b = fmaxf(v1[e], 0.f); v0[e] = a * a; v1[e] = b * b; } }
                    u32x4 w; w.x = cvt_pk_bf16(v0[0], v0[1]); w.y = cvt_pk_bf16(v0[2], v0[3]); w.z = cvt_pk_bf16(v1[0], v1[1]); w.w = cvt_pk_bf16(v1[2], v1[3]);
                    *(GAS u32x4*)(rowp + bj * HALF) = w; } }
    }
};
template <bool FIRST> struct EpiBr {
    static constexpr bool PERM = true, AFTER_DRAIN = false;
    const bf16_t* GB; bf16_t* MBuf;
    __device__ __forceinline__ void operator()(const f32x4 (&acc)[2][2][4][2], const Unit& u, int wr, int wc, int fr, int fq) const {
        const int row0 = u.pm * BM + wr * 64 + fr, col0 = u.pn * BM + wc * 32 + 8 * fq;
#pragma unroll
        for (int ai = 0; ai < 2; ++ai) {
            u32x4 gw[4][2], mw[4][2];
#pragma unroll
            for (int m = 0; m < 4; ++m) { const size_t off = (size_t)(row0 + ai * HALF + m * 16) * 1024 + col0;
#pragma unroll
                for (int bj = 0; bj < 2; ++bj) { gw[m][bj] = *(const GAS u32x4*)(GB + off + bj * HALF); if (!FIRST) mw[m][bj] = *(const GAS u32x4*)(MBuf + off + bj * HALF); } }
#pragma unroll
            for (int m = 0; m < 4; ++m) { const size_t off = (size_t)(row0 + ai * HALF + m * 16) * 1024 + col0;
#pragma unroll
                for (int bj = 0; bj < 2; ++bj) { const f32x4 v0 = acc[ai][bj][m][0], v1 = acc[ai][bj][m][1]; const u32x4 g_ = gw[m][bj];
                    float o[8] = {bf_lo(g_.x) * v0[0], bf_hi(g_.x) * v0[1], bf_lo(g_.y) * v0[2], bf_hi(g_.y) * v0[3], bf_lo(g_.z) * v1[0], bf_hi(g_.z) * v1[1], bf_lo(g_.w) * v1[2], bf_hi(g_.w) * v1[3]};
                    if (!FIRST) { const u32x4 m_ = mw[m][bj];
                        o[0] += bf_lo(m_.x); o[1] += bf_hi(m_.x); o[2] += bf_lo(m_.y); o[3] += bf_hi(m_.y); o[4] += bf_lo(m_.z); o[5] += bf_hi(m_.z); o[6] += bf_lo(m_.w); o[7] += bf_hi(m_.w); }
                    u32x4 w; w.x = cvt_pk_bf16(o[0], o[1]); w.y = cvt_pk_bf16(o[2], o[3]); w.z = cvt_pk_bf16(o[4], o[5]); w.w = cvt_pk_bf16(o[6], o[7]);
                    *(GAS u32x4*)(MBuf + off + bj * HALF) = w; } }
        }
    }
};
struct EpiRes {
    static constexpr bool PERM = false, AFTER_DRAIN = false;
    const float* base; float* out;
    __device__ __forceinline__ void operator()(const f32x4 (&acc)[2][2][4][2], const Unit& u, int wr, int wc, int fr, int fq) const {
        const int row0 = u.pm * BM + wr * 64 + fr, col0 = u.pn * BM + wc * 32 + 4 * fq;
#pragma unroll
        for (int ai = 0; ai < 2; ++ai) {
            f32x4 bs[4][2][2];
#pragma unroll
            for (int m = 0; m < 4; ++m) { const size_t off = (size_t)(row0 + ai * HALF + m * 16) * 1024 + col0;
#pragma unroll
                for (int bj = 0; bj < 2; ++bj)
#pragma unroll
                    for (int n = 0; n < 2; ++n) bs[m][bj][n] = *(const GAS f32x4*)(base + off + bj * HALF + n * 16); }
#pragma unroll
            for (int m = 0; m < 4; ++m) { const size_t off = (size_t)(row0 + ai * HALF + m * 16) * 1024 + col0;
#pragma unroll
                for (int bj = 0; bj < 2; ++bj)
#pragma unroll
                    for (int n = 0; n < 2; ++n) *(GAS f32x4*)(out + off + bj * HALF + n * 16) = bs[m][bj][n] + acc[ai][bj][m][n]; }
        }
    }
};
template <class Epi, class Sched, bool ALIGN_EPI = false, bool SP2 = false>
__device__ __forceinline__ void gemm_phase(PG8_LAS unsigned char* lds, const Gemm g, const Sched& S, const Epi& E, const int tid) {
    const int wid = __builtin_amdgcn_readfirstlane(tid >> 6), lane = tid & 63, wr = wid >> 2, wc = wid & 3, fr = lane & 15, fq = lane >> 4;
    const int K = g.K, nt = K / BK;
    unsigned voffA[2], voffB[2];
#pragma unroll
    for (int i = 0; i < 2; ++i) { int R, C; stage_rc(tid * 16 + i * 8192, R, C); const int Rb = Epi::PERM ? ((R & ~31) + perm32(R & 31)) : R;
        voffA[i] = (unsigned)(R * g.lda + C) * 2u; voffB[i] = (unsigned)(Rb * g.ldb + C) * 2u; }
    const size_t kstep = (size_t)(BK * 2);
    const size_t hstepA = (size_t)HALF * g.lda * 2, hstepB = (size_t)HALF * g.ldb * 2;
    const size_t tstepA = 2 * hstepA, tstepB = 2 * hstepB;
    const unsigned ldsw = (unsigned)wid * 1024u;
    const int aoff = lds_byte(wr * 64 + fr, fq * 8), boff = lds_byte(wc * 32 + fr, fq * 8);
#define PG8_SA(b, h) (((b) * 2 + (h)) * HTB)
#define PG8_SB(b, h) ((4 + (b) * 2 + (h)) * HTB)
#define PG8_STAGE(bufoff, gbase, voff) do { _Pragma("unroll") for (int _i = 0; _i < 2; ++_i) \
        __builtin_amdgcn_global_load_lds((const unsigned*)((const char*)(gbase) + (voff)[_i]), (PG8_LAS unsigned*)(lds + (bufoff) + ldsw + _i * 8192), 16, 0, 0); } while (0)
#define PG8_LDA(dst, b, h) do { _Pragma("unroll") for (int m = 0; m < 4; ++m) _Pragma("unroll") for (int k = 0; k < 2; ++k) dst[m][k] = *(const PG8_LAS bf16x8*)(lds + PG8_SA(b, h) + aoff + m * 2048 + k * 1024); } while (0)
#define PG8_LDB(dst, b, h) do { _Pragma("unroll") for (int n = 0; n < 2; ++n) _Pragma("unroll") for (int k = 0; k < 2; ++k) dst[n][k] = *(const PG8_LAS bf16x8*)(lds + PG8_SB(b, h) + boff + n * 2048 + k * 1024); } while (0)
#define PG8_MMA(ai, bj, At, Bt) do { __builtin_amdgcn_s_setprio(1); _Pragma("unroll") for (int m = 0; m < 4; ++m) _Pragma("unroll") for (int n = 0; n < 2; ++n) _Pragma("unroll") for (int k = 0; k < 2; ++k) \
        acc[ai][bj][m][n] = __builtin_amdgcn_mfma_f32_16x16x32_bf16(Bt[n][k], At[m][k], acc[ai][bj][m][n], 0, 0, 0); __builtin_amdgcn_s_setprio(0); } while (0)
#define PG8_WAIT_V(n) asm volatile("s_waitcnt vmcnt(" #n ")" ::: "memory")
#define PG8_WAIT_L(n) asm volatile("s_waitcnt lgkmcnt(" #n ")" ::: "memory")
#define PG8_BAR __builtin_amdgcn_s_barrier()
#define PG8_SCHED __builtin_amdgcn_sched_barrier(0)
    Unit cur, nxt; int ui = 0;
    if (!S.next(0, cur)) return;
    f32x4 acc[2][2][4][2];
#pragma unroll
    for (int a = 0; a < 2; ++a)
#pragma unroll
        for (int b = 0; b < 2; ++b)
#pragma unroll
            for (int m = 0; m < 4; ++m)
#pragma unroll
                for (int n = 0; n < 2; ++n) acc[a][b][m][n] = (f32x4){0.f, 0.f, 0.f, 0.f};
    bf16x8 At[4][2], B0[2][2], B1[2][2];
    const char* cA = (const char*)g.A + (size_t)cur.pm * tstepA; const char* cB = (const char*)g.Bt + (size_t)cur.pn * tstepB;
    S.a_ready(cur);
    if constexpr (SP2) {
        PG8_STAGE(PG8_SB(0, 0), cB, voffB); PG8_STAGE(PG8_SB(0, 1), cB + hstepB, voffB); PG8_STAGE(PG8_SA(0, 0), cA, voffA); PG8_STAGE(PG8_SA(0, 1), cA + hstepA, voffA);
        if (wr == 1) PG8_BAR;
        PG8_WAIT_V(2); PG8_BAR;
        PG8_STAGE(PG8_SB(1, 0), cB + kstep, voffB); PG8_STAGE(PG8_SA(1, 0), cA + kstep, voffA); PG8_STAGE(PG8_SB(1, 1), cB + hstepB + kstep, voffB);
        PG8_WAIT_V(6); PG8_BAR;
    } else {
        PG8_STAGE(PG8_SB(0, 0), cB, voffB); PG8_STAGE(PG8_SA(0, 0), cA, voffA); PG8_STAGE(PG8_SB(0, 1), cB + hstepB, voffB); PG8_STAGE(PG8_SA(0, 1), cA + hstepA, voffA);
        if (wr == 1) PG8_BAR;
        PG8_WAIT_V(4); PG8_BAR;
        PG8_STAGE(PG8_SB(1, 0), cB + kstep, voffB); PG8_STAGE(PG8_SA(1, 0), cA + kstep, voffA); PG8_STAGE(PG8_SB(1, 1), cB + hstepB + kstep, voffB);
        PG8_WAIT_V(6); PG8_BAR;
    }
    for (;;) {
        const bool has_next = S.next(ui + 1, nxt);
        const char* nA = has_next ? (const char*)g.A + (size_t)nxt.pm * tstepA : cA; const char* nB = has_next ? (const char*)g.Bt + (size_t)nxt.pn * tstepB : cB;
        for (int t = 0; t < nt; t += 2) {
            const bool last = (t == nt - 2);
            const char* a1 = cA + (size_t)(t + 1) * kstep;
            const char* a2 = last ? nA : cA + (size_t)(t + 2) * kstep; const char* b2 = last ? nB : cB + (size_t)(t + 2) * kstep;
            const char* a3 = a2 + kstep; const char* b3 = b2 + kstep;
            if (last && has_next) S.a_ready(nxt);
            if constexpr (SP2) {
            PG8_LDB(B0, 0, 0); PG8_LDB(B1, 0, 1); PG8_SCHED; PG8_LDA(At, 0, 0); PG8_STAGE(PG8_SA(1, 1), a1 + hstepA, voffA);
            PG8_WAIT_V(8); PG8_WAIT_L(0); PG8_BAR; PG8_MMA(0, 0, At, B0); PG8_MMA(0, 1, At, B1); PG8_BAR; PG8_SCHED;
            PG8_LDA(At, 0, 1); PG8_STAGE(PG8_SB(0, 0), b2, voffB); PG8_STAGE(PG8_SB(0, 1), b2 + hstepB, voffB); PG8_STAGE(PG8_SA(0, 0), a2, voffA);
            PG8_WAIT_V(8); PG8_WAIT_L(0); PG8_BAR; PG8_MMA(1, 0, At, B0); PG8_MMA(1, 1, At, B1); PG8_BAR; PG8_SCHED;
            PG8_LDB(B0, 1, 0); PG8_LDB(B1, 1, 1); PG8_SCHED; PG8_LDA(At, 1, 0); PG8_STAGE(PG8_SA(0, 1), a2 + hstepA, voffA);
            PG8_WAIT_V(8); PG8_WAIT_L(0); PG8_BAR; PG8_MMA(0, 0, At, B0); PG8_MMA(0, 1, At, B1); PG8_BAR; PG8_SCHED;
            PG8_LDA(At, 1, 1); PG8_STAGE(PG8_SB(1, 0), b3, voffB); PG8_STAGE(PG8_SB(1, 1), b3 + hstepB, voffB); PG8_STAGE(PG8_SA(1, 0), a3, voffA);
            PG8_WAIT_V(8); PG8_WAIT_L(0); PG8_BAR; PG8_MMA(1, 0, At, B0); PG8_MMA(1, 1, At, B1); PG8_BAR; PG8_SCHED;
            } else {
            PG8_LDB(B0, 0, 0); PG8_SCHED; PG8_LDA(At, 0, 0); PG8_STAGE(PG8_SA(1, 1), a1 + hstepA, voffA);
            PG8_WAIT_L(8); PG8_BAR; PG8_WAIT_L(0); PG8_MMA(0, 0, At, B0); PG8_BAR; PG8_SCHED;
            PG8_LDB(B1, 0, 1); PG8_STAGE(PG8_SB(0, 0), b2, voffB);
            PG8_BAR; PG8_WAIT_L(0); PG8_MMA(0, 1, At, B1); PG8_BAR;
            PG8_LDA(At, 0, 1); PG8_STAGE(PG8_SA(0, 0), a2, voffA);
            PG8_BAR; PG8_WAIT_L(0); PG8_MMA(1, 0, At, B0); PG8_BAR; PG8_SCHED;
            PG8_STAGE(PG8_SB(0, 1), b2 + hstepB, voffB);
            PG8_WAIT_V(6); PG8_BAR; PG8_MMA(1, 1, At, B1); PG8_BAR;
            PG8_LDB(B0, 1, 0); PG8_SCHED; PG8_LDA(At, 1, 0); PG8_STAGE(PG8_SA(0, 1), a2 + hstepA, voffA);
            PG8_WAIT_L(8); PG8_BAR; PG8_WAIT_L(0); PG8_MMA(0, 0, At, B0); PG8_BAR; PG8_SCHED;
            PG8_LDB(B1, 1, 1); PG8_STAGE(PG8_SB(1, 0), b3, voffB);
            PG8_BAR; PG8_WAIT_L(0); PG8_MMA(0, 1, At, B1); PG8_BAR;
            PG8_LDA(At, 1, 1); PG8_STAGE(PG8_SA(1, 0), a3, voffA);
            PG8_BAR; PG8_WAIT_L(0); PG8_MMA(1, 0, At, B0); PG8_BAR; PG8_SCHED;
            PG8_STAGE(PG8_SB(1, 1), b3 + hstepB, voffB);
            PG8_WAIT_V(6); PG8_BAR; PG8_MMA(1, 1, At, B1); PG8_BAR;
            }
        }
        if constexpr (ALIGN_EPI) { if (wr == 0) PG8_BAR; }
        if constexpr (!Epi::AFTER_DRAIN) { E(acc, cur, wr, wc, fr, fq); S.done(cur); }
        if (!has_next) break;
#pragma unroll
        for (int a = 0; a < 2; ++a)
#pragma unroll
            for (int b = 0; b < 2; ++b)
#pragma unroll
                for (int m = 0; m < 4; ++m)
#pragma unroll
                    for (int n = 0; n < 2; ++n) acc[a][b][m][n] = (f32x4){0.f, 0.f, 0.f, 0.f};
        cur = nxt; cA = nA; cB = nB; ++ui;
        if constexpr (ALIGN_EPI) { if (wr == 1) PG8_BAR; }
    }
    PG8_WAIT_V(0);
    if constexpr (!ALIGN_EPI) { if (wr == 0) PG8_BAR; }
    PG8_BAR;
    if constexpr (Epi::AFTER_DRAIN) { E.fused(acc, cur, wr, wc, fr, fq, lds, wid, lane); S.done(cur); }
#undef PG8_SA
#undef PG8_SB
#undef PG8_STAGE
#undef PG8_LDA
#undef PG8_LDB
#undef PG8_MMA
#undef PG8_WAIT_V
#undef PG8_WAIT_L
#undef PG8_BAR
#undef PG8_SCHED
}
}
constexpr int NB = 4, T = 8192, D = 1024, M = NB * T, FF = 4096;
constexpr int NRW = 1792, NAT = 1536, NPL = 512, NA = NRW + NAT + NPL  , NG = 3072, NIN = NA + NG  , W = 512;
constexpr int NH = 8, HD = 64, MB_BLK = 256, NBLK = T / MB_BLK  ;
constexpr int NWAVES = 8;
typedef unsigned short bf16;
typedef unsigned v4u __attribute__((ext_vector_type(4)));
typedef unsigned v2u __attribute__((ext_vector_type(2)));
typedef float f32x4 __attribute__((ext_vector_type(4)));
#define LAS __attribute__((address_space(3)))
typedef GAS unsigned gu32;
#define RLX_AGENT __ATOMIC_RELAXED, __HIP_MEMORY_SCOPE_AGENT
#define LDS_WAIT() asm volatile("s_waitcnt lgkmcnt(0)" ::: "memory")
#define VM_WAIT() asm volatile("s_waitcnt vmcnt(0)" ::: "memory")
__device__ __forceinline__ unsigned f2bf(float f) { unsigned u = __builtin_bit_cast(unsigned, f); return (u + 0x7fffu + ((u >> 16) & 1u)) >> 16; }
typedef float f32x2_t __attribute__((ext_vector_type(2)));
typedef __bf16 bf16x2_t __attribute__((ext_vector_type(2)));
__device__ __forceinline__ unsigned pk2(float lo, float hi) { f32x2_t v = {lo, hi}; bf16x2_t b = __builtin_convertvector(v, bf16x2_t); return __builtin_bit_cast(unsigned, b); }
__device__ __forceinline__ float bf2f(unsigned b) { return __builtin_bit_cast(float, b << 16); }
__device__ __forceinline__ float bflo(unsigned w) { return __builtin_bit_cast(float, w << 16); }
__device__ __forceinline__ float bfhi(unsigned w) { return __builtin_bit_cast(float, w & 0xffff0000u); }
__device__ __forceinline__ float sigmoidf_(float x) { return 1.0f / (1.0f + __expf(-x)); }
__device__ __forceinline__ float fsig(float x) { return __builtin_amdgcn_rcpf(1.0f + __builtin_amdgcn_exp2f(-1.4426950408889634f * x)); }
__device__ __forceinline__ float ftanh(float x) { return 2.0f * fsig(2.0f * x) - 1.0f; }
__device__ __forceinline__ float wave_sum(float v) {
#pragma unroll
    for (int o = 1; o < 64; o <<= 1) v += __shfl_xor(v, o);
    return v;
}

constexpr size_t MiB = 1u << 20;
constexpr size_t WS_CTL = 0, CTL_ZERO_BYTES = 1 * MiB;
constexpr size_t WS_WIN = 1 * MiB, WS_WB = 15 * MiB, WS_WO = 18 * MiB, WS_W1 = 20 * MiB, WS_W2 = 28 * MiB, WS_KM = 36 * MiB, WS_LORA = 37 * MiB;
constexpr size_t WS_H = 40 * MiB, WS_RW = 104 * MiB, WS_AT = 216 * MiB, WS_PL = 312 * MiB  , WS_VT = 344 * MiB  ;
constexpr size_t WS_GF = 376 * MiB, WS_PST = 408 * MiB, WS_QST = 440 * MiB, WS_SST = 472 * MiB, WS_BON = 504 * MiB, WS_SB = 505 * MiB, WS_HB = 507 * MiB, WS_END = 511 * MiB;
constexpr size_t WS_GB = 376 * MiB, WS_MB = 440 * MiB, WS_HID = 104 * MiB;
constexpr int CW_BAR = 4096, CW_Q = 8192, CW_S3F = 10240  , CW_S3Q = 11264  ;
constexpr int RING_OFF = 0, RING_BYTES = 131072;
constexpr int LDS_BYTES = 153600, LDSCTL_OFF = LDS_BYTES - 1024, MISC_OFF = LDSCTL_OFF + 320;
#define XB_TMO      128
#define XB_XCNT(j)  (256  + 64 * (j))
#define XB_XSUB(j)  (1280 + 64 * (j))
#define XB_XGEN(j)  (2304 + 64 * (j))
#define XB_TOP      3328
#define XB_TOPGEN   3392
#define XCD_BAR_WORDS 3456
#define XB_SPIN_CAP (1u << 18)
__device__ __forceinline__ unsigned xb_ld(unsigned* p)              { return __hip_atomic_load(p, __ATOMIC_RELAXED, __HIP_MEMORY_SCOPE_AGENT); }
__device__ __forceinline__ unsigned xb_add(unsigned* p, unsigned v) { return __hip_atomic_fetch_add(p, v, __ATOMIC_RELAXED, __HIP_MEMORY_SCOPE_AGENT); }
__device__ __forceinline__ unsigned xb_xcc_id() { return (unsigned)__builtin_amdgcn_s_getreg((3 << 11) | 20) & 0xFu; }
#define XB_SPIN(cond, bar) do { unsigned _sp = 0; while (cond) { __builtin_amdgcn_s_sleep(1); \
    if ((++_sp & 255u) == 0u) { if (xb_ld(&(bar)[XB_TMO])) break; if (_sp > XB_SPIN_CAP) { atomicAdd(&(bar)[XB_TMO], 1u); break; } } } } while (0)
struct XcdBarrier { unsigned* bar; unsigned x; volatile LAS unsigned* st; };
__device__ __forceinline__ XcdBarrier xcd_barrier_post(unsigned* bar, volatile LAS unsigned* st) {
    XcdBarrier b; b.bar = bar; b.x = xb_xcc_id(); b.st = st;
    if (threadIdx.x == 0) (void)xb_add(&bar[XB_XCNT(b.x)], 1u);
    return b;
}
__device__ __forceinline__ void xcd_barrier_complete(unsigned* bar, unsigned x, unsigned& nloc, unsigned& nx) {
    const unsigned G = gridDim.x * gridDim.y * gridDim.z;
    unsigned sum, cnt, mine, sp = 0u;
    for (;;) {
        sum = 0u; cnt = 0u; mine = 0u;
#pragma unroll
        for (unsigned j = 0; j < 16; ++j) { const unsigned c = xb_ld(&bar[XB_XCNT(j)]); sum += c; cnt += (c > 0u) ? 1u : 0u; mine = (j == x) ? c : mine; }
        if (sum == G) break;
        __builtin_amdgcn_s_sleep(1);
        if ((++sp & 255u) == 0u) { if (xb_ld(&bar[XB_TMO])) break; if (sp > XB_SPIN_CAP) { atomicAdd(&bar[XB_TMO], 1u); break; } }
    }
    nloc = mine > 0u ? mine : 1u; nx = cnt > 0u ? cnt : 1u;
}
__device__ __forceinline__ void xcd_barrier(const XcdBarrier& b, const bool t0) {
    asm volatile("s_waitcnt vmcnt(0)" ::: "memory");
    __syncthreads();
    if (t0) {
        unsigned* bar = b.bar;
        __builtin_amdgcn_s_waitcnt(0);
        unsigned nloc = b.st[0], nx = b.st[1];
        if (nloc == 0u) { xcd_barrier_complete(bar, b.x, nloc, nx); b.st[0] = nloc; b.st[1] = nx; }
        const unsigned old = xb_add(&bar[XB_XSUB(b.x)], 1u);
        const unsigned gen = old / nloc;
        if (old + 1u == (gen + 1u) * nloc) {
            __builtin_amdgcn_fence(__ATOMIC_RELEASE, "agent");
            asm volatile("s_waitcnt vmcnt(0)" ::: "memory");
            const unsigned og = xb_add(&bar[XB_TOP], 1u);
            const unsigned tg = og / nx;
            if (og + 1u == (tg + 1u) * nx) xb_add(&bar[XB_TOPGEN], 1u);
            else XB_SPIN(xb_ld(&bar[XB_TOPGEN]) == tg, bar);
            __builtin_amdgcn_fence(__ATOMIC_ACQUIRE, "agent");
            xb_add(&bar[XB_XGEN(b.x)], 1u);
            asm volatile("s_waitcnt vmcnt(0)" ::: "memory");
        } else {
            XB_SPIN(xb_ld(&bar[XB_XGEN(b.x)]) == gen, bar);
            __builtin_amdgcn_fence(__ATOMIC_ACQUIRE, "agent");
            asm volatile("s_waitcnt vmcnt(0)" ::: "memory");
        }
    }
    __syncthreads();
}

struct Args { const float* in[23]; float* out; unsigned char* ws; int ph_lo, ph_hi, l_lo, l_hi, fused, probe_upto, probe_dup, pad; };
enum Phase { PH_CONV = 0, PH_GEMMA, PH_MIX1, PH_MIX2, PH_S3, PH_GB, PH_GO, PH_NORM2, PH_FF1, PH_FF2, PH_N };
enum In { I_X = 0, I_N1G, I_WIN, I_MU, I_W0, I_WUP, I_A0, I_AUP, I_GUP, I_KK, I_KA, I_RK, I_LNG, I_LNB, I_QNG, I_KNG, I_POOLW, I_POOLS, I_WBR, I_WOUT, I_N2G, I_FF1, I_FF2 };

__device__ __forceinline__ void p0_transpose_item(const float* Wm, int K, int N, bf16* WT, LAS float* scr, int item, int lane) {
    const int nblk = N / 32, kb = item / nblk, nb = item % nblk, k0 = 64 * kb, n0 = 32 * nb;
#pragma unroll 8
    for (int i = 0; i < 32; ++i) { const int kk = 2 * i + (lane >> 5); scr[kk * 33 + (lane & 31)] = ((const GAS float*)Wm)[(size_t)(k0 + kk) * N + n0 + (lane & 31)]; }
    LDS_WAIT(); asm volatile("" ::: "memory");
    const int c = lane & 7;
#pragma unroll
    for (int j = 0; j < 4; ++j) { const int n = (lane >> 3) + 8 * j; const LAS float* s = scr + (8 * c) * 33 + n;
        v4u o; o.x = pk2(s[0 * 33], s[1 * 33]); o.y = pk2(s[2 * 33], s[3 * 33]); o.z = pk2(s[4 * 33], s[5 * 33]); o.w = pk2(s[6 * 33], s[7 * 33]);
        *(GAS v4u*)(WT + (size_t)(n0 + n) * K + k0 + 8 * c) = o; }
    LDS_WAIT(); asm volatile("" ::: "memory");
}
__device__ __forceinline__ void rms_rows(const float* x, const float* g, bf16* out, int gw, int NGW, int lane) {
    f32x4 gv[4];
#pragma unroll
    for (int j = 0; j < 4; ++j) gv[j] = ((const GAS f32x4*)g)[lane + 64 * j];
    for (int m0 = gw; m0 < M; m0 += 4 * NGW) {
        f32x4 v[4][4];
#pragma unroll
        for (int rr = 0; rr < 4; ++rr) { const int m = m0 + rr * NGW; if (m < M) { const GAS f32x4* xr = (const GAS f32x4*)(x + (size_t)m * D) + lane;
#pragma unroll
            for (int j = 0; j < 4; ++j) v[rr][j] = xr[64 * j]; } }
#pragma unroll
        for (int rr = 0; rr < 4; ++rr) { const int m = m0 + rr * NGW; if (m < M) {
            float s_ = 0.f;
#pragma unroll
            for (int j = 0; j < 4; ++j) s_ += (v[rr][j].x * v[rr][j].x + v[rr][j].y * v[rr][j].y) + (v[rr][j].z * v[rr][j].z + v[rr][j].w * v[rr][j].w);
            const float rstd = 1.0f / sqrtf(wave_sum(s_) * (1.0f / D) + 1e-6f);
            GAS unsigned long long* o8 = (GAS unsigned long long*)(out + (size_t)m * D) + lane;
#pragma unroll
            for (int j = 0; j < 4; ++j) { const f32x4 y = v[rr][j] * rstd * gv[j]; o8[64 * j] = (unsigned long long)pk2(y.x, y.y) | ((unsigned long long)pk2(y.z, y.w) << 32); } } }
    }
}

__device__ __forceinline__ void ph_attn_prep(LAS unsigned char* lds, bf16* AT, bf16* VT, const float* qg, const float* kg, float* KM, int G, const int tid) {
    LAS float* red = (LAS float*)lds;
    LAS unsigned char* vt = lds + 2048;
    const int lane = tid & 63, wave = tid >> 6, tsub = lane >> 3, dq = lane & 7;
    float gq[8], gk[8];
#pragma unroll
    for (int e = 0; e < 8; ++e) { gq[e] = ((const GAS float*)qg)[dq * 8 + e] * (0.125f * 1.4426950408889634f); gk[e] = ((const GAS float*)kg)[dq * 8 + e]; }
    for (int bid = blockIdx.x; bid < NB * NBLK * NH; bid += G) {
        const int h = bid & 7, n = (bid >> 3) & 31, b = bid >> 8;
        v4u qv[4], kv[4], vv[4];
#pragma unroll
        for (int j = 0; j < 4; ++j) { const size_t row = (size_t)b * T + n * 256 + wave * 32 + 8 * j + tsub; const bf16* qp = AT + row * NAT + h * 64 + dq * 8;
            qv[j] = *(const GAS v4u*)qp; kv[j] = *(const GAS v4u*)(qp + 512); vv[j] = *(const GAS v4u*)(qp + 1024); }
        float ksum[8];
#pragma unroll
        for (int e = 0; e < 8; ++e) ksum[e] = 0.f;
#pragma unroll
        for (int j = 0; j < 4; ++j) {
            const int tok = wave * 32 + 8 * j + tsub; const size_t row = (size_t)b * T + n * 256 + tok; bf16* qp = AT + row * NAT + h * 64 + dq * 8;
            float q[8], k[8];
            q[0] = bflo(qv[j].x); q[1] = bfhi(qv[j].x); q[2] = bflo(qv[j].y); q[3] = bfhi(qv[j].y); q[4] = bflo(qv[j].z); q[5] = bfhi(qv[j].z); q[6] = bflo(qv[j].w); q[7] = bfhi(qv[j].w);
            k[0] = bflo(kv[j].x); k[1] = bfhi(kv[j].x); k[2] = bflo(kv[j].y); k[3] = bfhi(kv[j].y); k[4] = bflo(kv[j].z); k[5] = bfhi(kv[j].z); k[6] = bflo(kv[j].w); k[7] = bfhi(kv[j].w);
            float qs = 0.f, ks = 0.f;
#pragma unroll
            for (int e = 0; e < 8; ++e) { qs += q[e] * q[e]; ks += k[e] * k[e]; }
            qs += __shfl_xor(qs, 1); qs += __shfl_xor(qs, 2); qs += __shfl_xor(qs, 4);
            ks += __shfl_xor(ks, 1); ks += __shfl_xor(ks, 2); ks += __shfl_xor(ks, 4);
            const float rq = 1.0f / sqrtf(qs * (1.0f / 64.0f) + 1e-6f), rk = 1.0f / sqrtf(ks * (1.0f / 64.0f) + 1e-6f);
#pragma unroll
            for (int e = 0; e < 8; ++e) { q[e] = q[e] * rq * gq[e]; k[e] = k[e] * rk * gk[e]; ksum[e] += k[e]; }
            v4u w; w.x = pk2(q[0], q[1]); w.y = pk2(q[2], q[3]); w.z = pk2(q[4], q[5]); w.w = pk2(q[6], q[7]); *(GAS v4u*)qp = w;
            w.x = pk2(k[0], k[1]); w.y = pk2(k[2], k[3]); w.z = pk2(k[4], k[5]); w.w = pk2(k[6], k[7]); *(GAS v4u*)(qp + 512) = w;
            const unsigned vw[4] = {vv[j].x, vv[j].y, vv[j].z, vv[j].w};
#pragma unroll
            for (int e = 0; e < 8; ++e) *(LAS bf16*)(vt + (dq * 8 + e) * 520 + tok * 2) = (bf16)((e & 1) ? (vw[e >> 1] >> 16) : (vw[e >> 1] & 0xffffu));
        }
#pragma unroll
        for (int e = 0; e < 8; ++e) { float s_ = ksum[e]; s_ += __shfl_xor(s_, 8); s_ += __shfl_xor(s_, 16); s_ += __shfl_xor(s_, 32); if (tsub == 0) red[wave * 64 + dq * 8 + e] = s_; }
        __syncthreads();
        if (wave == 0) { float s_ = 0.f; for (int w = 0; w < 8; ++w) s_ += red[w * 64 + lane]; ((GAS float*)KM)[(((size_t)b * NH + h) * NBLK + n) * 64 + lane] = s_ * (1.0f / 256.0f); }
#pragma unroll
        for (int j = 0; j < 4; ++j) { const int c = tid + 512 * j, dim = c >> 5, part = c & 31;
            const v2u lo = *(const LAS v2u*)(vt + dim * 520 + part * 16), hi = *(const LAS v2u*)(vt + dim * 520 + part * 16 + 8);
            v4u w; w.x = lo.x; w.y = lo.y; w.z = hi.x; w.w = hi.y;
            *(GAS v4u*)(VT + (((size_t)(b * NH + h) * (T / 32) + n * 8 + (part >> 2)) * 64 + dim) * 32 + (part & 3) * 8) = w; }
        __syncthreads();
    }
}
__device__ __forceinline__ void ph_pool(bf16* PL_, const bf16* HB_, int G, const int tid) {
    GAS bf16* PL = (GAS bf16*)PL_; const GAS bf16* HB = (const GAS bf16*)HB_;
    const int ch = tid, wdw = 2 << (ch >> 7);
    for (int u = blockIdx.x; u < M / 128; u += G) {
        float ring[16];
        const int tb0 = (u * 128) & (T - 1);
#pragma unroll
        for (int k = 0; k < 16; ++k) ring[k] = 0.f;
        unsigned short hv[15], cu[16], nx[16];
        if (tb0 > 0) {
#pragma unroll
            for (int j = 0; j < 15; ++j) hv[j] = HB[((size_t)(u - 1) * 15 + j) * 512 + ch];
        }
#pragma unroll
        for (int tt = 0; tt < 16; ++tt) cu[tt] = PL[((size_t)u * 128 + tt) * NPL + ch];
        if (tb0 > 0) {
#pragma unroll
            for (int j = 0; j < 15; ++j) ring[1 + j] = bf2f(hv[j]);
        }
#pragma unroll
        for (int t0 = 0; t0 < 128; t0 += 16) {
            if (t0 + 16 < 128) {
#pragma unroll
                for (int tt = 0; tt < 16; ++tt) nx[tt] = PL[((size_t)u * 128 + t0 + 16 + tt) * NPL + ch];
            }
#pragma unroll
            for (int tt = 0; tt < 16; ++tt) {
                const float cur = bf2f(cu[tt]);
                ring[tt] = cur;
                float sm = 0.f;
#pragma unroll
                for (int i = 0; i < 16; ++i) sm += (i < wdw) ? ring[(tt - i) & 15] : 0.f;
                const int tpos = tb0 + t0 + tt; const int cnt = (tpos + 1 < wdw) ? (tpos + 1) : wdw;
                PL[((size_t)u * 128 + t0 + tt) * NPL + ch] = (bf16)f2bf(sm / (float)cnt - cur);
            }
#pragma unroll
            for (int tt = 0; tt < 16; ++tt) cu[tt] = nx[tt];
        }
    }
}
namespace rw {
typedef short bf16x8 __attribute__((ext_vector_type(8)));
constexpr int MATB = 64 * 144;
constexpr int FPB = 64 * 272;
constexpr int X0 = 0, ACTW = X0, ACTA = X0 + MATB, ACTG = X0 + 2 * MATB  , AAB = X0, AAK = X0 + MATB, ARB = X0 + 2 * MATB, ARK = X0 + 3 * MATB;
constexpr int Y0 = 4 * MATB, LWP = Y0, AIP = Y0 + FPB, LGO = AIP, TOT = Y0 + 2 * FPB  , GCV = TOT + 2048  , DG = Y0  , TI = Y0 + 4096  , U0T = Y0 + 8192;
constexpr int PTAB = GCV + 256  ;
constexpr int Z0 = Y0 + 2 * FPB + 2048 + 256 + 3072, AT_ = Z0, BT_ = Z0 + MATB, KT_ = Z0 + 2 * MATB, RT_ = Z0 + 3 * MATB, ATT = Z0 + 4 * MATB, BHT = Z0 + 5 * MATB, KHT = Z0 + 6 * MATB, VTT = Z0 + 7 * MATB;
constexpr int S1_LDS = Z0 + 8 * MATB;
static_assert(S1_LDS <= 153600 - 1024, "S1 LDS map below the control words");
static_assert(U0T + MATB <= TOT, "U0T inside the dead f32 region");
__device__ __forceinline__ f32x4 mma(bf16x8 a, bf16x8 b, f32x4 c) { return __builtin_amdgcn_mfma_f32_16x16x32_bf16(a, b, c, 0, 0, 0); }
__device__ __forceinline__ bf16x8 ldf(const LAS unsigned char* mat, int row, int s, int g) { return *(const LAS bf16x8*)(mat + row * 144 + s * 64 + g * 16); }
__device__ __forceinline__ v2u pack4(f32x4 v) { v2u w; w.x = pk2(v[0], v[1]); w.y = pk2(v[2], v[3]); return w; }
__device__ __forceinline__ f32x4 unpack4(v2u w) { return (f32x4){bflo(w.x), bfhi(w.x), bflo(w.y), bfhi(w.y)}; }
__device__ __forceinline__ void unpack8(v4u w, float* o) { o[0] = bflo(w.x); o[1] = bfhi(w.x); o[2] = bflo(w.y); o[3] = bfhi(w.y); o[4] = bflo(w.z); o[5] = bfhi(w.z); o[6] = bflo(w.w); o[7] = bfhi(w.w); }
__device__ __forceinline__ v4u pack8(const float* o) { v4u w; w.x = pk2(o[0], o[1]); w.y = pk2(o[2], o[3]); w.z = pk2(o[4], o[5]); w.w = pk2(o[6], o[7]); return w; }
#define LDS_BAR() do { asm volatile("s_waitcnt lgkmcnt(0)" ::: "memory"); __builtin_amdgcn_s_barrier(); asm volatile("" ::: "memory"); } while (0)
#define RW_BAR() do { asm volatile("s_waitcnt vmcnt(0) lgkmcnt(0)" ::: "memory"); __builtin_amdgcn_s_barrier(); asm volatile("" ::: "memory"); } while (0)

struct S1Args {
    bf16* RW; const bf16* SB;
    const float *mu, *w0, *a0, *k_k, *k_a, *r_k;
    const bf16 *WupT, *AupT, *GupT;
    bf16 *Gf, *Pst, *Qst; float* bonus;
    bf16 *Rh, *O0; int ldo;
    bf16* Vm; int ldv;
};
__device__ __forceinline__ void s1_unit(LAS unsigned char* lds, const S1Args& A, const int unit, const int tid, int& hprev, const bool dummy = false) {
    const int lane = tid & 63, wave = __builtin_amdgcn_readfirstlane(tid >> 6), r = lane & 15, g = lane >> 4;
    const int h = unit & 7, cidx = unit >> 3  , c_in_b = cidx & 127;
    const size_t row0 = (size_t)cidx * 64;
    const int t = tid >> 3, q = tid & 7;
    float rp[8], kp[8], lwv[8], av[8], kk[8], vp[8];
    if (h != hprev) {
        LAS float* pt = (LAS float*)(lds + PTAB);
        for (int i = tid; i < 768; i += 512) {
            float v_;
            if (i < 192) v_ = ((const GAS float*)A.mu)[(i >> 6) * 512 + h * 64 + (i & 63)];
            else if (i < 448) v_ = ((const GAS float*)A.mu)[1536 + (i - 192)];
            else { const int j = i - 448, c_ = h * 64 + (j & 63); const int w_ = j >> 6; const float* pp_ = (w_ == 0) ? A.w0 : (w_ == 1) ? A.a0 : (w_ == 2) ? A.k_k : (w_ == 3) ? A.k_a : A.r_k; v_ = ((const GAS float*)pp_)[c_]; }
            pt[i] = v_;
        }
        hprev = h;
        LDS_BAR();
    }
    const LAS float* PT = (const LAS float*)(lds + PTAB);
    bf16x8 fw[2], fa[2], fg[4];
    {
        const int cb = wave >> 1;
        const bf16* wu = A.WupT + (size_t)(h * 64 + 16 * cb + r) * 64 + 8 * g;
        const bf16* au = A.AupT + (size_t)(h * 64 + 16 * cb + r) * 64 + 8 * g;
        const bf16* gu = A.GupT + (size_t)(h * 64 + 16 * cb + r) * 128 + 8 * g;
#pragma unroll
        for (int s = 0; s < 2; ++s) { fw[s] = *(const GAS bf16x8*)(wu + 32 * s); fa[s] = *(const GAS bf16x8*)(au + 32 * s); }
#pragma unroll
        for (int s = 0; s < 4; ++s) fg[s] = *(const GAS bf16x8*)(gu + 32 * s);
    }
    {
        const bf16* cur = A.RW + (row0 + t) * NRW;
        const bool hasprev = (t > 0) || (c_in_b > 0);
        const bf16* prv = (t > 0) ? (cur - NRW) : (hasprev ? A.SB + (size_t)(cidx - 1) * NRW : cur);
        v4u cw[7], pw[7];
#define S1COL(J) ((J) == 0 ? h * 64 + 8 * q : (J) == 1 ? 512 + h * 64 + 8 * q : (J) == 2 ? 1024 + h * 64 + 8 * q : (J) == 3 ? 1536 + 8 * q : (J) == 4 ? 1600 + 8 * q : (J) == 5 ? 1664 + 16 * q : 1664 + 16 * q + 8)
#pragma unroll
        for (int j = 0; j < 7; ++j) { cw[j] = *(const GAS v4u*)(cur + S1COL(j)); pw[j] = *(const GAS v4u*)(prv + S1COL(j)); }
#undef S1COL
        float c8[8], p8[8];
#define MIXLOAD(J, MUO, DST) do { unpack8(cw[J], c8); unpack8(pw[J], p8); \
            _Pragma("unroll") for (int e = 0; e < 8; ++e) { const float pv_ = hasprev ? p8[e] : 0.f; DST[e] = c8[e] + (pv_ - c8[e]) * PT[(MUO) + e]; } } while (0)
        MIXLOAD(0, 8 * q, rp); MIXLOAD(1, 64 + 8 * q, kp); MIXLOAD(2, 128 + 8 * q, vp);
#pragma unroll
        for (int e = 0; e < 8; ++e) *(LAS bf16*)(lds + VTT + (8 * q + e) * 144 + t * 2) = (bf16)f2bf(vp[e]);
        float x8[8];
        MIXLOAD(3, 192 + 8 * q, x8);
#pragma unroll
        for (int e = 0; e < 8; ++e) x8[e] = ftanh(x8[e]);
        *(LAS v4u*)(lds + ACTW + t * 144 + q * 16) = pack8(x8);
        MIXLOAD(4, 256 + 8 * q, x8);
        *(LAS v4u*)(lds + ACTA + t * 144 + q * 16) = pack8(x8);
        MIXLOAD(5, 320 + 16 * q, x8);
#pragma unroll
        for (int e = 0; e < 8; ++e) x8[e] = fsig(x8[e]);
        *(LAS v4u*)(lds + ACTG + t * 272 + q * 32) = pack8(x8);
        MIXLOAD(6, 320 + 16 * q + 8, x8);
#pragma unroll
        for (int e = 0; e < 8; ++e) x8[e] = fsig(x8[e]);
        *(LAS v4u*)(lds + ACTG + t * 272 + q * 32 + 16) = pack8(x8);
#undef MIXLOAD
    }
    LDS_BAR();
    if (!dummy) *(GAS v4u*)(A.Vm + (row0 + t) * A.ldv + h * 64 + 8 * q) = pack8(vp);
    {
        const int cb = wave >> 1;
#pragma unroll
        for (int i = 0; i < 2; ++i) {
            const int tb = 2 * (wave & 1) + i;
            f32x4 cw = {0.f, 0.f, 0.f, 0.f}, ca = {0.f, 0.f, 0.f, 0.f}, cg = {0.f, 0.f, 0.f, 0.f};
#pragma unroll
            for (int s = 0; s < 2; ++s) { cw = mma(fw[s], ldf(lds + ACTW, 16 * tb + r, s, g), cw); ca = mma(fa[s], ldf(lds + ACTA, 16 * tb + r, s, g), ca); }
#pragma unroll
            for (int s = 0; s < 4; ++s) cg = mma(fg[s], *(const LAS bf16x8*)(lds + ACTG + (16 * tb + r) * 272 + s * 64 + g * 16), cg);
            *(LAS f32x4*)(lds + LWP + (16 * tb + r) * 272 + (16 * cb + 4 * g) * 4) = cw;
            *(LAS f32x4*)(lds + AIP + (16 * tb + r) * 272 + (16 * cb + 4 * g) * 4) = ca;
            if (!dummy) *(GAS v2u*)(A.Gf + (row0 + 16 * tb + r) * W + h * 64 + 16 * cb + 4 * g) = pack4(cg);
        }
    }
    LDS_BAR();
    {
        const f32x4 l0 = *(const LAS f32x4*)(lds + LWP + t * 272 + q * 32), l1 = *(const LAS f32x4*)(lds + LWP + t * 272 + q * 32 + 16);
        const f32x4 a0v = *(const LAS f32x4*)(lds + AIP + t * 272 + q * 32), a1v = *(const LAS f32x4*)(lds + AIP + t * 272 + q * 32 + 16);
        float ss = 0.f, bon = 0.f;
#pragma unroll
        for (int e = 0; e < 8; ++e) { const int hc = 8 * q + e;
            const float lp = (e < 4) ? l0[e & 3] : l1[e & 3], ap = (e < 4) ? a0v[e & 3] : a1v[e & 3];
            lwv[e] = -0.60653065971263342f * fsig(PT[448 + hc] + lp);
            av[e] = fsig(PT[512 + hc] + ap);
            kk[e] = kp[e] * PT[576 + hc]; ss += kk[e] * kk[e];
            kp[e] = kp[e] * (1.0f + (av[e] - 1.0f) * PT[640 + hc]);
            bon += rp[e] * kp[e] * PT[704 + hc]; }
        ss += __shfl_xor(ss, 1); ss += __shfl_xor(ss, 2); ss += __shfl_xor(ss, 4);
        bon += __shfl_xor(bon, 1); bon += __shfl_xor(bon, 2); bon += __shfl_xor(bon, 4);
        const float inv = 1.0f / fmaxf(sqrtf(ss), 1e-12f);
#pragma unroll
        for (int e = 0; e < 8; ++e) kk[e] *= inv;
        if (q == 0 && !dummy) ((GAS float*)A.bonus)[(row0 + t) * 8 + h] = bon;
        *(LAS f32x4*)(lds + LWP + t * 272 + q * 32) = (f32x4){lwv[0], lwv[1], lwv[2], lwv[3]};
        *(LAS f32x4*)(lds + LWP + t * 272 + q * 32 + 16) = (f32x4){lwv[4], lwv[5], lwv[6], lwv[7]};
    }
    LDS_BAR();
    {
        const int c = tid & 63, seg = tid >> 6; float x[8]; float run = 0.f;
#pragma unroll
        for (int i = 0; i < 8; ++i) { run += *(const LAS float*)(lds + LWP + (8 * seg + i) * 272 + c * 4); x[i] = run; }
        *(LAS float*)(lds + TOT + (seg * 64 + c) * 4) = run;
        LDS_BAR();
        float off = 0.f;
        for (int s2 = 0; s2 < seg; ++s2) off += *(const LAS float*)(lds + TOT + (s2 * 64 + c) * 4);
#pragma unroll
        for (int i = 0; i < 8; ++i) *(LAS float*)(lds + LGO + (8 * seg + i) * 272 + c * 4) = x[i] + off;
    }
    LDS_BAR();
    {
        const f32x4 g0 = *(const LAS f32x4*)(lds + LGO + t * 272 + q * 32), g1 = *(const LAS f32x4*)(lds + LGO + t * 272 + q * 32 + 16);
        const f32x4 e0 = *(const LAS f32x4*)(lds + LGO + 63 * 272 + q * 32), e1 = *(const LAS f32x4*)(lds + LGO + 63 * 272 + q * 32 + 16);
        float at[8], bt[8], kt[8], rt[8], bh[8], kh[8];
#pragma unroll
        for (int e = 0; e < 8; ++e) { const float lg = (e < 4) ? g0[e & 3] : g1[e & 3], lc = (e < 4) ? e0[e & 3] : e1[e & 3];
            const float gm1 = __expf(lg - lwv[e]), gi = __expf(-lg), gt = __expf(lg), gr = __expf(lc - lg);
            const float bb = kk[e] * av[e];
            at[e] = -kk[e] * gm1; bt[e] = bb * gi; kt[e] = kp[e] * gi; rt[e] = rp[e] * gt; bh[e] = bb * gr; kh[e] = kp[e] * gr;
            if (t == 63) *(LAS float*)(lds + GCV + (8 * q + e) * 4) = __expf(lc); }
        *(LAS v4u*)(lds + AT_ + t * 144 + q * 16) = pack8(at); *(LAS v4u*)(lds + BT_ + t * 144 + q * 16) = pack8(bt);
        *(LAS v4u*)(lds + KT_ + t * 144 + q * 16) = pack8(kt); *(LAS v4u*)(lds + RT_ + t * 144 + q * 16) = pack8(rt);
#pragma unroll
        for (int e = 0; e < 8; ++e) { const int o = (8 * q + e) * 144 + t * 2;
            *(LAS bf16*)(lds + ATT + o) = (bf16)f2bf(at[e]); *(LAS bf16*)(lds + BHT + o) = (bf16)f2bf(bh[e]); *(LAS bf16*)(lds + KHT + o) = (bf16)f2bf(kh[e]); }
    }
    LDS_BAR();
    {
        const int hv_tb[10] = {0, 1, 1, 2, 2, 2, 3, 3, 3, 3}, hv_jb[10] = {0, 0, 1, 0, 1, 2, 0, 1, 2, 3};
        const int z_tb[6] = {0, 0, 0, 1, 1, 2}, z_jb[6] = {1, 2, 3, 2, 3, 3};
#pragma unroll
        for (int pass = 0; pass < 2; ++pass) {
            const int hi = (pass == 0) ? wave : (wave < 2 ? 8 + wave : -1);
            if (hi >= 0) {
                int tb = 0, jb = 0;
#pragma unroll
                for (int k = 0; k < 10; ++k) if (k == hi) { tb = hv_tb[k]; jb = hv_jb[k]; }
                f32x4 cab = {0.f, 0.f, 0.f, 0.f}, cak = cab, crb = cab, crk = cab;
#pragma unroll
                for (int s = 0; s < 2; ++s) { const bf16x8 fb = ldf(lds + BT_, 16 * jb + r, s, g), fk = ldf(lds + KT_, 16 * jb + r, s, g), fa = ldf(lds + AT_, 16 * tb + r, s, g), fr = ldf(lds + RT_, 16 * tb + r, s, g);
                    cab = mma(fb, fa, cab); cak = mma(fk, fa, cak); crb = mma(fb, fr, crb); crk = mma(fk, fr, crk); }
                const int tt = 16 * tb + r;
#pragma unroll
                for (int e = 0; e < 4; ++e) { const int j = 16 * jb + 4 * g + e; if (!(j < tt)) { cab[e] = 0.f; cak[e] = 0.f; } if (!(j <= tt)) { crb[e] = 0.f; crk[e] = 0.f; } }
                const int o = tt * 144 + (16 * jb + 4 * g) * 2;
                *(LAS v2u*)(lds + AAB + o) = pack4(cab); *(LAS v2u*)(lds + AAK + o) = pack4(cak); *(LAS v2u*)(lds + ARB + o) = pack4(crb); *(LAS v2u*)(lds + ARK + o) = pack4(crk);
                if (tb == jb) *(LAS f32x4*)(lds + DG + ((tb * 16 + r) * 16 + 4 * g) * 4) = cab;
            }
        }
        if (wave >= 2) {
            int tb = 0, jb = 0;
#pragma unroll
            for (int k = 0; k < 6; ++k) if (k == wave - 2) { tb = z_tb[k]; jb = z_jb[k]; }
            const int o = (16 * tb + r) * 144 + (16 * jb + 4 * g) * 2; const v2u z = {0u, 0u};
            *(LAS v2u*)(lds + AAB + o) = z; *(LAS v2u*)(lds + AAK + o) = z; *(LAS v2u*)(lds + ARB + o) = z; *(LAS v2u*)(lds + ARK + o) = z;
        }
    }
    LDS_BAR();
    f32x4 Y[4];
    if (wave == 7) {
        const int blk = lane >> 4, col = lane & 15; float x[16];
#pragma unroll
        for (int tt = 0; tt < 16; ++tt) {
            float acc = (tt == col) ? 1.0f : 0.0f;
            const LAS float* nrow = (const LAS float*)(lds + DG + ((blk * 16 + tt) * 16) * 4);
#pragma unroll
            for (int j = 0; j < 16; ++j) if (j < tt) acc += nrow[j] * x[j];
            x[tt] = acc;
            *(LAS bf16*)(lds + TI + ((blk * 16 + tt) * 16 + col) * 2) = (bf16)f2bf(acc);
        }
    }
    if (wave < 4) {
#pragma unroll
        for (int i = 0; i < 4; ++i) { Y[i] = (f32x4){0.f, 0.f, 0.f, 0.f};
#pragma unroll
            for (int s = 0; s < 2; ++s) Y[i] = mma(ldf(lds + AAK, 16 * i + r, s, g), ldf(lds + VTT, 16 * wave + r, s, g), Y[i]); }
    } else {
#pragma unroll
        for (int i = 0; i < 4; ++i) Y[i] = unpack4(*(const LAS v2u*)(lds + ATT + (16 * (wave - 4) + r) * 144 + (16 * i + 4 * g) * 2));
    }
    LDS_BAR();
    {
        v2u Xb[4];
        const bf16x8 zf = {0, 0, 0, 0, 0, 0, 0, 0};
#pragma unroll
        for (int i = 0; i < 4; ++i) {
            if (i >= 1) {
                v4u bw; bw.x = Xb[0].x; bw.y = Xb[0].y; bw.z = (i >= 2) ? Xb[1].x : 0u; bw.w = (i >= 2) ? Xb[1].y : 0u;
                v4u aw; const v2u a0 = *(const LAS v2u*)(lds + AAB + (16 * i + r) * 144 + (4 * g) * 2), a1 = *(const LAS v2u*)(lds + AAB + (16 * i + r) * 144 + (16 + 4 * g) * 2);
                aw.x = a0.x; aw.y = a0.y; aw.z = a1.x; aw.w = a1.y;
                Y[i] = mma(__builtin_bit_cast(bf16x8, aw), __builtin_bit_cast(bf16x8, bw), Y[i]);
            }
            if (i >= 3) {
                v4u bw; bw.x = Xb[2].x; bw.y = Xb[2].y; bw.z = 0u; bw.w = 0u;
                v4u aw; const v2u a0 = *(const LAS v2u*)(lds + AAB + (16 * i + r) * 144 + (32 + 4 * g) * 2);
                aw.x = a0.x; aw.y = a0.y; aw.z = 0u; aw.w = 0u;
                Y[i] = mma(__builtin_bit_cast(bf16x8, aw), __builtin_bit_cast(bf16x8, bw), Y[i]);
            }
            v4u tw; const v2u t0 = *(const LAS v2u*)(lds + TI + ((i * 16 + r) * 16 + 4 * g) * 2); tw.x = t0.x; tw.y = t0.y; tw.z = 0u; tw.w = 0u;
            v4u yw; const v2u yp = pack4(Y[i]); yw.x = yp.x; yw.y = yp.y; yw.z = 0u; yw.w = 0u;
            const f32x4 X = mma(__builtin_bit_cast(bf16x8, tw), __builtin_bit_cast(bf16x8, yw), (f32x4){0.f, 0.f, 0.f, 0.f});
            Xb[i] = pack4(X);
            const int dst = (wave < 4) ? (U0T + (16 * wave + r) * 144) : (ATT + (16 * (wave - 4) + r) * 144);
            *(LAS v2u*)(lds + dst + (16 * i + 4 * g) * 2) = Xb[i];
        }
        (void)zf;
    }
    LDS_BAR();
    {
#pragma unroll
        for (int i = 0; i < 2; ++i) {
            const int qq = 2 * wave + i, rb = qq >> 2, cb = qq & 3;
            f32x4 crh = {0.f, 0.f, 0.f, 0.f}, co0 = crh, cp = crh, cq = crh;
#pragma unroll
            for (int s = 0; s < 2; ++s) {
                const bf16x8 fah = ldf(lds + ATT, 16 * rb + r, s, g), fu0 = ldf(lds + U0T, 16 * rb + r, s, g), fvt = ldf(lds + VTT, 16 * rb + r, s, g), fbh = ldf(lds + BHT, 16 * rb + r, s, g), fkh = ldf(lds + KHT, 16 * rb + r, s, g);
                const bf16x8 frb = ldf(lds + ARB, 16 * cb + r, s, g), frk = ldf(lds + ARK, 16 * cb + r, s, g), fbhc = ldf(lds + BHT, 16 * cb + r, s, g), fu0c = ldf(lds + U0T, 16 * cb + r, s, g), fvtc = ldf(lds + VTT, 16 * cb + r, s, g);
                crh = mma(fah, frb, crh);
                co0 = mma(fu0, frb, co0); co0 = mma(fvt, frk, co0);
                cp = mma(fah, fbhc, cp);
                cq = mma(fbh, fu0c, cq); cq = mma(fkh, fvtc, cq);
            }
            crh = crh + unpack4(*(const LAS v2u*)(lds + RT_ + (16 * cb + r) * 144 + (16 * rb + 4 * g) * 2));
            if (rb == cb) {
#pragma unroll
                for (int e = 0; e < 4; ++e) if (4 * g + e == r) cp[e] += *(const LAS float*)(lds + GCV + (16 * rb + 4 * g + e) * 4);
            }
            const size_t tok = row0 + 16 * cb + r;
            if (!dummy) {
            *(GAS v2u*)(A.Rh + tok * A.ldo + h * 64 + 16 * rb + 4 * g) = pack4(crh);
            *(GAS v2u*)(A.O0 + tok * A.ldo + h * 64 + 16 * rb + 4 * g) = pack4(co0);
            const size_t su = (size_t)(((cidx >> 7) * 8 + h) * 128 + c_in_b);
            *(GAS v2u*)(A.Pst + su * 4096 + (16 * cb + r) * 64 + 32 * (rb >> 1) + 8 * g + 4 * (rb & 1)) = pack4(cp);
            *(GAS v2u*)(A.Qst + su * 4096 + (16 * cb + r) * 64 + 16 * g + 4 * rb) = pack4(cq);
            }
        }
    }
    LDS_BAR();
}

struct PQ { v4u p[4][2]; v4u q[2]; };
constexpr int S2_NS = 8, S2_SLOTB = 2048, S2_FLAGS = 4 * S2_NS * S2_SLOTB;
__device__ __forceinline__ void s2_chain(LAS unsigned char* lds, const bf16* Pst, const bf16* Qst, const int bh, const int vb, const int lane) {
    const int r = lane & 15, g = lane >> 4;
    f32x4 S[4];
#pragma unroll
    for (int i = 0; i < 4; ++i) S[i] = (f32x4){0.f, 0.f, 0.f, 0.f};
    const size_t ustep = (size_t)4096;
    const bf16* Pp = Pst + ((size_t)bh * 128) * 4096 + r * 64 + 8 * g;
    const bf16* Qp = Qst + ((size_t)bh * 128) * 4096 + (16 * vb + r) * 64 + 16 * g;
    LAS unsigned char* ring = lds + vb * (S2_NS * S2_SLOTB) + r * 128 + g * 8;
    volatile LAS int* prod = (volatile LAS int*)(lds + S2_FLAGS + vb * 64);
    volatile LAS int* cons = (volatile LAS int*)(lds + S2_FLAGS + 256 + vb * 64);
#define S2_GLD(DST, PTR) asm volatile("global_load_dwordx4 %0, %1, off" : "=v"(DST) : "v"(PTR) : "memory")
#define S2_LOAD(B, C) do { const int c_ = (C) < 128 ? (C) : 127; const bf16* P_ = Pp + (size_t)c_ * ustep; const bf16* Q_ = Qp + (size_t)c_ * ustep; \
        _Pragma("unroll") for (int i = 0; i < 4; ++i) { S2_GLD(B.p[i][0], P_ + (16 * i) * 64); S2_GLD(B.p[i][1], P_ + (16 * i) * 64 + 32); } \
        S2_GLD(B.q[0], Q_); S2_GLD(B.q[1], Q_ + 8); } while (0)
#define S2_READY(B, N) asm volatile("s_waitcnt vmcnt(" #N ")" : "+v"(B.p[0][0]), "+v"(B.p[0][1]), "+v"(B.p[1][0]), "+v"(B.p[1][1]), "+v"(B.p[2][0]), "+v"(B.p[2][1]), "+v"(B.p[3][0]), "+v"(B.p[3][1]), "+v"(B.q[0]), "+v"(B.q[1]) :: "memory")
#define S2_STEP(B, C) do { v2u sb_[4]; \
        { unsigned sp_ = 0; while ((C) - *cons >= S2_NS && ++sp_ < (1u << 22)) __builtin_amdgcn_s_sleep(1); } asm volatile("" ::: "memory");   \
        _Pragma("unroll") for (int i = 0; i < 4; ++i) { sb_[i] = pack4(S[i]); *(LAS v2u*)(ring + ((C) & (S2_NS - 1)) * S2_SLOTB + 32 * i) = sb_[i]; } \
        asm volatile("s_waitcnt lgkmcnt(0)" ::: "memory"); if (lane == 0) *prod = (C) + 1; \
        _Pragma("unroll") for (int i = 0; i < 4; ++i) { v2u qi_; qi_.x = (i & 1) ? B.q[i >> 1].z : B.q[i >> 1].x; qi_.y = (i & 1) ? B.q[i >> 1].w : B.q[i >> 1].y; f32x4 n_ = unpack4(qi_); \
            _Pragma("unroll") for (int s_ = 0; s_ < 2; ++s_) { \
                v4u bw_; bw_.x = sb_[2 * s_].x; bw_.y = sb_[2 * s_].y; bw_.z = sb_[2 * s_ + 1].x; bw_.w = sb_[2 * s_ + 1].y; \
                n_ = mma(__builtin_bit_cast(bf16x8, B.p[i][s_]), __builtin_bit_cast(bf16x8, bw_), n_); } \
            S[i] = n_; } } while (0)
#define PIN() asm volatile("" ::: "memory")
    PQ B0, B1, B2, B3;
    asm volatile("s_waitcnt vmcnt(0)" ::: "memory");
    S2_LOAD(B0, 0); S2_LOAD(B1, 1); S2_LOAD(B2, 2);
    for (int c = 0; c < 128; c += 4) {
        S2_LOAD(B3, c + 3); S2_READY(B0, 30); S2_STEP(B0, c);
        S2_LOAD(B0, c + 4); S2_READY(B1, 30); S2_STEP(B1, c + 1);
        S2_LOAD(B1, c + 5); S2_READY(B2, 30); S2_STEP(B2, c + 2);
        S2_LOAD(B2, c + 6); S2_READY(B3, 30); S2_STEP(B3, c + 3);
    }
    asm volatile("s_waitcnt vmcnt(0)" : "+v"(B0.p[0][0]), "+v"(B0.p[0][1]), "+v"(B0.p[1][0]), "+v"(B0.p[1][1]), "+v"(B0.p[2][0]), "+v"(B0.p[2][1]), "+v"(B0.p[3][0]), "+v"(B0.p[3][1]), "+v"(B0.q[0]), "+v"(B0.q[1]),
                 "+v"(B1.p[0][0]), "+v"(B1.p[0][1]), "+v"(B1.p[1][0]), "+v"(B1.p[1][1]), "+v"(B1.p[2][0]), "+v"(B1.p[2][1]), "+v"(B1.p[3][0]), "+v"(B1.p[3][1]), "+v"(B1.q[0]), "+v"(B1.q[1]) :: "memory");
    asm volatile("" : "+v"(B2.p[0][0]), "+v"(B2.p[0][1]), "+v"(B2.p[1][0]), "+v"(B2.p[1][1]), "+v"(B2.p[2][0]), "+v"(B2.p[2][1]), "+v"(B2.p[3][0]), "+v"(B2.p[3][1]), "+v"(B2.q[0]), "+v"(B2.q[1]) :: "memory");
#undef S2_LOAD
#undef S2_STEP
}
__device__ __forceinline__ void s2_storer(LAS unsigned char* lds, bf16* Sst, const int bh, const int vb, const int lane) {
    volatile LAS int* prod = (volatile LAS int*)(lds + S2_FLAGS + vb * 64);
    volatile LAS int* cons = (volatile LAS int*)(lds + S2_FLAGS + 256 + vb * 64);
    const LAS unsigned char* ring = lds + vb * (S2_NS * S2_SLOTB) + lane * 32;
    bf16* Sp = Sst + ((size_t)bh * 128) * 4096 + (16 * vb) * 64 + lane * 16;
    for (int c = 0; c < 128; ++c) {
        { unsigned sp_ = 0; while (*prod <= c && ++sp_ < (1u << 22)) __builtin_amdgcn_s_sleep(1); }
        asm volatile("" ::: "memory");
        const v4u a_ = *(const LAS v4u*)(ring + (c & (S2_NS - 1)) * S2_SLOTB), b_ = *(const LAS v4u*)(ring + (c & (S2_NS - 1)) * S2_SLOTB + 16);
        asm volatile("s_waitcnt lgkmcnt(0)" ::: "memory");
        if (lane == 0) *cons = c + 1;
        *(GAS v4u*)(Sp + (size_t)c * 4096) = a_; *(GAS v4u*)(Sp + (size_t)c * 4096 + 8) = b_;
    }
}

struct S3Args { const bf16 *Rh, *O0; int ldo; const bf16* Vp; int ldv; const bf16 *Gf, *Sst; const float *bonus, *lnx_g, *lnx_b; bf16* Y; int ldy; };
__device__ __forceinline__ void s3_unit(const S3Args& A, const int unit, const int lane) {
    const int r = lane & 15, g = lane >> 4;
    const int h = unit & 7, cidx = unit >> 3;
    bf16x8 sf[4][2];
#pragma unroll
    for (int i = 0; i < 4; ++i)
#pragma unroll
        for (int s = 0; s < 2; ++s) sf[i][s] = *(const GAS bf16x8*)(A.Sst + (size_t)(((cidx >> 7) * 8 + h) * 128 + (cidx & 127)) * 4096 + (16 * i + r) * 64 + 32 * s + 8 * g);
    struct TB { bf16x8 fr[2]; v2u o0[4], vv[4], gg[4]; float bon; };
#define S3_LOAD(B_, TB_) do { const size_t tok_ = (size_t)cidx * 64 + 16 * (TB_) + r; \
        _Pragma("unroll") for (int s_ = 0; s_ < 2; ++s_) B_.fr[s_] = *(const GAS bf16x8*)(A.Rh + tok_ * A.ldo + h * 64 + 32 * s_ + 8 * g); \
        _Pragma("unroll") for (int i_ = 0; i_ < 4; ++i_) { const int hv_ = h * 64 + 16 * i_ + 4 * g; B_.o0[i_] = *(const GAS v2u*)(A.O0 + tok_ * A.ldo + hv_); \
            B_.vv[i_] = *(const GAS v2u*)(A.Vp + tok_ * A.ldv + hv_); B_.gg[i_] = *(const GAS v2u*)(A.Gf + tok_ * W + hv_); } \
        B_.bon = ((const GAS float*)A.bonus)[tok_ * 8 + h]; } while (0)
#define S3_COMP(B_, TB_) do { const size_t tok_ = (size_t)cidx * 64 + 16 * (TB_) + r; f32x4 o[4]; \
        _Pragma("unroll") for (int i_ = 0; i_ < 4; ++i_) { o[i_] = unpack4(B_.o0[i_]); _Pragma("unroll") for (int s_ = 0; s_ < 2; ++s_) o[i_] = mma(sf[i_][s_], B_.fr[s_], o[i_]); } \
        float sm = 0.f; \
        _Pragma("unroll") for (int i_ = 0; i_ < 4; ++i_) sm += (o[i_][0] + o[i_][1]) + (o[i_][2] + o[i_][3]); \
        sm += __shfl_xor(sm, 16); sm += __shfl_xor(sm, 32); \
        const float mean = sm * (1.0f / 64.0f); float sq = 0.f; \
        _Pragma("unroll") for (int i_ = 0; i_ < 4; ++i_) { o[i_] = o[i_] - mean; sq += (o[i_][0] * o[i_][0] + o[i_][1] * o[i_][1]) + (o[i_][2] * o[i_][2] + o[i_][3] * o[i_][3]); } \
        sq += __shfl_xor(sq, 16); sq += __shfl_xor(sq, 32); \
        const float rstd = 1.0f / sqrtf(sq * (1.0f / 64.0f) + 64e-5f); \
        _Pragma("unroll") for (int i_ = 0; i_ < 4; ++i_) { const int hv_ = h * 64 + 16 * i_ + 4 * g; \
            const f32x4 y = (o[i_] * rstd * lg[i_] + lb[i_] + unpack4(B_.vv[i_]) * B_.bon) * unpack4(B_.gg[i_]); \
            *(GAS v2u*)(A.Y + tok_ * A.ldy + hv_) = pack4(y); } } while (0)
    TB t0, t1, t2;
    S3_LOAD(t0, 0); S3_LOAD(t1, 1);
    f32x4 lg[4], lb[4];
#pragma unroll
    for (int i = 0; i < 4; ++i) { const int hv = h * 64 + 16 * i + 4 * g; lg[i] = *(const GAS f32x4*)(A.lnx_g + hv); lb[i] = *(const GAS f32x4*)(A.lnx_b + hv); }
    S3_LOAD(t2, 2); S3_COMP(t0, 0);
    S3_LOAD(t0, 3); S3_COMP(t1, 1);
    S3_COMP(t2, 2); S3_COMP(t0, 3);
#undef S3_LOAD
#undef S3_COMP
}
}
namespace moba {
typedef short bf16x8 __attribute__((ext_vector_type(8)));
constexpr int OSP = 132;
constexpr int OSLOT = 0, LSUM = OSLOT + 4 * 256 * OSP, KMF = LSUM + 4 * 256 * 4, CNT = KMF + 8192, OFFS = CNT + 128, FILL = OFFS + 128, QLIST = FILL + 128, QSLOT = QLIST + 1024, ITEMS = QSLOT + 1024, ICTR = ITEMS + 1024, NVQ = ICTR + 64  , MOBA_LDS = NVQ + 256;
static_assert(MOBA_LDS <= 153600 - 1024, "MoBA LDS map below the control words");
__device__ __forceinline__ f32x4 mma(bf16x8 a, bf16x8 b, f32x4 c) { return __builtin_amdgcn_mfma_f32_16x16x32_bf16(a, b, c, 0, 0, 0); }
struct Args { bf16* AT; const bf16* VT; const float* KM; const float *qg, *kg; };
struct KV { bf16x8 k[2][2]; bf16x8 v[4]; };
__device__ __forceinline__ void item(LAS unsigned char* lds, const Args& A, const int b, const int h, const int qb, const int kblk, const int off, const int cnt, const int nkc, const bool own, const int lane) {
    const int r = lane & 15, g = lane >> 4;
    const float slope2 = exp2f(-(float)(h + 1)) * 1.4426950408889634f;
    int ql[2]; float aq[2];
    bf16x8 qf[2][2];
#pragma unroll
    for (int qt = 0; qt < 2; ++qt) {
        const int li = qt * 16 + r;
        int qv = -1;
        if (own) qv = off + li; else if (li < cnt) qv = (int)*(const LAS unsigned char*)(lds + QLIST + off + li);
        ql[qt] = qv;
        const int qrow = (qv >= 0) ? qv : 0;
        aq[qt] = (qv >= 0) ? -slope2 * (float)(256 * (qb - kblk) + qrow) : -1e30f;
    }
    const bf16* kbase = A.AT + ((size_t)b * T + kblk * 256 + 8 * (r >> 2) + (r & 3)) * NAT + 512 + h * 64 + 8 * g;
    const bf16* vbase = A.VT + (((size_t)(b * NH + h) * (T / 32) + kblk * 8) * 64 + r) * 32 + 8 * g;
    f32x4 o[4][2]; float l[2] = {0.f, 0.f};
#pragma unroll
    for (int db = 0; db < 4; ++db) { o[db][0] = (f32x4){0.f, 0.f, 0.f, 0.f}; o[db][1] = (f32x4){0.f, 0.f, 0.f, 0.f}; }
#define GLD16(DST, PTR) asm volatile("global_load_dwordx4 %0, %1, off" : "=v"(DST) : "v"(PTR) : "memory")
#define MOBA_LOAD(B, KC) do { const int kc_ = (KC) < nkc ? (KC) : nkc - 1; \
        _Pragma("unroll") for (int kt = 0; kt < 2; ++kt) { const bf16* kp_ = kbase + (size_t)(kc_ * 32 + kt * 4) * NAT; GLD16(B.k[kt][0], kp_); GLD16(B.k[kt][1], kp_ + 32); } \
        _Pragma("unroll") for (int db = 0; db < 4; ++db) { const bf16* vp_ = vbase + (size_t)kc_ * (64 * 32) + (16 * db) * 32; GLD16(B.v[db], vp_); } } while (0)
#define MOBA_READY(B, N) asm volatile("s_waitcnt vmcnt(" #N ")" : "+v"(B.k[0][0]), "+v"(B.k[0][1]), "+v"(B.k[1][0]), "+v"(B.k[1][1]), "+v"(B.v[0]), "+v"(B.v[1]), "+v"(B.v[2]), "+v"(B.v[3]) :: "memory")
#define MOBA_COMPUTE(B, KC) do { v4u pb_[2]; const int kb_ = (KC) * 32 + 8 * g; const bool dg_ = own && ((KC) == nkc - 1); \
        _Pragma("unroll") for (int qt = 0; qt < 2; ++qt) { unsigned pw_[4]; const float bs_ = aq[qt] + slope2 * (float)kb_; const int dl_ = ql[qt] - kb_; \
            _Pragma("unroll") for (int kt = 0; kt < 2; ++kt) { f32x4 st_ = {0.f, 0.f, 0.f, 0.f}; \
                st_ = mma(B.k[kt][0], qf[qt][0], st_); st_ = mma(B.k[kt][1], qf[qt][1], st_); f32x4 p_; \
                if (dg_) { _Pragma("unroll") for (int e = 0; e < 4; ++e) { float x_ = (st_[e] + bs_) + cst[kt * 4 + e]; if (4 * kt + e > dl_) x_ = -1e30f; p_[e] = __builtin_amdgcn_exp2f(x_); } } \
                else { _Pragma("unroll") for (int e = 0; e < 4; ++e) p_[e] = __builtin_amdgcn_exp2f((st_[e] + bs_) + cst[kt * 4 + e]); } \
                l[qt] += (p_[0] + p_[1]) + (p_[2] + p_[3]); pw_[2 * kt] = pk2(p_[0], p_[1]); pw_[2 * kt + 1] = pk2(p_[2], p_[3]); } \
            pb_[qt].x = pw_[0]; pb_[qt].y = pw_[1]; pb_[qt].z = pw_[2]; pb_[qt].w = pw_[3]; } \
        _Pragma("unroll") for (int db = 0; db < 4; ++db) { _Pragma("unroll") for (int qt = 0; qt < 2; ++qt) o[db][qt] = mma(B.v[db], __builtin_bit_cast(bf16x8, pb_[qt]), o[db][qt]); } } while (0)
    float cst[8];
#pragma unroll
    for (int j = 0; j < 8; ++j) cst[j] = slope2 * (float)j;
    KV B0, B1, B2;
    MOBA_LOAD(B0, 0); MOBA_LOAD(B1, 1);
#pragma unroll
    for (int qt = 0; qt < 2; ++qt) { const int qrow = (ql[qt] >= 0) ? ql[qt] : 0; const bf16* qp = A.AT + ((size_t)b * T + qb * 256 + qrow) * NAT + h * 64 + 8 * g;
        qf[qt][0] = *(const GAS bf16x8*)qp; qf[qt][1] = *(const GAS bf16x8*)(qp + 32); }
    asm volatile("" :: "v"(qf[0][0]), "v"(qf[0][1]), "v"(qf[1][0]), "v"(qf[1][1]) : "memory");
    for (int kc = 0; kc < nkc; kc += 3) {
        MOBA_LOAD(B2, kc + 2); MOBA_READY(B0, 16); MOBA_COMPUTE(B0, kc);
        if (kc + 1 < nkc) { MOBA_LOAD(B0, kc + 3); MOBA_READY(B1, 16); MOBA_COMPUTE(B1, kc + 1); }
        if (kc + 2 < nkc) { MOBA_LOAD(B1, kc + 4); MOBA_READY(B2, 16); MOBA_COMPUTE(B2, kc + 2); }
    }
    asm volatile("s_waitcnt vmcnt(0)" : "+v"(B0.k[0][0]), "+v"(B0.k[0][1]), "+v"(B0.k[1][0]), "+v"(B0.k[1][1]), "+v"(B0.v[0]), "+v"(B0.v[1]), "+v"(B0.v[2]), "+v"(B0.v[3]),
                 "+v"(B1.k[0][0]), "+v"(B1.k[0][1]), "+v"(B1.k[1][0]), "+v"(B1.k[1][1]), "+v"(B1.v[0]), "+v"(B1.v[1]), "+v"(B1.v[2]), "+v"(B1.v[3]),
                 "+v"(B2.k[0][0]), "+v"(B2.k[0][1]), "+v"(B2.k[1][0]), "+v"(B2.k[1][1]), "+v"(B2.v[0]), "+v"(B2.v[1]), "+v"(B2.v[2]), "+v"(B2.v[3]) :: "memory");
#undef MOBA_LOAD
#undef MOBA_COMPUTE
#pragma unroll
    for (int qt = 0; qt < 2; ++qt) {
        float ls = l[qt]; ls += __shfl_xor(ls, 16); ls += __shfl_xor(ls, 32);
        if (ql[qt] >= 0) {
            const int slot = own ? 0 : (int)*(const LAS unsigned char*)(lds + QSLOT + off + qt * 16 + r);
            LAS unsigned char* op = lds + OSLOT + (slot * 256 + ql[qt]) * OSP + g * 8;
#pragma unroll
            for (int db = 0; db < 4; ++db) { *(LAS unsigned*)(op + db * 32) = pk2(o[db][qt][0], o[db][qt][1]); *(LAS unsigned*)(op + db * 32 + 4) = pk2(o[db][qt][2], o[db][qt][3]); }
            if (g == 0) *((LAS float*)(lds + LSUM) + slot * 256 + ql[qt]) = ls;
        }
    }
}
__device__ __forceinline__ void unit(LAS unsigned char* lds, const Args& A, const int b, const int h, const int qb, const int tid, const bool dummy = false) {
    const int lane = tid & 63;
    const int wave = __builtin_amdgcn_readfirstlane(tid >> 6);
    if (tid < 96) ((LAS int*)(lds + CNT))[tid] = 0;
    if (tid == 0) *(LAS int*)(lds + ICTR) = 0;
    if (tid < 64) {
        float mq = fabsf(((const GAS float*)A.qg)[lane]), mk = fabsf(((const GAS float*)A.kg)[lane]);
#pragma unroll
        for (int o_ = 1; o_ < 64; o_ <<= 1) { mq = fmaxf(mq, __shfl_xor(mq, o_)); mk = fmaxf(mk, __shfl_xor(mk, o_)); }
        const float B2 = 64.0f * (0.125f * 1.4426950408889634f) * mq * mk * 1.02f, sl2 = exp2f(-(float)(h + 1)) * 1.4426950408889634f;
        const float dmin = ((B2 + 152.0f) / sl2 - 1.0f) * (1.0f / 256.0f);
        if (lane == 0) *(LAS int*)(lds + ICTR + 8) = (int)floorf(dmin) + 2;
    }
    int s0 = -1, s1 = -1, s2 = -1, sl0 = 0, sl1 = 0, sl2q = 0, nv = 1;
    if (qb > 0) {
        const int r = lane & 15, g = lane >> 4;
        bf16x8 qf[2][2];
#pragma unroll
        for (int nt = 0; nt < 2; ++nt) { const bf16* qp = A.AT + ((size_t)b * T + qb * 256 + wave * 32 + nt * 16 + r) * NAT + h * 64 + 8 * g;
            qf[nt][0] = *(const GAS bf16x8*)qp; qf[nt][1] = *(const GAS bf16x8*)(qp + 32); }
        f32x4 ga[2][2];
#pragma unroll
        for (int mt = 0; mt < 2; ++mt) {
            ga[mt][0] = (f32x4){0.f, 0.f, 0.f, 0.f}; ga[mt][1] = (f32x4){0.f, 0.f, 0.f, 0.f};
            const float* kmp = A.KM + ((size_t)(b * NH + h) * NBLK + mt * 16 + r) * 64 + 8 * g;
#pragma unroll
            for (int ks = 0; ks < 2; ++ks) {
                const f32x4 x0 = *(const GAS f32x4*)(kmp + 32 * ks), x1 = *(const GAS f32x4*)(kmp + 32 * ks + 4);
                v4u wh, wl;
                wh.x = pk2(x0[0], x0[1]); wh.y = pk2(x0[2], x0[3]); wh.z = pk2(x1[0], x1[1]); wh.w = pk2(x1[2], x1[3]);
                wl.x = pk2(x0[0] - bflo(wh.x), x0[1] - bfhi(wh.x)); wl.y = pk2(x0[2] - bflo(wh.y), x0[3] - bfhi(wh.y));
                wl.z = pk2(x1[0] - bflo(wh.z), x1[1] - bfhi(wh.z)); wl.w = pk2(x1[2] - bflo(wh.w), x1[3] - bfhi(wh.w));
#pragma unroll
                for (int nt = 0; nt < 2; ++nt) { ga[mt][nt] = mma(__builtin_bit_cast(bf16x8, wh), qf[nt][ks], ga[mt][nt]); ga[mt][nt] = mma(__builtin_bit_cast(bf16x8, wl), qf[nt][ks], ga[mt][nt]); }
            }
        }
        float tg0[2], tg1[2], tg2[2]; int ts0[2], ts1[2], ts2[2];
#define MOBA_INS(V, I) do { const float v_ = (V); const int i_ = (I); \
            if (v_ > g0 || (v_ == g0 && i_ < t0)) { g2 = g1; t2 = t1; g1 = g0; t1 = t0; g0 = v_; t0 = i_; } \
            else if (v_ > g1 || (v_ == g1 && i_ < t1)) { g2 = g1; t2 = t1; g1 = v_; t1 = i_; } \
            else if (v_ > g2 || (v_ == g2 && i_ < t2)) { g2 = v_; t2 = i_; } } while (0)
#pragma unroll
        for (int nt = 0; nt < 2; ++nt) {
            float g0 = -3e38f, g1 = -3e38f, g2 = -3e38f; int t0 = -1, t1 = -1, t2 = -1;
#pragma unroll
            for (int mt = 0; mt < 2; ++mt) {
#pragma unroll
                for (int e = 0; e < 4; ++e) { const int n = 16 * mt + 4 * g + e; const float gt = (n < qb) ? ga[mt][nt][e] : -3e38f;
                    if (gt > g0) { g2 = g1; t2 = t1; g1 = g0; t1 = t0; g0 = gt; t0 = n; }
                    else if (gt > g1) { g2 = g1; t2 = t1; g1 = gt; t1 = n; }
                    else if (gt > g2) { g2 = gt; t2 = n; } }
            }
#pragma unroll
            for (int o_ = 16; o_ <= 32; o_ <<= 1) {
                const float b0 = __shfl_xor(g0, o_), b1 = __shfl_xor(g1, o_), b2 = __shfl_xor(g2, o_);
                const int j0 = __shfl_xor(t0, o_), j1 = __shfl_xor(t1, o_), j2 = __shfl_xor(t2, o_);
                MOBA_INS(b0, j0); MOBA_INS(b1, j1); MOBA_INS(b2, j2);
            }
            tg0[nt] = g0; tg1[nt] = g1; tg2[nt] = g2; ts0[nt] = t0; ts1[nt] = t1; ts2[nt] = t2;
        }
#undef MOBA_INS
        if (lane < 32) { s0 = g ? ts0[1] : ts0[0]; s1 = g ? ts1[1] : ts1[0]; s2 = g ? ts2[1] : ts2[0]; }
        (void)tg0; (void)tg1; (void)tg2;
    }
    const int qid = wave * 32 + lane;
    RW_BAR();
    if (lane < 32) {
        const int Dd = *(const LAS int*)(lds + ICTR + 8);
        if (s0 >= 0 && qb - s0 >= Dd) s0 = -1; if (s0 >= 0) sl0 = nv++;
        if (s1 >= 0 && qb - s1 >= Dd) s1 = -1; if (s1 >= 0) sl1 = nv++;
        if (s2 >= 0 && qb - s2 >= Dd) s2 = -1; if (s2 >= 0) sl2q = nv++;
        if (s0 >= 0) __hip_atomic_fetch_add((LAS int*)(lds + CNT) + s0, 1, __ATOMIC_RELAXED, __HIP_MEMORY_SCOPE_WORKGROUP);
        if (s1 >= 0) __hip_atomic_fetch_add((LAS int*)(lds + CNT) + s1, 1, __ATOMIC_RELAXED, __HIP_MEMORY_SCOPE_WORKGROUP);
        if (s2 >= 0) __hip_atomic_fetch_add((LAS int*)(lds + CNT) + s2, 1, __ATOMIC_RELAXED, __HIP_MEMORY_SCOPE_WORKGROUP);
        *(LAS unsigned char*)(lds + NVQ + qid) = (unsigned char)nv;
    }
    RW_BAR();
    if (tid < 64) {
        const int c = (lane < qb) ? ((LAS int*)(lds + CNT))[lane] : 0, nit = (c + 31) >> 5;
        int run = c, irun = nit;
#pragma unroll
        for (int o_ = 1; o_ < 32; o_ <<= 1) { const int t_ = __shfl_up(run, o_), u_ = __shfl_up(irun, o_); if (lane >= o_) { run += t_; irun += u_; } }
        const int tot = __shfl(irun, 31), off = run - c, ib = irun - nit;
        if (lane < qb) ((LAS int*)(lds + OFFS))[lane] = off;
        for (int k = 0; k < nit; ++k) { ((LAS int*)(lds + ITEMS))[2 * (ib + k)] = lane | ((c - 32 * k < 32 ? c - 32 * k : 32) << 8); ((LAS int*)(lds + ITEMS))[2 * (ib + k) + 1] = off + 32 * k; }
        if (lane >= 32 && lane < 40) { const int i = 39 - lane; ((LAS int*)(lds + ITEMS))[2 * (tot + lane - 32)] = qb | (32 << 8) | (1 << 16) | ((i + 1) << 20); ((LAS int*)(lds + ITEMS))[2 * (tot + lane - 32) + 1] = 32 * i; }
        if (lane == 0) *(LAS int*)(lds + ICTR + 4) = tot + 8;
    }
    RW_BAR();
    if (lane < 32) {
        if (s0 >= 0) { const int p = __hip_atomic_fetch_add((LAS int*)(lds + FILL) + s0, 1, __ATOMIC_RELAXED, __HIP_MEMORY_SCOPE_WORKGROUP); *(LAS unsigned char*)(lds + QLIST + ((LAS int*)(lds + OFFS))[s0] + p) = (unsigned char)qid; *(LAS unsigned char*)(lds + QSLOT + ((LAS int*)(lds + OFFS))[s0] + p) = (unsigned char)sl0; }
        if (s1 >= 0) { const int p = __hip_atomic_fetch_add((LAS int*)(lds + FILL) + s1, 1, __ATOMIC_RELAXED, __HIP_MEMORY_SCOPE_WORKGROUP); *(LAS unsigned char*)(lds + QLIST + ((LAS int*)(lds + OFFS))[s1] + p) = (unsigned char)qid; *(LAS unsigned char*)(lds + QSLOT + ((LAS int*)(lds + OFFS))[s1] + p) = (unsigned char)sl1; }
        if (s2 >= 0) { const int p = __hip_atomic_fetch_add((LAS int*)(lds + FILL) + s2, 1, __ATOMIC_RELAXED, __HIP_MEMORY_SCOPE_WORKGROUP); *(LAS unsigned char*)(lds + QLIST + ((LAS int*)(lds + OFFS))[s2] + p) = (unsigned char)qid; *(LAS unsigned char*)(lds + QSLOT + ((LAS int*)(lds + OFFS))[s2] + p) = (unsigned char)sl2q; }
    }
    RW_BAR();
    {
        const int ni = *(const LAS int*)(lds + ICTR + 4);
        for (;;) {
            int idx = 0; if (lane == 0) idx = __hip_atomic_fetch_add((LAS int*)(lds + ICTR), 1, __ATOMIC_RELAXED, __HIP_MEMORY_SCOPE_WORKGROUP);
            idx = __builtin_amdgcn_readfirstlane(idx);
            if (idx >= ni) break;
            const int w0 = __builtin_amdgcn_readfirstlane(((const LAS int*)(lds + ITEMS))[2 * idx]), w1 = __builtin_amdgcn_readfirstlane(((const LAS int*)(lds + ITEMS))[2 * idx + 1]);
            const bool own = (w0 >> 16) & 1;
            item(lds, A, b, h, qb, w0 & 255, w1, (w0 >> 8) & 255, own ? (w0 >> 20) : 8, own, lane);
        }
    }
    RW_BAR();
    if (!dummy) {
        const int qloc = tid >> 1, half = tid & 1;
        const int nslot = (int)*(const LAS unsigned char*)(lds + NVQ + qloc);
        float acc[32]; float lt = 0.f;
#pragma unroll
        for (int d = 0; d < 32; ++d) acc[d] = 0.f;
        for (int sl = 0; sl < nslot; ++sl) {
            const LAS unsigned* op = (const LAS unsigned*)(lds + OSLOT + (sl * 256 + qloc) * OSP + half * 64);
#pragma unroll
            for (int d = 0; d < 16; ++d) { const unsigned w = op[d]; acc[2 * d] += bflo(w); acc[2 * d + 1] += bfhi(w); }
            lt += *((const LAS float*)(lds + LSUM) + sl * 256 + qloc);
        }
        const float inv = 1.0f / lt;
        bf16* yp = A.AT + ((size_t)b * T + qb * 256 + qloc) * NAT + h * 64 + half * 32;
#pragma unroll
        for (int c = 0; c < 4; ++c) { v4u w; w.x = pk2(acc[8*c] * inv, acc[8*c+1] * inv); w.y = pk2(acc[8*c+2] * inv, acc[8*c+3] * inv); w.z = pk2(acc[8*c+4] * inv, acc[8*c+5] * inv); w.w = pk2(acc[8*c+6] * inv, acc[8*c+7] * inv); *(GAS v4u*)(yp + 8 * c) = w; }
    }
    RW_BAR();
}
}

__global__ void __launch_bounds__(NWAVES * 64, 2) mk_fwd(Args args) {
    extern __shared__ __attribute__((aligned(16))) unsigned char lds_raw[];
    LAS unsigned char* lds = (LAS unsigned char*)lds_raw;
    const int tid0 = threadIdx.x;
    const int wv0 = __builtin_amdgcn_readfirstlane(tid0 >> 6);
    const int G = gridDim.x;
    unsigned char* ws0 = args.ws;
    const int lo = args.ph_lo, hi = args.ph_hi;
    const int NGW = G * NWAVES;
    const bool fused = args.fused != 0;
    volatile LAS unsigned* MISC = (volatile LAS unsigned*)(lds + MISC_OFF);
    for (int u = tid0; u < (LDS_BYTES - LDSCTL_OFF) / 4; u += NWAVES * 64) ((LAS unsigned*)(lds + LDSCTL_OFF))[u] = 0u;
    __syncthreads();
    XcdBarrier bar; bar.bar = (unsigned*)(ws0 + WS_CTL) + CW_BAR; bar.x = 0; bar.st = nullptr;
    if (fused) bar = xcd_barrier_post((unsigned*)(ws0 + WS_CTL) + CW_BAR, MISC + 8);
#define IN(k) (lo <= (k) && (k) < hi && (rep == 1 || (k) <= args.probe_upto || (k) == args.probe_dup))
#define SEAM(k) do { if (fused && !((k) == PH_FF2 && L == args.l_hi - 1)) xcd_barrier(bar, tidL == 0); } while (0)

    for (int L = args.l_lo; L < args.l_hi; ++L)
    for (int rep = (args.probe_upto >= 0 || args.probe_dup >= 0) ? 0 : 1; rep < 2; ++rep) {
    const float* xsrc = (L == 0) ? args.in[I_X] : args.out;
    int tidL; asm volatile("v_mbcnt_lo_u32_b32 %0, -1, 0\n\tv_mbcnt_hi_u32_b32 %0, -1, %0\n\tv_lshl_add_u32 %0, %1, 6, %0" : "=&v"(tidL) : "s"(wv0));
    const int tid = tidL, lane = tid & 63, wave = __builtin_amdgcn_readfirstlane(tid >> 6), gw = blockIdx.x * NWAVES + wave;
    if (IN(PH_CONV)) {
        unsigned char* ws = args.ws; asm volatile("" : "+s"(ws));
        LAS float* scr = (LAS float*)(lds + RING_OFF + wave * 16384);
        const float* w_in = args.in[I_WIN] + (size_t)L * D * NIN;
        const float* w_br = args.in[I_WBR] + (size_t)L * 3 * W * D;
        const float* w_out = args.in[I_WOUT] + (size_t)L * D * D;
        const float* w_f1 = args.in[I_FF1] + (size_t)L * D * FF;
        const float* w_f2 = args.in[I_FF2] + (size_t)L * FF * D;
        constexpr int I_IN = (D / 64) * (NIN / 32), I_B = (W / 64) * (D / 32), I_O = (D / 64) * (D / 32), I_1 = (D / 64) * (FF / 32), I_2 = (FF / 64) * (D / 32);
        constexpr int I_LU = 16, I_LG = 32;
        constexpr int NITEMS = I_IN + 2 * I_B + I_O + I_1 + I_2 + 2 * I_LU + I_LG;
        bf16* WupT = (bf16*)(ws + WS_LORA); bf16* AupT = WupT + 512 * 64; bf16* GupT = AupT + 512 * 64;
        for (int it = gw; it < NITEMS; it += NGW) {
            int r = it;
            if (r < I_IN) { p0_transpose_item(w_in, D, NIN, ((bf16*)(ws + WS_WIN)), scr, r, lane); continue; } r -= I_IN;
            if (r < I_B) { p0_transpose_item(w_br, W, D, ((bf16*)(ws + WS_WB)), scr, r, lane); continue; } r -= I_B;
            if (r < I_B) { p0_transpose_item(w_br + (size_t)W * D, W, D, ((bf16*)(ws + WS_WB)) + (size_t)D * W, scr, r, lane); continue; } r -= I_B;
            if (r < I_O) { p0_transpose_item(w_out, D, D, ((bf16*)(ws + WS_WO)), scr, r, lane); continue; } r -= I_O;
            if (r < I_1) { p0_transpose_item(w_f1, D, FF, ((bf16*)(ws + WS_W1)), scr, r, lane); continue; } r -= I_1;
            if (r < I_2) { p0_transpose_item(w_f2, FF, D, ((bf16*)(ws + WS_W2)), scr, r, lane); continue; } r -= I_2;
            if (r < I_LU) { p0_transpose_item(args.in[I_WUP] + (size_t)L * 64 * W, 64, W, WupT, scr, r, lane); continue; } r -= I_LU;
            if (r < I_LU) { p0_transpose_item(args.in[I_AUP] + (size_t)L * 64 * W, 64, W, AupT, scr, r, lane); continue; } r -= I_LU;
            p0_transpose_item(args.in[I_GUP] + (size_t)L * 128 * W, 128, W, GupT, scr, r, lane);
        }
        const float* pw = args.in[I_POOLW] + (size_t)L * 4 * 128 * 128; const float* ps = args.in[I_POOLS] + (size_t)L * W; const float* wb2 = w_br + (size_t)2 * W * D;
        bf16* WeT = ((bf16*)(ws + WS_WB)) + (size_t)2 * D * W;
        for (int idx = blockIdx.x * (NWAVES * 64) + tid; idx < W * D; idx += G * NWAVES * 64) {
            const int gc = idx / D, dout = idx % D, g = gc >> 7;
            const GAS float* pwr = (const GAS float*)pw + (size_t)gc * 128; float acc = 0.f;
            for (int dp = 0; dp < 128; ++dp) acc += pwr[dp] * ((const GAS float*)ps)[g * 128 + dp] * ((const GAS float*)wb2)[(size_t)(g * 128 + dp) * D + dout];
            ((GAS bf16*)WeT)[(size_t)dout * W + gc] = (bf16)f2bf(acc);
        }
        rms_rows(xsrc, args.in[I_N1G] + (size_t)L * D, ((bf16*)(ws + WS_H)), gw, NGW, lane);
        SEAM(PH_CONV);
    }
    if (IN(PH_GEMMA)) {
        unsigned char* ws = args.ws; asm volatile("" : "+s"(ws));
        pg8::Gemm g{((bf16*)(ws + WS_H)), ((bf16*)(ws + WS_WIN)), M, NA, D, D, D}; pg8::StaticOrder S; S.init(M, NA, G, (int)blockIdx.x);
        pg8::EpiA E{(bf16*)(ws + WS_RW), (bf16*)(ws + WS_AT), (bf16*)(ws + WS_PL), (bf16*)(ws + WS_SB), (bf16*)(ws + WS_HB)};
        pg8::gemm_phase<pg8::EpiA, pg8::StaticOrder, true, true>(lds + RING_OFF, g, S, E, tidL);
        SEAM(PH_GEMMA);
    }
    if (IN(PH_MIX1)) {
        unsigned char* ws = args.ws; asm volatile("" : "+s"(ws));
        ph_attn_prep(lds, (bf16*)(ws + WS_AT), (bf16*)(ws + WS_VT), args.in[I_QNG] + L * 64, args.in[I_KNG] + L * 64, (float*)(ws + WS_KM), G, tidL);
        ph_pool((bf16*)(ws + WS_PL), (const bf16*)(ws + WS_HB), G, tidL);
        __syncthreads();
        rw::S1Args A1; A1.RW = (bf16*)(ws + WS_RW); A1.SB = (const bf16*)(ws + WS_SB);
        A1.mu = args.in[I_MU] + L * NRW; A1.w0 = args.in[I_W0] + L * W; A1.a0 = args.in[I_A0] + L * W; A1.k_k = args.in[I_KK] + L * W; A1.k_a = args.in[I_KA] + L * W; A1.r_k = args.in[I_RK] + L * W;
        A1.WupT = (const bf16*)(ws + WS_LORA); A1.AupT = A1.WupT + 512 * 64; A1.GupT = A1.AupT + 512 * 64;
        A1.Gf = (bf16*)(ws + WS_GF); A1.Pst = (bf16*)(ws + WS_PST); A1.Qst = (bf16*)(ws + WS_QST); A1.bonus = (float*)(ws + WS_BON);
        A1.Rh = (bf16*)(ws + WS_RW); A1.O0 = (bf16*)(ws + WS_RW) + 512; A1.ldo = NRW; A1.Vm = (bf16*)(ws + WS_RW) + 1024; A1.ldv = NRW;
        int hprev = -1;
        for (int unit = blockIdx.x; unit < NB * 128 * NH; unit += G) rw::s1_unit(lds, A1, unit, tidL, hprev);
        SEAM(PH_MIX1);
    }
    if (IN(PH_MIX2)) {
        unsigned char* ws = args.ws; asm volatile("" : "+s"(ws));
#define S3_PUBLISH(BH) do { asm volatile("s_waitcnt vmcnt(0)" ::: "memory"); __syncthreads(); \
            if (tid == 0) { __builtin_amdgcn_fence(__ATOMIC_RELEASE, "agent"); asm volatile("s_waitcnt vmcnt(0)" ::: "memory"); \
                __hip_atomic_store((unsigned*)(ws + WS_CTL) + CW_S3F + L * 64 + (BH), 1u, __ATOMIC_RELAXED, __HIP_MEMORY_SCOPE_AGENT); } } while (0)
        { moba::Args MA; MA.AT = (bf16*)(ws + WS_AT); MA.VT = (const bf16*)(ws + WS_VT); MA.KM = (const float*)(ws + WS_KM); MA.qg = args.in[I_QNG] + L * 64; MA.kg = args.in[I_KNG] + L * 64;
          if (G == 256) {
              const int xcd = blockIdx.x & 7, slot = blockIdx.x >> 3;
              if (slot < 4) {
                  if (tid < 8) *(volatile LAS int*)(lds + rw::S2_FLAGS + tid * 64) = 0;
                  __syncthreads();
                  if (wave < 4) rw::s2_chain(lds, (const bf16*)(ws + WS_PST), (const bf16*)(ws + WS_QST), slot * 8 + xcd, wave, lane);
                  else rw::s2_storer(lds, (bf16*)(ws + WS_SST), slot * 8 + xcd, wave - 4, lane);
                  S3_PUBLISH(slot * 8 + xcd);
              }
              volatile LAS int* qslot = (volatile LAS int*)(lds + LDSCTL_OFF + 64);
              for (int qx = 0; qx < 8; ++qx) {
                  const int x = (xcd + qx) & 7;
                  gu32* qw = (gu32*)(ws + WS_CTL) + CW_Q + (L * 8 + x) * 64;
                  for (;;) {
                      __syncthreads();
                      if (tid == 0) *qslot = (int)__hip_atomic_fetch_add(qw, 1u, RLX_AGENT);
                      __syncthreads();
                      const int u = *qslot;
                      if (u >= 128) break;
                      const int pb_ = u >> 5, ph_ = (pb_ & 1) ? 7 - x : x;
                      int tq = tidL; asm volatile("" : "+v"(tq));
#ifdef PROBE_MOBA2
                      moba::unit(lds, MA, pb_, ph_, 31 - (u & 31), tq, true);
#endif
                      moba::unit(lds, MA, pb_, ph_, 31 - (u & 31), tq);
                  }
              }
          } else {
              for (int bh = blockIdx.x; bh < NB * NH; bh += G) {
                  __syncthreads();
                  if (tid < 8) *(volatile LAS int*)(lds + rw::S2_FLAGS + tid * 64) = 0;
                  __syncthreads();
                  if (wave < 4) rw::s2_chain(lds, (const bf16*)(ws + WS_PST), (const bf16*)(ws + WS_QST), bh, wave, lane);
                  else rw::s2_storer(lds, (bf16*)(ws + WS_SST), bh, wave - 4, lane);
                  S3_PUBLISH(bh);
              }
              __syncthreads();
              for (int u = blockIdx.x; u < NB * NH * NBLK; u += G) { int tq = tidL; asm volatile("" : "+v"(tq)); moba::unit(lds, MA, u >> 8, (u >> 5) & 7, u & 31, tq); } } }
#undef S3_PUBLISH
        {
            if (tid < NB * NH) { unsigned sp_ = 0; while (__hip_atomic_load((unsigned*)(ws + WS_CTL) + CW_S3F + L * 64 + tid, __ATOMIC_RELAXED, __HIP_MEMORY_SCOPE_AGENT) == 0u && ++sp_ < (1u << 24)) __builtin_amdgcn_s_sleep(2); }
            if (tid < 64) { __builtin_amdgcn_fence(__ATOMIC_ACQUIRE, "agent"); asm volatile("s_waitcnt vmcnt(0)" ::: "memory"); }
            __syncthreads();
            rw::S3Args A3; A3.Rh = (const bf16*)(ws + WS_RW); A3.O0 = A3.Rh + 512; A3.ldo = NRW; A3.Vp = A3.Rh + 1024; A3.ldv = NRW; A3.Gf = (const bf16*)(ws + WS_GF); A3.Sst = (const bf16*)(ws + WS_SST);
            A3.bonus = (const float*)(ws + WS_BON); A3.lnx_g = args.in[I_LNG] + L * W; A3.lnx_b = args.in[I_LNB] + L * W; A3.Y = (bf16*)(ws + WS_RW); A3.ldy = NRW;
            gu32* s3q = (gu32*)(ws + WS_CTL) + CW_S3Q + L * 64;
            int cur = 0; if (lane == 0) cur = (int)__hip_atomic_fetch_add(s3q, 1u, RLX_AGENT);
            cur = __builtin_amdgcn_readfirstlane(cur);
            while (cur < NB * 128 * NH) {
                int nxt = 0;
                if (lane == 0) asm volatile("global_atomic_add %0, %1, %2, %3 sc0" : "=v"(nxt) : "v"(0), "v"(1), "s"(s3q) : "memory");
                rw::s3_unit(A3, cur, lane);
                asm volatile("s_waitcnt vmcnt(0)" : "+v"(nxt) :: "memory");
                cur = __builtin_amdgcn_readfirstlane(nxt);
            }
        }
        SEAM(PH_MIX2);
    }
    if (IN(PH_GB)) {
        unsigned char* ws = args.ws; asm volatile("" : "+s"(ws));
        bf16* GBp = (bf16*)(ws + WS_GB); bf16* MBp = (bf16*)(ws + WS_MB);
        pg8::StaticOrder S; S.init(M, D, G, (int)blockIdx.x);
#pragma unroll
        for (int b = 0; b < 3; ++b) {
            { int tv = tidL; asm volatile("" : "+v"(tv)); pg8::Gemm g{((bf16*)(ws + WS_H)), ((bf16*)(ws + WS_WIN)) + (size_t)(NA + b * D) * D, M, D, D, D, D}; pg8::EpiAct<1> E{GBp, D};
              pg8::gemm_phase<pg8::EpiAct<1>, pg8::StaticOrder, true, true>(lds + RING_OFF, g, S, E, tv); }
            __syncthreads();
            { int tv = tidL; asm volatile("" : "+v"(tv)); const bf16* Ysrc = (b == 0) ? (const bf16*)(ws + WS_RW) : (b == 1 ? (const bf16*)(ws + WS_AT) : (const bf16*)(ws + WS_PL));
              pg8::Gemm g{Ysrc, ((bf16*)(ws + WS_WB)) + (size_t)b * D * W, M, D, W, (b == 0) ? NRW : (b == 1 ? NAT : NPL), W};
              if (b == 0) { pg8::EpiBr<true> E{GBp, MBp}; pg8::gemm_phase<pg8::EpiBr<true>, pg8::StaticOrder, true, true>(lds + RING_OFF, g, S, E, tv); }
              else { pg8::EpiBr<false> E{GBp, MBp}; pg8::gemm_phase<pg8::EpiBr<false>, pg8::StaticOrder, true, true>(lds + RING_OFF, g, S, E, tv); } }
            __syncthreads();
        }
        SEAM(PH_GB);
    }
    if (IN(PH_GO)) {
        unsigned char* ws = args.ws; asm volatile("" : "+s"(ws));
        pg8::Gemm g{(const bf16*)(ws + WS_MB), ((bf16*)(ws + WS_WO)), M, D, D, D, D}; pg8::StaticOrder S; S.init(M, D, G, (int)blockIdx.x);
        pg8::EpiRes E{xsrc, args.out};
        pg8::gemm_phase<pg8::EpiRes, pg8::StaticOrder, true, true>(lds + RING_OFF, g, S, E, tidL);
        SEAM(PH_GO);
    }
    if (IN(PH_NORM2)) { unsigned char* ws = args.ws; asm volatile("" : "+s"(ws)); rms_rows(args.out, args.in[I_N2G] + (size_t)L * D, ((bf16*)(ws + WS_H)), gw, NGW, lane); SEAM(PH_NORM2); }
        unsigned char* ws = args.ws; asm volatile("" : "+s"(ws));
    if (IN(PH_FF1)) {
        unsigned char* ws = args.ws; asm volatile("" : "+s"(ws));
        pg8::Gemm g{((bf16*)(ws + WS_H)), ((bf16*)(ws + WS_W1)), M, FF, D, D, D}; pg8::StaticOrder S; S.init(M, FF, G, (int)blockIdx.x);
        pg8::EpiAct<2> E{(bf16*)(ws + WS_HID), FF};
        pg8::gemm_phase<pg8::EpiAct<2>, pg8::StaticOrder, true, true>(lds + RING_OFF, g, S, E, tidL);
        SEAM(PH_FF1);
    }
    if (IN(PH_FF2)) {
        unsigned char* ws = args.ws; asm volatile("" : "+s"(ws));
        pg8::Gemm g{(const bf16*)(ws + WS_HID), ((bf16*)(ws + WS_W2)), M, D, FF, FF, FF}; pg8::StaticOrder S; S.init(M, D, G, (int)blockIdx.x);
        pg8::EpiRes E{args.out, args.out};
        pg8::gemm_phase<pg8::EpiRes, pg8::StaticOrder, true, true>(lds + RING_OFF, g, S, E, tidL);
        SEAM(PH_FF2);
    }
    }
#undef IN
#undef SEAM
}

#ifndef MK_MULTI
#define MK_MULTI 0
#endif
#ifndef PROBE_UPTO
#define PROBE_UPTO (-1)
#endif
#ifndef PROBE_DUP
#define PROBE_DUP (-1)
#endif
extern "C" void kernel_launch(void* const* d_in, const int* in_sizes, int n_in, void* d_out, int out_size, void* d_ws, size_t ws_size, hipStream_t stream) {
    static int grid = 0;
    if (grid == 0) {
        if (n_in != 23 || in_sizes[0] != M * D || out_size != M * D || ws_size < WS_END) { fprintf(stderr, "kernel_launch: unexpected shapes (n_in %d, in0 %d, out %d, ws %zu)\n", n_in, n_in > 0 ? in_sizes[0] : -1, out_size, ws_size); grid = -1; return; }
        int dev = 0, cus = 0;
        if (hipGetDevice(&dev) != hipSuccess || hipDeviceGetAttribute(&cus, hipDeviceAttributeMultiprocessorCount, dev) != hipSuccess) { grid = -1; return; }
        if (hipFuncSetAttribute((const void*)mk_fwd, hipFuncAttributeMaxDynamicSharedMemorySize, LDS_BYTES) != hipSuccess) { fprintf(stderr, "kernel_launch: hipFuncSetAttribute failed\n"); grid = -1; return; }
        int per_cu = 0;
        if (hipOccupancyMaxActiveBlocksPerMultiprocessor(&per_cu, (const void*)mk_fwd, NWAVES * 64, LDS_BYTES) != hipSuccess || per_cu < 1) fprintf(stderr, "kernel_launch: occupancy query reports %d\n", per_cu);
        (void)hipGetLastError();
        grid = cus;
    }
    if (grid < 0) return;
    unsigned char* ws = (unsigned char*)d_ws;
    (void)hipMemsetAsync(ws + WS_CTL, 0, CTL_ZERO_BYTES, stream);
    Args a{};
    for (int i = 0; i < 23; ++i) a.in[i] = (const float*)d_in[i];
    a.out = (float*)d_out; a.ws = ws;
#if MK_MULTI
    for (int L = 0; L < 2; ++L) for (int p = 0; p < PH_N; ++p) { a.ph_lo = p; a.ph_hi = p + 1; a.l_lo = L; a.l_hi = L + 1; a.fused = 0; a.probe_upto = -1; a.probe_dup = -1; hipLaunchKernelGGL(mk_fwd, dim3(grid), dim3(NWAVES * 64), LDS_BYTES, stream, a); }
#else
    a.ph_lo = 0; a.ph_hi = PH_N; a.l_lo = 0; a.l_hi = 2; a.fused = 1; a.probe_upto = PROBE_UPTO; a.probe_dup = PROBE_DUP;
    hipLaunchKernelGGL(mk_fwd, dim3(grid), dim3(NWAVES * 64), LDS_BYTES, stream, a);
#endif
}
```

```cpp
#include <hip/hip_runtime.h>
#include <cstdio>
#include <cstdint>
#define GAS __attribute__((address_space(1)))
namespace pg8 {
#define PG8_LAS __attribute__((address_space(3)))
typedef unsigned short bf16_t;
typedef short bf16x8 __attribute__((ext_vector_type(8)));
typedef float f32x4 __attribute__((ext_vector_type(4)));
typedef unsigned u32x4 __attribute__((ext_vector_type(4)));
typedef int i32x4 __attribute__((ext_vector_type(4)));
typedef unsigned u32x2 __attribute__((ext_vector_type(2)));
constexpr int BM = 256, BK = 64, HALF = 128, HTB = HALF * BK * 2  , STAGE_BYTES = 8 * HTB, NXCD = 8, WGM = 8;

__host__ __device__ __forceinline__ int lds_byte(int r, int c) { const int st = (r >> 4) * 2 + (c >> 5), rr = r & 15, cc = c & 31, ob = rr * 64 + cc * 2; return st * 1024 + (ob ^ (((ob >> 9) & 1) << 5)); }
__host__ __device__ __forceinline__ void stage_rc(int b, int& R, int& C) { const int st = b / 1024, sb = b % 1024, swz = sb ^ (((sb >> 9) & 1) << 5); R = (st >> 1) * 16 + swz / 64; C = (st & 1) * 32 + (swz % 64) / 2; }
__host__ __device__ __forceinline__ int perm32(int rho) { const int n = rho >> 4, i = rho & 15; return 8 * (i >> 2) + 4 * n + (i & 3); }

struct Unit { int pm, pn; };
struct Gemm { const bf16_t* A; const bf16_t* Bt; int M, N, K, lda, ldb; };

struct StaticOrder {
    int nM, nN, nwg, G, c;
    __host__ __device__ void init(int M, int N, int G_, int c_) { nM = M / BM; nN = N / BM; nwg = nM * nN; G = G_; c = c_; }
    __host__ __device__ bool next(int i, Unit& u) const {
        const long L = (long)i * G + c; if (L >= nwg) return false;
        int wgid = (int)L; { const int q = nwg / NXCD, r = nwg % NXCD, xcd = wgid % NXCD, off = wgid / NXCD; wgid = (xcd < r ? xcd * (q + 1) : r * (q + 1) + (xcd - r) * q) + off; }
        const int nig = WGM * nN, gid = wgid / nig, fm = gid * WGM, gsz = (nM - fm) < WGM ? (nM - fm) : WGM;
        u.pm = fm + ((wgid % nig) % gsz); u.pn = (wgid % nig) / gsz; return true;
    }
    __device__ __forceinline__ void a_ready(const Unit&) const {}
    __device__ __forceinline__ void done(const Unit&) const {}
};

typedef float pg8_f32x2 __attribute__((ext_vector_type(2)));
typedef __bf16 pg8_bf16x2 __attribute__((ext_vector_type(2)));
__device__ __forceinline__ unsigned cvt_pk_bf16(float lo, float hi) { pg8_f32x2 v = {lo, hi}; pg8_bf16x2 b = __builtin_convertvector(v, pg8_bf16x2); return __builtin_bit_cast(unsigned, b); }
__device__ __forceinline__ float sigm(float x) { return __builtin_amdgcn_rcpf(1.0f + __builtin_amdgcn_exp2f(-1.4426950408889634f * x)); }
__device__ __forceinline__ float bf_lo(unsigned w) { return __builtin_bit_cast(float, w << 16); }
__device__ __forceinline__ float bf_hi(unsigned w) { return __builtin_bit_cast(float, w & 0xffff0000u); }
struct EpiA {
    static constexpr bool PERM = true, AFTER_DRAIN = false;
    bf16_t *RW, *AT, *PL, *SB, *HB;
    __device__ __forceinline__ void operator()(const f32x4 (&acc)[2][2][4][2], const Unit& u, int wr, int wc, int fr, int fq) const {
        bf16_t* base; int ldc, colt;
        if (u.pn < 7) { base = RW; ldc = 1792; colt = u.pn * 256; } else if (u.pn < 13) { base = AT; ldc = 1536; colt = (u.pn - 7) * 256; } else { base = PL; ldc = 512; colt = (u.pn - 13) * 256; }
        const int row0 = u.pm * BM + wr * 64 + fr, col0 = colt + wc * 32 + 8 * fq;
#pragma unroll
        for (int ai = 0; ai < 2; ++ai)
#pragma unroll
            for (int m = 0; m < 4; ++m) { bf16_t* rowp = base + (size_t)(row0 + ai * HALF + m * 16) * ldc + col0;
#pragma unroll
                for (int bj = 0; bj < 2; ++bj) { const f32x4 v0 = acc[ai][bj][m][0], v1 = acc[ai][bj][m][1];
                    u32x4 w; w.x = cvt_pk_bf16(v0[0], v0[1]); w.y = cvt_pk_bf16(v0[2], v0[3]); w.z = cvt_pk_bf16(v1[0], v1[1]); w.w = cvt_pk_bf16(v1[2], v1[3]);
                    *(GAS u32x4*)(rowp + bj * HALF) = w;
                    if (u.pn < 7 && m == 3 && fr == 15) *(GAS u32x4*)(SB + (size_t)((row0 + ai * HALF + 48) >> 6) * 1792 + col0 + bj * HALF) = w;
                    if (u.pn >= 13 && m == 3 && wr == 1 && fr >= 1) *(GAS u32x4*)(HB + ((size_t)((row0 + ai * HALF + 48) >> 7) * 15 + (fr - 1)) * 512 + col0 + bj * HALF) = w; } }
    }
};
template <int MODE, bool RS = false> struct EpiAct {
    static constexpr bool PERM = true, AFTER_DRAIN = false;
    bf16_t* O; int ldc; const float* ssq;
    __device__ __forceinline__ void operator()(const f32x4 (&acc)[2][2][4][2], const Unit& u, int wr, int wc, int fr, int fq) const {
        const int row0 = u.pm * BM + wr * 64 + fr, col0 = u.pn * BM + wc * 32 + 8 * fq;
        float rs[2][4];
        if (RS) {
#pragma unroll
            for (int ai = 0; ai < 2; ++ai)
#pragma unroll
                for (int m = 0; m < 4; ++m) rs[ai][m] = (float)((const GAS unsigned long long*)ssq)[row0 + ai * HALF + m * 16] * (1.0f / 65536.0f);
#pragma unroll
            for (int ai = 0; ai < 2; ++ai)
#pragma unroll
                for (int m = 0; m < 4; ++m) rs[ai][m] = __builtin_amdgcn_rsqf(rs[ai][m] * (1.0f / 1024.0f) + 1e-6f);
        }
#pragma unroll
        for (int ai = 0; ai < 2; ++ai)
#pragma unroll
            for (int m = 0; m < 4; ++m) { bf16_t* rowp = O + (size_t)(row0 + ai * HALF + m * 16) * ldc + col0;
#pragma unroll
                for (int bj = 0; bj < 2; ++bj) { f32x4 v0 = acc[ai][bj][m][0], v1 = acc[ai][bj][m][1];
                    if (RS) { v0 = v0 * rs[ai][m]; v1 = v1 * rs[ai][m]; }
#pragma unroll
                    for (int e = 0; e < 4; ++e) {
                        if (MODE == 1) { v0[e] = sigm(v0[e]); v1[e] = sigm(v1[e]); }
                        if (MODE == 2) { const float a = fmaxf(v0[e], 0.f), b = fmaxf(v1[e], 0.f); v0[e] = a * a; v1[e] = b * b; } }
                    u32x4 w; w.x = cvt_pk_bf16(v0[0], v0[1]); w.y = cvt_pk_bf16(v0[2], v0[3]); w.z = cvt_pk_bf16(v1[0], v1[1]); w.w = cvt_pk_bf16(v1[2], v1[3]);
                    *(GAS u32x4*)(rowp + bj * HALF) = w; } }
    }
};
struct EpiGate8 {
    static constexpr bool PERM = true, AFTER_DRAIN = false;
    bf16_t* O; const float* sA; const float* sB;
    __device__ __forceinline__ void operator()(const f32x4 (&acc)[2][2][4][2], const Unit& u, int wr, int wc, int fr, int fq) const {
        const int row0 = u.pm * BM + wr * 64 + fr, col0 = u.pn * BM + wc * 32 + 8 * fq;
        float ra[2][4]; f32x4 cb[2][2];
#pragma unroll
        for (int ai = 0; ai < 2; ++ai)
#pragma unroll
            for (int m = 0; m < 4; ++m) ra[ai][m] = ((const GAS float*)sA)[row0 + ai * HALF + m * 16];
#pragma unroll
        for (int bj = 0; bj < 2; ++bj) { cb[bj][0] = *(const GAS f32x4*)(sB + col0 + bj * HALF); cb[bj][1] = *(const GAS f32x4*)(sB + col0 + bj * HALF + 4); }
#pragma unroll
        for (int ai = 0; ai < 2; ++ai)
#pragma unroll
            for (int m = 0; m < 4; ++m) { bf16_t* rowp = O + (size_t)(row0 + ai * HALF + m * 16) * 1024 + col0;
#pragma unroll
                for (int bj = 0; bj < 2; ++bj) { const i32x4 i0 = __builtin_bit_cast(i32x4, acc[ai][bj][m][0]), i1 = __builtin_bit_cast(i32x4, acc[ai][bj][m][1]); f32x4 v0, v1;
#pragma unroll
                    for (int e = 0; e < 4; ++e) { v0[e] = sigm((float)i0[e] * ra[ai][m] * cb[bj][0][e]); v1[e] = sigm((float)i1[e] * ra[ai][m] * cb[bj][1][e]); }
                    u32x4 w; w.x = cvt_pk_bf16(v0[0], v0[1]); w.y = cvt_pk_bf16(v0[2], v0[3]); w.z = cvt_pk_bf16(v1[0], v1[1]); w.w = cvt_pk_bf16(v1[2], v1[3]);
                    *(GAS u32x4*)(rowp + bj * HALF) = w; } }
    }
};
template <bool FIRST> struct EpiBr {
    static constexpr bool PERM = true, AFTER_DRAIN = false;
    const bf16_t* GB; bf16_t* MBuf;
    __device__ __forceinline__ void operator()(const f32x4 (&acc)[2][2][4][2], const Unit& u, int wr, int wc, int fr, int fq) const {
        const int row0 = u.pm * BM + wr * 64 + fr, col0 = u.pn * BM + wc * 32 + 8 * fq;
        u32x4 gw[2][2][2], mw[2][2][2];
#define EPB_LOAD(BUF, Q) do { _Pragma("unroll") for (int mm = 0; mm < 2; ++mm) { const size_t off = (size_t)(row0 + ((Q) >> 1) * HALF + (2 * ((Q) & 1) + mm) * 16) * 1024 + col0; \
            _Pragma("unroll") for (int bj = 0; bj < 2; ++bj) { gw[BUF][mm][bj] = *(const GAS u32x4*)(GB + off + bj * HALF); if (!FIRST) mw[BUF][mm][bj] = *(const GAS u32x4*)(MBuf + off + bj * HALF); } } } while (0)
#define EPB_STORE(BUF, Q) do { _Pragma("unroll") for (int mm = 0; mm < 2; ++mm) { const int ai = (Q) >> 1, m = 2 * ((Q) & 1) + mm; const size_t off = (size_t)(row0 + ai * HALF + m * 16) * 1024 + col0; \
            _Pragma("unroll") for (int bj = 0; bj < 2; ++bj) { const f32x4 v0 = acc[ai][bj][m][0], v1 = acc[ai][bj][m][1]; const u32x4 g_ = gw[BUF][mm][bj]; \
                float o[8] = {bf_lo(g_.x) * v0[0], bf_hi(g_.x) * v0[1], bf_lo(g_.y) * v0[2], bf_hi(g_.y) * v0[3], bf_lo(g_.z) * v1[0], bf_hi(g_.z) * v1[1], bf_lo(g_.w) * v1[2], bf_hi(g_.w) * v1[3]}; \
                if (!FIRST) { const u32x4 m_ = mw[BUF][mm][bj]; \
                    o[0] += bf_lo(m_.x); o[1] += bf_hi(m_.x); o[2] += bf_lo(m_.y); o[3] += bf_hi(m_.y); o[4] += bf_lo(m_.z); o[5] += bf_hi(m_.z); o[6] += bf_lo(m_.w); o[7] += bf_hi(m_.w); } \
                u32x4 w; w.x = cvt_pk_bf16(o[0], o[1]); w.y = cvt_pk_bf16(o[2], o[3]); w.z = cvt_pk_bf16(o[4], o[5]); w.w = cvt_pk_bf16(o[6], o[7]); \
                *(GAS u32x4*)(MBuf + off + bj * HALF) = w; } } } while (0)
        EPB_LOAD(0, 0); EPB_LOAD(1, 1); EPB_STORE(0, 0); EPB_LOAD(0, 2); EPB_STORE(1, 1); EPB_LOAD(1, 3); EPB_STORE(0, 2); EPB_STORE(1, 3);
#undef EPB_LOAD
#undef EPB_STORE
    }
};
template <bool XB> struct EpiRes {
    static constexpr bool PERM = false, AFTER_DRAIN = false;
    const float* base; float* out; bf16_t* xb; float* ssq;
    __device__ __forceinline__ void operator()(const f32x4 (&acc)[2][2][4][2], const Unit& u, int wr, int wc, int fr, int fq) const {
        const int row0 = u.pm * BM + wr * 64 + fr, col0 = u.pn * BM + wc * 32 + 4 * fq;
        f32x4 bs[2][2][2][2];
#define EPR_LOAD(BUF, Q) do { _Pragma("unroll") for (int mm = 0; mm < 2; ++mm) { const size_t off = (size_t)(row0 + ((Q) >> 1) * HALF + (2 * ((Q) & 1) + mm) * 16) * 1024 + col0; \
            _Pragma("unroll") for (int bj = 0; bj < 2; ++bj) _Pragma("unroll") for (int n = 0; n < 2; ++n) bs[BUF][mm][bj][n] = *(const GAS f32x4*)(base + off + bj * HALF + n * 16); } } while (0)
#define EPR_STORE(BUF, Q) do { _Pragma("unroll") for (int mm = 0; mm < 2; ++mm) { const int ai = (Q) >> 1, m = 2 * ((Q) & 1) + mm; const int row = row0 + ai * HALF + m * 16; const size_t off = (size_t)row * 1024 + col0; float sq_ = 0.f; \
            _Pragma("unroll") for (int bj = 0; bj < 2; ++bj) _Pragma("unroll") for (int n = 0; n < 2; ++n) { const f32x4 v_ = bs[BUF][mm][bj][n] + acc[ai][bj][m][n]; *(GAS f32x4*)(out + off + bj * HALF + n * 16) = v_; \
                if (XB) { u32x2 w_; w_.x = cvt_pk_bf16(v_[0], v_[1]); w_.y = cvt_pk_bf16(v_[2], v_[3]); *(GAS u32x2*)(xb + off + bj * HALF + n * 16) = w_; sq_ += (v_[0] * v_[0] + v_[1] * v_[1]) + (v_[2] * v_[2] + v_[3] * v_[3]); } } \
            if (XB) { sq_ += __shfl_xor(sq_, 16); sq_ += __shfl_xor(sq_, 32); if (fq == 0) __hip_atomic_fetch_add((GAS unsigned long long*)ssq + row, (unsigned long long)(sq_ * 65536.0f + 0.5f), __ATOMIC_RELAXED, __HIP_MEMORY_SCOPE_AGENT); } } } while (0)
        EPR_LOAD(0, 0); EPR_LOAD(1, 1); EPR_STORE(0, 0); EPR_LOAD(0, 2); EPR_STORE(1, 1); EPR_LOAD(1, 3); EPR_STORE(0, 2); EPR_STORE(1, 3);
#undef EPR_LOAD
#undef EPR_STORE
    }
};
template <bool I8> __device__ __forceinline__ f32x4 mma_op(bf16x8 a, bf16x8 b, f32x4 c) {
    if constexpr (I8) return __builtin_bit_cast(f32x4, __builtin_amdgcn_mfma_i32_16x16x64_i8(__builtin_bit_cast(i32x4, a), __builtin_bit_cast(i32x4, b), __builtin_bit_cast(i32x4, c), 0, 0, 0));
    else return __builtin_amdgcn_mfma_f32_16x16x32_bf16(a, b, c, 0, 0, 0);
}
template <class Epi, class Sched, bool ALIGN_EPI = false, bool SP2 = false, bool I8 = false>
__device__ __forceinline__ void gemm_phase(PG8_LAS unsigned char* lds, const Gemm g, const Sched& S, const Epi& E, const int tid) {
    const int wid = __builtin_amdgcn_readfirstlane(tid >> 6), lane = tid & 63, wr = wid >> 2, wc = wid & 3, fr = lane & 15, fq = lane >> 4;
    const int K = g.K, nt = K / BK;
    unsigned voffA[2], voffB[2];
#pragma unroll
    for (int i = 0; i < 2; ++i) { int R, C; stage_rc(tid * 16 + i * 8192, R, C); const int Rb = Epi::PERM ? ((R & ~31) + perm32(R & 31)) : R;
        voffA[i] = (unsigned)(R * g.lda + C) * 2u; voffB[i] = (unsigned)(Rb * g.ldb + C) * 2u; }
    const size_t kstep = (size_t)(BK * 2);
    const size_t hstepA = (size_t)HALF * g.lda * 2, hstepB = (size_t)HALF * g.ldb * 2;
    const size_t tstepA = 2 * hstepA, tstepB = 2 * hstepB;
    const unsigned ldsw = (unsigned)wid * 1024u;
    const int aoff = lds_byte(wr * 64 + fr, fq * 8), boff = lds_byte(wc * 32 + fr, fq * 8);
#define PG8_SA(b, h) (((b) * 2 + (h)) * HTB)
#define PG8_SB(b, h) ((4 + (b) * 2 + (h)) * HTB)
#define PG8_STAGE(bufoff, gbase, voff) do { _Pragma("unroll") for (int _i = 0; _i < 2; ++_i) \
        __builtin_amdgcn_global_load_lds((const unsigned*)((const char*)(gbase) + (voff)[_i]), (PG8_LAS unsigned*)(lds + (bufoff) + ldsw + _i * 8192), 16, 0, 0); } while (0)
#define PG8_LDA(dst, b, h) do { _Pragma("unroll") for (int m = 0; m < 4; ++m) _Pragma("unroll") for (int k = 0; k < 2; ++k) dst[m][k] = *(const PG8_LAS bf16x8*)(lds + PG8_SA(b, h) + aoff + m * 2048 + k * 1024); } while (0)
#define PG8_LDB(dst, b, h) do { _Pragma("unroll") for (int n = 0; n < 2; ++n) _Pragma("unroll") for (int k = 0; k < 2; ++k) dst[n][k] = *(const PG8_LAS bf16x8*)(lds + PG8_SB(b, h) + boff + n * 2048 + k * 1024); } while (0)
#define PG8_MMA(ai, bj, At, Bt) do { __builtin_amdgcn_s_setprio(1); _Pragma("unroll") for (int m = 0; m < 4; ++m) _Pragma("unroll") for (int n = 0; n < 2; ++n) _Pragma("unroll") for (int k = 0; k < 2; ++k) \
        acc[ai][bj][m][n] = mma_op<I8>(Bt[n][k], At[m][k], acc[ai][bj][m][n]); __builtin_amdgcn_s_setprio(0); } while (0)
#define PG8_WAIT_V(n) asm volatile("s_waitcnt vmcnt(" #n ")" ::: "memory")
#define PG8_WAIT_L(n) asm volatile("s_waitcnt lgkmcnt(" #n ")" ::: "memory")
#define PG8_BAR __builtin_amdgcn_s_barrier()
#define PG8_SCHED __builtin_amdgcn_sched_barrier(0)
    Unit cur, nxt; int ui = 0;
    if (!S.next(0, cur)) return;
    f32x4 acc[2][2][4][2];
#pragma unroll
    for (int a = 0; a < 2; ++a)
#pragma unroll
        for (int b = 0; b < 2; ++b)
#pragma unroll
            for (int m = 0; m < 4; ++m)
#pragma unroll
                for (int n = 0; n < 2; ++n) acc[a][b][m][n] = (f32x4){0.f, 0.f, 0.f, 0.f};
    bf16x8 At[4][2], B0[2][2], B1[2][2];
    const char* cA = (const char*)g.A + (size_t)cur.pm * tstepA; const char* cB = (const char*)g.Bt + (size_t)cur.pn * tstepB;
    S.a_ready(cur);
    if constexpr (SP2) {
        PG8_STAGE(PG8_SB(0, 0), cB, voffB); PG8_STAGE(PG8_SB(0, 1), cB + hstepB, voffB); PG8_STAGE(PG8_SA(0, 0), cA, voffA); PG8_STAGE(PG8_SA(0, 1), cA + hstepA, voffA);
        if (wr == 1) PG8_BAR;
        PG8_WAIT_V(2); PG8_BAR;
        PG8_STAGE(PG8_SB(1, 0), cB + kstep, voffB); PG8_STAGE(PG8_SA(1, 0), cA + kstep, voffA); PG8_STAGE(PG8_SB(1, 1), cB + hstepB + kstep, voffB);
        PG8_WAIT_V(6); PG8_BAR;
    } else {
        PG8_STAGE(PG8_SB(0, 0), cB, voffB); PG8_STAGE(PG8_SA(0, 0), cA, voffA); PG8_STAGE(PG8_SB(0, 1), cB + hstepB, voffB); PG8_STAGE(PG8_SA(0, 1), cA + hstepA, voffA);
        if (wr == 1) PG8_BAR;
        PG8_WAIT_V(4); PG8_BAR;
        PG8_STAGE(PG8_SB(1, 0), cB + kstep, voffB); PG8_STAGE(PG8_SA(1, 0), cA + kstep, voffA); PG8_STAGE(PG8_SB(1, 1), cB + hstepB + kstep, voffB);
        PG8_WAIT_V(6); PG8_BAR;
    }
    for (;;) {
        const bool has_next = S.next(ui + 1, nxt);
        const char* nA = has_next ? (const char*)g.A + (size_t)nxt.pm * tstepA : cA; const char* nB = has_next ? (const char*)g.Bt + (size_t)nxt.pn * tstepB : cB;
        for (int t = 0; t < nt; t += 2) {
            const bool last = (t == nt - 2);
            const char* a1 = cA + (size_t)(t + 1) * kstep;
            const char* a2 = last ? nA : cA + (size_t)(t + 2) * kstep; const char* b2 = last ? nB : cB + (size_t)(t + 2) * kstep;
            const char* a3 = a2 + kstep; const char* b3 = b2 + kstep;
            if (last && has_next) S.a_ready(nxt);
            if constexpr (SP2) {
            PG8_LDB(B0, 0, 0); PG8_LDB(B1, 0, 1); PG8_SCHED; PG8_LDA(At, 0, 0); PG8_STAGE(PG8_SA(1, 1), a1 + hstepA, voffA);
            PG8_WAIT_V(8); PG8_WAIT_L(0); PG8_BAR; PG8_MMA(0, 0, At, B0); PG8_MMA(0, 1, At, B1); PG8_BAR; PG8_SCHED;
            PG8_LDA(At, 0, 1); PG8_STAGE(PG8_SB(0, 0), b2, voffB); PG8_STAGE(PG8_SB(0, 1), b2 + hstepB, voffB); PG8_STAGE(PG8_SA(0, 0), a2, voffA);
            PG8_WAIT_V(8); PG8_WAIT_L(0); PG8_BAR; PG8_MMA(1, 0, At, B0); PG8_MMA(1, 1, At, B1); PG8_BAR; PG8_SCHED;
            PG8_LDB(B0, 1, 0); PG8_LDB(B1, 1, 1); PG8_SCHED; PG8_LDA(At, 1, 0); PG8_STAGE(PG8_SA(0, 1), a2 + hstepA, voffA);
            PG8_WAIT_V(8); PG8_WAIT_L(0); PG8_BAR; PG8_MMA(0, 0, At, B0); PG8_MMA(0, 1, At, B1); PG8_BAR; PG8_SCHED;
            PG8_LDA(At, 1, 1); PG8_STAGE(PG8_SB(1, 0), b3, voffB); PG8_STAGE(PG8_SB(1, 1), b3 + hstepB, voffB); PG8_STAGE(PG8_SA(1, 0), a3, voffA);
            PG8_WAIT_V(8); PG8_WAIT_L(0); PG8_BAR; PG8_MMA(1, 0, At, B0); PG8_MMA(1, 1, At, B1); PG8_BAR; PG8_SCHED;
            } else {
            PG8_LDB(B0, 0, 0); PG8_SCHED; PG8_LDA(At, 0, 0); PG8_STAGE(PG8_SA(1, 1), a1 + hstepA, voffA);
            PG8_WAIT_L(8); PG8_BAR; PG8_WAIT_L(0); PG8_MMA(0, 0, At, B0); PG8_BAR; PG8_SCHED;
            PG8_LDB(B1, 0, 1); PG8_STAGE(PG8_SB(0, 0), b2, voffB);
            PG8_BAR; PG8_WAIT_L(0); PG8_MMA(0, 1, At, B1); PG8_BAR;
            PG8_LDA(At, 0, 1); PG8_STAGE(PG8_SA(0, 0), a2, voffA);
            PG8_BAR; PG8_WAIT_L(0); PG8_MMA(1, 0, At, B0); PG8_BAR; PG8_SCHED;
            PG8_STAGE(PG8_SB(0, 1), b2 + hstepB, voffB);
            PG8_WAIT_V(6); PG8_BAR; PG8_MMA(1, 1, At, B1); PG8_BAR;
            PG8_LDB(B0, 1, 0); PG8_SCHED; PG8_LDA(At, 1, 0); PG8_STAGE(PG8_SA(0, 1), a2 + hstepA, voffA);
            PG8_WAIT_L(8); PG8_BAR; PG8_WAIT_L(0); PG8_MMA(0, 0, At, B0); PG8_BAR; PG8_SCHED;
            PG8_LDB(B1, 1, 1); PG8_STAGE(PG8_SB(1, 0), b3, voffB);
            PG8_BAR; PG8_WAIT_L(0); PG8_MMA(0, 1, At, B1); PG8_BAR;
            PG8_LDA(At, 1, 1); PG8_STAGE(PG8_SA(1, 0), a3, voffA);
            PG8_BAR; PG8_WAIT_L(0); PG8_MMA(1, 0, At, B0); PG8_BAR; PG8_SCHED;
            PG8_STAGE(PG8_SB(1, 1), b3 + hstepB, voffB);
            PG8_WAIT_V(6); PG8_BAR; PG8_MMA(1, 1, At, B1); PG8_BAR;
            }
        }
        if constexpr (ALIGN_EPI) { if (wr == 0) PG8_BAR; }
        if constexpr (!Epi::AFTER_DRAIN) { E(acc, cur, wr, wc, fr, fq); S.done(cur); }
        if (!has_next) break;
#pragma unroll
        for (int a = 0; a < 2; ++a)
#pragma unroll
            for (int b = 0; b < 2; ++b)
#pragma unroll
                for (int m = 0; m < 4; ++m)
#pragma unroll
                    for (int n = 0; n < 2; ++n) acc[a][b][m][n] = (f32x4){0.f, 0.f, 0.f, 0.f};
        cur = nxt; cA = nA; cB = nB; ++ui;
        if constexpr (ALIGN_EPI) { if (wr == 1) PG8_BAR; }
    }
    PG8_WAIT_V(0);
    if constexpr (!ALIGN_EPI) { if (wr == 0) PG8_BAR; }
    PG8_BAR;
    if constexpr (Epi::AFTER_DRAIN) { E.fused(acc, cur, wr, wc, fr, fq, lds, wid, lane); S.done(cur); }
#undef PG8_SA
#undef PG8_SB
#undef PG8_STAGE
#undef PG8_LDA
#undef PG8_LDB
#undef PG8_MMA
#undef PG8_WAIT_V
#undef PG8_WAIT_L
#undef PG8_BAR
#undef PG8_SCHED
}
}
constexpr int NB = 4, T = 8192, D = 1024, M = NB * T, FF = 4096;
constexpr int NRW = 1792, NAT = 1536, NPL = 512, NA = NRW + NAT + NPL  , NG = 3072, NIN = NA + NG  , W = 512;
constexpr int NH = 8, HD = 64, MB_BLK = 256, NBLK = T / MB_BLK  ;
constexpr int NWAVES = 8;
typedef unsigned short bf16;
typedef unsigned v4u __attribute__((ext_vector_type(4)));
typedef unsigned v2u __attribute__((ext_vector_type(2)));
typedef float f32x4 __attribute__((ext_vector_type(4)));
#define LAS __attribute__((address_space(3)))
typedef GAS unsigned gu32;
#define RLX_AGENT __ATOMIC_RELAXED, __HIP_MEMORY_SCOPE_AGENT
#define LDS_WAIT() asm volatile("s_waitcnt lgkmcnt(0)" ::: "memory")
#define VM_WAIT() asm volatile("s_waitcnt vmcnt(0)" ::: "memory")
__device__ __forceinline__ unsigned f2bf(float f) { unsigned u = __builtin_bit_cast(unsigned, f); return (u + 0x7fffu + ((u >> 16) & 1u)) >> 16; }
typedef float f32x2_t __attribute__((ext_vector_type(2)));
typedef __bf16 bf16x2_t __attribute__((ext_vector_type(2)));
__device__ __forceinline__ unsigned pk2(float lo, float hi) { f32x2_t v = {lo, hi}; bf16x2_t b = __builtin_convertvector(v, bf16x2_t); return __builtin_bit_cast(unsigned, b); }
__device__ __forceinline__ float bf2f(unsigned b) { return __builtin_bit_cast(float, b << 16); }
__device__ __forceinline__ float bflo(unsigned w) { return __builtin_bit_cast(float, w << 16); }
__device__ __forceinline__ float bfhi(unsigned w) { return __builtin_bit_cast(float, w & 0xffff0000u); }
__device__ __forceinline__ float sigmoidf_(float x) { return 1.0f / (1.0f + __expf(-x)); }
__device__ __forceinline__ float fsig(float x) { return __builtin_amdgcn_rcpf(1.0f + __builtin_amdgcn_exp2f(-1.4426950408889634f * x)); }
__device__ __forceinline__ float ftanh(float x) { return 2.0f * fsig(2.0f * x) - 1.0f; }
__device__ __forceinline__ float wave_sum(float v) {
#pragma unroll
    for (int o = 1; o < 64; o <<= 1) v += __shfl_xor(v, o);
    return v;
}

constexpr size_t MiB = 1u << 20;
constexpr size_t WS_CTL = 0, CTL_ZERO_BYTES = 768 * 1024;
constexpr size_t WS_WIN = 1 * MiB, WS_WB = 15 * MiB, WS_WO = 18 * MiB, WS_W1 = 20 * MiB, WS_W2 = 28 * MiB, WS_KM = 36 * MiB, WS_LORA = 37 * MiB;
constexpr size_t WS_H = 40 * MiB, WS_RW = 104 * MiB, WS_AT = 216 * MiB, WS_PL = 312 * MiB  , WS_VT = 344 * MiB  ;
constexpr size_t WS_GF = 376 * MiB, WS_PST = 408 * MiB, WS_QST = 440 * MiB, WS_SST = 472 * MiB, WS_BON = 504 * MiB, WS_SB = 505 * MiB, WS_HB = 507 * MiB, WS_SCL = 511 * MiB  , WS_END = 511 * MiB + 512 * 1024;
constexpr size_t WS_GB = 376 * MiB, WS_MB = 440 * MiB, WS_HID = 104 * MiB;
constexpr int SC_SA = 0  , SC_SB = 2 * 32768  ;
constexpr int CW_BAR = 4096, CW_Q = 8192, CW_S3F = 10240  , CW_S3Q = 11264  , CW_SA = 196608  , CW_SB = 229376  , CW_SSQ = 65536  ;
constexpr int RING_OFF = 0, RING_BYTES = 131072;
constexpr int LDS_BYTES = 153600, LDSCTL_OFF = LDS_BYTES - 1024, MISC_OFF = LDSCTL_OFF + 320;
#define XB_TMO      128
#define XB_XCNT(j)  (256  + 64 * (j))
#define XB_XSUB(j)  (1280 + 64 * (j))
#define XB_XGEN(j)  (2304 + 64 * (j))
#define XB_TOP      3328
#define XB_TOPGEN   3392
#define XCD_BAR_WORDS 3456
#define XB_SPIN_CAP (1u << 18)
__device__ __forceinline__ unsigned xb_ld(unsigned* p)              { return __hip_atomic_load(p, __ATOMIC_RELAXED, __HIP_MEMORY_SCOPE_AGENT); }
__device__ __forceinline__ unsigned xb_add(unsigned* p, unsigned v) { return __hip_atomic_fetch_add(p, v, __ATOMIC_RELAXED, __HIP_MEMORY_SCOPE_AGENT); }
__device__ __forceinline__ unsigned xb_xcc_id() { return (unsigned)__builtin_amdgcn_s_getreg((3 << 11) | 20) & 0xFu; }
#define XB_SPIN(cond, bar) do { unsigned _sp = 0; while (cond) { __builtin_amdgcn_s_sleep(1); \
    if ((++_sp & 255u) == 0u) { if (xb_ld(&(bar)[XB_TMO])) break; if (_sp > XB_SPIN_CAP) { atomicAdd(&(bar)[XB_TMO], 1u); break; } } } } while (0)
struct XcdBarrier { unsigned* bar; unsigned x; volatile LAS unsigned* st; };
__device__ __forceinline__ XcdBarrier xcd_barrier_post(unsigned* bar, volatile LAS unsigned* st) {
    XcdBarrier b; b.bar = bar; b.x = xb_xcc_id(); b.st = st;
    if (threadIdx.x == 0) (void)xb_add(&bar[XB_XCNT(b.x)], 1u);
    return b;
}
__device__ __forceinline__ void xcd_barrier_complete(unsigned* bar, unsigned x, unsigned& nloc, unsigned& nx) {
    const unsigned G = gridDim.x * gridDim.y * gridDim.z;
    unsigned sum, cnt, mine, sp = 0u;
    for (;;) {
        sum = 0u; cnt = 0u; mine = 0u;
#pragma unroll
        for (unsigned j = 0; j < 16; ++j) { const unsigned c = xb_ld(&bar[XB_XCNT(j)]); sum += c; cnt += (c > 0u) ? 1u : 0u; mine = (j == x) ? c : mine; }
        if (sum == G) break;
        __builtin_amdgcn_s_sleep(1);
        if ((++sp & 255u) == 0u) { if (xb_ld(&bar[XB_TMO])) break; if (sp > XB_SPIN_CAP) { atomicAdd(&bar[XB_TMO], 1u); break; } }
    }
    nloc = mine > 0u ? mine : 1u; nx = cnt > 0u ? cnt : 1u;
}
__device__ __forceinline__ void xcd_barrier(const XcdBarrier& b, const bool t0) {
    asm volatile("s_waitcnt vmcnt(0)" ::: "memory");
    __syncthreads();
    if (t0) {
        unsigned* bar = b.bar;
        __builtin_amdgcn_s_waitcnt(0);
        unsigned nloc = b.st[0], nx = b.st[1];
        if (nloc == 0u) { xcd_barrier_complete(bar, b.x, nloc, nx); b.st[0] = nloc; b.st[1] = nx; }
        const unsigned old = xb_add(&bar[XB_XSUB(b.x)], 1u);
        const unsigned gen = old / nloc;
        if (old + 1u == (gen + 1u) * nloc) {
            __builtin_amdgcn_fence(__ATOMIC_RELEASE, "agent");
            asm volatile("s_waitcnt vmcnt(0)" ::: "memory");
            const unsigned og = xb_add(&bar[XB_TOP], 1u);
            const unsigned tg = og / nx;
            if (og + 1u == (tg + 1u) * nx) xb_add(&bar[XB_TOPGEN], 1u);
            else XB_SPIN(xb_ld(&bar[XB_TOPGEN]) == tg, bar);
            __builtin_amdgcn_fence(__ATOMIC_ACQUIRE, "agent");
            xb_add(&bar[XB_XGEN(b.x)], 1u);
            asm volatile("s_waitcnt vmcnt(0)" ::: "memory");
        } else {
            XB_SPIN(xb_ld(&bar[XB_XGEN(b.x)]) == gen, bar);
            __builtin_amdgcn_fence(__ATOMIC_ACQUIRE, "agent");
            asm volatile("s_waitcnt vmcnt(0)" ::: "memory");
        }
    }
    __syncthreads();
}

struct Args { const float* in[23]; float* out; unsigned char* ws; int ph_lo, ph_hi, l_lo, l_hi, fused, probe_upto, probe_dup, pad; };
enum Phase { PH_CONV = 0, PH_GEMMA, PH_MIX1, PH_MIX2, PH_S3, PH_GB, PH_GO, PH_NORM2, PH_FF1, PH_FF2, PH_N };
enum In { I_X = 0, I_N1G, I_WIN, I_MU, I_W0, I_WUP, I_A0, I_AUP, I_GUP, I_KK, I_KA, I_RK, I_LNG, I_LNB, I_QNG, I_KNG, I_POOLW, I_POOLS, I_WBR, I_WOUT, I_N2G, I_FF1, I_FF2 };

__device__ __forceinline__ void p0_transpose_item(const float* Wm, int K, int N, bf16* WT, LAS float* scr, int item, int lane, const float* ksc = nullptr) {
    const int nblk = N / 32, kb = item / nblk, nb = item % nblk, k0 = 64 * kb, n0 = 32 * nb;
#pragma unroll 8
    for (int i = 0; i < 32; ++i) { const int kk = 2 * i + (lane >> 5); float v_ = ((const GAS float*)Wm)[(size_t)(k0 + kk) * N + n0 + (lane & 31)]; if (ksc != nullptr) v_ *= ((const GAS float*)ksc)[k0 + kk]; scr[kk * 33 + (lane & 31)] = v_; }
    LDS_WAIT(); asm volatile("" ::: "memory");
    const int c = lane & 7;
#pragma unroll
    for (int j = 0; j < 4; ++j) { const int n = (lane >> 3) + 8 * j; const LAS float* s = scr + (8 * c) * 33 + n;
        v4u o; o.x = pk2(s[0 * 33], s[1 * 33]); o.y = pk2(s[2 * 33], s[3 * 33]); o.z = pk2(s[4 * 33], s[5 * 33]); o.w = pk2(s[6 * 33], s[7 * 33]);
        *(GAS v4u*)(WT + (size_t)(n0 + n) * K + k0 + 8 * c) = o; }
    LDS_WAIT(); asm volatile("" ::: "memory");
}
__device__ __forceinline__ void rms_rows(const float* x, const float* g, bf16* out, int gw, int NGW, int lane) {
    f32x4 gv[4];
#pragma unroll
    for (int j = 0; j < 4; ++j) gv[j] = ((const GAS f32x4*)g)[lane + 64 * j];
    for (int m0 = gw; m0 < M; m0 += 4 * NGW) {
        f32x4 v[4][4];
#pragma unroll
        for (int rr = 0; rr < 4; ++rr) { const int m = m0 + rr * NGW; if (m < M) { const GAS f32x4* xr = (const GAS f32x4*)(x + (size_t)m * D) + lane;
#pragma unroll
            for (int j = 0; j < 4; ++j) v[rr][j] = xr[64 * j]; } }
#pragma unroll
        for (int rr = 0; rr < 4; ++rr) { const int m = m0 + rr * NGW; if (m < M) {
            float s_ = 0.f;
#pragma unroll
            for (int j = 0; j < 4; ++j) s_ += (v[rr][j].x * v[rr][j].x + v[rr][j].y * v[rr][j].y) + (v[rr][j].z * v[rr][j].z + v[rr][j].w * v[rr][j].w);
            const float rstd = __builtin_amdgcn_rsqf(wave_sum(s_) * (1.0f / D) + 1e-6f);
            GAS unsigned long long* o8 = (GAS unsigned long long*)(out + (size_t)m * D) + lane;
#pragma unroll
            for (int j = 0; j < 4; ++j) { const f32x4 y = v[rr][j] * rstd * gv[j]; o8[64 * j] = (unsigned long long)pk2(y.x, y.y) | ((unsigned long long)pk2(y.z, y.w) << 32); } } }
    }
}

__device__ __forceinline__ unsigned pack4_i8(float a, float b, float c, float d) {
    return ((unsigned)(int)a & 0xffu) | (((unsigned)(int)b & 0xffu) << 8) | (((unsigned)(int)c & 0xffu) << 16) | (((unsigned)(int)d & 0xffu) << 24);
}
__device__ __forceinline__ void h8_rows(const bf16* h, unsigned char* h8, float* sA, int gw, int NGW, int lane, const int pitch8 = D) {
    for (int m0 = gw; m0 < M; m0 += 4 * NGW) {
        v4u v[4][2];
#pragma unroll
        for (int rr = 0; rr < 4; ++rr) { const int m = m0 + rr * NGW; if (m < M) { const GAS v4u* hr = (const GAS v4u*)(h + (size_t)m * D) + 2 * lane; v[rr][0] = hr[0]; v[rr][1] = hr[1]; } }
#pragma unroll
        for (int rr = 0; rr < 4; ++rr) { const int m = m0 + rr * NGW; if (m < M) {
            float f[16];
#pragma unroll
            for (int hq = 0; hq < 2; ++hq) { const v4u w_ = v[rr][hq]; f[8 * hq + 0] = bflo(w_.x); f[8 * hq + 1] = bfhi(w_.x); f[8 * hq + 2] = bflo(w_.y); f[8 * hq + 3] = bfhi(w_.y); f[8 * hq + 4] = bflo(w_.z); f[8 * hq + 5] = bfhi(w_.z); f[8 * hq + 6] = bflo(w_.w); f[8 * hq + 7] = bfhi(w_.w); }
            float mx = 0.f;
#pragma unroll
            for (int e = 0; e < 16; ++e) mx = fmaxf(mx, fabsf(f[e]));
#pragma unroll
            for (int o_ = 1; o_ < 64; o_ <<= 1) mx = fmaxf(mx, __shfl_xor(mx, o_));
            mx = fmaxf(mx, 1e-30f);
            const float inv = 127.0f * __builtin_amdgcn_rcpf(mx);
            if (lane == 0) ((GAS float*)sA)[m] = mx * (1.0f / 127.0f);
#pragma unroll
            for (int e = 0; e < 16; ++e) f[e] = fminf(fmaxf(rintf(f[e] * inv), -127.0f), 127.0f);
            v4u w; w.x = pack4_i8(f[0], f[1], f[2], f[3]); w.y = pack4_i8(f[4], f[5], f[6], f[7]); w.z = pack4_i8(f[8], f[9], f[10], f[11]); w.w = pack4_i8(f[12], f[13], f[14], f[15]);
            *((GAS v4u*)(h8 + (size_t)m * pitch8) + lane) = w; } }
    }
}
template <int NC>
__device__ __forceinline__ void gate_cols_i8(const float* Wm, const int col0, unsigned char* W8, float* sB, LAS unsigned char* lds, const int tid) {
    constexpr int RO = 64 / NC, NR = 128 / RO, BL = 2 * NC, P = 128 / BL;
    const int lane = tid & 63, wave = tid >> 6, c = lane & (NC - 1), ro = lane / NC;
    LAS float* red = (LAS float*)lds;
    LAS unsigned char* tb = lds + 1024 + wave * (16 * 144);
    const GAS float* src = (const GAS float*)Wm + (size_t)(128 * wave + ro) * NIN + NA + col0 + c;
    float v[NR];
#pragma unroll
    for (int hh = 0; hh < NR / 16; ++hh) {
#pragma unroll
        for (int i = 0; i < 16; ++i) v[16 * hh + i] = src[(size_t)(RO * (16 * hh + i)) * NIN];
        __builtin_amdgcn_sched_barrier(0);
    }
    float mx = 0.f;
#pragma unroll
    for (int i = 0; i < NR; ++i) mx = fmaxf(mx, fabsf(v[i]));
#pragma unroll
    for (int o_ = NC; o_ < 64; o_ <<= 1) mx = fmaxf(mx, __shfl_xor(mx, o_));
    __syncthreads();
    if (lane < NC) red[wave * 16 + c] = mx;
    __syncthreads();
    float mc = 0.f;
#pragma unroll
    for (int w = 0; w < 8; ++w) mc = fmaxf(mc, red[w * 16 + c]);
    mc = fmaxf(mc, 1e-30f);
    const float inv = 127.0f * __builtin_amdgcn_rcpf(mc);
    if (tid < NC) ((GAS float*)sB)[col0 + c] = mc * (1.0f / 127.0f);
#pragma unroll
    for (int i = 0; i < NR; ++i) { const float q = fminf(fmaxf(rintf(v[i] * inv), -127.0f), 127.0f); *(LAS unsigned char*)(tb + c * 144 + RO * i + ro) = (unsigned char)((int)q & 0xff); }
    asm volatile("s_waitcnt lgkmcnt(0)" ::: "memory");
    { const int cc = lane / P, part = lane % P;
      GAS v4u* dst = (GAS v4u*)(W8 + (size_t)(col0 + cc) * D + 128 * wave + BL * part);
      dst[0] = *(const LAS v4u*)(tb + cc * 144 + BL * part);
      if constexpr (BL == 32) dst[1] = *(const LAS v4u*)(tb + cc * 144 + BL * part + 16); }
}
__device__ __forceinline__ void ph_attn_prep(LAS unsigned char* lds, bf16* AT, bf16* VT, const float* qg, const float* kg, float* KM, int G, const int tid) {
    LAS float* red = (LAS float*)lds;
    LAS unsigned char* vt = lds + 2048;
    const int lane = tid & 63, wave = tid >> 6, tsub = lane >> 3, dq = lane & 7;
    float gq[8], gk[8];
#pragma unroll
    for (int e = 0; e < 8; ++e) { gq[e] = ((const GAS float*)qg)[dq * 8 + e] * (0.125f * 1.4426950408889634f); gk[e] = ((const GAS float*)kg)[dq * 8 + e]; }
    const int w_ = (int)blockIdx.x, bid0 = (G == 256) ? (((w_ >> 6) * 8 + (w_ & 7)) * 8 + ((w_ >> 3) & 7)) : w_, bstep = (G == 256) ? 32 * 8 : G;
    for (int bid = bid0; bid < NB * NBLK * NH; bid += bstep) {
        const int h = bid & 7, n = (bid >> 3) & 31, b = bid >> 8;
        v4u qv[4], kv[4], vv[4];
#pragma unroll
        for (int j = 0; j < 4; ++j) { const size_t row = (size_t)b * T + n * 256 + wave * 32 + 8 * j + tsub; const bf16* qp = AT + row * NAT + h * 64 + dq * 8;
            qv[j] = *(const GAS v4u*)qp; kv[j] = *(const GAS v4u*)(qp + 512); vv[j] = *(const GAS v4u*)(qp + 1024); }
        float ksum[8];
#pragma unroll
        for (int e = 0; e < 8; ++e) ksum[e] = 0.f;
#pragma unroll
        for (int j = 0; j < 4; ++j) {
            const int tok = wave * 32 + 8 * j + tsub; const size_t row = (size_t)b * T + n * 256 + tok; bf16* qp = AT + row * NAT + h * 64 + dq * 8;
            float q[8], k[8];
            q[0] = bflo(qv[j].x); q[1] = bfhi(qv[j].x); q[2] = bflo(qv[j].y); q[3] = bfhi(qv[j].y); q[4] = bflo(qv[j].z); q[5] = bfhi(qv[j].z); q[6] = bflo(qv[j].w); q[7] = bfhi(qv[j].w);
            k[0] = bflo(kv[j].x); k[1] = bfhi(kv[j].x); k[2] = bflo(kv[j].y); k[3] = bfhi(kv[j].y); k[4] = bflo(kv[j].z); k[5] = bfhi(kv[j].z); k[6] = bflo(kv[j].w); k[7] = bfhi(kv[j].w);
            float qs = 0.f, ks = 0.f;
#pragma unroll
            for (int e = 0; e < 8; ++e) { qs += q[e] * q[e]; ks += k[e] * k[e]; }
            qs += __shfl_xor(qs, 1); qs += __shfl_xor(qs, 2); qs += __shfl_xor(qs, 4);
            ks += __shfl_xor(ks, 1); ks += __shfl_xor(ks, 2); ks += __shfl_xor(ks, 4);
            const float rq = __builtin_amdgcn_rsqf(qs * (1.0f / 64.0f) + 1e-6f), rk = __builtin_amdgcn_rsqf(ks * (1.0f / 64.0f) + 1e-6f);
#pragma unroll
            for (int e = 0; e < 8; ++e) { q[e] = q[e] * rq * gq[e]; k[e] = k[e] * rk * gk[e]; ksum[e] += k[e]; }
            v4u w; w.x = pk2(q[0], q[1]); w.y = pk2(q[2], q[3]); w.z = pk2(q[4], q[5]); w.w = pk2(q[6], q[7]); *(GAS v4u*)qp = w;
            w.x = pk2(k[0], k[1]); w.y = pk2(k[2], k[3]); w.z = pk2(k[4], k[5]); w.w = pk2(k[6], k[7]); *(GAS v4u*)(qp + 512) = w;
            const unsigned vw[4] = {vv[j].x, vv[j].y, vv[j].z, vv[j].w};
#pragma unroll
            for (int e = 0; e < 8; ++e) *(LAS bf16*)(vt + (dq * 8 + e) * 520 + tok * 2) = (bf16)((e & 1) ? (vw[e >> 1] >> 16) : (vw[e >> 1] & 0xffffu));
        }
#pragma unroll
        for (int e = 0; e < 8; ++e) { float s_ = ksum[e]; s_ += __shfl_xor(s_, 8); s_ += __shfl_xor(s_, 16); s_ += __shfl_xor(s_, 32); if (tsub == 0) red[wave * 64 + dq * 8 + e] = s_; }
        __syncthreads();
        if (wave == 0) { float s_ = 0.f; for (int w = 0; w < 8; ++w) s_ += red[w * 64 + lane]; ((GAS float*)KM)[(((size_t)b * NH + h) * NBLK + n) * 64 + lane] = s_ * (1.0f / 256.0f); }
#pragma unroll
        for (int j = 0; j < 4; ++j) { const int c = tid + 512 * j, dim = c >> 5, part = c & 31;
            const v2u lo = *(const LAS v2u*)(vt + dim * 520 + part * 16), hi = *(const LAS v2u*)(vt + dim * 520 + part * 16 + 8);
            v4u w; w.x = lo.x; w.y = lo.y; w.z = hi.x; w.w = hi.y;
            *(GAS v4u*)(VT + (((size_t)(b * NH + h) * (T / 32) + n * 8 + (part >> 2)) * 64 + dim) * 32 + (part & 3) * 8) = w; }
        __syncthreads();
    }
}
__device__ __forceinline__ void ph_pool(bf16* PL_, const bf16* HB_, int G, const int tid) {
    GAS bf16* PL = (GAS bf16*)PL_; const GAS bf16* HB = (const GAS bf16*)HB_;
    const int ch = tid, wdw = 2 << (ch >> 7);
    for (int u = blockIdx.x; u < M / 128; u += G) {
        float ring[16];
        const int tb0 = (u * 128) & (T - 1);
#pragma unroll
        for (int k = 0; k < 16; ++k) ring[k] = 0.f;
        unsigned short hv[15], cu[16], nx[16];
        if (tb0 > 0) {
#pragma unroll
            for (int j = 0; j < 15; ++j) hv[j] = HB[((size_t)(u - 1) * 15 + j) * 512 + ch];
        }
#pragma unroll
        for (int tt = 0; tt < 16; ++tt) cu[tt] = PL[((size_t)u * 128 + tt) * NPL + ch];
        if (tb0 > 0) {
#pragma unroll
            for (int j = 0; j < 15; ++j) ring[1 + j] = bf2f(hv[j]);
        }
#pragma unroll
        for (int t0 = 0; t0 < 128; t0 += 16) {
            if (t0 + 16 < 128) {
#pragma unroll
                for (int tt = 0; tt < 16; ++tt) nx[tt] = PL[((size_t)u * 128 + t0 + 16 + tt) * NPL + ch];
            }
#pragma unroll
            for (int tt = 0; tt < 16; ++tt) {
                const float cur = bf2f(cu[tt]);
                ring[tt] = cur;
                float sm = 0.f;
#pragma unroll
                for (int i = 0; i < 16; ++i) sm += (i < wdw) ? ring[(tt - i) & 15] : 0.f;
                const int tpos = tb0 + t0 + tt; const int cnt = (tpos + 1 < wdw) ? (tpos + 1) : wdw;
                PL[((size_t)u * 128 + t0 + tt) * NPL + ch] = (bf16)f2bf(sm * __builtin_amdgcn_rcpf((float)cnt) - cur);
            }
#pragma unroll
            for (int tt = 0; tt < 16; ++tt) cu[tt] = nx[tt];
        }
    }
}
namespace rw {
typedef short bf16x8 __attribute__((ext_vector_type(8)));
constexpr int MATB = 64 * 144;
constexpr int FPB = 64 * 272;
constexpr int X0 = 0, ACTW = X0, ACTA = X0 + MATB, ACTG = X0 + 2 * MATB  , AAB = X0, AAK = X0 + MATB, ARB = X0 + 2 * MATB, ARK = X0 + 3 * MATB;
constexpr int Y0 = 4 * MATB, LWP = Y0, AIP = Y0 + FPB, LGO = AIP, TOT = Y0 + 2 * FPB  , GCV = TOT + 2048  , DG = Y0  , TI = Y0 + 4096  , U0T = Y0 + 8192;
constexpr int PTAB = GCV + 256  ;
constexpr int Z0 = Y0 + 2 * FPB + 2048 + 256 + 3072, AT_ = Z0, BT_ = Z0 + MATB, KT_ = Z0 + 2 * MATB, RT_ = Z0 + 3 * MATB, ATT = Z0 + 4 * MATB, BHT = Z0 + 5 * MATB, KHT = Z0 + 6 * MATB, VTT = Z0 + 7 * MATB;
constexpr int S1_LDS = Z0 + 8 * MATB;
static_assert(S1_LDS <= 153600 - 1024, "S1 LDS map below the control words");
static_assert(U0T + MATB <= TOT, "U0T inside the dead f32 region");
__device__ __forceinline__ f32x4 mma(bf16x8 a, bf16x8 b, f32x4 c) { return __builtin_amdgcn_mfma_f32_16x16x32_bf16(a, b, c, 0, 0, 0); }
__device__ __forceinline__ bf16x8 ldf(const LAS unsigned char* mat, int row, int s, int g) { return *(const LAS bf16x8*)(mat + row * 144 + s * 64 + g * 16); }
__device__ __forceinline__ v2u pack4(f32x4 v) { v2u w; w.x = pk2(v[0], v[1]); w.y = pk2(v[2], v[3]); return w; }
__device__ __forceinline__ f32x4 unpack4(v2u w) { return (f32x4){bflo(w.x), bfhi(w.x), bflo(w.y), bfhi(w.y)}; }
__device__ __forceinline__ void unpack8(v4u w, float* o) { o[0] = bflo(w.x); o[1] = bfhi(w.x); o[2] = bflo(w.y); o[3] = bfhi(w.y); o[4] = bflo(w.z); o[5] = bfhi(w.z); o[6] = bflo(w.w); o[7] = bfhi(w.w); }
__device__ __forceinline__ v4u pack8(const float* o) { v4u w; w.x = pk2(o[0], o[1]); w.y = pk2(o[2], o[3]); w.z = pk2(o[4], o[5]); w.w = pk2(o[6], o[7]); return w; }
#define LDS_BAR() do { asm volatile("s_waitcnt lgkmcnt(0)" ::: "memory"); __builtin_amdgcn_s_barrier(); asm volatile("" ::: "memory"); } while (0)
#define RW_BAR() do { asm volatile("s_waitcnt vmcnt(0) lgkmcnt(0)" ::: "memory"); __builtin_amdgcn_s_barrier(); asm volatile("" ::: "memory"); } while (0)

struct S1Args {
    bf16* RW; const bf16* SB;
    const float *mu, *w0, *a0, *k_k, *k_a, *r_k;
    const bf16 *WupT, *AupT, *GupT;
    bf16 *Gf, *Pst, *Qst; float* bonus;
    bf16 *Rh, *O0; int ldo;
    bf16* Vm; int ldv;
};
__device__ __forceinline__ void s1_unit(LAS unsigned char* lds, const S1Args& A, const int unit, const int tid, int& hprev, const bool dummy = false) {
    const int lane = tid & 63, wave = __builtin_amdgcn_readfirstlane(tid >> 6), r = lane & 15, g = lane >> 4;
    const int h = unit & 7, cidx = unit >> 3  , c_in_b = cidx & 127;
    const size_t row0 = (size_t)cidx * 64;
    const int t = tid >> 3, q = tid & 7;
    float rp[8], kp[8], lwv[8], av[8], kk[8], vp[8];
    if (h != hprev) {
        LAS float* pt = (LAS float*)(lds + PTAB);
        for (int i = tid; i < 768; i += 512) {
            float v_;
            if (i < 192) v_ = ((const GAS float*)A.mu)[(i >> 6) * 512 + h * 64 + (i & 63)];
            else if (i < 448) v_ = ((const GAS float*)A.mu)[1536 + (i - 192)];
            else { const int j = i - 448, c_ = h * 64 + (j & 63); const int w_ = j >> 6; const float* pp_ = (w_ == 0) ? A.w0 : (w_ == 1) ? A.a0 : (w_ == 2) ? A.k_k : (w_ == 3) ? A.k_a : A.r_k; v_ = ((const GAS float*)pp_)[c_]; }
            pt[i] = v_;
        }
        hprev = h;
        LDS_BAR();
    }
    const LAS float* PT = (const LAS float*)(lds + PTAB);
    bf16x8 fw[2], fa[2], fg[4];
    {
        const int cb = wave >> 1;
        const bf16* wu = A.WupT + (size_t)(h * 64 + 16 * cb + r) * 64 + 8 * g;
        const bf16* au = A.AupT + (size_t)(h * 64 + 16 * cb + r) * 64 + 8 * g;
        const bf16* gu = A.GupT + (size_t)(h * 64 + 16 * cb + r) * 128 + 8 * g;
#pragma unroll
        for (int s = 0; s < 2; ++s) { fw[s] = *(const GAS bf16x8*)(wu + 32 * s); fa[s] = *(const GAS bf16x8*)(au + 32 * s); }
#pragma unroll
        for (int s = 0; s < 4; ++s) fg[s] = *(const GAS bf16x8*)(gu + 32 * s);
    }
    {
        const bf16* cur = A.RW + (row0 + t) * NRW;
        const bool hasprev = (t > 0) || (c_in_b > 0);
        const bf16* prv = (t > 0) ? (cur - NRW) : (hasprev ? A.SB + (size_t)(cidx - 1) * NRW : cur);
        v4u cw[7], pw[7];
#define S1COL(J) ((J) == 0 ? h * 64 + 8 * q : (J) == 1 ? 512 + h * 64 + 8 * q : (J) == 2 ? 1024 + h * 64 + 8 * q : (J) == 3 ? 1536 + 8 * q : (J) == 4 ? 1600 + 8 * q : (J) == 5 ? 1664 + 16 * q : 1664 + 16 * q + 8)
#pragma unroll
        for (int j = 0; j < 7; ++j) { cw[j] = *(const GAS v4u*)(cur + S1COL(j)); pw[j] = *(const GAS v4u*)(prv + S1COL(j)); }
#undef S1COL
        float c8[8], p8[8];
#define MIXLOAD(J, MUO, DST) do { unpack8(cw[J], c8); unpack8(pw[J], p8); \
            _Pragma("unroll") for (int e = 0; e < 8; ++e) { const float pv_ = hasprev ? p8[e] : 0.f; DST[e] = c8[e] + (pv_ - c8[e]) * PT[(MUO) + e]; } } while (0)
        MIXLOAD(0, 8 * q, rp); MIXLOAD(1, 64 + 8 * q, kp); MIXLOAD(2, 128 + 8 * q, vp);
#pragma unroll
        for (int e = 0; e < 8; ++e) *(LAS bf16*)(lds + VTT + (8 * q + e) * 144 + t * 2) = (bf16)f2bf(vp[e]);
        float x8[8];
        MIXLOAD(3, 192 + 8 * q, x8);
#pragma unroll
        for (int e = 0; e < 8; ++e) x8[e] = ftanh(x8[e]);
        *(LAS v4u*)(lds + ACTW + t * 144 + q * 16) = pack8(x8);
        MIXLOAD(4, 256 + 8 * q, x8);
        *(LAS v4u*)(lds + ACTA + t * 144 + q * 16) = pack8(x8);
        MIXLOAD(5, 320 + 16 * q, x8);
#pragma unroll
        for (int e = 0; e < 8; ++e) x8[e] = fsig(x8[e]);
        *(LAS v4u*)(lds + ACTG + t * 272 + q * 32) = pack8(x8);
        MIXLOAD(6, 320 + 16 * q + 8, x8);
#pragma unroll
        for (int e = 0; e < 8; ++e) x8[e] = fsig(x8[e]);
        *(LAS v4u*)(lds + ACTG + t * 272 + q * 32 + 16) = pack8(x8);
#undef MIXLOAD
    }
    LDS_BAR();
    if (!dummy) *(GAS v4u*)(A.Vm + (row0 + t) * A.ldv + h * 64 + 8 * q) = pack8(vp);
    {
        const int cb = wave >> 1;
#pragma unroll
        for (int i = 0; i < 2; ++i) {
            const int tb = 2 * (wave & 1) + i;
            f32x4 cw = {0.f, 0.f, 0.f, 0.f}, ca = {0.f, 0.f, 0.f, 0.f}, cg = {0.f, 0.f, 0.f, 0.f};
#pragma unroll
            for (int s = 0; s < 2; ++s) { cw = mma(fw[s], ldf(lds + ACTW, 16 * tb + r, s, g), cw); ca = mma(fa[s], ldf(lds + ACTA, 16 * tb + r, s, g), ca); }
#pragma unroll
            for (int s = 0; s < 4; ++s) cg = mma(fg[s], *(const LAS bf16x8*)(lds + ACTG + (16 * tb + r) * 272 + s * 64 + g * 16), cg);
            *(LAS f32x4*)(lds + LWP + (16 * tb + r) * 272 + (16 * cb + 4 * g) * 4) = cw;
            *(LAS f32x4*)(lds + AIP + (16 * tb + r) * 272 + (16 * cb + 4 * g) * 4) = ca;
            if (!dummy) *(GAS v2u*)(A.Gf + (row0 + 16 * tb + r) * W + h * 64 + 16 * cb + 4 * g) = pack4(cg);
        }
    }
    LDS_BAR();
    {
        const f32x4 l0 = *(const LAS f32x4*)(lds + LWP + t * 272 + q * 32), l1 = *(const LAS f32x4*)(lds + LWP + t * 272 + q * 32 + 16);
        const f32x4 a0v = *(const LAS f32x4*)(lds + AIP + t * 272 + q * 32), a1v = *(const LAS f32x4*)(lds + AIP + t * 272 + q * 32 + 16);
        float ss = 0.f, bon = 0.f;
#pragma unroll
        for (int e = 0; e < 8; ++e) { const int hc = 8 * q + e;
            const float lp = (e < 4) ? l0[e & 3] : l1[e & 3], ap = (e < 4) ? a0v[e & 3] : a1v[e & 3];
            lwv[e] = -0.60653065971263342f * fsig(PT[448 + hc] + lp);
            av[e] = fsig(PT[512 + hc] + ap);
            kk[e] = kp[e] * PT[576 + hc]; ss += kk[e] * kk[e];
            kp[e] = kp[e] * (1.0f + (av[e] - 1.0f) * PT[640 + hc]);
            bon += rp[e] * kp[e] * PT[704 + hc]; }
        ss += __shfl_xor(ss, 1); ss += __shfl_xor(ss, 2); ss += __shfl_xor(ss, 4);
        bon += __shfl_xor(bon, 1); bon += __shfl_xor(bon, 2); bon += __shfl_xor(bon, 4);
        const float inv = __builtin_amdgcn_rsqf(fmaxf(ss, 1e-24f));
#pragma unroll
        for (int e = 0; e < 8; ++e) kk[e] *= inv;
        if (q == 0 && !dummy) ((GAS float*)A.bonus)[(row0 + t) * 8 + h] = bon;
        *(LAS f32x4*)(lds + LWP + t * 272 + q * 32) = (f32x4){lwv[0], lwv[1], lwv[2], lwv[3]};
        *(LAS f32x4*)(lds + LWP + t * 272 + q * 32 + 16) = (f32x4){lwv[4], lwv[5], lwv[6], lwv[7]};
    }
    LDS_BAR();
    {
        const int c = tid & 63, seg = tid >> 6; float x[8]; float run = 0.f;
#pragma unroll
        for (int i = 0; i < 8; ++i) { run += *(const LAS float*)(lds + LWP + (8 * seg + i) * 272 + c * 4); x[i] = run; }
        *(LAS float*)(lds + TOT + (seg * 64 + c) * 4) = run;
        LDS_BAR();
        float off = 0.f;
        for (int s2 = 0; s2 < seg; ++s2) off += *(const LAS float*)(lds + TOT + (s2 * 64 + c) * 4);
#pragma unroll
        for (int i = 0; i < 8; ++i) *(LAS float*)(lds + LGO + (8 * seg + i) * 272 + c * 4) = x[i] + off;
    }
    LDS_BAR();
    {
        const f32x4 g0 = *(const LAS f32x4*)(lds + LGO + t * 272 + q * 32), g1 = *(const LAS f32x4*)(lds + LGO + t * 272 + q * 32 + 16);
        const f32x4 e0 = *(const LAS f32x4*)(lds + LGO + 63 * 272 + q * 32), e1 = *(const LAS f32x4*)(lds + LGO + 63 * 272 + q * 32 + 16);
        float at[8], bt[8], kt[8], rt[8], bh[8], kh[8];
#pragma unroll
        for (int e = 0; e < 8; ++e) { const float lg = (e < 4) ? g0[e & 3] : g1[e & 3], lc = (e < 4) ? e0[e & 3] : e1[e & 3];
            const float gm1 = __expf(lg - lwv[e]), gi = __expf(-lg), gt = __expf(lg), gr = __expf(lc - lg);
            const float bb = kk[e] * av[e];
            at[e] = -kk[e] * gm1; bt[e] = bb * gi; kt[e] = kp[e] * gi; rt[e] = rp[e] * gt; bh[e] = bb * gr; kh[e] = kp[e] * gr;
            if (t == 63) *(LAS float*)(lds + GCV + (8 * q + e) * 4) = __expf(lc); }
        *(LAS v4u*)(lds + AT_ + t * 144 + q * 16) = pack8(at); *(LAS v4u*)(lds + BT_ + t * 144 + q * 16) = pack8(bt);
        *(LAS v4u*)(lds + KT_ + t * 144 + q * 16) = pack8(kt); *(LAS v4u*)(lds + RT_ + t * 144 + q * 16) = pack8(rt);
#pragma unroll
        for (int e = 0; e < 8; ++e) { const int o = (8 * q + e) * 144 + t * 2;
            *(LAS bf16*)(lds + ATT + o) = (bf16)f2bf(at[e]); *(LAS bf16*)(lds + BHT + o) = (bf16)f2bf(bh[e]); *(LAS bf16*)(lds + KHT + o) = (bf16)f2bf(kh[e]); }
    }
    LDS_BAR();
    {
        const int hv_tb[10] = {0, 1, 1, 2, 2, 2, 3, 3, 3, 3}, hv_jb[10] = {0, 0, 1, 0, 1, 2, 0, 1, 2, 3};
        const int z_tb[6] = {0, 0, 0, 1, 1, 2}, z_jb[6] = {1, 2, 3, 2, 3, 3};
#pragma unroll
        for (int pass = 0; pass < 2; ++pass) {
            const int hi = (pass == 0) ? wave : (wave < 2 ? 8 + wave : -1);
            if (hi >= 0) {
                int tb = 0, jb = 0;
#pragma unroll
                for (int k = 0; k < 10; ++k) if (k == hi) { tb = hv_tb[k]; jb = hv_jb[k]; }
                f32x4 cab = {0.f, 0.f, 0.f, 0.f}, cak = cab, crb = cab, crk = cab;
#pragma unroll
                for (int s = 0; s < 2; ++s) { const bf16x8 fb = ldf(lds + BT_, 16 * jb + r, s, g), fk = ldf(lds + KT_, 16 * jb + r, s, g), fa = ldf(lds + AT_, 16 * tb + r, s, g), fr = ldf(lds + RT_, 16 * tb + r, s, g);
                    cab = mma(fb, fa, cab); cak = mma(fk, fa, cak); crb = mma(fb, fr, crb); crk = mma(fk, fr, crk); }
                const int tt = 16 * tb + r;
#pragma unroll
                for (int e = 0; e < 4; ++e) { const int j = 16 * jb + 4 * g + e; if (!(j < tt)) { cab[e] = 0.f; cak[e] = 0.f; } if (!(j <= tt)) { crb[e] = 0.f; crk[e] = 0.f; } }
                const int o = tt * 144 + (16 * jb + 4 * g) * 2;
                *(LAS v2u*)(lds + AAB + o) = pack4(cab); *(LAS v2u*)(lds + AAK + o) = pack4(cak); *(LAS v2u*)(lds + ARB + o) = pack4(crb); *(LAS v2u*)(lds + ARK + o) = pack4(crk);
                if (tb == jb) *(LAS f32x4*)(lds + DG + ((tb * 16 + r) * 16 + 4 * g) * 4) = cab;
            }
        }
        if (wave >= 2) {
            int tb = 0, jb = 0;
#pragma unroll
            for (int k = 0; k < 6; ++k) if (k == wave - 2) { tb = z_tb[k]; jb = z_jb[k]; }
            const int o = (16 * tb + r) * 144 + (16 * jb + 4 * g) * 2; const v2u z = {0u, 0u};
            *(LAS v2u*)(lds + AAB + o) = z; *(LAS v2u*)(lds + AAK + o) = z; *(LAS v2u*)(lds + ARB + o) = z; *(LAS v2u*)(lds + ARK + o) = z;
        }
    }
    LDS_BAR();
    f32x4 Y[4];
    if (wave == 7) {
        const int blk = lane >> 4, col = lane & 15; float x[16];
#pragma unroll
        for (int tt = 0; tt < 16; ++tt) {
            float acc = (tt == col) ? 1.0f : 0.0f;
            const LAS float* nrow = (const LAS float*)(lds + DG + ((blk * 16 + tt) * 16) * 4);
#pragma unroll
            for (int j = 0; j < 16; ++j) if (j < tt) acc += nrow[j] * x[j];
            x[tt] = acc;
            *(LAS bf16*)(lds + TI + ((blk * 16 + tt) * 16 + col) * 2) = (bf16)f2bf(acc);
        }
    }
    if (wave < 4) {
#pragma unroll
        for (int i = 0; i < 4; ++i) { Y[i] = (f32x4){0.f, 0.f, 0.f, 0.f};
#pragma unroll
            for (int s = 0; s < 2; ++s) Y[i] = mma(ldf(lds + AAK, 16 * i + r, s, g), ldf(lds + VTT, 16 * wave + r, s, g), Y[i]); }
    } else {
#pragma unroll
        for (int i = 0; i < 4; ++i) Y[i] = unpack4(*(const LAS v2u*)(lds + ATT + (16 * (wave - 4) + r) * 144 + (16 * i + 4 * g) * 2));
    }
    LDS_BAR();
    {
        v2u Xb[4];
        const bf16x8 zf = {0, 0, 0, 0, 0, 0, 0, 0};
#pragma unroll
        for (int i = 0; i < 4; ++i) {
            if (i >= 1) {
                v4u bw; bw.x = Xb[0].x; bw.y = Xb[0].y; bw.z = (i >= 2) ? Xb[1].x : 0u; bw.w = (i >= 2) ? Xb[1].y : 0u;
                v4u aw; const v2u a0 = *(const LAS v2u*)(lds + AAB + (16 * i + r) * 144 + (4 * g) * 2), a1 = *(const LAS v2u*)(lds + AAB + (16 * i + r) * 144 + (16 + 4 * g) * 2);
                aw.x = a0.x; aw.y = a0.y; aw.z = a1.x; aw.w = a1.y;
                Y[i] = mma(__builtin_bit_cast(bf16x8, aw), __builtin_bit_cast(bf16x8, bw), Y[i]);
            }
            if (i >= 3) {
                v4u bw; bw.x = Xb[2].x; bw.y = Xb[2].y; bw.z = 0u; bw.w = 0u;
                v4u aw; const v2u a0 = *(const LAS v2u*)(lds + AAB + (16 * i + r) * 144 + (32 + 4 * g) * 2);
                aw.x = a0.x; aw.y = a0.y; aw.z = 0u; aw.w = 0u;
                Y[i] = mma(__builtin_bit_cast(bf16x8, aw), __builtin_bit_cast(bf16x8, bw), Y[i]);
            }
            v4u tw; const v2u t0 = *(const LAS v2u*)(lds + TI + ((i * 16 + r) * 16 + 4 * g) * 2); tw.x = t0.x; tw.y = t0.y; tw.z = 0u; tw.w = 0u;
            v4u yw; const v2u yp = pack4(Y[i]); yw.x = yp.x; yw.y = yp.y; yw.z = 0u; yw.w = 0u;
            const f32x4 X = mma(__builtin_bit_cast(bf16x8, tw), __builtin_bit_cast(bf16x8, yw), (f32x4){0.f, 0.f, 0.f, 0.f});
            Xb[i] = pack4(X);
            const int dst = (wave < 4) ? (U0T + (16 * wave + r) * 144) : (ATT + (16 * (wave - 4) + r) * 144);
            *(LAS v2u*)(lds + dst + (16 * i + 4 * g) * 2) = Xb[i];
        }
        (void)zf;
    }
    LDS_BAR();
    {
#pragma unroll
        for (int i = 0; i < 2; ++i) {
            const int qq = 2 * wave + i, rb = qq >> 2, cb = qq & 3;
            f32x4 crh = {0.f, 0.f, 0.f, 0.f}, co0 = crh, cp = crh, cq = crh;
#pragma unroll
            for (int s = 0; s < 2; ++s) {
                const bf16x8 fah = ldf(lds + ATT, 16 * rb + r, s, g), fu0 = ldf(lds + U0T, 16 * rb + r, s, g), fvt = ldf(lds + VTT, 16 * rb + r, s, g), fbh = ldf(lds + BHT, 16 * rb + r, s, g), fkh = ldf(lds + KHT, 16 * rb + r, s, g);
                const bf16x8 frb = ldf(lds + ARB, 16 * cb + r, s, g), frk = ldf(lds + ARK, 16 * cb + r, s, g), fbhc = ldf(lds + BHT, 16 * cb + r, s, g), fu0c = ldf(lds + U0T, 16 * cb + r, s, g), fvtc = ldf(lds + VTT, 16 * cb + r, s, g);
                crh = mma(fah, frb, crh);
                co0 = mma(fu0, frb, co0); co0 = mma(fvt, frk, co0);
                cp = mma(fah, fbhc, cp);
                cq = mma(fbh, fu0c, cq); cq = mma(fkh, fvtc, cq);
            }
            crh = crh + unpack4(*(const LAS v2u*)(lds + RT_ + (16 * cb + r) * 144 + (16 * rb + 4 * g) * 2));
            if (rb == cb) {
#pragma unroll
                for (int e = 0; e < 4; ++e) if (4 * g + e == r) cp[e] += *(const LAS float*)(lds + GCV + (16 * rb + 4 * g + e) * 4);
            }
            const size_t tok = row0 + 16 * cb + r;
            if (!dummy) {
            *(GAS v2u*)(A.Rh + tok * A.ldo + h * 64 + 16 * rb + 4 * g) = pack4(crh);
            *(GAS v2u*)(A.O0 + tok * A.ldo + h * 64 + 16 * rb + 4 * g) = pack4(co0);
            const size_t su = (size_t)(((cidx >> 7) * 8 + h) * 128 + c_in_b);
            *(GAS v2u*)(A.Pst + su * 4096 + (16 * cb + r) * 64 + 32 * (rb >> 1) + 8 * g + 4 * (rb & 1)) = pack4(cp);
            *(GAS v2u*)(A.Qst + su * 4096 + (16 * cb + r) * 64 + 16 * g + 4 * rb) = pack4(cq);
            }
        }
    }
    LDS_BAR();
}

struct PQ { v4u p[4][2]; v4u q[2]; };
constexpr int S2_NS = 8, S2_SLOTB = 2048, S2_FLAGS = 4 * S2_NS * S2_SLOTB;
__device__ __forceinline__ void s2_chain(LAS unsigned char* lds, const bf16* Pst, const bf16* Qst, const int bh, const int vb, const int lane) {
    const int r = lane & 15, g = lane >> 4;
    f32x4 S[4];
#pragma unroll
    for (int i = 0; i < 4; ++i) S[i] = (f32x4){0.f, 0.f, 0.f, 0.f};
    const size_t ustep = (size_t)4096;
    const bf16* Pp = Pst + ((size_t)bh * 128) * 4096 + r * 64 + 8 * g;
    const bf16* Qp = Qst + ((size_t)bh * 128) * 4096 + (16 * vb + r) * 64 + 16 * g;
    LAS unsigned char* ring = lds + vb * (S2_NS * S2_SLOTB) + r * 128 + g * 8;
    volatile LAS int* prod = (volatile LAS int*)(lds + S2_FLAGS + vb * 64);
    volatile LAS int* cons = (volatile LAS int*)(lds + S2_FLAGS + 256 + vb * 64);
#define S2_GLD(DST, PTR) asm volatile("global_load_dwordx4 %0, %1, off" : "=v"(DST) : "v"(PTR) : "memory")
#define S2_LOAD(B, C) do { const int c_ = (C) < 128 ? (C) : 127; const bf16* P_ = Pp + (size_t)c_ * ustep; const bf16* Q_ = Qp + (size_t)c_ * ustep; \
        _Pragma("unroll") for (int i = 0; i < 4; ++i) { S2_GLD(B.p[i][0], P_ + (16 * i) * 64); S2_GLD(B.p[i][1], P_ + (16 * i) * 64 + 32); } \
        S2_GLD(B.q[0], Q_); S2_GLD(B.q[1], Q_ + 8); } while (0)
#define S2_READY(B, N) asm volatile("s_waitcnt vmcnt(" #N ")" : "+v"(B.p[0][0]), "+v"(B.p[0][1]), "+v"(B.p[1][0]), "+v"(B.p[1][1]), "+v"(B.p[2][0]), "+v"(B.p[2][1]), "+v"(B.p[3][0]), "+v"(B.p[3][1]), "+v"(B.q[0]), "+v"(B.q[1]) :: "memory")
#define S2_STEP(B, C) do { v2u sb_[4]; \
        { unsigned sp_ = 0; while ((C) - *cons >= S2_NS && ++sp_ < (1u << 22)) __builtin_amdgcn_s_sleep(1); } asm volatile("" ::: "memory");   \
        _Pragma("unroll") for (int i = 0; i < 4; ++i) { sb_[i] = pack4(S[i]); *(LAS v2u*)(ring + ((C) & (S2_NS - 1)) * S2_SLOTB + 32 * i) = sb_[i]; } \
        asm volatile("s_waitcnt lgkmcnt(0)" ::: "memory"); if (lane == 0) *prod = (C) + 1; \
        _Pragma("unroll") for (int i = 0; i < 4; ++i) { v2u qi_; qi_.x = (i & 1) ? B.q[i >> 1].z : B.q[i >> 1].x; qi_.y = (i & 1) ? B.q[i >> 1].w : B.q[i >> 1].y; f32x4 n_ = unpack4(qi_); \
            _Pragma("unroll") for (int s_ = 0; s_ < 2; ++s_) { \
                v4u bw_; bw_.x = sb_[2 * s_].x; bw_.y = sb_[2 * s_].y; bw_.z = sb_[2 * s_ + 1].x; bw_.w = sb_[2 * s_ + 1].y; \
                n_ = mma(__builtin_bit_cast(bf16x8, B.p[i][s_]), __builtin_bit_cast(bf16x8, bw_), n_); } \
            S[i] = n_; } } while (0)
#define PIN() asm volatile("" ::: "memory")
    PQ B0, B1, B2, B3;
    asm volatile("s_waitcnt vmcnt(0)" ::: "memory");
    S2_LOAD(B0, 0); S2_LOAD(B1, 1); S2_LOAD(B2, 2);
    for (int c = 0; c < 128; c += 4) {
        S2_LOAD(B3, c + 3); S2_READY(B0, 30); S2_STEP(B0, c);
        S2_LOAD(B0, c + 4); S2_READY(B1, 30); S2_STEP(B1, c + 1);
        S2_LOAD(B1, c + 5); S2_READY(B2, 30); S2_STEP(B2, c + 2);
        S2_LOAD(B2, c + 6); S2_READY(B3, 30); S2_STEP(B3, c + 3);
    }
    asm volatile("s_waitcnt vmcnt(0)" : "+v"(B0.p[0][0]), "+v"(B0.p[0][1]), "+v"(B0.p[1][0]), "+v"(B0.p[1][1]), "+v"(B0.p[2][0]), "+v"(B0.p[2][1]), "+v"(B0.p[3][0]), "+v"(B0.p[3][1]), "+v"(B0.q[0]), "+v"(B0.q[1]),
                 "+v"(B1.p[0][0]), "+v"(B1.p[0][1]), "+v"(B1.p[1][0]), "+v"(B1.p[1][1]), "+v"(B1.p[2][0]), "+v"(B1.p[2][1]), "+v"(B1.p[3][0]), "+v"(B1.p[3][1]), "+v"(B1.q[0]), "+v"(B1.q[1]) :: "memory");
    asm volatile("" : "+v"(B2.p[0][0]), "+v"(B2.p[0][1]), "+v"(B2.p[1][0]), "+v"(B2.p[1][1]), "+v"(B2.p[2][0]), "+v"(B2.p[2][1]), "+v"(B2.p[3][0]), "+v"(B2.p[3][1]), "+v"(B2.q[0]), "+v"(B2.q[1]) :: "memory");
#undef S2_LOAD
#undef S2_STEP
}
__device__ __forceinline__ void s2_storer(LAS unsigned char* lds, bf16* Sst, const int bh, const int vb, const int lane) {
    volatile LAS int* prod = (volatile LAS int*)(lds + S2_FLAGS + vb * 64);
    volatile LAS int* cons = (volatile LAS int*)(lds + S2_FLAGS + 256 + vb * 64);
    const LAS unsigned char* ring = lds + vb * (S2_NS * S2_SLOTB) + lane * 32;
    bf16* Sp = Sst + ((size_t)bh * 128) * 4096 + (16 * vb) * 64 + lane * 16;
    for (int c = 0; c < 128; ++c) {
        { unsigned sp_ = 0; while (*prod <= c && ++sp_ < (1u << 22)) __builtin_amdgcn_s_sleep(1); }
        asm volatile("" ::: "memory");
        const v4u a_ = *(const LAS v4u*)(ring + (c & (S2_NS - 1)) * S2_SLOTB), b_ = *(const LAS v4u*)(ring + (c & (S2_NS - 1)) * S2_SLOTB + 16);
        asm volatile("s_waitcnt lgkmcnt(0)" ::: "memory");
        if (lane == 0) *cons = c + 1;
        *(GAS v4u*)(Sp + (size_t)c * 4096) = a_; *(GAS v4u*)(Sp + (size_t)c * 4096 + 8) = b_;
    }
}

struct S3Args { const bf16 *Rh, *O0; int ldo; const bf16* Vp; int ldv; const bf16 *Gf, *Sst; const float *bonus, *lnx_g, *lnx_b; bf16* Y; int ldy; };
__device__ __forceinline__ void s3_unit(const S3Args& A, const int unit, const int lane) {
    const int r = lane & 15, g = lane >> 4;
    const int h = unit & 7, cidx = unit >> 3;
    bf16x8 sf[4][2];
#pragma unroll
    for (int i = 0; i < 4; ++i)
#pragma unroll
        for (int s = 0; s < 2; ++s) sf[i][s] = *(const GAS bf16x8*)(A.Sst + (size_t)(((cidx >> 7) * 8 + h) * 128 + (cidx & 127)) * 4096 + (32 * (i >> 1) + 8 * (r >> 2) + 4 * (i & 1) + (r & 3)) * 64 + 32 * s + 8 * g);
    struct TB { bf16x8 fr[2]; v4u o0[2], vv[2], gg[2]; float bon; };
#define S3_LOAD(B_, TB_) do { const size_t tok_ = (size_t)cidx * 64 + 16 * (TB_) + r; \
        _Pragma("unroll") for (int s_ = 0; s_ < 2; ++s_) B_.fr[s_] = *(const GAS bf16x8*)(A.Rh + tok_ * A.ldo + h * 64 + 32 * s_ + 8 * g); \
        _Pragma("unroll") for (int j_ = 0; j_ < 2; ++j_) { const int hv_ = h * 64 + 32 * j_ + 8 * g; B_.o0[j_] = *(const GAS v4u*)(A.O0 + tok_ * A.ldo + hv_); \
            B_.vv[j_] = *(const GAS v4u*)(A.Vp + tok_ * A.ldv + hv_); B_.gg[j_] = *(const GAS v4u*)(A.Gf + tok_ * W + hv_); } \
        B_.bon = ((const GAS float*)A.bonus)[tok_ * 8 + h]; } while (0)
#define S3_HALF(W_, HI_) ((HI_) ? (v2u){(W_).z, (W_).w} : (v2u){(W_).x, (W_).y})
#define S3_COMP(B_, TB_) do { const size_t tok_ = (size_t)cidx * 64 + 16 * (TB_) + r; f32x4 o[4]; \
        _Pragma("unroll") for (int i_ = 0; i_ < 4; ++i_) { o[i_] = unpack4(S3_HALF(B_.o0[i_ >> 1], i_ & 1)); _Pragma("unroll") for (int s_ = 0; s_ < 2; ++s_) o[i_] = mma(sf[i_][s_], B_.fr[s_], o[i_]); } \
        float sm = 0.f; \
        _Pragma("unroll") for (int i_ = 0; i_ < 4; ++i_) sm += (o[i_][0] + o[i_][1]) + (o[i_][2] + o[i_][3]); \
        sm += __shfl_xor(sm, 16); sm += __shfl_xor(sm, 32); \
        const float mean = sm * (1.0f / 64.0f); float sq = 0.f; \
        _Pragma("unroll") for (int i_ = 0; i_ < 4; ++i_) { o[i_] = o[i_] - mean; sq += (o[i_][0] * o[i_][0] + o[i_][1] * o[i_][1]) + (o[i_][2] * o[i_][2] + o[i_][3] * o[i_][3]); } \
        sq += __shfl_xor(sq, 16); sq += __shfl_xor(sq, 32); \
        const float rstd = __builtin_amdgcn_rsqf(sq * (1.0f / 64.0f) + 64e-5f); \
        _Pragma("unroll") for (int j_ = 0; j_ < 2; ++j_) { const int hv_ = h * 64 + 32 * j_ + 8 * g; \
            const f32x4 y0 = (o[2 * j_] * rstd * lg[2 * j_] + lb[2 * j_] + unpack4(S3_HALF(B_.vv[j_], 0)) * B_.bon) * unpack4(S3_HALF(B_.gg[j_], 0)); \
            const f32x4 y1 = (o[2 * j_ + 1] * rstd * lg[2 * j_ + 1] + lb[2 * j_ + 1] + unpack4(S3_HALF(B_.vv[j_], 1)) * B_.bon) * unpack4(S3_HALF(B_.gg[j_], 1)); \
            const v2u p0 = pack4(y0), p1 = pack4(y1); v4u w_; w_.x = p0.x; w_.y = p0.y; w_.z = p1.x; w_.w = p1.y; \
            *(GAS v4u*)(A.Y + tok_ * A.ldy + hv_) = w_; } } while (0)
    TB t0, t1, t2, t3;
    S3_LOAD(t0, 0); S3_LOAD(t1, 1);
    f32x4 lg[4], lb[4];
#pragma unroll
    for (int i = 0; i < 4; ++i) { const int hv = h * 64 + 32 * (i >> 1) + 8 * g + 4 * (i & 1); lg[i] = *(const GAS f32x4*)(A.lnx_g + hv); lb[i] = *(const GAS f32x4*)(A.lnx_b + hv); }
    S3_LOAD(t2, 2); S3_LOAD(t3, 3);
    S3_COMP(t0, 0); S3_COMP(t1, 1); S3_COMP(t2, 2); S3_COMP(t3, 3);
#undef S3_LOAD
#undef S3_HALF
#undef S3_COMP
}
}
namespace moba {
typedef short bf16x8 __attribute__((ext_vector_type(8)));
constexpr int OSP = 132;
constexpr int OSLOT = 0, LSUM = OSLOT + 4 * 256 * OSP, KMF = LSUM + 4 * 256 * 4, CNT = KMF + 8192, OFFS = CNT + 128, FILL = OFFS + 128, QLIST = FILL + 128, QSLOT = QLIST + 1024, ITEMS = QSLOT + 1024, ICTR = ITEMS + 1024, NVQ = ICTR + 64  , MOBA_LDS = NVQ + 256;
static_assert(MOBA_LDS <= 153600 - 1024, "MoBA LDS map below the control words");
__device__ __forceinline__ f32x4 mma(bf16x8 a, bf16x8 b, f32x4 c) { return __builtin_amdgcn_mfma_f32_16x16x32_bf16(a, b, c, 0, 0, 0); }
struct Args { bf16* AT; const bf16* VT; const float* KM; const float *qg, *kg; };
struct KV { bf16x8 k[2][2]; bf16x8 v[4]; };
__device__ __forceinline__ void item(LAS unsigned char* lds, const Args& A, const int b, const int h, const int qb, const int kblk, const int off, const int cnt, const int nkc, const bool own, const int lane) {
    const int r = lane & 15, g = lane >> 4;
    const float slope2 = exp2f(-(float)(h + 1)) * 1.4426950408889634f;
    int ql[2]; float aq[2];
    bf16x8 qf[2][2];
#pragma unroll
    for (int qt = 0; qt < 2; ++qt) {
        const int li = qt * 16 + r;
        int qv = -1;
        if (own) qv = off + li; else if (li < cnt) qv = (int)*(const LAS unsigned char*)(lds + QLIST + off + li);
        ql[qt] = qv;
        const int qrow = (qv >= 0) ? qv : 0;
        aq[qt] = (qv >= 0) ? -slope2 * (float)(256 * (qb - kblk) + qrow) : -1e30f;
    }
    const bf16* kbase = A.AT + ((size_t)b * T + kblk * 256 + 8 * (r >> 2) + (r & 3)) * NAT + 512 + h * 64 + 8 * g;
    const bf16* vbase = A.VT + (((size_t)(b * NH + h) * (T / 32) + kblk * 8) * 64 + r) * 32 + 8 * g;
    f32x4 o[4][2]; float l[2] = {0.f, 0.f};
#pragma unroll
    for (int db = 0; db < 4; ++db) { o[db][0] = (f32x4){0.f, 0.f, 0.f, 0.f}; o[db][1] = (f32x4){0.f, 0.f, 0.f, 0.f}; }
#define GLD16(DST, PTR) asm volatile("global_load_dwordx4 %0, %1, off" : "=v"(DST) : "v"(PTR) : "memory")
#define MOBA_LOAD(B, KC) do { const int kc_ = (KC) < nkc ? (KC) : nkc - 1; \
        _Pragma("unroll") for (int kt = 0; kt < 2; ++kt) { const bf16* kp_ = kbase + (size_t)(kc_ * 32 + kt * 4) * NAT; GLD16(B.k[kt][0], kp_); GLD16(B.k[kt][1], kp_ + 32); } \
        _Pragma("unroll") for (int db = 0; db < 4; ++db) { const bf16* vp_ = vbase + (size_t)kc_ * (64 * 32) + (16 * db) * 32; GLD16(B.v[db], vp_); } } while (0)
#define MOBA_READY(B, N) asm volatile("s_waitcnt vmcnt(" #N ")" : "+v"(B.k[0][0]), "+v"(B.k[0][1]), "+v"(B.k[1][0]), "+v"(B.k[1][1]), "+v"(B.v[0]), "+v"(B.v[1]), "+v"(B.v[2]), "+v"(B.v[3]) :: "memory")
#define MOBA_COMPUTE(B, KC) do { v4u pb_[2]; const int kb_ = (KC) * 32 + 8 * g; const bool dg_ = own && ((KC) == nkc - 1); \
        _Pragma("unroll") for (int qt = 0; qt < 2; ++qt) { unsigned pw_[4]; const float bs_ = aq[qt] + slope2 * (float)kb_; const int dl_ = ql[qt] - kb_; \
            _Pragma("unroll") for (int kt = 0; kt < 2; ++kt) { f32x4 st_ = {0.f, 0.f, 0.f, 0.f}; \
                st_ = mma(B.k[kt][0], qf[qt][0], st_); st_ = mma(B.k[kt][1], qf[qt][1], st_); f32x4 p_; \
                if (dg_) { _Pragma("unroll") for (int e = 0; e < 4; ++e) { float x_ = (st_[e] + bs_) + cst[kt * 4 + e]; if (4 * kt + e > dl_) x_ = -1e30f; p_[e] = __builtin_amdgcn_exp2f(x_); } } \
                else { _Pragma("unroll") for (int e = 0; e < 4; ++e) p_[e] = __builtin_amdgcn_exp2f((st_[e] + bs_) + cst[kt * 4 + e]); } \
                l[qt] += (p_[0] + p_[1]) + (p_[2] + p_[3]); pw_[2 * kt] = pk2(p_[0], p_[1]); pw_[2 * kt + 1] = pk2(p_[2], p_[3]); } \
            pb_[qt].x = pw_[0]; pb_[qt].y = pw_[1]; pb_[qt].z = pw_[2]; pb_[qt].w = pw_[3]; } \
        _Pragma("unroll") for (int db = 0; db < 4; ++db) { _Pragma("unroll") for (int qt = 0; qt < 2; ++qt) o[db][qt] = mma(B.v[db], __builtin_bit_cast(bf16x8, pb_[qt]), o[db][qt]); } } while (0)
    float cst[8];
#pragma unroll
    for (int j = 0; j < 8; ++j) cst[j] = slope2 * (float)j;
    KV B0, B1, B2;
    MOBA_LOAD(B0, 0); MOBA_LOAD(B1, 1);
#pragma unroll
    for (int qt = 0; qt < 2; ++qt) { const int qrow = (ql[qt] >= 0) ? ql[qt] : 0; const bf16* qp = A.AT + ((size_t)b * T + qb * 256 + qrow) * NAT + h * 64 + 8 * g;
        qf[qt][0] = *(const GAS bf16x8*)qp; qf[qt][1] = *(const GAS bf16x8*)(qp + 32); }
    asm volatile("" :: "v"(qf[0][0]), "v"(qf[0][1]), "v"(qf[1][0]), "v"(qf[1][1]) : "memory");
    for (int kc = 0; kc < nkc; kc += 3) {
        MOBA_LOAD(B2, kc + 2); MOBA_READY(B0, 16); MOBA_COMPUTE(B0, kc);
        if (kc + 1 < nkc) { MOBA_LOAD(B0, kc + 3); MOBA_READY(B1, 16); MOBA_COMPUTE(B1, kc + 1); }
        if (kc + 2 < nkc) { MOBA_LOAD(B1, kc + 4); MOBA_READY(B2, 16); MOBA_COMPUTE(B2, kc + 2); }
    }
    asm volatile("s_waitcnt vmcnt(0)" : "+v"(B0.k[0][0]), "+v"(B0.k[0][1]), "+v"(B0.k[1][0]), "+v"(B0.k[1][1]), "+v"(B0.v[0]), "+v"(B0.v[1]), "+v"(B0.v[2]), "+v"(B0.v[3]),
                 "+v"(B1.k[0][0]), "+v"(B1.k[0][1]), "+v"(B1.k[1][0]), "+v"(B1.k[1][1]), "+v"(B1.v[0]), "+v"(B1.v[1]), "+v"(B1.v[2]), "+v"(B1.v[3]),
                 "+v"(B2.k[0][0]), "+v"(B2.k[0][1]), "+v"(B2.k[1][0]), "+v"(B2.k[1][1]), "+v"(B2.v[0]), "+v"(B2.v[1]), "+v"(B2.v[2]), "+v"(B2.v[3]) :: "memory");
#undef MOBA_LOAD
#undef MOBA_COMPUTE
#pragma unroll
    for (int qt = 0; qt < 2; ++qt) {
        float ls = l[qt]; ls += __shfl_xor(ls, 16); ls += __shfl_xor(ls, 32);
        if (ql[qt] >= 0) {
            const int slot = own ? 0 : (int)*(const LAS unsigned char*)(lds + QSLOT + off + qt * 16 + r);
            LAS unsigned char* op = lds + OSLOT + (slot * 256 + ql[qt]) * OSP + g * 8;
#pragma unroll
            for (int db = 0; db < 4; ++db) { *(LAS unsigned*)(op + db * 32) = pk2(o[db][qt][0], o[db][qt][1]); *(LAS unsigned*)(op + db * 32 + 4) = pk2(o[db][qt][2], o[db][qt][3]); }
            if (g == 0) *((LAS float*)(lds + LSUM) + slot * 256 + ql[qt]) = ls;
        }
    }
}
__device__ __forceinline__ void unit(LAS unsigned char* lds, const Args& A, const int b, const int h, const int qb, const int tid, const bool dummy = false, gu32* qw = nullptr, volatile LAS int* qslot = nullptr) {
    const int lane = tid & 63;
    const int wave = __builtin_amdgcn_readfirstlane(tid >> 6);
    if (tid < 96) ((LAS int*)(lds + CNT))[tid] = 0;
    if (tid == 0) *(LAS int*)(lds + ICTR) = 0;
    const int r = lane & 15, g = lane >> 4;
    float mq = fabsf(((const GAS float*)A.qg)[lane]), mk = fabsf(((const GAS float*)A.kg)[lane]);
    bf16x8 qf[2][2]; f32x4 kx[2][2][2];
    if (qb > 0) {
#pragma unroll
        for (int nt = 0; nt < 2; ++nt) { const bf16* qp = A.AT + ((size_t)b * T + qb * 256 + wave * 32 + nt * 16 + r) * NAT + h * 64 + 8 * g;
            qf[nt][0] = *(const GAS bf16x8*)qp; qf[nt][1] = *(const GAS bf16x8*)(qp + 32); }
#pragma unroll
        for (int mt = 0; mt < 2; ++mt) { const float* kmp = A.KM + ((size_t)(b * NH + h) * NBLK + mt * 16 + r) * 64 + 8 * g;
#pragma unroll
            for (int ks = 0; ks < 2; ++ks) { kx[mt][ks][0] = *(const GAS f32x4*)(kmp + 32 * ks); kx[mt][ks][1] = *(const GAS f32x4*)(kmp + 32 * ks + 4); } }
    }
    {
#pragma unroll
        for (int o_ = 1; o_ < 64; o_ <<= 1) { mq = fmaxf(mq, __shfl_xor(mq, o_)); mk = fmaxf(mk, __shfl_xor(mk, o_)); }
        const float B2 = 64.0f * (0.125f * 1.4426950408889634f) * mq * mk * 1.02f, sl2 = exp2f(-(float)(h + 1)) * 1.4426950408889634f;
        const float dmin = ((B2 + 152.0f) / sl2 - 1.0f) * (1.0f / 256.0f);
        if (tid == 0) *(LAS int*)(lds + ICTR + 8) = (int)floorf(dmin) + 2;
    }
    int s0 = -1, s1 = -1, s2 = -1, sl0 = 0, sl1 = 0, sl2q = 0, nv = 1;
    if (qb > 0) {
        f32x4 ga[2][2];
#pragma unroll
        for (int mt = 0; mt < 2; ++mt) {
            ga[mt][0] = (f32x4){0.f, 0.f, 0.f, 0.f}; ga[mt][1] = (f32x4){0.f, 0.f, 0.f, 0.f};
#pragma unroll
            for (int ks = 0; ks < 2; ++ks) {
                const f32x4 x0 = kx[mt][ks][0], x1 = kx[mt][ks][1];
                v4u wh, wl;
                wh.x = pk2(x0[0], x0[1]); wh.y = pk2(x0[2], x0[3]); wh.z = pk2(x1[0], x1[1]); wh.w = pk2(x1[2], x1[3]);
                wl.x = pk2(x0[0] - bflo(wh.x), x0[1] - bfhi(wh.x)); wl.y = pk2(x0[2] - bflo(wh.y), x0[3] - bfhi(wh.y));
                wl.z = pk2(x1[0] - bflo(wh.z), x1[1] - bfhi(wh.z)); wl.w = pk2(x1[2] - bflo(wh.w), x1[3] - bfhi(wh.w));
#pragma unroll
                for (int nt = 0; nt < 2; ++nt) { ga[mt][nt] = mma(__builtin_bit_cast(bf16x8, wh), qf[nt][ks], ga[mt][nt]); ga[mt][nt] = mma(__builtin_bit_cast(bf16x8, wl), qf[nt][ks], ga[mt][nt]); }
            }
        }
        float tg0[2], tg1[2], tg2[2]; int ts0[2], ts1[2], ts2[2];
#define MOBA_INS(V, I) do { const float v_ = (V); const int i_ = (I); \
            if (v_ > g0 || (v_ == g0 && i_ < t0)) { g2 = g1; t2 = t1; g1 = g0; t1 = t0; g0 = v_; t0 = i_; } \
            else if (v_ > g1 || (v_ == g1 && i_ < t1)) { g2 = g1; t2 = t1; g1 = v_; t1 = i_; } \
            else if (v_ > g2 || (v_ == g2 && i_ < t2)) { g2 = v_; t2 = i_; } } while (0)
#pragma unroll
        for (int nt = 0; nt < 2; ++nt) {
            float g0 = -3e38f, g1 = -3e38f, g2 = -3e38f; int t0 = -1, t1 = -1, t2 = -1;
#pragma unroll
            for (int mt = 0; mt < 2; ++mt) {
#pragma unroll
                for (int e = 0; e < 4; ++e) { const int n = 16 * mt + 4 * g + e; const float gt = (n < qb) ? ga[mt][nt][e] : -3e38f;
                    if (gt > g0) { g2 = g1; t2 = t1; g1 = g0; t1 = t0; g0 = gt; t0 = n; }
                    else if (gt > g1) { g2 = g1; t2 = t1; g1 = gt; t1 = n; }
                    else if (gt > g2) { g2 = gt; t2 = n; } }
            }
#pragma unroll
            for (int o_ = 16; o_ <= 32; o_ <<= 1) {
                const float b0 = __shfl_xor(g0, o_), b1 = __shfl_xor(g1, o_), b2 = __shfl_xor(g2, o_);
                const int j0 = __shfl_xor(t0, o_), j1 = __shfl_xor(t1, o_), j2 = __shfl_xor(t2, o_);
                MOBA_INS(b0, j0); MOBA_INS(b1, j1); MOBA_INS(b2, j2);
            }
            tg0[nt] = g0; tg1[nt] = g1; tg2[nt] = g2; ts0[nt] = t0; ts1[nt] = t1; ts2[nt] = t2;
        }
#undef MOBA_INS
        if (lane < 32) { s0 = g ? ts0[1] : ts0[0]; s1 = g ? ts1[1] : ts1[0]; s2 = g ? ts2[1] : ts2[0]; }
        (void)tg0; (void)tg1; (void)tg2;
    }
    const int qid = wave * 32 + lane;
    RW_BAR();
    if (lane < 32) {
        const int Dd = *(const LAS int*)(lds + ICTR + 8);
        if (s0 >= 0 && qb - s0 >= Dd) s0 = -1; if (s0 >= 0) sl0 = nv++;
        if (s1 >= 0 && qb - s1 >= Dd) s1 = -1; if (s1 >= 0) sl1 = nv++;
        if (s2 >= 0 && qb - s2 >= Dd) s2 = -1; if (s2 >= 0) sl2q = nv++;
        if (s0 >= 0) __hip_atomic_fetch_add((LAS int*)(lds + CNT) + s0, 1, __ATOMIC_RELAXED, __HIP_MEMORY_SCOPE_WORKGROUP);
        if (s1 >= 0) __hip_atomic_fetch_add((LAS int*)(lds + CNT) + s1, 1, __ATOMIC_RELAXED, __HIP_MEMORY_SCOPE_WORKGROUP);
        if (s2 >= 0) __hip_atomic_fetch_add((LAS int*)(lds + CNT) + s2, 1, __ATOMIC_RELAXED, __HIP_MEMORY_SCOPE_WORKGROUP);
        *(LAS unsigned char*)(lds + NVQ + qid) = (unsigned char)nv;
    }
    RW_BAR();
    if (tid < 64) {
        const int c = (lane < qb) ? ((LAS int*)(lds + CNT))[lane] : 0, nit = (c + 31) >> 5;
        int run = c, irun = nit;
#pragma unroll
        for (int o_ = 1; o_ < 32; o_ <<= 1) { const int t_ = __shfl_up(run, o_), u_ = __shfl_up(irun, o_); if (lane >= o_) { run += t_; irun += u_; } }
        const int tot = __shfl(irun, 31), off = run - c, ib = irun - nit;
        if (lane < qb) ((LAS int*)(lds + OFFS))[lane] = off;
        for (int k = 0; k < nit; ++k) { ((LAS int*)(lds + ITEMS))[2 * (ib + k)] = lane | ((c - 32 * k < 32 ? c - 32 * k : 32) << 8); ((LAS int*)(lds + ITEMS))[2 * (ib + k) + 1] = off + 32 * k; }
        if (lane >= 32 && lane < 40) { const int i = 39 - lane; ((LAS int*)(lds + ITEMS))[2 * (tot + lane - 32)] = qb | (32 << 8) | (1 << 16) | ((i + 1) << 20); ((LAS int*)(lds + ITEMS))[2 * (tot + lane - 32) + 1] = 32 * i; }
        if (lane == 0) *(LAS int*)(lds + ICTR + 4) = tot + 8;
    }
    RW_BAR();
    if (lane < 32) {
        if (s0 >= 0) { const int p = __hip_atomic_fetch_add((LAS int*)(lds + FILL) + s0, 1, __ATOMIC_RELAXED, __HIP_MEMORY_SCOPE_WORKGROUP); *(LAS unsigned char*)(lds + QLIST + ((LAS int*)(lds + OFFS))[s0] + p) = (unsigned char)qid; *(LAS unsigned char*)(lds + QSLOT + ((LAS int*)(lds + OFFS))[s0] + p) = (unsigned char)sl0; }
        if (s1 >= 0) { const int p = __hip_atomic_fetch_add((LAS int*)(lds + FILL) + s1, 1, __ATOMIC_RELAXED, __HIP_MEMORY_SCOPE_WORKGROUP); *(LAS unsigned char*)(lds + QLIST + ((LAS int*)(lds + OFFS))[s1] + p) = (unsigned char)qid; *(LAS unsigned char*)(lds + QSLOT + ((LAS int*)(lds + OFFS))[s1] + p) = (unsigned char)sl1; }
        if (s2 >= 0) { const int p = __hip_atomic_fetch_add((LAS int*)(lds + FILL) + s2, 1, __ATOMIC_RELAXED, __HIP_MEMORY_SCOPE_WORKGROUP); *(LAS unsigned char*)(lds + QLIST + ((LAS int*)(lds + OFFS))[s2] + p) = (unsigned char)qid; *(LAS unsigned char*)(lds + QSLOT + ((LAS int*)(lds + OFFS))[s2] + p) = (unsigned char)sl2q; }
    }
    RW_BAR();
    {
        const int ni = *(const LAS int*)(lds + ICTR + 4);
        for (;;) {
            int idx = 0; if (lane == 0) idx = __hip_atomic_fetch_add((LAS int*)(lds + ICTR), 1, __ATOMIC_RELAXED, __HIP_MEMORY_SCOPE_WORKGROUP);
            idx = __builtin_amdgcn_readfirstlane(idx);
            if (idx >= ni) break;
            const int w0 = __builtin_amdgcn_readfirstlane(((const LAS int*)(lds + ITEMS))[2 * idx]), w1 = __builtin_amdgcn_readfirstlane(((const LAS int*)(lds + ITEMS))[2 * idx + 1]);
            const bool own = (w0 >> 16) & 1;
            item(lds, A, b, h, qb, w0 & 255, w1, (w0 >> 8) & 255, own ? (w0 >> 20) : 8, own, lane);
        }
    }
    RW_BAR();
    int nxt_ = 0;
    if (qw != nullptr && tid == 0) asm volatile("global_atomic_add %0, %1, %2, %3 sc0" : "=v"(nxt_) : "v"(0), "v"(1), "s"(qw) : "memory");
    if (!dummy) {
        const int qloc = tid >> 1, half = tid & 1;
        const int nslot = (int)*(const LAS unsigned char*)(lds + NVQ + qloc);
        float acc[32]; float lt = 0.f;
#pragma unroll
        for (int d = 0; d < 32; ++d) acc[d] = 0.f;
        for (int sl = 0; sl < nslot; ++sl) {
            const LAS unsigned* op = (const LAS unsigned*)(lds + OSLOT + (sl * 256 + qloc) * OSP + half * 64);
#pragma unroll
            for (int d = 0; d < 16; ++d) { const unsigned w = op[d]; acc[2 * d] += bflo(w); acc[2 * d + 1] += bfhi(w); }
            lt += *((const LAS float*)(lds + LSUM) + sl * 256 + qloc);
        }
        const float inv = __builtin_amdgcn_rcpf(lt);
        bf16* yp = A.AT + ((size_t)b * T + qb * 256 + qloc) * NAT + h * 64 + half * 32;
#pragma unroll
        for (int c = 0; c < 4; ++c) { v4u w; w.x = pk2(acc[8*c] * inv, acc[8*c+1] * inv); w.y = pk2(acc[8*c+2] * inv, acc[8*c+3] * inv); w.z = pk2(acc[8*c+4] * inv, acc[8*c+5] * inv); w.w = pk2(acc[8*c+6] * inv, acc[8*c+7] * inv); *(GAS v4u*)(yp + 8 * c) = w; }
    }
    if (qw != nullptr) { if (tid < 64) asm volatile("s_waitcnt vmcnt(0)" : "+v"(nxt_) :: "memory"); if (tid == 0) *qslot = nxt_; LDS_BAR(); }
    else RW_BAR();
}
}

__global__ void __launch_bounds__(NWAVES * 64, 2) mk_fwd(Args args) {
    extern __shared__ __attribute__((aligned(16))) unsigned char lds_raw[];
    LAS unsigned char* lds = (LAS unsigned char*)lds_raw;
    const int tid0 = threadIdx.x;
    const int wv0 = __builtin_amdgcn_readfirstlane(tid0 >> 6);
    const int G = gridDim.x;
    unsigned char* ws0 = args.ws;
    const int lo = args.ph_lo, hi = args.ph_hi;
    const int NGW = G * NWAVES;
    const bool fused = args.fused != 0;
    volatile LAS unsigned* MISC = (volatile LAS unsigned*)(lds + MISC_OFF);
    for (int u = tid0; u < (LDS_BYTES - LDSCTL_OFF) / 4; u += NWAVES * 64) ((LAS unsigned*)(lds + LDSCTL_OFF))[u] = 0u;
    __syncthreads();
    XcdBarrier bar; bar.bar = (unsigned*)(ws0 + WS_CTL) + CW_BAR; bar.x = 0; bar.st = nullptr;
    if (fused) bar = xcd_barrier_post((unsigned*)(ws0 + WS_CTL) + CW_BAR, MISC + 8);
#define IN(k) (lo <= (k) && (k) < hi && (rep == 1 || (k) <= args.probe_upto || (k) == args.probe_dup))
#define SEAM(k) do { if (fused && !((k) == PH_FF2 && L == args.l_hi - 1)) xcd_barrier(bar, tidL == 0); } while (0)

    for (int L = args.l_lo; L < args.l_hi; ++L)
    for (int rep = (args.probe_upto >= 0 || args.probe_dup >= 0) ? 0 : 1; rep < 2; ++rep) {
    const float* xsrc = (L == 0) ? args.in[I_X] : args.out;
    int tidL; asm volatile("v_mbcnt_lo_u32_b32 %0, -1, 0\n\tv_mbcnt_hi_u32_b32 %0, -1, %0\n\tv_lshl_add_u32 %0, %1, 6, %0" : "=&v"(tidL) : "s"(wv0));
    const int tid = tidL, lane = tid & 63, wave = __builtin_amdgcn_readfirstlane(tid >> 6), gw = blockIdx.x * NWAVES + wave;
    if (IN(PH_CONV)) {
        unsigned char* ws = args.ws; asm volatile("" : "+s"(ws));
        LAS float* scr = (LAS float*)(lds + RING_OFF + wave * 16384);
        const float* w_in = args.in[I_WIN] + (size_t)L * D * NIN;
        const float* w_br = args.in[I_WBR] + (size_t)L * 3 * W * D;
        const float* w_out = args.in[I_WOUT] + (size_t)L * D * D;
        const float* w_f1 = args.in[I_FF1] + (size_t)L * D * FF;
        const float* w_f2 = args.in[I_FF2] + (size_t)L * FF * D;
        constexpr int I_IN = (D / 64) * (NIN / 32), I_B = (W / 64) * (D / 32), I_O = (D / 64) * (D / 32), I_1 = (D / 64) * (FF / 32), I_2 = (FF / 64) * (D / 32);
        constexpr int I_LU = 16, I_LG = 32;
        constexpr int NITEMS = I_IN + 2 * I_B + I_O + I_1 + I_2 + 2 * I_LU + I_LG;
        bf16* WupT = (bf16*)(ws + WS_LORA); bf16* AupT = WupT + 512 * 64; bf16* GupT = AupT + 512 * 64;
        for (int it = gw; it < NITEMS; it += NGW) {
            int r = it;
            if (r < I_IN) { if (r % (NIN / 32) < NA / 32) p0_transpose_item(w_in, D, NIN, ((bf16*)(ws + WS_WIN)), scr, r, lane); continue; } r -= I_IN;
            if (r < I_B) { p0_transpose_item(w_br, W, D, ((bf16*)(ws + WS_WB)), scr, r, lane); continue; } r -= I_B;
            if (r < I_B) { p0_transpose_item(w_br + (size_t)W * D, W, D, ((bf16*)(ws + WS_WB)) + (size_t)D * W, scr, r, lane); continue; } r -= I_B;
            if (r < I_O) { p0_transpose_item(w_out, D, D, ((bf16*)(ws + WS_WO)), scr, r, lane); continue; } r -= I_O;
            if (r < I_1) { p0_transpose_item(w_f1, D, FF, ((bf16*)(ws + WS_W1)), scr, r, lane, args.in[I_N2G] + (size_t)L * D); continue; } r -= I_1;
            if (r < I_2) { p0_transpose_item(w_f2, FF, D, ((bf16*)(ws + WS_W2)), scr, r, lane); continue; } r -= I_2;
            if (r < I_LU) { p0_transpose_item(args.in[I_WUP] + (size_t)L * 64 * W, 64, W, WupT, scr, r, lane); continue; } r -= I_LU;
            if (r < I_LU) { p0_transpose_item(args.in[I_AUP] + (size_t)L * 64 * W, 64, W, AupT, scr, r, lane); continue; } r -= I_LU;
            p0_transpose_item(args.in[I_GUP] + (size_t)L * 128 * W, 128, W, GupT, scr, r, lane);
        }
        const float* pw = args.in[I_POOLW] + (size_t)L * 4 * 128 * 128; const float* ps = args.in[I_POOLS] + (size_t)L * W; const float* wb2 = w_br + (size_t)2 * W * D;
        bf16* WeT = ((bf16*)(ws + WS_WB)) + (size_t)2 * D * W;
        for (int idx = blockIdx.x * (NWAVES * 64) + tid; idx < W * D; idx += G * NWAVES * 64) {
            const int gc = idx / D, dout = idx % D, g = gc >> 7;
            const GAS float* pwr = (const GAS float*)pw + (size_t)gc * 128; float acc = 0.f;
            for (int dp = 0; dp < 128; ++dp) acc += pwr[dp] * ((const GAS float*)ps)[g * 128 + dp] * ((const GAS float*)wb2)[(size_t)(g * 128 + dp) * D + dout];
            ((GAS bf16*)WeT)[(size_t)dout * W + gc] = (bf16)f2bf(acc);
        }
        rms_rows(xsrc, args.in[I_N1G] + (size_t)L * D, ((bf16*)(ws + WS_H)), gw, NGW, lane);
        SEAM(PH_CONV);
    }
    if (IN(PH_GEMMA)) {
        unsigned char* ws = args.ws; asm volatile("" : "+s"(ws));
        pg8::Gemm g{((bf16*)(ws + WS_H)), ((bf16*)(ws + WS_WIN)), M, NA, D, D, D}; pg8::StaticOrder S; S.init(M, NA, G, (int)blockIdx.x);
        pg8::EpiA E{(bf16*)(ws + WS_RW), (bf16*)(ws + WS_AT), (bf16*)(ws + WS_PL), (bf16*)(ws + WS_SB), (bf16*)(ws + WS_HB)};
        pg8::gemm_phase<pg8::EpiA, pg8::StaticOrder, true, true>(lds + RING_OFF, g, S, E, tidL);
        if ((int)blockIdx.x >= G / 2) {
            int tg = tidL; asm volatile("" : "+v"(tg));
            for (int idx = (int)blockIdx.x - G / 2; idx < 128; idx += G - G / 2) {
                gate_cols_i8<16>(args.in[I_WIN] + (size_t)L * D * NIN, 16 * idx, (unsigned char*)(ws + WS_WIN) + (size_t)NA * D * 2, (float*)(ws + WS_SCL) + SC_SB + L * NG, lds, tg);
                gate_cols_i8<8>(args.in[I_WIN] + (size_t)L * D * NIN, 2048 + 8 * idx, (unsigned char*)(ws + WS_WIN) + (size_t)NA * D * 2, (float*)(ws + WS_SCL) + SC_SB + L * NG, lds, tg);
            }
        }
        SEAM(PH_GEMMA);
    }
    if (IN(PH_MIX1)) {
        unsigned char* ws = args.ws; asm volatile("" : "+s"(ws));
        h8_rows((const bf16*)(ws + WS_H), (unsigned char*)(ws + WS_H), (float*)(ws + WS_SCL) + SC_SA + L * M, gw, NGW, lane, 2 * D);
        ph_attn_prep(lds, (bf16*)(ws + WS_AT), (bf16*)(ws + WS_VT), args.in[I_QNG] + L * 64, args.in[I_KNG] + L * 64, (float*)(ws + WS_KM), G, tidL);
        ph_pool((bf16*)(ws + WS_PL), (const bf16*)(ws + WS_HB), G, tidL);
        __syncthreads();
        rw::S1Args A1; A1.RW = (bf16*)(ws + WS_RW); A1.SB = (const bf16*)(ws + WS_SB);
        A1.mu = args.in[I_MU] + L * NRW; A1.w0 = args.in[I_W0] + L * W; A1.a0 = args.in[I_A0] + L * W; A1.k_k = args.in[I_KK] + L * W; A1.k_a = args.in[I_KA] + L * W; A1.r_k = args.in[I_RK] + L * W;
        A1.WupT = (const bf16*)(ws + WS_LORA); A1.AupT = A1.WupT + 512 * 64; A1.GupT = A1.AupT + 512 * 64;
        A1.Gf = (bf16*)(ws + WS_GF); A1.Pst = (bf16*)(ws + WS_PST); A1.Qst = (bf16*)(ws + WS_QST); A1.bonus = (float*)(ws + WS_BON);
        A1.Rh = (bf16*)(ws + WS_RW); A1.O0 = (bf16*)(ws + WS_RW) + 512; A1.ldo = NRW; A1.Vm = (bf16*)(ws + WS_RW) + 1024; A1.ldv = NRW;
        int hprev = -1;
        const int w_ = (int)blockIdx.x, s1base = (G == 256) ? (((w_ >> 6) * 8 + (w_ & 7)) * 8 + ((w_ >> 3) & 7)) : w_, s1step = (G == 256) ? 32 * 8 : G;
        for (int unit = s1base; unit < NB * 128 * NH; unit += s1step) rw::s1_unit(lds, A1, unit, tidL, hprev);
        SEAM(PH_MIX1);
    }
    if (IN(PH_MIX2)) {
        unsigned char* ws = args.ws; asm volatile("" : "+s"(ws));
#define S3_PUBLISH(BH) do { asm volatile("s_waitcnt vmcnt(0)" ::: "memory"); __syncthreads(); \
            if (tid == 0) { __builtin_amdgcn_fence(__ATOMIC_RELEASE, "agent"); asm volatile("s_waitcnt vmcnt(0)" ::: "memory"); \
                __hip_atomic_store((unsigned*)(ws + WS_CTL) + CW_S3F + L * 64 + (BH), 1u, __ATOMIC_RELAXED, __HIP_MEMORY_SCOPE_AGENT); } } while (0)
        { moba::Args MA; MA.AT = (bf16*)(ws + WS_AT); MA.VT = (const bf16*)(ws + WS_VT); MA.KM = (const float*)(ws + WS_KM); MA.qg = args.in[I_QNG] + L * 64; MA.kg = args.in[I_KNG] + L * 64;
          if (G == 256) {
              const int xcd = blockIdx.x & 7, slot = blockIdx.x >> 3;
              if (slot < 4) {
                  if (tid < 8) *(volatile LAS int*)(lds + rw::S2_FLAGS + tid * 64) = 0;
                  __syncthreads();
                  if (wave < 4) rw::s2_chain(lds, (const bf16*)(ws + WS_PST), (const bf16*)(ws + WS_QST), slot * 8 + xcd, wave, lane);
                  else rw::s2_storer(lds, (bf16*)(ws + WS_SST), slot * 8 + xcd, wave - 4, lane);
                  S3_PUBLISH(slot * 8 + xcd);
              }
              volatile LAS int* qslot = (volatile LAS int*)(lds + LDSCTL_OFF + 64);
              for (int qx = 0; qx < 8; ++qx) {
                  if (qx > 0) {
                      __syncthreads();
                      if (tid < 64) { unsigned c_ = 128u; if (tid < 8) c_ = __hip_atomic_load((gu32*)(ws + WS_CTL) + CW_Q + (L * 8 + ((xcd + tid) & 7)) * 64, __ATOMIC_RELAXED, __HIP_MEMORY_SCOPE_AGENT);
                          const unsigned long long m_ = __ballot(tid >= qx && tid < 8 && c_ < 128u); if (tid == 0) *qslot = m_ ? (int)__ffsll((long long)m_) - 1 : 8; }
                      __syncthreads();
                      qx = *qslot; if (qx >= 8) break;
                  }
                  const int x = (xcd + qx) & 7;
                  gu32* qw = (gu32*)(ws + WS_CTL) + CW_Q + (L * 8 + x) * 64;
                  __syncthreads();
                  if (tid == 0) *qslot = (int)__hip_atomic_fetch_add(qw, 1u, RLX_AGENT);
                  __syncthreads();
                  for (;;) {
                      const int u = *qslot;
                      if (u >= 128) break;
                      const int j_ = u >> 5, pb_ = (x < 4 && j_ >= 2) ? 5 - j_ : j_, ph_ = (pb_ & 1) ? 7 - x : x;
                      int tq = tidL; asm volatile("" : "+v"(tq));
                      moba::unit(lds, MA, pb_, ph_, 31 - (u & 31), tq, false, qw, qslot);
                  }
              }
          } else {
              for (int bh = blockIdx.x; bh < NB * NH; bh += G) {
                  __syncthreads();
                  if (tid < 8) *(volatile LAS int*)(lds + rw::S2_FLAGS + tid * 64) = 0;
                  __syncthreads();
                  if (wave < 4) rw::s2_chain(lds, (const bf16*)(ws + WS_PST), (const bf16*)(ws + WS_QST), bh, wave, lane);
                  else rw::s2_storer(lds, (bf16*)(ws + WS_SST), bh, wave - 4, lane);
                  S3_PUBLISH(bh);
              }
              __syncthreads();
              for (int u = blockIdx.x; u < NB * NH * NBLK; u += G) { int tq = tidL; asm volatile("" : "+v"(tq)); moba::unit(lds, MA, u >> 8, (u >> 5) & 7, u & 31, tq); } } }
#undef S3_PUBLISH
        {
            if (tid < NB * NH) { unsigned sp_ = 0; while (__hip_atomic_load((unsigned*)(ws + WS_CTL) + CW_S3F + L * 64 + tid, __ATOMIC_RELAXED, __HIP_MEMORY_SCOPE_AGENT) == 0u && ++sp_ < (1u << 24)) __builtin_amdgcn_s_sleep(2); }
            if (tid < 64) { __builtin_amdgcn_fence(__ATOMIC_ACQUIRE, "agent"); asm volatile("s_waitcnt vmcnt(0)" ::: "memory"); }
            __syncthreads();
            rw::S3Args A3; A3.Rh = (const bf16*)(ws + WS_RW); A3.O0 = A3.Rh + 512; A3.ldo = NRW; A3.Vp = A3.Rh + 1024; A3.ldv = NRW; A3.Gf = (const bf16*)(ws + WS_GF); A3.Sst = (const bf16*)(ws + WS_SST);
            A3.bonus = (const float*)(ws + WS_BON); A3.lnx_g = args.in[I_LNG] + L * W; A3.lnx_b = args.in[I_LNB] + L * W; A3.Y = (bf16*)(ws + WS_RW); A3.ldy = NRW;
            gu32* s3q = (gu32*)(ws + WS_CTL) + CW_S3Q + L * 64;
            int cur = 0; if (lane == 0) cur = (int)__hip_atomic_fetch_add(s3q, 1u, RLX_AGENT);
            cur = __builtin_amdgcn_readfirstlane(cur);
            while (cur < NB * 128 * NH) {
                int nxt = 0;
                if (lane == 0) asm volatile("global_atomic_add %0, %1, %2, %3 sc0" : "=v"(nxt) : "v"(0), "v"(1), "s"(s3q) : "memory");
                rw::s3_unit(A3, cur, lane);
                asm volatile("s_waitcnt vmcnt(0)" : "+v"(nxt) :: "memory");
                cur = __builtin_amdgcn_readfirstlane(nxt);
            }
        }
        SEAM(PH_MIX2);
    }
    if (IN(PH_GB)) {
        unsigned char* ws = args.ws; asm volatile("" : "+s"(ws));
        bf16* GBp = (bf16*)(ws + WS_GB); bf16* MBp = (bf16*)(ws + WS_MB);
        pg8::StaticOrder S; S.init(M, D, G, (int)blockIdx.x);
#pragma unroll
        for (int b = 0; b < 3; ++b) {
            { int tv = tidL; asm volatile("" : "+v"(tv));
              pg8::Gemm g{(const bf16*)(ws + WS_H), (const bf16*)((unsigned char*)(ws + WS_WIN) + (size_t)NA * D * 2 + (size_t)b * D * D), M, D, D / 2, D, D / 2};
              pg8::EpiGate8 E{GBp, (const float*)(ws + WS_SCL) + SC_SA + L * M, (const float*)(ws + WS_SCL) + SC_SB + L * NG + b * D};
              pg8::gemm_phase<pg8::EpiGate8, pg8::StaticOrder, true, true, true>(lds + RING_OFF, g, S, E, tv); }
            __syncthreads();
            { int tv = tidL; asm volatile("" : "+v"(tv)); const bf16* Ysrc = (b == 0) ? (const bf16*)(ws + WS_RW) : (b == 1 ? (const bf16*)(ws + WS_AT) : (const bf16*)(ws + WS_PL));
              pg8::Gemm g{Ysrc, ((bf16*)(ws + WS_WB)) + (size_t)b * D * W, M, D, W, (b == 0) ? NRW : (b == 1 ? NAT : NPL), W};
              if (b == 0) { pg8::EpiBr<true> E{GBp, MBp}; pg8::gemm_phase<pg8::EpiBr<true>, pg8::StaticOrder, true, true>(lds + RING_OFF, g, S, E, tv); }
              else { pg8::EpiBr<false> E{GBp, MBp}; pg8::gemm_phase<pg8::EpiBr<false>, pg8::StaticOrder, true, true>(lds + RING_OFF, g, S, E, tv); } }
            __syncthreads();
        }
        SEAM(PH_GB);
    }
    if (IN(PH_GO)) {
        unsigned char* ws = args.ws; asm volatile("" : "+s"(ws));
        pg8::Gemm g{(const bf16*)(ws + WS_MB), ((bf16*)(ws + WS_WO)), M, D, D, D, D}; pg8::StaticOrder S; S.init(M, D, G, (int)blockIdx.x);
        pg8::EpiRes<true> E{xsrc, args.out, (bf16*)(ws + WS_H), (float*)(ws + WS_CTL) + CW_SSQ + L * 2 * M};
        pg8::gemm_phase<pg8::EpiRes<true>, pg8::StaticOrder, true, true>(lds + RING_OFF, g, S, E, tidL);
        SEAM(PH_GO);
    }
        unsigned char* ws = args.ws; asm volatile("" : "+s"(ws));
    if (IN(PH_FF1)) {
        unsigned char* ws = args.ws; asm volatile("" : "+s"(ws));
        pg8::Gemm g{((bf16*)(ws + WS_H)), ((bf16*)(ws + WS_W1)), M, FF, D, D, D}; pg8::StaticOrder S; S.init(M, FF, G, (int)blockIdx.x);
        pg8::EpiAct<2, true> E{(bf16*)(ws + WS_HID), FF, (const float*)(ws + WS_CTL) + CW_SSQ + L * 2 * M};
        pg8::gemm_phase<pg8::EpiAct<2, true>, pg8::StaticOrder, true, true>(lds + RING_OFF, g, S, E, tidL);
        SEAM(PH_FF1);
    }
    if (IN(PH_FF2)) {
        unsigned char* ws = args.ws; asm volatile("" : "+s"(ws));
        pg8::Gemm g{(const bf16*)(ws + WS_HID), ((bf16*)(ws + WS_W2)), M, D, FF, FF, FF}; pg8::StaticOrder S; S.init(M, D, G, (int)blockIdx.x);
        pg8::EpiRes<false> E{args.out, args.out, nullptr, nullptr};
        pg8::gemm_phase<pg8::EpiRes<false>, pg8::StaticOrder, true, true>(lds + RING_OFF, g, S, E, tidL);
        SEAM(PH_FF2);
    }
    }
#undef IN
#undef SEAM
}

#ifndef MK_MULTI
#define MK_MULTI 0
#endif
#ifndef PROBE_UPTO
#define PROBE_UPTO (-1)
#endif
#ifndef PROBE_DUP
#define PROBE_DUP (-1)
#endif
extern "C" void kernel_launch(void* const* d_in, const int* in_sizes, int n_in, void* d_out, int out_size, void* d_ws, size_t ws_size, hipStream_t stream) {
    static int grid = 0;
    if (grid == 0) {
        if (n_in != 23 || in_sizes[0] != M * D || out_size != M * D || ws_size < WS_END) { fprintf(stderr, "kernel_launch: unexpected shapes (n_in %d, in0 %d, out %d, ws %zu)\n", n_in, n_in > 0 ? in_sizes[0] : -1, out_size, ws_size); grid = -1; return; }
        int dev = 0, cus = 0;
        if (hipGetDevice(&dev) != hipSuccess || hipDeviceGetAttribute(&cus, hipDeviceAttributeMultiprocessorCount, dev) != hipSuccess) { grid = -1; return; }
        if (hipFuncSetAttribute((const void*)mk_fwd, hipFuncAttributeMaxDynamicSharedMemorySize, LDS_BYTES) != hipSuccess) { fprintf(stderr, "kernel_launch: hipFuncSetAttribute failed\n"); grid = -1; return; }
        int per_cu = 0;
        if (hipOccupancyMaxActiveBlocksPerMultiprocessor(&per_cu, (const void*)mk_fwd, NWAVES * 64, LDS_BYTES) != hipSuccess || per_cu < 1) fprintf(stderr, "kernel_launch: occupancy query reports %d\n", per_cu);
        (void)hipGetLastError();
        grid = cus;
    }
    if (grid < 0) return;
    unsigned char* ws = (unsigned char*)d_ws;
    (void)hipMemsetAsync(ws + WS_CTL, 0, CTL_ZERO_BYTES, stream);
    Args a{};
    for (int i = 0; i < 23; ++i) a.in[i] = (const float*)d_in[i];
    a.out = (float*)d_out; a.ws = ws;
#if MK_MULTI
    for (int L = 0; L < 2; ++L) for (int p = 0; p < PH_N; ++p) { a.ph_lo = p; a.ph_hi = p + 1; a.l_lo = L; a.l_hi = L + 1; a.fused = 0; a.probe_upto = -1; a.probe_dup = -1; hipLaunchKernelGGL(mk_fwd, dim3(grid), dim3(NWAVES * 64), LDS_BYTES, stream, a); }
#else
    a.ph_lo = 0; a.ph_hi = PH_N; a.l_lo = 0; a.l_hi = 2; a.fused = 1; a.probe_upto = PROBE_UPTO; a.probe_dup = PROBE_DUP;
    hipLaunchKernelGGL(mk_fwd, dim3(grid), dim3(NWAVES * 64), LDS_BYTES, stream, a);
#endif
}
```
